# Optimizing an MI355X kernel written in HIP

```python
import math
import jax, jax.numpy as jnp
from jax import lax
import numpy as np

D_MODEL = 2048
BATCH = 16
SEQ = 2048
DEPTH = 4

N_MIXERS = 3
HEAD_DIM = 128
GRID_W = 64
ROPE_THETA = 10000.0
Q_BLOCK = 128
D_FF = ((8 * D_MODEL // 3 + 255) // 256) * 256
ALPHA = (2 * DEPTH) ** 0.25
BETA = (8 * DEPTH) ** -0.25
LN_EPS = 1e-5
RMS_EPS = 1e-6
NEG_INF = -1e30
A_HEADS = D_MODEL // HEAD_DIM
A_KV_HEADS = A_HEADS // 4
A_GROUP = A_HEADS // A_KV_HEADS
DILATED_PATTERNS = ((128, 1), (512, 4), (2048, 16))
B_GROUPS = len(DILATED_PATTERNS)
B_HEADS = D_MODEL // (2 * HEAD_DIM)
C_HEADS = D_MODEL // HEAD_DIM
C_Q_LORA = 3 * D_MODEL // 8
C_KV_LORA = D_MODEL // 4
C_NOPE = HEAD_DIM
C_ROPE = HEAD_DIM // 2
C_V = HEAD_DIM

kernel_name = "hybrid_interleaved_macaron_deepnorm_encoder"


def layer_norm(x, g, b):
    xf = x.astype(jnp.float32)
    mu = jnp.mean(xf, axis=-1, keepdims=True)
    var = jnp.mean(jnp.square(xf - mu), axis=-1, keepdims=True)
    return ((xf - mu) * lax.rsqrt(var + LN_EPS)).astype(x.dtype) * g + b


def rms_norm(x, g):
    xf = x.astype(jnp.float32)
    y = xf * lax.rsqrt(jnp.mean(jnp.square(xf), axis=-1, keepdims=True) + RMS_EPS)
    return y.astype(x.dtype) * g


def swiglu(x, w_in, w_out):
    gate, up = jnp.split(x @ w_in, 2, axis=-1)
    return (jax.nn.silu(gate) * up) @ w_out


def rope_cos_sin(pos, dim):
    inv = ROPE_THETA ** (-jnp.arange(0, dim, 2, dtype=jnp.float32) / dim)
    ang = pos.astype(jnp.float32)[:, None] * inv[None, :]
    return jnp.cos(ang), jnp.sin(ang)


def apply_rope(x, cos, sin):
    c = cos[None, :, None, :].astype(x.dtype)
    s = sin[None, :, None, :].astype(x.dtype)
    x1, x2 = jnp.split(x, 2, axis=-1)
    return jnp.concatenate([x1 * c - x2 * s, x1 * s + x2 * c], axis=-1)


def apply_axial_rope(x, row_cs, col_cs):
    xr, xc = jnp.split(x, 2, axis=-1)
    return jnp.concatenate([apply_rope(xr, *row_cs), apply_rope(xc, *col_cs)], axis=-1)


def block_attention(q, k, v, scale):
    bsz, seq, kh, grp, dk = q.shape
    nb = seq // Q_BLOCK
    qb = q.reshape(bsz, nb, Q_BLOCK, kh, grp, dk).transpose(1, 0, 2, 3, 4, 5)

    def one_block(q_blk):
        s = jnp.einsum('bqhgd,bkhd->bhgqk', q_blk, k).astype(jnp.float32) * scale
        p = jax.nn.softmax(s, axis=-1).astype(v.dtype)
        return jnp.einsum('bhgqk,bkhd->bqhgd', p, v)

    o = lax.map(one_block, qb)
    return o.transpose(1, 0, 2, 3, 4, 5).reshape(bsz, seq, kh * grp, v.shape[-1])


def dilated_window_attention(q, k, v, dilation, half):
    bsz, seq, nh, dh = q.shape
    L = seq // dilation
    n = bsz * dilation

    def to_residue(t):
        return t.reshape(bsz, L, dilation, nh, dh).transpose(0, 2, 1, 3, 4).reshape(n, L, nh, dh)

    qr, kr, vr = to_residue(q), to_residue(k), to_residue(v)
    nb = -(-L // Q_BLOCK)
    Lp = nb * Q_BLOCK
    kb_len = Q_BLOCK + 2 * half
    qr = jnp.pad(qr, ((0, 0), (0, Lp - L), (0, 0), (0, 0)))
    kv_pad = ((0, 0), (half, half + Lp - L), (0, 0), (0, 0))
    kr, vr = jnp.pad(kr, kv_pad), jnp.pad(vr, kv_pad)
    idx = (jnp.arange(nb) * Q_BLOCK)[:, None] + jnp.arange(kb_len)[None, :]
    kb, vb = kr[:, idx], vr[:, idx]
    qb = qr.reshape(n, nb, Q_BLOCK, nh, dh)
    s = jnp.einsum('nbqhd,nbkhd->nbhqk', qb, kb).astype(jnp.float32) * (dh ** -0.5)
    rel = jnp.arange(kb_len)[None, :] - half - jnp.arange(Q_BLOCK)[:, None]
    key_pos = idx - half
    valid = (jnp.abs(rel) <= half)[None] & ((key_pos >= 0) & (key_pos < L))[:, None, :]
    s = jnp.where(valid[None, :, None], s, NEG_INF)
    m = jnp.max(s, axis=-1, keepdims=True)
    p = jnp.exp(s - m)
    den = jnp.sum(p, axis=-1, keepdims=True)
    o = jnp.einsum('nbhqk,nbkhd->nbqhd', (p / den).astype(v.dtype), vb)
    lse = (m + jnp.log(den))[..., 0]
    o = o.reshape(n, Lp, nh, dh)[:, :L]
    o = o.reshape(bsz, dilation, L, nh, dh).transpose(0, 2, 1, 3, 4).reshape(bsz, seq, nh, dh)
    lse = lse.transpose(0, 1, 3, 2).reshape(n, Lp, nh)[:, :L]
    lse = lse.reshape(bsz, dilation, L, nh).transpose(0, 2, 1, 3).reshape(bsz, seq, nh)
    return o, lse


def mixer_a(h, w_in, q_gain, k_gain, w_out):
    bsz, seq, _ = h.shape
    rows = seq // GRID_W
    row = jnp.repeat(jnp.arange(rows), GRID_W)
    col = jnp.tile(jnp.arange(GRID_W), rows)
    row_cs = rope_cos_sin(row, HEAD_DIM // 2)
    col_cs = rope_cos_sin(col, HEAD_DIM // 2)
    qkv = h @ w_in
    q, k, v = jnp.split(qkv, [A_HEADS * HEAD_DIM, (A_HEADS + A_KV_HEADS) * HEAD_DIM], axis=-1)
    q = rms_norm(q.reshape(bsz, seq, A_HEADS, HEAD_DIM), q_gain)
    k = rms_norm(k.reshape(bsz, seq, A_KV_HEADS, HEAD_DIM), k_gain)
    v = v.reshape(bsz, seq, A_KV_HEADS, HEAD_DIM)
    q = apply_axial_rope(q, row_cs, col_cs).reshape(bsz, seq, A_KV_HEADS, A_GROUP, HEAD_DIM)
    k = apply_axial_rope(k, row_cs, col_cs)
    o = block_attention(q, k, v, HEAD_DIM ** -0.5)
    return o.reshape(bsz, seq, A_HEADS * HEAD_DIM) @ w_out


def mixer_b(h, w_in, w_out):
    bsz, seq, _ = h.shape
    cos, sin = rope_cos_sin(jnp.arange(seq), HEAD_DIM)
    qkv = (h @ w_in).reshape(bsz, seq, B_GROUPS, 3, B_HEADS, HEAD_DIM)
    outs, lses = [], []
    for g, (window, dilation) in enumerate(DILATED_PATTERNS):
        q = apply_rope(qkv[:, :, g, 0], cos, sin)
        k = apply_rope(qkv[:, :, g, 1], cos, sin)
        o, lse = dilated_window_attention(q, k, qkv[:, :, g, 2], dilation, window // (2 * dilation))
        outs.append(o)
        lses.append(lse)
    wts = jax.nn.softmax(jnp.stack(lses, axis=0), axis=0)
    o = jnp.sum(wts[..., None].astype(h.dtype) * jnp.stack(outs, axis=0), axis=0)
    return o.reshape(bsz, seq, B_HEADS * HEAD_DIM) @ w_out


def mixer_c(h, w_in, q_gain, kv_gain, w_q_up, w_kv_up, w_out):
    bsz, seq, _ = h.shape
    cos, sin = rope_cos_sin(jnp.arange(seq), C_ROPE)
    cq, ckv, k_rope = jnp.split(h @ w_in, [C_Q_LORA, C_Q_LORA + C_KV_LORA], axis=-1)
    q = (rms_norm(cq, q_gain) @ w_q_up).reshape(bsz, seq, C_HEADS, C_NOPE + C_ROPE)
    kv = (rms_norm(ckv, kv_gain) @ w_kv_up).reshape(bsz, seq, C_HEADS, C_NOPE + C_V)
    q_nope, q_rope = jnp.split(q, [C_NOPE], axis=-1)
    k_nope, v = jnp.split(kv, [C_NOPE], axis=-1)
    q_rope = apply_rope(q_rope, cos, sin)
    k_rope = apply_rope(k_rope[:, :, None, :], cos, sin)
    q = jnp.concatenate([q_nope, q_rope], axis=-1)[:, :, :, None, :]
    k = jnp.concatenate([k_nope, jnp.broadcast_to(k_rope, (bsz, seq, C_HEADS, C_ROPE))], axis=-1)
    o = block_attention(q, k, v, (C_NOPE + C_ROPE) ** -0.5)
    return o.reshape(bsz, seq, C_HEADS * C_V) @ w_out


def setup_inputs(seed: int = 0) -> dict:
    key = jax.random.key(seed)
    keys = iter(jax.random.split(key, 1 + 16 * DEPTH))
    f32 = jnp.float32

    def w(shape, fan_in, scale=1.0):
        return jax.random.normal(next(keys), shape, f32) * (fan_in ** -0.5 * scale)

    def gain(n):
        return 1.0 + 0.02 * jax.random.normal(next(keys), (n,), f32)

    def bias(n):
        return 0.02 * jax.random.normal(next(keys), (n,), f32)

    p = {"x": jax.random.normal(next(keys), (BATCH, SEQ, D_MODEL), f32)}
    for i in range(DEPTH):
        p[f"ffn1_w_in_{i}"] = w((D_MODEL, 2 * D_FF), D_MODEL)
        p[f"ffn1_w_out_{i}"] = w((D_FF, D_MODEL), D_FF, BETA)
        p[f"ln1_g_{i}"] = gain(D_MODEL)
        p[f"ln1_b_{i}"] = bias(D_MODEL)
        kind = i % N_MIXERS
        if kind == 0:
            p[f"a_w_in_{i}"] = w((D_MODEL, (A_HEADS + 2 * A_KV_HEADS) * HEAD_DIM), D_MODEL)
            p[f"a_q_gain_{i}"] = gain(HEAD_DIM)
            p[f"a_k_gain_{i}"] = gain(HEAD_DIM)
            p[f"a_w_out_{i}"] = w((A_HEADS * HEAD_DIM, D_MODEL), A_HEADS * HEAD_DIM, BETA)
        elif kind == 1:
            p[f"b_w_in_{i}"] = w((D_MODEL, B_GROUPS * 3 * B_HEADS * HEAD_DIM), D_MODEL)
            p[f"b_w_out_{i}"] = w((B_HEADS * HEAD_DIM, D_MODEL), B_HEADS * HEAD_DIM, BETA)
        else:
            p[f"c_w_in_{i}"] = w((D_MODEL, C_Q_LORA + C_KV_LORA + C_ROPE), D_MODEL)
            p[f"c_q_gain_{i}"] = gain(C_Q_LORA)
            p[f"c_kv_gain_{i}"] = gain(C_KV_LORA)
            p[f"c_w_q_up_{i}"] = w((C_Q_LORA, C_HEADS * (C_NOPE + C_ROPE)), C_Q_LORA)
            p[f"c_w_kv_up_{i}"] = w((C_KV_LORA, C_HEADS * (C_NOPE + C_V)), C_KV_LORA)
            p[f"c_w_out_{i}"] = w((C_HEADS * C_V, D_MODEL), C_HEADS * C_V, BETA)
        p[f"ln2_g_{i}"] = gain(D_MODEL)
        p[f"ln2_b_{i}"] = bias(D_MODEL)
        p[f"ffn2_w_in_{i}"] = w((D_MODEL, 2 * D_FF), D_MODEL)
        p[f"ffn2_w_out_{i}"] = w((D_FF, D_MODEL), D_FF, BETA)
        p[f"ln3_g_{i}"] = gain(D_MODEL)
        p[f"ln3_b_{i}"] = bias(D_MODEL)
    return p


def reference(x,
              ffn1_w_in_0, ffn1_w_out_0, ln1_g_0, ln1_b_0,
              a_w_in_0, a_q_gain_0, a_k_gain_0, a_w_out_0,
              ln2_g_0, ln2_b_0, ffn2_w_in_0, ffn2_w_out_0, ln3_g_0, ln3_b_0,
              ffn1_w_in_1, ffn1_w_out_1, ln1_g_1, ln1_b_1,
              b_w_in_1, b_w_out_1,
              ln2_g_1, ln2_b_1, ffn2_w_in_1, ffn2_w_out_1, ln3_g_1, ln3_b_1,
              ffn1_w_in_2, ffn1_w_out_2, ln1_g_2, ln1_b_2,
              c_w_in_2, c_q_gain_2, c_kv_gain_2, c_w_q_up_2, c_w_kv_up_2, c_w_out_2,
              ln2_g_2, ln2_b_2, ffn2_w_in_2, ffn2_w_out_2, ln3_g_2, ln3_b_2,
              ffn1_w_in_3, ffn1_w_out_3, ln1_g_3, ln1_b_3,
              a_w_in_3, a_q_gain_3, a_k_gain_3, a_w_out_3,
              ln2_g_3, ln2_b_3, ffn2_w_in_3, ffn2_w_out_3, ln3_g_3, ln3_b_3):
    mixers = (mixer_a, mixer_b, mixer_c)
    ffn1 = [(ffn1_w_in_0, ffn1_w_out_0), (ffn1_w_in_1, ffn1_w_out_1),
            (ffn1_w_in_2, ffn1_w_out_2), (ffn1_w_in_3, ffn1_w_out_3)]
    ffn2 = [(ffn2_w_in_0, ffn2_w_out_0), (ffn2_w_in_1, ffn2_w_out_1),
            (ffn2_w_in_2, ffn2_w_out_2), (ffn2_w_in_3, ffn2_w_out_3)]
    ln1 = [(ln1_g_0, ln1_b_0), (ln1_g_1, ln1_b_1), (ln1_g_2, ln1_b_2), (ln1_g_3, ln1_b_3)]
    ln2 = [(ln2_g_0, ln2_b_0), (ln2_g_1, ln2_b_1), (ln2_g_2, ln2_b_2), (ln2_g_3, ln2_b_3)]
    ln3 = [(ln3_g_0, ln3_b_0), (ln3_g_1, ln3_b_1), (ln3_g_2, ln3_b_2), (ln3_g_3, ln3_b_3)]
    mix_params = [(a_w_in_0, a_q_gain_0, a_k_gain_0, a_w_out_0),
                  (b_w_in_1, b_w_out_1),
                  (c_w_in_2, c_q_gain_2, c_kv_gain_2, c_w_q_up_2, c_w_kv_up_2, c_w_out_2),
                  (a_w_in_3, a_q_gain_3, a_k_gain_3, a_w_out_3)]
    h = x
    for i in range(DEPTH):
        h = layer_norm(ALPHA * h + 0.5 * swiglu(h, *ffn1[i]), *ln1[i])
        h = layer_norm(ALPHA * h + mixers[i % N_MIXERS](h, *mix_params[i]), *ln2[i])
        h = layer_norm(ALPHA * h + 0.5 * swiglu(h, *ffn2[i]), *ln3[i])
    return h
```

```cpp
#include <hip/hip_runtime.h>
#include <cstdio>
#include <cstdint>

#ifndef MK_PER_PHASE
#define MK_PER_PHASE 1
#endif

namespace pg8 {
#define PG8_LAS __attribute__((address_space(3)))
typedef unsigned short bf16_t;
typedef short bf16x8 __attribute__((ext_vector_type(8)));
typedef float f32x4 __attribute__((ext_vector_type(4)));
typedef unsigned u32x4 __attribute__((ext_vector_type(4)));
constexpr int BM = 256, BK = 64, HALF = 128, HTB = HALF * BK * 2  , STAGE_BYTES = 8 * HTB, NXCD = 8, WGM = 8;

__host__ __device__ __forceinline__ int lds_byte(int r, int c) { const int st = (r >> 4) * 2 + (c >> 5), rr = r & 15, cc = c & 31, ob = rr * 64 + cc * 2; return st * 1024 + (ob ^ (((ob >> 9) & 1) << 5)); }
__host__ __device__ __forceinline__ void stage_rc(int b, int& R, int& C) { const int st = b / 1024, sb = b % 1024, swz = sb ^ (((sb >> 9) & 1) << 5); R = (st >> 1) * 16 + swz / 64; C = (st & 1) * 32 + (swz % 64) / 2; }
__host__ __device__ __forceinline__ int perm32(int rho) { const int n = rho >> 4, i = rho & 15; return 8 * (i >> 2) + 4 * n + (i & 3); }

struct Unit { int pm, pn; };
struct Gemm { const bf16_t* A; const bf16_t* Bt; int M, N, K; };

struct StaticOrder {
    int nM, nN, nwg, G, c;
    __host__ __device__ void init(int M, int N, int G_, int c_) { nM = M / BM; nN = N / BM; nwg = nM * nN; G = G_; c = c_; }
    __host__ __device__ bool next(int i, Unit& u) const {
        const long L = (long)i * G + c; if (L >= nwg) return false;
        int wgid = (int)L; { const int q = nwg / NXCD, r = nwg % NXCD, xcd = wgid % NXCD, off = wgid / NXCD; wgid = (xcd < r ? xcd * (q + 1) : r * (q + 1) + (xcd - r) * q) + off; }
        const int nig = WGM * nN, gid = wgid / nig, fm = gid * WGM, gsz = (nM - fm) < WGM ? (nM - fm) : WGM;
        u.pm = fm + ((wgid % nig) % gsz); u.pn = (wgid % nig) / gsz; return true;
    }
    __device__ __forceinline__ void a_ready(const Unit&) const {}
    __device__ __forceinline__ void done(const Unit&) const {}
};

__device__ __forceinline__ unsigned cvt_pk_bf16(float lo, float hi) { unsigned r; asm volatile("v_cvt_pk_bf16_f32 %0, %1, %2" : "=v"(r) : "v"(lo), "v"(hi)); return r; }

struct EpiBf16 {
    static constexpr bool PERM = true, AFTER_DRAIN = false;
    bf16_t* O; int ldc;
    __device__ __forceinline__ void operator()(const f32x4 (&acc)[2][2][4][2], const Unit& u, int wr, int wc, int fr, int fq) const {
        const int row0 = u.pm * BM + wr * 64 + fr; const int col0 = u.pn * BM + wc * 32 + 8 * fq;
#pragma unroll
        for (int ai = 0; ai < 2; ++ai)
#pragma unroll
            for (int m = 0; m < 4; ++m) { bf16_t* rowp = O + (size_t)(row0 + ai * HALF + m * 16) * ldc + col0;
#pragma unroll
                for (int bj = 0; bj < 2; ++bj) { const f32x4 v0 = acc[ai][bj][m][0], v1 = acc[ai][bj][m][1];
                    u32x4 w; w.x = cvt_pk_bf16(v0[0], v0[1]); w.y = cvt_pk_bf16(v0[2], v0[3]); w.z = cvt_pk_bf16(v1[0], v1[1]); w.w = cvt_pk_bf16(v1[2], v1[3]);
                    *(u32x4*)(rowp + bj * HALF) = w; } }
    }
};
__device__ __forceinline__ float silu_mul(float g, float u) { return g * u * __builtin_amdgcn_rcpf(1.0f + __builtin_amdgcn_exp2f(-1.4426950408889634f * g)); }
struct EpiSwiGLU {
    static constexpr bool PERM = true, AFTER_DRAIN = false;
    bf16_t* O; int ldc;
    __device__ __forceinline__ void operator()(const f32x4 (&acc)[2][2][4][2], const Unit& u, int wr, int wc, int fr, int fq) const {
        const int row0 = u.pm * BM + wr * 64 + fr; const int col0 = u.pn * HALF + wc * 32 + 8 * fq;
#pragma unroll
        for (int ai = 0; ai < 2; ++ai)
#pragma unroll
            for (int m = 0; m < 4; ++m) { bf16_t* rowp = O + (size_t)(row0 + ai * HALF + m * 16) * ldc + col0;
                const f32x4 g0 = acc[ai][0][m][0], g1 = acc[ai][0][m][1], u0 = acc[ai][1][m][0], u1 = acc[ai][1][m][1];
                u32x4 w; w.x = cvt_pk_bf16(silu_mul(g0[0], u0[0]), silu_mul(g0[1], u0[1])); w.y = cvt_pk_bf16(silu_mul(g0[2], u0[2]), silu_mul(g0[3], u0[3]));
                w.z = cvt_pk_bf16(silu_mul(g1[0], u1[0]), silu_mul(g1[1], u1[1])); w.w = cvt_pk_bf16(silu_mul(g1[2], u1[2]), silu_mul(g1[3], u1[3]));
                *(u32x4*)rowp = w; }
    }
};
struct EpiResid {
    static constexpr bool PERM = false, AFTER_DRAIN = false;
    const float* hin; float* hout; int ldc; float alpha, s;
    __device__ __forceinline__ void operator()(const f32x4 (&acc)[2][2][4][2], const Unit& u, int wr, int wc, int fr, int fq) const {
        const int row0 = u.pm * BM + wr * 64 + fr, col0 = u.pn * BM + wc * 32 + 4 * fq;
#pragma unroll
        for (int ai = 0; ai < 2; ++ai)
#pragma unroll
            for (int m = 0; m < 4; ++m) { const size_t off = (size_t)(row0 + ai * HALF + m * 16) * ldc + col0;
#pragma unroll
                for (int bj = 0; bj < 2; ++bj)
#pragma unroll
                    for (int n = 0; n < 2; ++n) { const f32x4 hv = *(const f32x4*)(hin + off + bj * HALF + n * 16); *(f32x4*)(hout + off + bj * HALF + n * 16) = hv * alpha + acc[ai][bj][m][n] * s; } }
    }
};

template <class Epi, class Sched, bool ALIGN_EPI = false, bool SP2 = false>
__device__ __forceinline__ void gemm_phase(PG8_LAS unsigned char* lds, const Gemm g, const Sched& S, const Epi& E) {
    int tid_ = threadIdx.x; asm volatile("" : "+v"(tid_));
    const int tid = tid_, wid = __builtin_amdgcn_readfirstlane(tid >> 6), lane = tid & 63, wr = wid >> 2, wc = wid & 3, fr = lane & 15, fq = lane >> 4;
    const int K = g.K, nt = K / BK;
    unsigned voffA[2], voffB[2];
#pragma unroll
    for (int i = 0; i < 2; ++i) { int R, C; stage_rc(tid * 16 + i * 8192, R, C); const int Rb = Epi::PERM ? ((R & ~31) + perm32(R & 31)) : R;
        voffA[i] = (unsigned)(R * K + C) * 2u; voffB[i] = (unsigned)(Rb * K + C) * 2u; }
    const size_t kstep = (size_t)(BK * 2);
    const size_t hstep = (size_t)HALF * K * 2;
    const size_t tstep = 2 * hstep;
    const unsigned ldsw = (unsigned)wid * 1024u;
    const int aoff = lds_byte(wr * 64 + fr, fq * 8), boff = lds_byte(wc * 32 + fr, fq * 8);
#define PG8_SA(b, h) (((b) * 2 + (h)) * HTB)
#define PG8_SB(b, h) ((4 + (b) * 2 + (h)) * HTB)
#define PG8_STAGE(bufoff, gbase, voff) do { _Pragma("unroll") for (int _i = 0; _i < 2; ++_i) \
        __builtin_amdgcn_global_load_lds((const unsigned*)((const char*)(gbase) + (voff)[_i]), (PG8_LAS unsigned*)(lds + (bufoff) + ldsw + _i * 8192), 16, 0, 0); } while (0)
#define PG8_LDA(dst, b, h) do { _Pragma("unroll") for (int m = 0; m < 4; ++m) _Pragma("unroll") for (int k = 0; k < 2; ++k) dst[m][k] = *(const PG8_LAS bf16x8*)(lds + PG8_SA(b, h) + aoff + m * 2048 + k * 1024); } while (0)
#define PG8_LDB(dst, b, h) do { _Pragma("unroll") for (int n = 0; n < 2; ++n) _Pragma("unroll") for (int k = 0; k < 2; ++k) dst[n][k] = *(const PG8_LAS bf16x8*)(lds + PG8_SB(b, h) + boff + n * 2048 + k * 1024); } while (0)
#define PG8_MMA(ai, bj, At, Bt) do { __builtin_amdgcn_s_setprio(1); _Pragma("unroll") for (int m = 0; m < 4; ++m) _Pragma("unroll") for (int n = 0; n < 2; ++n) _Pragma("unroll") for (int k = 0; k < 2; ++k) \
        acc[ai][bj][m][n] = __builtin_amdgcn_mfma_f32_16x16x32_bf16(Bt[n][k], At[m][k], acc[ai][bj][m][n], 0, 0, 0); __builtin_amdgcn_s_setprio(0); } while (0)
#define PG8_WAIT_V(n) asm volatile("s_waitcnt vmcnt(" #n ")" ::: "memory")
#define PG8_WAIT_L(n) asm volatile("s_waitcnt lgkmcnt(" #n ")" ::: "memory")
#define PG8_BAR __builtin_amdgcn_s_barrier()
#define PG8_SCHED __builtin_amdgcn_sched_barrier(0)
    Unit cur, nxt; int ui = 0;
    if (!S.next(0, cur)) return;
    f32x4 acc[2][2][4][2];
#pragma unroll
    for (int a = 0; a < 2; ++a)
#pragma unroll
        for (int b = 0; b < 2; ++b)
#pragma unroll
            for (int m = 0; m < 4; ++m)
#pragma unroll
                for (int n = 0; n < 2; ++n) acc[a][b][m][n] = (f32x4){0.f, 0.f, 0.f, 0.f};
    bf16x8 At[4][2], B0[2][2], B1[2][2];
    const char* cA = (const char*)g.A + (size_t)cur.pm * tstep; const char* cB = (const char*)g.Bt + (size_t)cur.pn * tstep;
    S.a_ready(cur);
    if constexpr (SP2) {
        PG8_STAGE(PG8_SB(0, 0), cB, voffB); PG8_STAGE(PG8_SB(0, 1), cB + hstep, voffB); PG8_STAGE(PG8_SA(0, 0), cA, voffA); PG8_STAGE(PG8_SA(0, 1), cA + hstep, voffA);
        if (wr == 1) PG8_BAR;
        PG8_WAIT_V(2); PG8_BAR;
        PG8_STAGE(PG8_SB(1, 0), cB + kstep, voffB); PG8_STAGE(PG8_SA(1, 0), cA + kstep, voffA); PG8_STAGE(PG8_SB(1, 1), cB + hstep + kstep, voffB);
        PG8_WAIT_V(6); PG8_BAR;
    } else {
        PG8_STAGE(PG8_SB(0, 0), cB, voffB); PG8_STAGE(PG8_SA(0, 0), cA, voffA); PG8_STAGE(PG8_SB(0, 1), cB + hstep, voffB); PG8_STAGE(PG8_SA(0, 1), cA + hstep, voffA);
        if (wr == 1) PG8_BAR;
        PG8_WAIT_V(4); PG8_BAR;
        PG8_STAGE(PG8_SB(1, 0), cB + kstep, voffB); PG8_STAGE(PG8_SA(1, 0), cA + kstep, voffA); PG8_STAGE(PG8_SB(1, 1), cB + hstep + kstep, voffB);
        PG8_WAIT_V(6); PG8_BAR;
    }
    for (;;) {
        const bool has_next = S.next(ui + 1, nxt);
        const char* nA = has_next ? (const char*)g.A + (size_t)nxt.pm * tstep : cA; const char* nB = has_next ? (const char*)g.Bt + (size_t)nxt.pn * tstep : cB;
        for (int t = 0; t < nt; t += 2) {
            const bool last = (t == nt - 2);
            const char* a1 = cA + (size_t)(t + 1) * kstep;
            const char* a2 = last ? nA : cA + (size_t)(t + 2) * kstep; const char* b2 = last ? nB : cB + (size_t)(t + 2) * kstep;
            const char* a3 = a2 + kstep; const char* b3 = b2 + kstep;
            if (last && has_next) S.a_ready(nxt);
            if constexpr (SP2) {
            PG8_LDB(B0, 0, 0); PG8_LDB(B1, 0, 1); PG8_SCHED; PG8_LDA(At, 0, 0); PG8_STAGE(PG8_SA(1, 1), a1 + hstep, voffA);
            PG8_WAIT_V(8); PG8_WAIT_L(0); PG8_BAR; PG8_MMA(0, 0, At, B0); PG8_MMA(0, 1, At, B1); PG8_BAR; PG8_SCHED;
            PG8_LDA(At, 0, 1); PG8_STAGE(PG8_SB(0, 0), b2, voffB); PG8_STAGE(PG8_SB(0, 1), b2 + hstep, voffB); PG8_STAGE(PG8_SA(0, 0), a2, voffA);
            PG8_WAIT_V(8); PG8_WAIT_L(0); PG8_BAR; PG8_MMA(1, 0, At, B0); PG8_MMA(1, 1, At, B1); PG8_BAR; PG8_SCHED;
            PG8_LDB(B0, 1, 0); PG8_LDB(B1, 1, 1); PG8_SCHED; PG8_LDA(At, 1, 0); PG8_STAGE(PG8_SA(0, 1), a2 + hstep, voffA);
            PG8_WAIT_V(8); PG8_WAIT_L(0); PG8_BAR; PG8_MMA(0, 0, At, B0); PG8_MMA(0, 1, At, B1); PG8_BAR; PG8_SCHED;
            PG8_LDA(At, 1, 1); PG8_STAGE(PG8_SB(1, 0), b3, voffB); PG8_STAGE(PG8_SB(1, 1), b3 + hstep, voffB); PG8_STAGE(PG8_SA(1, 0), a3, voffA);
            PG8_WAIT_V(8); PG8_WAIT_L(0); PG8_BAR; PG8_MMA(1, 0, At, B0); PG8_MMA(1, 1, At, B1); PG8_BAR; PG8_SCHED;
            } else {
            PG8_LDB(B0, 0, 0); PG8_SCHED; PG8_LDA(At, 0, 0); PG8_STAGE(PG8_SA(1, 1), a1 + hstep, voffA);
            PG8_WAIT_L(8); PG8_BAR; PG8_WAIT_L(0); PG8_MMA(0, 0, At, B0); PG8_BAR; PG8_SCHED;
            PG8_LDB(B1, 0, 1); PG8_STAGE(PG8_SB(0, 0), b2, voffB);
            PG8_BAR; PG8_WAIT_L(0); PG8_MMA(0, 1, At, B1); PG8_BAR;
            PG8_LDA(At, 0, 1); PG8_STAGE(PG8_SA(0, 0), a2, voffA);
            PG8_BAR; PG8_WAIT_L(0); PG8_MMA(1, 0, At, B0); PG8_BAR; PG8_SCHED;
            PG8_STAGE(PG8_SB(0, 1), b2 + hstep, voffB);
            PG8_WAIT_V(6); PG8_BAR; PG8_MMA(1, 1, At, B1); PG8_BAR;
            PG8_LDB(B0, 1, 0); PG8_SCHED; PG8_LDA(At, 1, 0); PG8_STAGE(PG8_SA(0, 1), a2 + hstep, voffA);
            PG8_WAIT_L(8); PG8_BAR; PG8_WAIT_L(0); PG8_MMA(0, 0, At, B0); PG8_BAR; PG8_SCHED;
            PG8_LDB(B1, 1, 1); PG8_STAGE(PG8_SB(1, 0), b3, voffB);
            PG8_BAR; PG8_WAIT_L(0); PG8_MMA(0, 1, At, B1); PG8_BAR;
            PG8_LDA(At, 1, 1); PG8_STAGE(PG8_SA(1, 0), a3, voffA);
            PG8_BAR; PG8_WAIT_L(0); PG8_MMA(1, 0, At, B0); PG8_BAR; PG8_SCHED;
            PG8_STAGE(PG8_SB(1, 1), b3 + hstep, voffB);
            PG8_WAIT_V(6); PG8_BAR; PG8_MMA(1, 1, At, B1); PG8_BAR;
            }
        }
        if constexpr (ALIGN_EPI) { if (wr == 0) PG8_BAR; }
        if constexpr (!Epi::AFTER_DRAIN) { E(acc, cur, wr, wc, fr, fq); S.done(cur); }
        if (!has_next) break;
#pragma unroll
        for (int a = 0; a < 2; ++a)
#pragma unroll
            for (int b = 0; b < 2; ++b)
#pragma unroll
                for (int m = 0; m < 4; ++m)
#pragma unroll
                    for (int n = 0; n < 2; ++n) acc[a][b][m][n] = (f32x4){0.f, 0.f, 0.f, 0.f};
        cur = nxt; cA = nA; cB = nB; ++ui;
        if constexpr (ALIGN_EPI) { if (wr == 1) PG8_BAR; }
    }
    PG8_WAIT_V(0);
    if constexpr (!ALIGN_EPI) { if (wr == 0) PG8_BAR; }
    PG8_BAR;
#undef PG8_SA
#undef PG8_SB
#undef PG8_STAGE
#undef PG8_LDA
#undef PG8_LDB
#undef PG8_MMA
#undef PG8_WAIT_V
#undef PG8_WAIT_L
#undef PG8_BAR
#undef PG8_SCHED
}
}

#ifndef PG8_SP2
#define PG8_SP2 true
#endif
#ifndef PG8_ALIGN
#define PG8_ALIGN true
#endif

constexpr int NWAVES = 8;
constexpr int BATCH = 16, SEQ = 2048, DM = 2048, DFF = 5632, MTOK = BATCH * SEQ, DEPTH = 4;
constexpr float ALPHA = 1.6817928305074292f;
constexpr float LN_EPS = 1e-5f, RMS_EPS = 1e-6f;
constexpr int A_QKV = 3072, B_QKV = 9216, C_IN = 1344, C_INP = 1536, C_QL = 768, C_KVL = 512, C_Q = 3072, C_KV = 4096;

constexpr size_t MiB = 1u << 20;
constexpr size_t WS_CTL = 0, CTL_ZERO_BYTES = 1 * MiB;
constexpr size_t WS_TABB = 1 * MiB;
constexpr size_t WS_TABC = 2 * MiB;
constexpr size_t WS_TABA = 3 * MiB;
constexpr size_t WS_WT = 8 * MiB;
constexpr size_t WS_HB = 80 * MiB;
constexpr size_t WS_R = 208 * MiB;
constexpr size_t WS_END = WS_R + 900 * MiB;
constexpr size_t WT_FFN_OUT = (size_t)2 * DFF * DM;
constexpr size_t WT_A_OUT = (size_t)A_QKV * DM, WT_B_OUT = (size_t)B_QKV * DM;
constexpr size_t WT_C_QUP = (size_t)C_INP * DM, WT_C_KVUP = WT_C_QUP + (size_t)C_Q * C_QL, WT_C_OUT = WT_C_KVUP + (size_t)C_KV * C_KVL;
constexpr size_t R_ACT = 0;
constexpr size_t RA_QKV = 0, RA_ATT = 192 * MiB;
constexpr size_t RB_QKV = 0, RB_ATT = 576 * MiB;
constexpr size_t RC_IN = 0, RC_QN = 96 * MiB, RC_KVN = 144 * MiB, RC_KR = 176 * MiB, RC_Q = 192 * MiB, RC_KV = 384 * MiB, RC_ATT = 640 * MiB;
constexpr int CW_BAR = 4096;

constexpr int RING_OFF = 0, RING_BYTES = 131072;
constexpr int LDSCTL_OFF = RING_BYTES, MISC_OFF = LDSCTL_OFF + 320;
constexpr int LDS_BYTES = 147456;

#define GAS __attribute__((address_space(1)))
#define LAS __attribute__((address_space(3)))
typedef unsigned short bf16;
typedef unsigned v4u __attribute__((ext_vector_type(4)));
typedef unsigned v2u __attribute__((ext_vector_type(2)));
typedef float f32x4 __attribute__((ext_vector_type(4)));
typedef GAS unsigned gu32;
#define RLX_AGENT __ATOMIC_RELAXED, __HIP_MEMORY_SCOPE_AGENT
#define LDS_WAIT() asm volatile("s_waitcnt lgkmcnt(0)" ::: "memory")
#define VM_WAIT() asm volatile("s_waitcnt vmcnt(0)" ::: "memory")
__device__ __forceinline__ unsigned f2bf(float f) { unsigned u = __builtin_bit_cast(unsigned, f); return (u + 0x7fffu + ((u >> 16) & 1u)) >> 16; }
__device__ __forceinline__ unsigned pk2(float lo, float hi) { return f2bf(lo) | (f2bf(hi) << 16); }
__device__ __forceinline__ float bflo(unsigned w) { return __uint_as_float(w << 16); }
__device__ __forceinline__ float bfhi(unsigned w) { return __uint_as_float(w & 0xffff0000u); }
__device__ __forceinline__ float bf1(bf16 b) { return __uint_as_float(((unsigned)b) << 16); }

#define XB_TMO      128
#define XB_XCNT(j)  (256  + 64 * (j))
#define XB_XSUB(j)  (1280 + 64 * (j))
#define XB_XGEN(j)  (2304 + 64 * (j))
#define XB_TOP      3328
#define XB_TOPGEN   3392
#define XCD_BAR_WORDS 3456
#define XB_SPIN_CAP (1u << 22)
__device__ __forceinline__ unsigned xb_ld(unsigned* p)              { return __hip_atomic_load(p, __ATOMIC_RELAXED, __HIP_MEMORY_SCOPE_AGENT); }
__device__ __forceinline__ unsigned xb_add(unsigned* p, unsigned v) { return __hip_atomic_fetch_add(p, v, __ATOMIC_RELAXED, __HIP_MEMORY_SCOPE_AGENT); }
__device__ __forceinline__ unsigned xb_xcc_id() { return (unsigned)__builtin_amdgcn_s_getreg((3 << 11) | 20) & 0xFu; }
#define XB_SPIN(cond, bar) do { unsigned _sp = 0; while (cond) { __builtin_amdgcn_s_sleep(1); \
    if ((++_sp & 255u) == 0u) { if (xb_ld(&(bar)[XB_TMO])) break; if (_sp > XB_SPIN_CAP) { atomicAdd(&(bar)[XB_TMO], 1u); break; } } } } while (0)
struct XcdBarrier { unsigned* bar; unsigned x; volatile LAS unsigned* st; };
__device__ __forceinline__ XcdBarrier xcd_barrier_post(unsigned* bar, volatile LAS unsigned* st) {
    XcdBarrier b; b.bar = bar; b.x = xb_xcc_id(); b.st = st;
    if (threadIdx.x == 0) (void)xb_add(&bar[XB_XCNT(b.x)], 1u);
    return b;
}
__device__ __forceinline__ void xcd_barrier_complete(unsigned* bar, unsigned x, unsigned& nloc, unsigned& nx) {
    const unsigned G = gridDim.x * gridDim.y * gridDim.z;
    unsigned sum, cnt, mine, sp = 0u;
    for (;;) {
        sum = 0u; cnt = 0u; mine = 0u;
#pragma unroll
        for (unsigned j = 0; j < 16; ++j) { const unsigned c = xb_ld(&bar[XB_XCNT(j)]); sum += c; cnt += (c > 0u) ? 1u : 0u; mine = (j == x) ? c : mine; }
        if (sum == G) break;
        __builtin_amdgcn_s_sleep(1);
        if ((++sp & 255u) == 0u) { if (xb_ld(&bar[XB_TMO])) break; if (sp > XB_SPIN_CAP) { atomicAdd(&bar[XB_TMO], 1u); break; } }
    }
    nloc = mine > 0u ? mine : 1u; nx = cnt > 0u ? cnt : 1u;
}
__device__ __forceinline__ void xcd_barrier(const XcdBarrier& b) {
    asm volatile("s_waitcnt vmcnt(0)" ::: "memory");
    __syncthreads();
    if (threadIdx.x == 0) {
        unsigned* bar = b.bar;
        __builtin_amdgcn_s_waitcnt(0);
        unsigned nloc = b.st[0], nx = b.st[1];
        if (nloc == 0u) { xcd_barrier_complete(bar, b.x, nloc, nx); b.st[0] = nloc; b.st[1] = nx; }
        const unsigned old = xb_add(&bar[XB_XSUB(b.x)], 1u);
        const unsigned gen = old / nloc;
        if (old + 1u == (gen + 1u) * nloc) {
            __builtin_amdgcn_fence(__ATOMIC_RELEASE, "agent");
            asm volatile("s_waitcnt vmcnt(0)" ::: "memory");
            const unsigned og = xb_add(&bar[XB_TOP], 1u);
            const unsigned tg = og / nx;
            if (og + 1u == (tg + 1u) * nx) xb_add(&bar[XB_TOPGEN], 1u);
            else XB_SPIN(xb_ld(&bar[XB_TOPGEN]) == tg, bar);
            __builtin_amdgcn_fence(__ATOMIC_ACQUIRE, "agent");
            xb_add(&bar[XB_XGEN(b.x)], 1u);
            asm volatile("s_waitcnt vmcnt(0)" ::: "memory");
        } else {
            XB_SPIN(xb_ld(&bar[XB_XGEN(b.x)]) == gen, bar);
            __builtin_amdgcn_fence(__ATOMIC_ACQUIRE, "agent");
            asm volatile("s_waitcnt vmcnt(0)" ::: "memory");
        }
    }
    __syncthreads();
}

template <class T> __device__ __forceinline__ T* lnd(T* p) { asm volatile("" : "+s"(p)); return p; }
__device__ __forceinline__ float wave_sum(float v) {
#pragma unroll
    for (int o = 1; o < 64; o <<= 1) v += __shfl_xor(v, o);
    return v;
}
__device__ __forceinline__ void cvt_weight(const float* W, int K, int Nsrc, bf16* WT, int Ndst, int kind, LAS float* scr, int gw, int NGW, int lane) {
    asm volatile("" : "+v"(lane));
    const int nblk = Ndst / 32, nitems = (K / 64) * nblk;
    for (int item = gw; item < nitems; item += NGW) {
        const int kb = item / nblk, nb = item % nblk, k0 = 64 * kb, n0 = 32 * nb;
        int c0;
        if (kind == 1) { const int t = n0 >> 8, r = n0 & 255; c0 = (r >> 7) * DFF + 128 * t + (r & 127); }
        else c0 = (n0 < Nsrc) ? n0 : -1;
        if (c0 >= 0) {
#pragma unroll 8
            for (int i = 0; i < 32; ++i) { const int kk = 2 * i + (lane >> 5); scr[kk * 33 + (lane & 31)] = W[(size_t)(k0 + kk) * Nsrc + c0 + (lane & 31)]; }
        } else {
#pragma unroll 8
            for (int i = 0; i < 32; ++i) { const int kk = 2 * i + (lane >> 5); scr[kk * 33 + (lane & 31)] = 0.f; }
        }
        LDS_WAIT(); asm volatile("" ::: "memory");
        const int c = lane & 7;
#pragma unroll
        for (int j = 0; j < 4; ++j) { const int n = (lane >> 3) + 8 * j; const LAS float* s = scr + (8 * c) * 33 + n;
            v4u o; o.x = pk2(s[0 * 33], s[1 * 33]); o.y = pk2(s[2 * 33], s[3 * 33]); o.z = pk2(s[4 * 33], s[5 * 33]); o.w = pk2(s[6 * 33], s[7 * 33]);
            *(GAS v4u*)(WT + (size_t)(n0 + n) * K + k0 + 8 * c) = o; }
        LDS_WAIT(); asm volatile("" ::: "memory");
    }
}
__device__ __forceinline__ void ln_rows(float* H, bf16* HBo, const float* g, const float* b, int gw, int NGW, int lane) {
    asm volatile("" : "+v"(lane));
    for (int m = gw; m < MTOK; m += NGW) {
        GAS f32x4* xr = (GAS f32x4*)(H + (size_t)m * DM) + 2 * lane;
        f32x4 v[8]; float s = 0.f;
#pragma unroll
        for (int j = 0; j < 4; ++j) { v[2 * j] = xr[128 * j]; v[2 * j + 1] = xr[128 * j + 1]; }
#pragma unroll
        for (int j = 0; j < 8; ++j) s += (v[j].x + v[j].y) + (v[j].z + v[j].w);
        const float mean = wave_sum(s) * (1.f / DM); float s2 = 0.f;
#pragma unroll
        for (int j = 0; j < 8; ++j) { v[j] = v[j] - mean; s2 += (v[j].x * v[j].x + v[j].y * v[j].y) + (v[j].z * v[j].z + v[j].w * v[j].w); }
        const float rstd = 1.f / sqrtf(wave_sum(s2) * (1.f / DM) + LN_EPS);
        GAS v4u* ob = (GAS v4u*)(HBo + (size_t)m * DM) + lane;
#pragma unroll
        for (int j = 0; j < 4; ++j) {
            const f32x4 g0 = *((const f32x4*)g + 128 * j + 2 * lane), g1 = *((const f32x4*)g + 128 * j + 2 * lane + 1);
            const f32x4 b0 = *((const f32x4*)b + 128 * j + 2 * lane), b1 = *((const f32x4*)b + 128 * j + 2 * lane + 1);
            const f32x4 y0 = v[2 * j] * rstd * g0 + b0, y1 = v[2 * j + 1] * rstd * g1 + b1;
            xr[128 * j] = y0; xr[128 * j + 1] = y1;
            v4u o; o.x = pk2(y0.x, y0.y); o.y = pk2(y0.z, y0.w); o.z = pk2(y1.x, y1.y); o.w = pk2(y1.z, y1.w);
            ob[64 * j] = o;
        }
    }
}
__device__ __forceinline__ void cvt_rows_bf16(const float* X, bf16* O, size_t n8, size_t gt, size_t NGT) {
    for (size_t i = gt; i < n8; i += NGT) { const f32x4 a = *((const GAS f32x4*)X + 2 * i), c = *((const GAS f32x4*)X + 2 * i + 1);
        v4u o; o.x = pk2(a.x, a.y); o.y = pk2(a.z, a.w); o.z = pk2(c.x, c.y); o.w = pk2(c.z, c.w); *((GAS v4u*)O + i) = o; }
}
__device__ __forceinline__ void sincos_tab(float ang, float& c, float& s) {
    const double x = (double)ang; const double k = __builtin_rint(x * 0.15915494309189533577); const double r = x - k * 6.28318530717958647692;
    const double r2 = r * r; double sn = 0.0, cs = 0.0;
#pragma unroll
    for (int n = 14; n >= 0; --n) { sn = sn * (-r2) / (double)((2 * n + 2) * (2 * n + 3)) + 1.0; cs = cs * (-r2) / (double)((2 * n + 1) * (2 * n + 2)) + 1.0; }
    s = (float)(sn * r); c = (float)cs;
}
__device__ __forceinline__ void build_tables(unsigned char* ws, size_t gt, size_t NGT) {
    float* cb = (float*)(ws + WS_TABB); float* sb = cb + 2048 * 64;
    for (size_t i = gt; i < 2048 * 64; i += NGT) { const int pos = (int)(i >> 6), f = (int)(i & 63); const float inv = __builtin_amdgcn_exp2f(-13.287712379549449f * ((float)(2 * f) / 128.0f)); float c, s; sincos_tab((float)pos * inv, c, s); cb[i] = c; sb[i] = s; }
    float* cc = (float*)(ws + WS_TABC); float* sc = cc + 2048 * 32;
    for (size_t i = gt; i < 2048 * 32; i += NGT) { const int pos = (int)(i >> 5), f = (int)(i & 31); const float inv = __builtin_amdgcn_exp2f(-13.287712379549449f * ((float)(2 * f) / 64.0f)); float c, s; sincos_tab((float)pos * inv, c, s); cc[i] = c; sc[i] = s; }
    float* ca = (float*)(ws + WS_TABA); float* sa = ca + 64 * 32;
    for (size_t i = gt; i < 64 * 32; i += NGT) { const int pos = (int)(i >> 5), f = (int)(i & 31); const float inv = __builtin_amdgcn_exp2f(-13.287712379549449f * ((float)(2 * f) / 64.0f)); float c, s; sincos_tab((float)pos * inv, c, s); ca[i] = c; sa[i] = s; }
}

__device__ __forceinline__ void prep_a(bf16* QKV, const float* qg, const float* kg, const unsigned char* ws, int gw, int NGW, int lane) {
    asm volatile("" : "+v"(lane));
    const float* ca = (const float*)(ws + WS_TABA); const float* sa = ca + 64 * 32;
    const int half = lane >> 5, i = lane & 31, ia = 64 * half + i, ib = ia + 32;
    const float gqa = qg[ia], gqb = qg[ib], gka = kg[ia], gkb = kg[ib];
    for (int tok = gw; tok < MTOK; tok += NGW) {
        const int s = tok & (SEQ - 1), pos = half ? (s & 63) : (s >> 6);
        const float c = ca[pos * 32 + i], sn = sa[pos * 32 + i];
        bf16* row = QKV + (size_t)tok * A_QKV;
#pragma unroll 4
        for (int h = 0; h < 20; ++h) {
            bf16* p = row + h * 128;
            float a = bf1(p[ia]), b = bf1(p[ib]);
            const float ss = wave_sum(a * a + b * b);
            const float r = 1.f / sqrtf(ss * (1.f / 128.f) + RMS_EPS);
            a = a * r * (h < 16 ? gqa : gka); b = b * r * (h < 16 ? gqb : gkb);
            p[ia] = (bf16)f2bf(a * c - b * sn); p[ib] = (bf16)f2bf(a * sn + b * c);
        }
    }
}
__device__ __forceinline__ void prep_b(bf16* QKV, const unsigned char* ws, int gw, int NGW, int lane) {
    asm volatile("" : "+v"(lane));
    const float* cb = (const float*)(ws + WS_TABB); const float* sb = cb + 2048 * 64;
    for (int tok = gw; tok < MTOK; tok += NGW) {
        const int s = tok & (SEQ - 1);
        const float c = cb[s * 64 + lane], sn = sb[s * 64 + lane];
        bf16* row = QKV + (size_t)tok * B_QKV;
#pragma unroll 4
        for (int j = 0; j < 48; ++j) {
            const int g = j >> 4, t = (j >> 3) & 1, h = j & 7;
            bf16* p = row + g * 3072 + t * 1024 + h * 128;
            const float a = bf1(p[lane]), b = bf1(p[lane + 64]);
            p[lane] = (bf16)f2bf(a * c - b * sn); p[lane + 64] = (bf16)f2bf(a * sn + b * c);
        }
    }
}
__device__ __forceinline__ void prep_c1(const bf16* CIN, bf16* CQN, bf16* CKVN, bf16* KR, const float* qg, const float* kvg, const unsigned char* ws, int gw, int NGW, int lane) {
    asm volatile("" : "+v"(lane));
    const float* cc = (const float*)(ws + WS_TABC); const float* sc = cc + 2048 * 32;
    for (int tok = gw; tok < MTOK; tok += NGW) {
        const bf16* row = CIN + (size_t)tok * C_INP;
        { float v[12]; float ss = 0.f;
#pragma unroll
          for (int j = 0; j < 12; ++j) { v[j] = bf1(row[j * 64 + lane]); ss += v[j] * v[j]; }
          const float r = 1.f / sqrtf(wave_sum(ss) * (1.f / 768.f) + RMS_EPS);
#pragma unroll
          for (int j = 0; j < 12; ++j) CQN[(size_t)tok * C_QL + j * 64 + lane] = (bf16)f2bf(v[j] * r * qg[j * 64 + lane]); }
        { float v[8]; float ss = 0.f;
#pragma unroll
          for (int j = 0; j < 8; ++j) { v[j] = bf1(row[768 + j * 64 + lane]); ss += v[j] * v[j]; }
          const float r = 1.f / sqrtf(wave_sum(ss) * (1.f / 512.f) + RMS_EPS);
#pragma unroll
          for (int j = 0; j < 8; ++j) CKVN[(size_t)tok * C_KVL + j * 64 + lane] = (bf16)f2bf(v[j] * r * kvg[j * 64 + lane]); }
        if (lane < 32) { const int s = tok & (SEQ - 1); const float c = cc[s * 32 + lane], sn = sc[s * 32 + lane];
          const float a = bf1(row[1280 + lane]), b = bf1(row[1280 + 32 + lane]);
          KR[(size_t)tok * 64 + lane] = (bf16)f2bf(a * c - b * sn); KR[(size_t)tok * 64 + 32 + lane] = (bf16)f2bf(a * sn + b * c); }
    }
}
__device__ __forceinline__ void prep_c2(bf16* Q, const unsigned char* ws, int gw, int NGW, int lane) {
    asm volatile("" : "+v"(lane));
    const float* cc = (const float*)(ws + WS_TABC); const float* sc = cc + 2048 * 32;
    const int i = lane & 31, hh = lane >> 5;
    for (int tok = gw; tok < MTOK; tok += NGW) {
        const int s = tok & (SEQ - 1); const float c = cc[s * 32 + i], sn = sc[s * 32 + i];
        bf16* row = Q + (size_t)tok * C_Q;
#pragma unroll
        for (int j = 0; j < 8; ++j) { bf16* p = row + (2 * j + hh) * 192 + 128; const float a = bf1(p[i]), b = bf1(p[i + 32]);
            p[i] = (bf16)f2bf(a * c - b * sn); p[i + 32] = (bf16)f2bf(a * sn + b * c); }
    }
}

struct NState { float m, l, o[8]; };
__device__ __forceinline__ void nst_init(NState& S) { S.m = -1e30f; S.l = 0.f;
#pragma unroll
    for (int j = 0; j < 8; ++j) S.o[j] = 0.f; }
__device__ __forceinline__ void nst_update(NState& S, float s, bool valid, const v4u vv) {
    const float mn = valid ? fmaxf(S.m, s) : S.m; const float al = __builtin_amdgcn_exp2f(S.m - mn); const float p = valid ? __builtin_amdgcn_exp2f(s - mn) : 0.f;
    S.l = S.l * al + p; S.m = mn;
    S.o[0] = S.o[0] * al + p * bflo(vv.x); S.o[1] = S.o[1] * al + p * bfhi(vv.x); S.o[2] = S.o[2] * al + p * bflo(vv.y); S.o[3] = S.o[3] * al + p * bfhi(vv.y);
    S.o[4] = S.o[4] * al + p * bflo(vv.z); S.o[5] = S.o[5] * al + p * bfhi(vv.z); S.o[6] = S.o[6] * al + p * bflo(vv.w); S.o[7] = S.o[7] * al + p * bfhi(vv.w);
}
__device__ __forceinline__ void nst_finish(NState& S, bf16* out, int lane) {
#pragma unroll
    for (int x = 16; x <= 32; x <<= 1) {
        const float m2 = __shfl_xor(S.m, x), l2 = __shfl_xor(S.l, x); const float mn = fmaxf(S.m, m2); const float a = __builtin_amdgcn_exp2f(S.m - mn), b = __builtin_amdgcn_exp2f(m2 - mn);
        S.l = S.l * a + l2 * b; S.m = mn;
#pragma unroll
        for (int j = 0; j < 8; ++j) { const float o2 = __shfl_xor(S.o[j], x); S.o[j] = S.o[j] * a + o2 * b; }
    }
    if (lane < 16) { const float rl = 1.f / S.l; v4u w; w.x = pk2(S.o[0] * rl, S.o[1] * rl); w.y = pk2(S.o[2] * rl, S.o[3] * rl); w.z = pk2(S.o[4] * rl, S.o[5] * rl); w.w = pk2(S.o[6] * rl, S.o[7] * rl);
        *(GAS v4u*)(out + lane * 8) = w; }
}
__device__ __forceinline__ float dot8(const float (&q)[8], const v4u k) {
    return q[0] * bflo(k.x) + q[1] * bfhi(k.x) + q[2] * bflo(k.y) + q[3] * bfhi(k.y) + q[4] * bflo(k.z) + q[5] * bfhi(k.z) + q[6] * bflo(k.w) + q[7] * bfhi(k.w);
}
__device__ __forceinline__ float red16(float s) { s += __shfl_xor(s, 1); s += __shfl_xor(s, 2); s += __shfl_xor(s, 4); s += __shfl_xor(s, 8); return s; }
__device__ __forceinline__ void ldq8(float (&q)[8], const bf16* p, float sc) { const v4u w = *(const GAS v4u*)p;
    q[0] = bflo(w.x) * sc; q[1] = bfhi(w.x) * sc; q[2] = bflo(w.y) * sc; q[3] = bfhi(w.y) * sc; q[4] = bflo(w.z) * sc; q[5] = bfhi(w.z) * sc; q[6] = bflo(w.w) * sc; q[7] = bfhi(w.w) * sc; }

__device__ __forceinline__ void naive_attn_a(const bf16* QKV, bf16* ATT, int gw, int NGW, int lane) {
    asm volatile("" : "+v"(lane));
    const int g = lane >> 4, i = lane & 15; const float sc = 0.08838834764831845f * 1.4426950408889634f;
    for (int p = gw; p < MTOK * 16; p += NGW) {
        const int tok = p >> 4, h = p & 15, b = tok >> 11;
        float q[8]; ldq8(q, QKV + (size_t)tok * A_QKV + h * 128 + i * 8, sc);
        const bf16* kb = QKV + (size_t)(b * SEQ) * A_QKV + 2048 + (h >> 2) * 128 + i * 8;
        NState S; nst_init(S);
        for (int t0 = 0; t0 < SEQ; t0 += 4) { const bf16* kp = kb + (size_t)(t0 + g) * A_QKV; const v4u kk = *(const GAS v4u*)kp, vv = *(const GAS v4u*)(kp + 512);
            nst_update(S, red16(dot8(q, kk)), true, vv); }
        nst_finish(S, ATT + (size_t)tok * DM + h * 128, lane);
    }
}
__device__ __forceinline__ void naive_attn_b(const bf16* QKV, bf16* ATT, int gw, int NGW, int lane) {
    asm volatile("" : "+v"(lane));
    const int g = lane >> 4, i = lane & 15; const float sc = 0.08838834764831845f * 1.4426950408889634f;
    for (int p = gw; p < MTOK * 8; p += NGW) {
        const int tok = p >> 3, h = p & 7, s = tok & (SEQ - 1);
        NState S; nst_init(S);
        for (int grp = 0; grp < 3; ++grp) {
            const int dil = grp == 0 ? 1 : (grp == 1 ? 4 : 16);
            float q[8]; ldq8(q, QKV + (size_t)tok * B_QKV + grp * 3072 + h * 128 + i * 8, sc);
            for (int j0 = -64; j0 <= 64; j0 += 4) { const int j = j0 + g; const int t = s + j * dil; const bool valid = (j <= 64) && (t >= 0) && (t < SEQ);
                const int tc = valid ? t : s; const bf16* kp = QKV + (size_t)(tok - s + tc) * B_QKV + grp * 3072 + 1024 + h * 128 + i * 8;
                const v4u kk = *(const GAS v4u*)kp, vv = *(const GAS v4u*)(kp + 1024);
                nst_update(S, red16(dot8(q, kk)), valid, vv); }
        }
        nst_finish(S, ATT + (size_t)tok * 1024 + h * 128, lane);
    }
}
__device__ __forceinline__ void naive_attn_c(const bf16* Q, const bf16* KV, const bf16* KR, bf16* ATT, int gw, int NGW, int lane) {
    asm volatile("" : "+v"(lane));
    const int g = lane >> 4, i = lane & 15; const float sc = 0.07216878364870322f * 1.4426950408889634f;
    for (int p = gw; p < MTOK * 16; p += NGW) {
        const int tok = p >> 4, h = p & 15, b = tok >> 11;
        float q[8]; ldq8(q, Q + (size_t)tok * C_Q + h * 192 + i * 8, sc);
        float qr[4]; { const v2u w = *(const GAS v2u*)(Q + (size_t)tok * C_Q + h * 192 + 128 + i * 4); qr[0] = bflo(w.x) * sc; qr[1] = bfhi(w.x) * sc; qr[2] = bflo(w.y) * sc; qr[3] = bfhi(w.y) * sc; }
        const bf16* kb = KV + (size_t)(b * SEQ) * C_KV + h * 256 + i * 8; const bf16* rb = KR + (size_t)(b * SEQ) * 64 + i * 4;
        NState S; nst_init(S);
        for (int t0 = 0; t0 < SEQ; t0 += 4) { const bf16* kp = kb + (size_t)(t0 + g) * C_KV; const v4u kk = *(const GAS v4u*)kp, vv = *(const GAS v4u*)(kp + 128);
            const v2u kr = *(const GAS v2u*)(rb + (size_t)(t0 + g) * 64);
            const float d = dot8(q, kk) + qr[0] * bflo(kr.x) + qr[1] * bfhi(kr.x) + qr[2] * bflo(kr.y) + qr[3] * bfhi(kr.y);
            nst_update(S, red16(d), true, vv); }
        nst_finish(S, ATT + (size_t)tok * DM + h * 128, lane);
    }
}

constexpr int N_IN = 57;
struct Args { const float* in[N_IN]; float* out; unsigned char* ws; int ph_lo, ph_hi; };
constexpr int N_PHASES = 1 + 4 * 8 + 3 + 3 + 5 + 3;

__global__ void __launch_bounds__(NWAVES * 64, 2) mega_fwd(Args args) {
    extern __shared__ __attribute__((aligned(16))) unsigned char lds_raw[];
    LAS unsigned char* lds = (LAS unsigned char*)lds_raw;
    volatile LAS unsigned* MISC = (volatile LAS unsigned*)(lds + MISC_OFF);
    const int tid = threadIdx.x, lane = tid & 63, wave = __builtin_amdgcn_readfirstlane(tid >> 6);
    const int G = gridDim.x; const int bx = blockIdx.x; const int vcu = (G % 8 == 0) ? (bx % 8) * (G / 8) + bx / 8 : bx;
    const int gw = vcu * NWAVES + wave, NGW = G * NWAVES;
    const size_t gt = (size_t)vcu * (NWAVES * 64) + tid, NGT = (size_t)G * NWAVES * 64;
    unsigned char* ws = args.ws;
    gu32* ctl = (gu32*)(ws + WS_CTL);
    for (int u = tid; u < (LDS_BYTES - LDSCTL_OFF) / 4; u += NWAVES * 64) ((LAS unsigned*)(lds + LDSCTL_OFF))[u] = 0u;
    __syncthreads();
    XcdBarrier bar; bar.bar = (unsigned*)(ctl + CW_BAR); bar.x = 0; bar.st = nullptr;
    if (!MK_PER_PHASE) bar = xcd_barrier_post((unsigned*)(ctl + CW_BAR), MISC + 8);
    const int lo = args.ph_lo, hi = args.ph_hi;
    int ph = 0;
#define IN_PH() (lo <= ph && ph < hi)
#define SEAM() do { if (!MK_PER_PHASE) { if (lo <= ph && ph + 1 < hi) xcd_barrier(bar); } ++ph; } while (0)

    bf16* WT = (bf16*)(ws + WS_WT); bf16* HB = (bf16*)(ws + WS_HB); unsigned char* R = ws + WS_R;
    float* H32 = args.out;
    LAS float* scr = (LAS float*)(lds + RING_OFF + wave * 16384);

    if (IN_PH()) {
        build_tables(ws, gt, NGT);
        cvt_rows_bf16(args.in[0], HB, (size_t)MTOK * DM / 8, gt, NGT);
        cvt_weight(args.in[1], DM, 2 * DFF, WT, 2 * DFF, 1, scr, gw, NGW, lane);
        cvt_weight(args.in[2], DFF, DM, WT + WT_FFN_OUT, DM, 0, scr, gw, NGW, lane);
    }
    SEAM();

    for (int L = 0; L < DEPTH; ++L) {
        const int kind = (L == 3) ? 0 : L;
        const int base = (L == 0) ? 1 : (L == 1) ? 15 : (L == 2) ? 27 : 43;
        const int nmix = (kind == 0) ? 4 : (kind == 1) ? 2 : 6;
        for (int sub = 0; sub < 3; ++sub) {
            if (sub != 1) {
                if (IN_PH()) {
                    pg8::Gemm g{lnd(HB), lnd(WT), MTOK, 2 * DFF, DM}; pg8::StaticOrder S; S.init(MTOK, 2 * DFF, G, bx);
                    pg8::EpiSwiGLU E{lnd((bf16*)(R + R_ACT)), DFF};
                    pg8::gemm_phase<pg8::EpiSwiGLU, pg8::StaticOrder, PG8_ALIGN, PG8_SP2>(lds + RING_OFF, g, S, E);
                }
                SEAM();
            } else {
                if (IN_PH()) {
                    const int N = (kind == 0) ? A_QKV : (kind == 1) ? B_QKV : C_INP;
                    pg8::Gemm g{lnd(HB), lnd(WT), MTOK, N, DM}; pg8::StaticOrder S; S.init(MTOK, N, G, bx);
                    pg8::EpiBf16 E{lnd((bf16*)(R + 0)), N};
                    pg8::gemm_phase<pg8::EpiBf16, pg8::StaticOrder, PG8_ALIGN, PG8_SP2>(lds + RING_OFF, g, S, E);
                }
                SEAM();
                if (kind == 0) {
                    if (IN_PH()) prep_a((bf16*)(R + RA_QKV), args.in[base + 5], args.in[base + 6], ws, gw, NGW, lane);
                    SEAM();
                    if (IN_PH()) naive_attn_a((const bf16*)(R + RA_QKV), (bf16*)(R + RA_ATT), gw, NGW, lane);
                    SEAM();
                } else if (kind == 1) {
                    if (IN_PH()) prep_b((bf16*)(R + RB_QKV), ws, gw, NGW, lane);
                    SEAM();
                    if (IN_PH()) naive_attn_b((const bf16*)(R + RB_QKV), (bf16*)(R + RB_ATT), gw, NGW, lane);
                    SEAM();
                } else {
                    if (IN_PH()) prep_c1((const bf16*)(R + RC_IN), (bf16*)(R + RC_QN), (bf16*)(R + RC_KVN), (bf16*)(R + RC_KR), args.in[base + 5], args.in[base + 6], ws, gw, NGW, lane);
                    SEAM();
                    if (IN_PH()) {
                        { pg8::Gemm g{lnd((const bf16*)(R + RC_QN)), lnd(WT + WT_C_QUP), MTOK, C_Q, C_QL}; pg8::StaticOrder S; S.init(MTOK, C_Q, G, bx);
                          pg8::EpiBf16 E{lnd((bf16*)(R + RC_Q)), C_Q};
                          pg8::gemm_phase<pg8::EpiBf16, pg8::StaticOrder, PG8_ALIGN, PG8_SP2>(lds + RING_OFF, g, S, E); }
                        { pg8::Gemm g{lnd((const bf16*)(R + RC_KVN)), lnd(WT + WT_C_KVUP), MTOK, C_KV, C_KVL}; pg8::StaticOrder S; S.init(MTOK, C_KV, G, bx);
                          pg8::EpiBf16 E{lnd((bf16*)(R + RC_KV)), C_KV};
                          pg8::gemm_phase<pg8::EpiBf16, pg8::StaticOrder, PG8_ALIGN, PG8_SP2>(lds + RING_OFF, g, S, E); }
                    }
                    SEAM();
                    if (IN_PH()) prep_c2((bf16*)(R + RC_Q), ws, gw, NGW, lane);
                    SEAM();
                    if (IN_PH()) naive_attn_c((const bf16*)(R + RC_Q), (const bf16*)(R + RC_KV), (const bf16*)(R + RC_KR), (bf16*)(R + RC_ATT), gw, NGW, lane);
                    SEAM();
                }
            }
            if (IN_PH()) {
                const bf16* A; const bf16* Bt; int K; float s;
                if (sub != 1) { A = (const bf16*)(R + R_ACT); Bt = WT + WT_FFN_OUT; K = DFF; s = 0.5f; }
                else if (kind == 0) { A = (const bf16*)(R + RA_ATT); Bt = WT + WT_A_OUT; K = DM; s = 1.0f; }
                else if (kind == 1) { A = (const bf16*)(R + RB_ATT); Bt = WT + WT_B_OUT; K = 1024; s = 1.0f; }
                else { A = (const bf16*)(R + RC_ATT); Bt = WT + WT_C_OUT; K = DM; s = 1.0f; }
                pg8::Gemm g{lnd(A), lnd(Bt), MTOK, DM, K}; pg8::StaticOrder S; S.init(MTOK, DM, G, bx);
                pg8::EpiResid E{lnd((L == 0 && sub == 0) ? args.in[0] : (const float*)H32), lnd(H32), DM, ALPHA, s};
                pg8::gemm_phase<pg8::EpiResid, pg8::StaticOrder, PG8_ALIGN, PG8_SP2>(lds + RING_OFF, g, S, E);
            }
            SEAM();
            if (IN_PH()) {
                const int lnidx = (sub == 0) ? base + 2 : (sub == 1) ? base + 4 + nmix : base + 8 + nmix;
                ln_rows(H32, HB, args.in[lnidx], args.in[lnidx + 1], gw, NGW, lane);
                if (sub == 0) {
                    if (kind == 0) { cvt_weight(args.in[base + 4], DM, A_QKV, WT, A_QKV, 0, scr, gw, NGW, lane); cvt_weight(args.in[base + 7], DM, DM, WT + WT_A_OUT, DM, 0, scr, gw, NGW, lane); }
                    else if (kind == 1) { cvt_weight(args.in[base + 4], DM, B_QKV, WT, B_QKV, 0, scr, gw, NGW, lane); cvt_weight(args.in[base + 5], 1024, DM, WT + WT_B_OUT, DM, 0, scr, gw, NGW, lane); }
                    else { cvt_weight(args.in[base + 4], DM, C_IN, WT, C_INP, 0, scr, gw, NGW, lane); cvt_weight(args.in[base + 7], C_QL, C_Q, WT + WT_C_QUP, C_Q, 0, scr, gw, NGW, lane);
                           cvt_weight(args.in[base + 8], C_KVL, C_KV, WT + WT_C_KVUP, C_KV, 0, scr, gw, NGW, lane); cvt_weight(args.in[base + 9], DM, DM, WT + WT_C_OUT, DM, 0, scr, gw, NGW, lane); }
                } else {
                    int wi = -1;
                    if (sub == 1) wi = base + 6 + nmix;
                    else if (L + 1 < DEPTH) wi = ((L + 1 == 1) ? 15 : (L + 1 == 2) ? 27 : 43);
                    if (wi >= 0) { cvt_weight(args.in[wi], DM, 2 * DFF, WT, 2 * DFF, 1, scr, gw, NGW, lane); cvt_weight(args.in[wi + 1], DFF, DM, WT + WT_FFN_OUT, DM, 0, scr, gw, NGW, lane); }
                }
            }
            SEAM();
        }
    }
#undef IN_PH
#undef SEAM
}

extern "C" void kernel_launch(void* const* d_in, const int* in_sizes, int n_in, void* d_out, int out_size, void* d_ws, size_t ws_size, hipStream_t stream) {
    static int grid = 0;
    if (grid == 0) {
        if (n_in != N_IN || in_sizes[0] != MTOK * DM || out_size != MTOK * DM || ws_size < WS_END) {
            fprintf(stderr, "kernel_launch: shape mismatch: n_in %d in0 %d out %d ws %zu (need >= %zu)\n", n_in, n_in > 0 ? in_sizes[0] : -1, out_size, ws_size, (size_t)WS_END); grid = -1; return; }
        int dev = 0, cus = 0, per_cu = 0;
        if (hipGetDevice(&dev) != hipSuccess || hipDeviceGetAttribute(&cus, hipDeviceAttributeMultiprocessorCount, dev) != hipSuccess) { fprintf(stderr, "kernel_launch: device query failed\n"); grid = -1; return; }
        if (hipFuncSetAttribute((const void*)mega_fwd, hipFuncAttributeMaxDynamicSharedMemorySize, LDS_BYTES) != hipSuccess) { fprintf(stderr, "kernel_launch: hipFuncSetAttribute failed\n"); grid = -1; return; }
        if (hipOccupancyMaxActiveBlocksPerMultiprocessor(&per_cu, (const void*)mega_fwd, NWAVES * 64, LDS_BYTES) != hipSuccess || per_cu < 1)
            fprintf(stderr, "kernel_launch: note: occupancy query reports %d workgroups per CU\n", per_cu);
        (void)hipGetLastError();
        grid = cus;
    }
    if (grid < 0) return;
    if (hipMemsetAsync((char*)d_ws + WS_CTL, 0, CTL_ZERO_BYTES, stream) != hipSuccess) { fprintf(stderr, "kernel_launch: memset failed\n"); return; }
    Args a{};
    for (int i = 0; i < N_IN; ++i) a.in[i] = (const float*)d_in[i];
    a.out = (float*)d_out; a.ws = (unsigned char*)d_ws;
#if MK_PER_PHASE
    for (int p = 0; p < N_PHASES; ++p) { a.ph_lo = p; a.ph_hi = p + 1; hipLaunchKernelGGL(mega_fwd, dim3(grid), dim3(NWAVES * 64), LDS_BYTES, stream, a); }
#else
    a.ph_lo = 0; a.ph_hi = N_PHASES;
    hipLaunchKernelGGL(mega_fwd, dim3(grid), dim3(NWAVES * 64), LDS_BYTES, stream, a);
#endif
    const hipError_t le = hipPeekAtLastError();
    if (le != hipSuccess) fprintf(stderr, "kernel_launch: launch failed: %s\n", hipGetErrorName(le));
}
```

```cpp
#include <hip/hip_runtime.h>
#include <cstdio>
#include <cstdint>

#ifndef MK_PER_PHASE
#define MK_PER_PHASE 0
#endif

namespace pg8 {
#define PG8_LAS __attribute__((address_space(3)))
typedef unsigned short bf16_t;
typedef short bf16x8 __attribute__((ext_vector_type(8)));
typedef float f32x4 __attribute__((ext_vector_type(4)));
typedef unsigned u32x4 __attribute__((ext_vector_type(4)));
constexpr int BM = 256, BK = 64, HALF = 128, HTB = HALF * BK * 2  , STAGE_BYTES = 8 * HTB, NXCD = 8, WGM = 8;

__host__ __device__ __forceinline__ int lds_byte(int r, int c) { const int st = (r >> 4) * 2 + (c >> 5), rr = r & 15, cc = c & 31, ob = rr * 64 + cc * 2; return st * 1024 + (ob ^ (((ob >> 9) & 1) << 5)); }
__host__ __device__ __forceinline__ void stage_rc(int b, int& R, int& C) { const int st = b / 1024, sb = b % 1024, swz = sb ^ (((sb >> 9) & 1) << 5); R = (st >> 1) * 16 + swz / 64; C = (st & 1) * 32 + (swz % 64) / 2; }
__host__ __device__ __forceinline__ int perm32(int rho) { const int n = rho >> 4, i = rho & 15; return 8 * (i >> 2) + 4 * n + (i & 3); }

struct Unit { int pm, pn; };
struct Gemm { const bf16_t* A; const bf16_t* Bt; int M, N, K; };

struct StaticOrder {
    int nM, nN, nwg, G, c;
    __host__ __device__ void init(int M, int N, int G_, int c_) { nM = M / BM; nN = N / BM; nwg = nM * nN; G = G_; c = c_; }
    __host__ __device__ bool next(int i, Unit& u) const {
        const long L = (long)i * G + c; if (L >= nwg) return false;
        int wgid = (int)L; { const int q = nwg / NXCD, r = nwg % NXCD, xcd = wgid % NXCD, off = wgid / NXCD; wgid = (xcd < r ? xcd * (q + 1) : r * (q + 1) + (xcd - r) * q) + off; }
        const int nig = WGM * nN, gid = wgid / nig, fm = gid * WGM, gsz = (nM - fm) < WGM ? (nM - fm) : WGM;
        u.pm = fm + ((wgid % nig) % gsz); u.pn = (wgid % nig) / gsz; return true;
    }
    __device__ __forceinline__ void a_ready(const Unit&) const {}
    __device__ __forceinline__ void done(const Unit&) const {}
};

__device__ __forceinline__ unsigned cvt_pk_bf16(float lo, float hi) { unsigned r; asm volatile("v_cvt_pk_bf16_f32 %0, %1, %2" : "=v"(r) : "v"(lo), "v"(hi)); return r; }

struct EpiBf16 {
    static constexpr bool PERM = true, AFTER_DRAIN = false;
    bf16_t* O; int ldc;
    __device__ __forceinline__ void operator()(const f32x4 (&acc)[2][2][4][2], const Unit& u, int wr, int wc, int fr, int fq) const {
        const int row0 = u.pm * BM + wr * 64 + fr; const int col0 = u.pn * BM + wc * 32 + 8 * fq;
#pragma unroll
        for (int ai = 0; ai < 2; ++ai)
#pragma unroll
            for (int m = 0; m < 4; ++m) { bf16_t* rowp = O + (size_t)(row0 + ai * HALF + m * 16) * ldc + col0;
#pragma unroll
                for (int bj = 0; bj < 2; ++bj) { const f32x4 v0 = acc[ai][bj][m][0], v1 = acc[ai][bj][m][1];
                    u32x4 w; w.x = cvt_pk_bf16(v0[0], v0[1]); w.y = cvt_pk_bf16(v0[2], v0[3]); w.z = cvt_pk_bf16(v1[0], v1[1]); w.w = cvt_pk_bf16(v1[2], v1[3]);
                    *(u32x4*)(rowp + bj * HALF) = w; } }
    }
};
__device__ __forceinline__ float silu_mul(float g, float u) { return g * u * __builtin_amdgcn_rcpf(1.0f + __builtin_amdgcn_exp2f(-1.4426950408889634f * g)); }
struct EpiSwiGLU {
    static constexpr bool PERM = true, AFTER_DRAIN = false;
    bf16_t* O; int ldc;
    __device__ __forceinline__ void operator()(const f32x4 (&acc)[2][2][4][2], const Unit& u, int wr, int wc, int fr, int fq) const {
        const int row0 = u.pm * BM + wr * 64 + fr; const int col0 = u.pn * HALF + wc * 32 + 8 * fq;
#pragma unroll
        for (int ai = 0; ai < 2; ++ai)
#pragma unroll
            for (int m = 0; m < 4; ++m) { bf16_t* rowp = O + (size_t)(row0 + ai * HALF + m * 16) * ldc + col0;
                const f32x4 g0 = acc[ai][0][m][0], g1 = acc[ai][0][m][1], u0 = acc[ai][1][m][0], u1 = acc[ai][1][m][1];
                u32x4 w; w.x = cvt_pk_bf16(silu_mul(g0[0], u0[0]), silu_mul(g0[1], u0[1])); w.y = cvt_pk_bf16(silu_mul(g0[2], u0[2]), silu_mul(g0[3], u0[3]));
                w.z = cvt_pk_bf16(silu_mul(g1[0], u1[0]), silu_mul(g1[1], u1[1])); w.w = cvt_pk_bf16(silu_mul(g1[2], u1[2]), silu_mul(g1[3], u1[3]));
                *(u32x4*)rowp = w; }
    }
};
struct EpiResid {
    static constexpr bool PERM = false, AFTER_DRAIN = false;
    const float* hin; float* hout; int ldc; float alpha, s;
    __device__ __forceinline__ void operator()(const f32x4 (&acc)[2][2][4][2], const Unit& u, int wr, int wc, int fr, int fq) const {
        const int row0 = u.pm * BM + wr * 64 + fr, col0 = u.pn * BM + wc * 32 + 4 * fq;
#pragma unroll
        for (int ai = 0; ai < 2; ++ai)
#pragma unroll
            for (int m = 0; m < 4; ++m) { const size_t off = (size_t)(row0 + ai * HALF + m * 16) * ldc + col0;
#pragma unroll
                for (int bj = 0; bj < 2; ++bj)
#pragma unroll
                    for (int n = 0; n < 2; ++n) { const f32x4 hv = *(const f32x4*)(hin + off + bj * HALF + n * 16); *(f32x4*)(hout + off + bj * HALF + n * 16) = hv * alpha + acc[ai][bj][m][n] * s; } }
    }
};

template <class Epi, class Sched, bool ALIGN_EPI = false, bool SP2 = false>
__device__ __forceinline__ void gemm_phase(PG8_LAS unsigned char* lds, const Gemm g, const Sched& S, const Epi& E) {
    int tid_ = threadIdx.x; asm volatile("" : "+v"(tid_));
    const int tid = tid_, wid = __builtin_amdgcn_readfirstlane(tid >> 6), lane = tid & 63, wr = wid >> 2, wc = wid & 3, fr = lane & 15, fq = lane >> 4;
    const int K = g.K, nt = K / BK;
    unsigned voffA[2], voffB[2];
#pragma unroll
    for (int i = 0; i < 2; ++i) { int R, C; stage_rc(tid * 16 + i * 8192, R, C); const int Rb = Epi::PERM ? ((R & ~31) + perm32(R & 31)) : R;
        voffA[i] = (unsigned)(R * K + C) * 2u; voffB[i] = (unsigned)(Rb * K + C) * 2u; }
    const size_t kstep = (size_t)(BK * 2);
    const size_t hstep = (size_t)HALF * K * 2;
    const size_t tstep = 2 * hstep;
    const unsigned ldsw = (unsigned)wid * 1024u;
    const int aoff = lds_byte(wr * 64 + fr, fq * 8), boff = lds_byte(wc * 32 + fr, fq * 8);
#define PG8_SA(b, h) (((b) * 2 + (h)) * HTB)
#define PG8_SB(b, h) ((4 + (b) * 2 + (h)) * HTB)
#define PG8_STAGE(bufoff, gbase, voff) do { _Pragma("unroll") for (int _i = 0; _i < 2; ++_i) \
        __builtin_amdgcn_global_load_lds((const unsigned*)((const char*)(gbase) + (voff)[_i]), (PG8_LAS unsigned*)(lds + (bufoff) + ldsw + _i * 8192), 16, 0, 0); } while (0)
#define PG8_LDA(dst, b, h) do { _Pragma("unroll") for (int m = 0; m < 4; ++m) _Pragma("unroll") for (int k = 0; k < 2; ++k) dst[m][k] = *(const PG8_LAS bf16x8*)(lds + PG8_SA(b, h) + aoff + m * 2048 + k * 1024); } while (0)
#define PG8_LDB(dst, b, h) do { _Pragma("unroll") for (int n = 0; n < 2; ++n) _Pragma("unroll") for (int k = 0; k < 2; ++k) dst[n][k] = *(const PG8_LAS bf16x8*)(lds + PG8_SB(b, h) + boff + n * 2048 + k * 1024); } while (0)
#define PG8_MMA(ai, bj, At, Bt) do { __builtin_amdgcn_s_setprio(1); _Pragma("unroll") for (int m = 0; m < 4; ++m) _Pragma("unroll") for (int n = 0; n < 2; ++n) _Pragma("unroll") for (int k = 0; k < 2; ++k) \
        acc[ai][bj][m][n] = __builtin_amdgcn_mfma_f32_16x16x32_bf16(Bt[n][k], At[m][k], acc[ai][bj][m][n], 0, 0, 0); __builtin_amdgcn_s_setprio(0); } while (0)
#define PG8_WAIT_V(n) asm volatile("s_waitcnt vmcnt(" #n ")" ::: "memory")
#define PG8_WAIT_L(n) asm volatile("s_waitcnt lgkmcnt(" #n ")" ::: "memory")
#define PG8_BAR __builtin_amdgcn_s_barrier()
#define PG8_SCHED __builtin_amdgcn_sched_barrier(0)
    Unit cur, nxt; int ui = 0;
    if (!S.next(0, cur)) return;
    f32x4 acc[2][2][4][2];
#pragma unroll
    for (int a = 0; a < 2; ++a)
#pragma unroll
        for (int b = 0; b < 2; ++b)
#pragma unroll
            for (int m = 0; m < 4; ++m)
#pragma unroll
                for (int n = 0; n < 2; ++n) acc[a][b][m][n] = (f32x4){0.f, 0.f, 0.f, 0.f};
    bf16x8 At[4][2], B0[2][2], B1[2][2];
    const char* cA = (const char*)g.A + (size_t)cur.pm * tstep; const char* cB = (const char*)g.Bt + (size_t)cur.pn * tstep;
    S.a_ready(cur);
    if constexpr (SP2) {
        PG8_STAGE(PG8_SB(0, 0), cB, voffB); PG8_STAGE(PG8_SB(0, 1), cB + hstep, voffB); PG8_STAGE(PG8_SA(0, 0), cA, voffA); PG8_STAGE(PG8_SA(0, 1), cA + hstep, voffA);
        if (wr == 1) PG8_BAR;
        PG8_WAIT_V(2); PG8_BAR;
        PG8_STAGE(PG8_SB(1, 0), cB + kstep, voffB); PG8_STAGE(PG8_SA(1, 0), cA + kstep, voffA); PG8_STAGE(PG8_SB(1, 1), cB + hstep + kstep, voffB);
        PG8_WAIT_V(6); PG8_BAR;
    } else {
        PG8_STAGE(PG8_SB(0, 0), cB, voffB); PG8_STAGE(PG8_SA(0, 0), cA, voffA); PG8_STAGE(PG8_SB(0, 1), cB + hstep, voffB); PG8_STAGE(PG8_SA(0, 1), cA + hstep, voffA);
        if (wr == 1) PG8_BAR;
        PG8_WAIT_V(4); PG8_BAR;
        PG8_STAGE(PG8_SB(1, 0), cB + kstep, voffB); PG8_STAGE(PG8_SA(1, 0), cA + kstep, voffA); PG8_STAGE(PG8_SB(1, 1), cB + hstep + kstep, voffB);
        PG8_WAIT_V(6); PG8_BAR;
    }
    for (;;) {
        const bool has_next = S.next(ui + 1, nxt);
        const char* nA = has_next ? (const char*)g.A + (size_t)nxt.pm * tstep : cA; const char* nB = has_next ? (const char*)g.Bt + (size_t)nxt.pn * tstep : cB;
        for (int t = 0; t < nt; t += 2) {
            const bool last = (t == nt - 2);
            const char* a1 = cA + (size_t)(t + 1) * kstep;
            const char* a2 = last ? nA : cA + (size_t)(t + 2) * kstep; const char* b2 = last ? nB : cB + (size_t)(t + 2) * kstep;
            const char* a3 = a2 + kstep; const char* b3 = b2 + kstep;
            if (last && has_next) S.a_ready(nxt);
            if constexpr (SP2) {
            PG8_LDB(B0, 0, 0); PG8_LDB(B1, 0, 1); PG8_SCHED; PG8_LDA(At, 0, 0); PG8_STAGE(PG8_SA(1, 1), a1 + hstep, voffA);
            PG8_WAIT_V(8); PG8_WAIT_L(0); PG8_BAR; PG8_MMA(0, 0, At, B0); PG8_MMA(0, 1, At, B1); PG8_BAR; PG8_SCHED;
            PG8_LDA(At, 0, 1); PG8_STAGE(PG8_SB(0, 0), b2, voffB); PG8_STAGE(PG8_SB(0, 1), b2 + hstep, voffB); PG8_STAGE(PG8_SA(0, 0), a2, voffA);
            PG8_WAIT_V(8); PG8_WAIT_L(0); PG8_BAR; PG8_MMA(1, 0, At, B0); PG8_MMA(1, 1, At, B1); PG8_BAR; PG8_SCHED;
            PG8_LDB(B0, 1, 0); PG8_LDB(B1, 1, 1); PG8_SCHED; PG8_LDA(At, 1, 0); PG8_STAGE(PG8_SA(0, 1), a2 + hstep, voffA);
            PG8_WAIT_V(8); PG8_WAIT_L(0); PG8_BAR; PG8_MMA(0, 0, At, B0); PG8_MMA(0, 1, At, B1); PG8_BAR; PG8_SCHED;
            PG8_LDA(At, 1, 1); PG8_STAGE(PG8_SB(1, 0), b3, voffB); PG8_STAGE(PG8_SB(1, 1), b3 + hstep, voffB); PG8_STAGE(PG8_SA(1, 0), a3, voffA);
            PG8_WAIT_V(8); PG8_WAIT_L(0); PG8_BAR; PG8_MMA(1, 0, At, B0); PG8_MMA(1, 1, At, B1); PG8_BAR; PG8_SCHED;
            } else {
            PG8_LDB(B0, 0, 0); PG8_SCHED; PG8_LDA(At, 0, 0); PG8_STAGE(PG8_SA(1, 1), a1 + hstep, voffA);
            PG8_WAIT_L(8); PG8_BAR; PG8_WAIT_L(0); PG8_MMA(0, 0, At, B0); PG8_BAR; PG8_SCHED;
            PG8_LDB(B1, 0, 1); PG8_STAGE(PG8_SB(0, 0), b2, voffB);
            PG8_BAR; PG8_WAIT_L(0); PG8_MMA(0, 1, At, B1); PG8_BAR;
            PG8_LDA(At, 0, 1); PG8_STAGE(PG8_SA(0, 0), a2, voffA);
            PG8_BAR; PG8_WAIT_L(0); PG8_MMA(1, 0, At, B0); PG8_BAR; PG8_SCHED;
            PG8_STAGE(PG8_SB(0, 1), b2 + hstep, voffB);
            PG8_WAIT_V(6); PG8_BAR; PG8_MMA(1, 1, At, B1); PG8_BAR;
            PG8_LDB(B0, 1, 0); PG8_SCHED; PG8_LDA(At, 1, 0); PG8_STAGE(PG8_SA(0, 1), a2 + hstep, voffA);
            PG8_WAIT_L(8); PG8_BAR; PG8_WAIT_L(0); PG8_MMA(0, 0, At, B0); PG8_BAR; PG8_SCHED;
            PG8_LDB(B1, 1, 1); PG8_STAGE(PG8_SB(1, 0), b3, voffB);
            PG8_BAR; PG8_WAIT_L(0); PG8_MMA(0, 1, At, B1); PG8_BAR;
            PG8_LDA(At, 1, 1); PG8_STAGE(PG8_SA(1, 0), a3, voffA);
            PG8_BAR; PG8_WAIT_L(0); PG8_MMA(1, 0, At, B0); PG8_BAR; PG8_SCHED;
            PG8_STAGE(PG8_SB(1, 1), b3 + hstep, voffB);
            PG8_WAIT_V(6); PG8_BAR; PG8_MMA(1, 1, At, B1); PG8_BAR;
            }
        }
        if constexpr (ALIGN_EPI) { if (wr == 0) PG8_BAR; }
        if constexpr (!Epi::AFTER_DRAIN) { E(acc, cur, wr, wc, fr, fq); S.done(cur); }
        if (!has_next) break;
#pragma unroll
        for (int a = 0; a < 2; ++a)
#pragma unroll
            for (int b = 0; b < 2; ++b)
#pragma unroll
                for (int m = 0; m < 4; ++m)
#pragma unroll
                    for (int n = 0; n < 2; ++n) acc[a][b][m][n] = (f32x4){0.f, 0.f, 0.f, 0.f};
        cur = nxt; cA = nA; cB = nB; ++ui;
        if constexpr (ALIGN_EPI) { if (wr == 1) PG8_BAR; }
    }
    PG8_WAIT_V(0);
    if constexpr (!ALIGN_EPI) { if (wr == 0) PG8_BAR; }
    PG8_BAR;
#undef PG8_SA
#undef PG8_SB
#undef PG8_STAGE
#undef PG8_LDA
#undef PG8_LDB
#undef PG8_MMA
#undef PG8_WAIT_V
#undef PG8_WAIT_L
#undef PG8_BAR
#undef PG8_SCHED
}
}

#ifndef PG8_SP2
#define PG8_SP2 true
#endif
#ifndef PG8_ALIGN
#define PG8_ALIGN true
#endif

constexpr int NWAVES = 8;
constexpr int BATCH = 16, SEQ = 2048, DM = 2048, DFF = 5632, MTOK = BATCH * SEQ, DEPTH = 4;
constexpr float ALPHA = 1.6817928305074292f;
constexpr float LN_EPS = 1e-5f, RMS_EPS = 1e-6f;
constexpr int A_QKV = 3072, B_QKV = 9216, C_IN = 1344, C_INP = 1536, C_QL = 768, C_KVL = 512, C_Q = 3072, C_KV = 4096;

constexpr size_t MiB = 1u << 20;
constexpr size_t WS_CTL = 0, CTL_ZERO_BYTES = 1 * MiB;
constexpr size_t WS_TABB = 1 * MiB;
constexpr size_t WS_TABC = 2 * MiB;
constexpr size_t WS_TABA = 3 * MiB;
constexpr size_t WS_WT = 8 * MiB;
constexpr size_t WS_HB = 80 * MiB;
constexpr size_t WS_R = 208 * MiB;
constexpr size_t WS_END = WS_R + 900 * MiB;
constexpr size_t WT_FFN_OUT = (size_t)2 * DFF * DM;
constexpr size_t WT_A_OUT = (size_t)A_QKV * DM, WT_B_OUT = (size_t)B_QKV * DM;
constexpr size_t WT_C_QUP = (size_t)C_INP * DM, WT_C_KVUP = WT_C_QUP + (size_t)C_Q * C_QL, WT_C_OUT = WT_C_KVUP + (size_t)C_KV * C_KVL;
constexpr size_t R_ACT = 0;
constexpr size_t RA_QKV = 0, RA_ATT = 192 * MiB;
constexpr size_t RB_QKV = 0, RB_ATT = 576 * MiB;
constexpr size_t RC_IN = 0, RC_QN = 96 * MiB, RC_KVN = 144 * MiB, RC_KR = 176 * MiB, RC_Q = 192 * MiB, RC_KV = 384 * MiB, RC_ATT = 640 * MiB;
constexpr int CW_BAR = 4096;

constexpr int RING_OFF = 0, RING_BYTES = 131072;
constexpr int LDSCTL_OFF = RING_BYTES, MISC_OFF = LDSCTL_OFF + 320;
constexpr int LDS_BYTES = 147456;

#define GAS __attribute__((address_space(1)))
#define LAS __attribute__((address_space(3)))
typedef unsigned short bf16;
typedef unsigned v4u __attribute__((ext_vector_type(4)));
typedef unsigned v2u __attribute__((ext_vector_type(2)));
typedef float f32x4 __attribute__((ext_vector_type(4)));
typedef GAS unsigned gu32;
#define RLX_AGENT __ATOMIC_RELAXED, __HIP_MEMORY_SCOPE_AGENT
#define LDS_WAIT() asm volatile("s_waitcnt lgkmcnt(0)" ::: "memory")
#define VM_WAIT() asm volatile("s_waitcnt vmcnt(0)" ::: "memory")
__device__ __forceinline__ unsigned f2bf(float f) { unsigned u = __builtin_bit_cast(unsigned, f); return (u + 0x7fffu + ((u >> 16) & 1u)) >> 16; }
__device__ __forceinline__ unsigned pk2(float lo, float hi) { return f2bf(lo) | (f2bf(hi) << 16); }
__device__ __forceinline__ float bflo(unsigned w) { return __uint_as_float(w << 16); }
__device__ __forceinline__ float bfhi(unsigned w) { return __uint_as_float(w & 0xffff0000u); }
__device__ __forceinline__ float bf1(bf16 b) { return __uint_as_float(((unsigned)b) << 16); }

#define XB_TMO      128
#define XB_XCNT(j)  (256  + 64 * (j))
#define XB_XSUB(j)  (1280 + 64 * (j))
#define XB_XGEN(j)  (2304 + 64 * (j))
#define XB_TOP      3328
#define XB_TOPGEN   3392
#define XCD_BAR_WORDS 3456
#define XB_SPIN_CAP (1u << 22)
__device__ __forceinline__ unsigned xb_ld(unsigned* p)              { return __hip_atomic_load(p, __ATOMIC_RELAXED, __HIP_MEMORY_SCOPE_AGENT); }
__device__ __forceinline__ unsigned xb_add(unsigned* p, unsigned v) { return __hip_atomic_fetch_add(p, v, __ATOMIC_RELAXED, __HIP_MEMORY_SCOPE_AGENT); }
__device__ __forceinline__ unsigned xb_xcc_id() { return (unsigned)__builtin_amdgcn_s_getreg((3 << 11) | 20) & 0xFu; }
#define XB_SPIN(cond, bar) do { unsigned _sp = 0; while (cond) { __builtin_amdgcn_s_sleep(1); \
    if ((++_sp & 255u) == 0u) { if (xb_ld(&(bar)[XB_TMO])) break; if (_sp > XB_SPIN_CAP) { atomicAdd(&(bar)[XB_TMO], 1u); break; } } } } while (0)
struct XcdBarrier { unsigned* bar; unsigned x; volatile LAS unsigned* st; };
__device__ __forceinline__ XcdBarrier xcd_barrier_post(unsigned* bar, volatile LAS unsigned* st) {
    XcdBarrier b; b.bar = bar; b.x = xb_xcc_id(); b.st = st;
    if (threadIdx.x == 0) (void)xb_add(&bar[XB_XCNT(b.x)], 1u);
    return b;
}
__device__ __forceinline__ void xcd_barrier_complete(unsigned* bar, unsigned x, unsigned& nloc, unsigned& nx) {
    const unsigned G = gridDim.x * gridDim.y * gridDim.z;
    unsigned sum, cnt, mine, sp = 0u;
    for (;;) {
        sum = 0u; cnt = 0u; mine = 0u;
#pragma unroll
        for (unsigned j = 0; j < 16; ++j) { const unsigned c = xb_ld(&bar[XB_XCNT(j)]); sum += c; cnt += (c > 0u) ? 1u : 0u; mine = (j == x) ? c : mine; }
        if (sum == G) break;
        __builtin_amdgcn_s_sleep(1);
        if ((++sp & 255u) == 0u) { if (xb_ld(&bar[XB_TMO])) break; if (sp > XB_SPIN_CAP) { atomicAdd(&bar[XB_TMO], 1u); break; } }
    }
    nloc = mine > 0u ? mine : 1u; nx = cnt > 0u ? cnt : 1u;
}
__device__ __forceinline__ void xcd_barrier(const XcdBarrier& b) {
    asm volatile("s_waitcnt vmcnt(0)" ::: "memory");
    __syncthreads();
    if (threadIdx.x == 0) {
        unsigned* bar = b.bar;
        __builtin_amdgcn_s_waitcnt(0);
        unsigned nloc = b.st[0], nx = b.st[1];
        if (nloc == 0u) { xcd_barrier_complete(bar, b.x, nloc, nx); b.st[0] = nloc; b.st[1] = nx; }
        const unsigned old = xb_add(&bar[XB_XSUB(b.x)], 1u);
        const unsigned gen = old / nloc;
        if (old + 1u == (gen + 1u) * nloc) {
            __builtin_amdgcn_fence(__ATOMIC_RELEASE, "agent");
            asm volatile("s_waitcnt vmcnt(0)" ::: "memory");
            const unsigned og = xb_add(&bar[XB_TOP], 1u);
            const unsigned tg = og / nx;
            if (og + 1u == (tg + 1u) * nx) xb_add(&bar[XB_TOPGEN], 1u);
            else XB_SPIN(xb_ld(&bar[XB_TOPGEN]) == tg, bar);
            __builtin_amdgcn_fence(__ATOMIC_ACQUIRE, "agent");
            xb_add(&bar[XB_XGEN(b.x)], 1u);
            asm volatile("s_waitcnt vmcnt(0)" ::: "memory");
        } else {
            XB_SPIN(xb_ld(&bar[XB_XGEN(b.x)]) == gen, bar);
            __builtin_amdgcn_fence(__ATOMIC_ACQUIRE, "agent");
            asm volatile("s_waitcnt vmcnt(0)" ::: "memory");
        }
    }
    __syncthreads();
}

template <class T> __device__ __forceinline__ T* lnd(T* p) { asm volatile("" : "+s"(p)); return p; }
__device__ __forceinline__ float wave_sum(float v) {
#pragma unroll
    for (int o = 1; o < 64; o <<= 1) v += __shfl_xor(v, o);
    return v;
}
__device__ __forceinline__ void cvt_weight(const float* W, int K, int Nsrc, bf16* WT, int Ndst, int kind, LAS float* scr, int gw, int NGW, int lane) {
    asm volatile("" : "+v"(lane));
    const int nblk = Ndst / 32, nitems = (K / 64) * nblk;
    for (int item = gw; item < nitems; item += NGW) {
        const int kb = item / nblk, nb = item % nblk, k0 = 64 * kb, n0 = 32 * nb;
        int c0;
        if (kind == 1) { const int t = n0 >> 8, r = n0 & 255; c0 = (r >> 7) * DFF + 128 * t + (r & 127); }
        else c0 = (n0 < Nsrc) ? n0 : -1;
        if (c0 >= 0) {
#pragma unroll 8
            for (int i = 0; i < 32; ++i) { const int kk = 2 * i + (lane >> 5); scr[kk * 33 + (lane & 31)] = W[(size_t)(k0 + kk) * Nsrc + c0 + (lane & 31)]; }
        } else {
#pragma unroll 8
            for (int i = 0; i < 32; ++i) { const int kk = 2 * i + (lane >> 5); scr[kk * 33 + (lane & 31)] = 0.f; }
        }
        LDS_WAIT(); asm volatile("" ::: "memory");
        const int c = lane & 7;
#pragma unroll
        for (int j = 0; j < 4; ++j) { const int n = (lane >> 3) + 8 * j; const LAS float* s = scr + (8 * c) * 33 + n;
            v4u o; o.x = pk2(s[0 * 33], s[1 * 33]); o.y = pk2(s[2 * 33], s[3 * 33]); o.z = pk2(s[4 * 33], s[5 * 33]); o.w = pk2(s[6 * 33], s[7 * 33]);
            *(GAS v4u*)(WT + (size_t)(n0 + n) * K + k0 + 8 * c) = o; }
        LDS_WAIT(); asm volatile("" ::: "memory");
    }
}
__device__ __forceinline__ void ln_rows(float* H, bf16* HBo, const float* g, const float* b, int gw, int NGW, int lane) {
    asm volatile("" : "+v"(lane));
    for (int m = gw; m < MTOK; m += NGW) {
        GAS f32x4* xr = (GAS f32x4*)(H + (size_t)m * DM) + 2 * lane;
        f32x4 v[8]; float s = 0.f;
#pragma unroll
        for (int j = 0; j < 4; ++j) { v[2 * j] = xr[128 * j]; v[2 * j + 1] = xr[128 * j + 1]; }
#pragma unroll
        for (int j = 0; j < 8; ++j) s += (v[j].x + v[j].y) + (v[j].z + v[j].w);
        const float mean = wave_sum(s) * (1.f / DM); float s2 = 0.f;
#pragma unroll
        for (int j = 0; j < 8; ++j) { v[j] = v[j] - mean; s2 += (v[j].x * v[j].x + v[j].y * v[j].y) + (v[j].z * v[j].z + v[j].w * v[j].w); }
        const float rstd = 1.f / sqrtf(wave_sum(s2) * (1.f / DM) + LN_EPS);
        GAS v4u* ob = (GAS v4u*)(HBo + (size_t)m * DM) + lane;
#pragma unroll
        for (int j = 0; j < 4; ++j) {
            const f32x4 g0 = *((const f32x4*)g + 128 * j + 2 * lane), g1 = *((const f32x4*)g + 128 * j + 2 * lane + 1);
            const f32x4 b0 = *((const f32x4*)b + 128 * j + 2 * lane), b1 = *((const f32x4*)b + 128 * j + 2 * lane + 1);
            const f32x4 y0 = v[2 * j] * rstd * g0 + b0, y1 = v[2 * j + 1] * rstd * g1 + b1;
            xr[128 * j] = y0; xr[128 * j + 1] = y1;
            v4u o; o.x = pk2(y0.x, y0.y); o.y = pk2(y0.z, y0.w); o.z = pk2(y1.x, y1.y); o.w = pk2(y1.z, y1.w);
            ob[64 * j] = o;
        }
    }
}
__device__ __forceinline__ void cvt_rows_bf16(const float* X, bf16* O, size_t n8, size_t gt, size_t NGT) {
    for (size_t i = gt; i < n8; i += NGT) { const f32x4 a = *((const GAS f32x4*)X + 2 * i), c = *((const GAS f32x4*)X + 2 * i + 1);
        v4u o; o.x = pk2(a.x, a.y); o.y = pk2(a.z, a.w); o.z = pk2(c.x, c.y); o.w = pk2(c.z, c.w); *((GAS v4u*)O + i) = o; }
}
__device__ __forceinline__ void sincos_tab(float ang, float& c, float& s) {
    const double x = (double)ang; const double k = __builtin_rint(x * 0.15915494309189533577); const double r = x - k * 6.28318530717958647692;
    const double r2 = r * r; double sn = 0.0, cs = 0.0;
#pragma unroll
    for (int n = 14; n >= 0; --n) { sn = sn * (-r2) / (double)((2 * n + 2) * (2 * n + 3)) + 1.0; cs = cs * (-r2) / (double)((2 * n + 1) * (2 * n + 2)) + 1.0; }
    s = (float)(sn * r); c = (float)cs;
}
__device__ __forceinline__ void build_tables(unsigned char* ws, size_t gt, size_t NGT) {
    float* cb = (float*)(ws + WS_TABB); float* sb = cb + 2048 * 64;
    for (size_t i = gt; i < 2048 * 64; i += NGT) { const int pos = (int)(i >> 6), f = (int)(i & 63); const float inv = __builtin_amdgcn_exp2f(-13.287712379549449f * ((float)(2 * f) / 128.0f)); float c, s; sincos_tab((float)pos * inv, c, s); cb[i] = c; sb[i] = s; }
    float* cc = (float*)(ws + WS_TABC); float* sc = cc + 2048 * 32;
    for (size_t i = gt; i < 2048 * 32; i += NGT) { const int pos = (int)(i >> 5), f = (int)(i & 31); const float inv = __builtin_amdgcn_exp2f(-13.287712379549449f * ((float)(2 * f) / 64.0f)); float c, s; sincos_tab((float)pos * inv, c, s); cc[i] = c; sc[i] = s; }
    float* ca = (float*)(ws + WS_TABA); float* sa = ca + 64 * 32;
    for (size_t i = gt; i < 64 * 32; i += NGT) { const int pos = (int)(i >> 5), f = (int)(i & 31); const float inv = __builtin_amdgcn_exp2f(-13.287712379549449f * ((float)(2 * f) / 64.0f)); float c, s; sincos_tab((float)pos * inv, c, s); ca[i] = c; sa[i] = s; }
}

__device__ __forceinline__ void prep_a(bf16* QKV, const float* qg, const float* kg, const unsigned char* ws, int gw, int NGW, int lane) {
    asm volatile("" : "+v"(lane));
    const float* ca = (const float*)(ws + WS_TABA); const float* sa = ca + 64 * 32;
    const int half = lane >> 5, i = lane & 31, ia = 64 * half + i, ib = ia + 32;
    const float gqa = qg[ia], gqb = qg[ib], gka = kg[ia], gkb = kg[ib];
    for (int tok = gw; tok < MTOK; tok += NGW) {
        const int s = tok & (SEQ - 1), pos = half ? (s & 63) : (s >> 6);
        const float c = ca[pos * 32 + i], sn = sa[pos * 32 + i];
        bf16* row = QKV + (size_t)tok * A_QKV;
#pragma unroll 4
        for (int h = 0; h < 20; ++h) {
            bf16* p = row + h * 128;
            float a = bf1(p[ia]), b = bf1(p[ib]);
            const float ss = wave_sum(a * a + b * b);
            const float r = 1.f / sqrtf(ss * (1.f / 128.f) + RMS_EPS);
            a = a * r * (h < 16 ? gqa : gka); b = b * r * (h < 16 ? gqb : gkb);
            p[ia] = (bf16)f2bf(a * c - b * sn); p[ib] = (bf16)f2bf(a * sn + b * c);
        }
    }
}
__device__ __forceinline__ void prep_b(bf16* QKV, const unsigned char* ws, int gw, int NGW, int lane) {
    asm volatile("" : "+v"(lane));
    const float* cb = (const float*)(ws + WS_TABB); const float* sb = cb + 2048 * 64;
    for (int tok = gw; tok < MTOK; tok += NGW) {
        const int s = tok & (SEQ - 1);
        const float c = cb[s * 64 + lane], sn = sb[s * 64 + lane];
        bf16* row = QKV + (size_t)tok * B_QKV;
#pragma unroll 4
        for (int j = 0; j < 48; ++j) {
            const int g = j >> 4, t = (j >> 3) & 1, h = j & 7;
            bf16* p = row + g * 3072 + t * 1024 + h * 128;
            const float a = bf1(p[lane]), b = bf1(p[lane + 64]);
            p[lane] = (bf16)f2bf(a * c - b * sn); p[lane + 64] = (bf16)f2bf(a * sn + b * c);
        }
    }
}
__device__ __forceinline__ void prep_c1(const bf16* CIN, bf16* CQN, bf16* CKVN, bf16* KR, const float* qg, const float* kvg, const unsigned char* ws, int gw, int NGW, int lane) {
    asm volatile("" : "+v"(lane));
    const float* cc = (const float*)(ws + WS_TABC); const float* sc = cc + 2048 * 32;
    for (int tok = gw; tok < MTOK; tok += NGW) {
        const bf16* row = CIN + (size_t)tok * C_INP;
        { float v[12]; float ss = 0.f;
#pragma unroll
          for (int j = 0; j < 12; ++j) { v[j] = bf1(row[j * 64 + lane]); ss += v[j] * v[j]; }
          const float r = 1.f / sqrtf(wave_sum(ss) * (1.f / 768.f) + RMS_EPS);
#pragma unroll
          for (int j = 0; j < 12; ++j) CQN[(size_t)tok * C_QL + j * 64 + lane] = (bf16)f2bf(v[j] * r * qg[j * 64 + lane]); }
        { float v[8]; float ss = 0.f;
#pragma unroll
          for (int j = 0; j < 8; ++j) { v[j] = bf1(row[768 + j * 64 + lane]); ss += v[j] * v[j]; }
          const float r = 1.f / sqrtf(wave_sum(ss) * (1.f / 512.f) + RMS_EPS);
#pragma unroll
          for (int j = 0; j < 8; ++j) CKVN[(size_t)tok * C_KVL + j * 64 + lane] = (bf16)f2bf(v[j] * r * kvg[j * 64 + lane]); }
        if (lane < 32) { const int s = tok & (SEQ - 1); const float c = cc[s * 32 + lane], sn = sc[s * 32 + lane];
          const float a = bf1(row[1280 + lane]), b = bf1(row[1280 + 32 + lane]);
          KR[(size_t)tok * 64 + lane] = (bf16)f2bf(a * c - b * sn); KR[(size_t)tok * 64 + 32 + lane] = (bf16)f2bf(a * sn + b * c); }
    }
}
__device__ __forceinline__ void prep_c2(bf16* Q, const unsigned char* ws, int gw, int NGW, int lane) {
    asm volatile("" : "+v"(lane));
    const float* cc = (const float*)(ws + WS_TABC); const float* sc = cc + 2048 * 32;
    const int i = lane & 31, hh = lane >> 5;
    for (int tok = gw; tok < MTOK; tok += NGW) {
        const int s = tok & (SEQ - 1); const float c = cc[s * 32 + i], sn = sc[s * 32 + i];
        bf16* row = Q + (size_t)tok * C_Q;
#pragma unroll
        for (int j = 0; j < 8; ++j) { bf16* p = row + (2 * j + hh) * 192 + 128; const float a = bf1(p[i]), b = bf1(p[i + 32]);
            p[i] = (bf16)f2bf(a * c - b * sn); p[i + 32] = (bf16)f2bf(a * sn + b * c); }
    }
}

struct NState { float m, l, o[8]; };
__device__ __forceinline__ void nst_init(NState& S) { S.m = -1e30f; S.l = 0.f;
#pragma unroll
    for (int j = 0; j < 8; ++j) S.o[j] = 0.f; }
__device__ __forceinline__ void nst_update(NState& S, float s, bool valid, const v4u vv) {
    const float mn = valid ? fmaxf(S.m, s) : S.m; const float al = __builtin_amdgcn_exp2f(S.m - mn); const float p = valid ? __builtin_amdgcn_exp2f(s - mn) : 0.f;
    S.l = S.l * al + p; S.m = mn;
    S.o[0] = S.o[0] * al + p * bflo(vv.x); S.o[1] = S.o[1] * al + p * bfhi(vv.x); S.o[2] = S.o[2] * al + p * bflo(vv.y); S.o[3] = S.o[3] * al + p * bfhi(vv.y);
    S.o[4] = S.o[4] * al + p * bflo(vv.z); S.o[5] = S.o[5] * al + p * bfhi(vv.z); S.o[6] = S.o[6] * al + p * bflo(vv.w); S.o[7] = S.o[7] * al + p * bfhi(vv.w);
}
__device__ __forceinline__ void nst_finish(NState& S, bf16* out, int lane) {
#pragma unroll
    for (int x = 16; x <= 32; x <<= 1) {
        const float m2 = __shfl_xor(S.m, x), l2 = __shfl_xor(S.l, x); const float mn = fmaxf(S.m, m2); const float a = __builtin_amdgcn_exp2f(S.m - mn), b = __builtin_amdgcn_exp2f(m2 - mn);
        S.l = S.l * a + l2 * b; S.m = mn;
#pragma unroll
        for (int j = 0; j < 8; ++j) { const float o2 = __shfl_xor(S.o[j], x); S.o[j] = S.o[j] * a + o2 * b; }
    }
    if (lane < 16) { const float rl = 1.f / S.l; v4u w; w.x = pk2(S.o[0] * rl, S.o[1] * rl); w.y = pk2(S.o[2] * rl, S.o[3] * rl); w.z = pk2(S.o[4] * rl, S.o[5] * rl); w.w = pk2(S.o[6] * rl, S.o[7] * rl);
        *(GAS v4u*)(out + lane * 8) = w; }
}
__device__ __forceinline__ float dot8(const float (&q)[8], const v4u k) {
    return q[0] * bflo(k.x) + q[1] * bfhi(k.x) + q[2] * bflo(k.y) + q[3] * bfhi(k.y) + q[4] * bflo(k.z) + q[5] * bfhi(k.z) + q[6] * bflo(k.w) + q[7] * bfhi(k.w);
}
__device__ __forceinline__ float red16(float s) { s += __shfl_xor(s, 1); s += __shfl_xor(s, 2); s += __shfl_xor(s, 4); s += __shfl_xor(s, 8); return s; }
__device__ __forceinline__ void ldq8(float (&q)[8], const bf16* p, float sc) { const v4u w = *(const GAS v4u*)p;
    q[0] = bflo(w.x) * sc; q[1] = bfhi(w.x) * sc; q[2] = bflo(w.y) * sc; q[3] = bfhi(w.y) * sc; q[4] = bflo(w.z) * sc; q[5] = bfhi(w.z) * sc; q[6] = bflo(w.w) * sc; q[7] = bfhi(w.w) * sc; }

__device__ __forceinline__ void naive_attn_a(const bf16* QKV, bf16* ATT, int gw, int NGW, int lane) {
    asm volatile("" : "+v"(lane));
    const int g = lane >> 4, i = lane & 15; const float sc = 0.08838834764831845f * 1.4426950408889634f;
    for (int p = gw; p < MTOK * 16; p += NGW) {
        const int tok = p >> 4, h = p & 15, b = tok >> 11;
        float q[8]; ldq8(q, QKV + (size_t)tok * A_QKV + h * 128 + i * 8, sc);
        const bf16* kb = QKV + (size_t)(b * SEQ) * A_QKV + 2048 + (h >> 2) * 128 + i * 8;
        NState S; nst_init(S);
        for (int t0 = 0; t0 < SEQ; t0 += 4) { const bf16* kp = kb + (size_t)(t0 + g) * A_QKV; const v4u kk = *(const GAS v4u*)kp, vv = *(const GAS v4u*)(kp + 512);
            nst_update(S, red16(dot8(q, kk)), true, vv); }
        nst_finish(S, ATT + (size_t)tok * DM + h * 128, lane);
    }
}
__device__ __forceinline__ void naive_attn_b(const bf16* QKV, bf16* ATT, int gw, int NGW, int lane) {
    asm volatile("" : "+v"(lane));
    const int g = lane >> 4, i = lane & 15; const float sc = 0.08838834764831845f * 1.4426950408889634f;
    for (int p = gw; p < MTOK * 8; p += NGW) {
        const int tok = p >> 3, h = p & 7, s = tok & (SEQ - 1);
        NState S; nst_init(S);
        for (int grp = 0; grp < 3; ++grp) {
            const int dil = grp == 0 ? 1 : (grp == 1 ? 4 : 16);
            float q[8]; ldq8(q, QKV + (size_t)tok * B_QKV + grp * 3072 + h * 128 + i * 8, sc);
            for (int j0 = -64; j0 <= 64; j0 += 4) { const int j = j0 + g; const int t = s + j * dil; const bool valid = (j <= 64) && (t >= 0) && (t < SEQ);
                const int tc = valid ? t : s; const bf16* kp = QKV + (size_t)(tok - s + tc) * B_QKV + grp * 3072 + 1024 + h * 128 + i * 8;
                const v4u kk = *(const GAS v4u*)kp, vv = *(const GAS v4u*)(kp + 1024);
                nst_update(S, red16(dot8(q, kk)), valid, vv); }
        }
        nst_finish(S, ATT + (size_t)tok * 1024 + h * 128, lane);
    }
}
__device__ __forceinline__ void naive_attn_c(const bf16* Q, const bf16* KV, const bf16* KR, bf16* ATT, int gw, int NGW, int lane) {
    asm volatile("" : "+v"(lane));
    const int g = lane >> 4, i = lane & 15; const float sc = 0.07216878364870322f * 1.4426950408889634f;
    for (int p = gw; p < MTOK * 16; p += NGW) {
        const int tok = p >> 4, h = p & 15, b = tok >> 11;
        float q[8]; ldq8(q, Q + (size_t)tok * C_Q + h * 192 + i * 8, sc);
        float qr[4]; { const v2u w = *(const GAS v2u*)(Q + (size_t)tok * C_Q + h * 192 + 128 + i * 4); qr[0] = bflo(w.x) * sc; qr[1] = bfhi(w.x) * sc; qr[2] = bflo(w.y) * sc; qr[3] = bfhi(w.y) * sc; }
        const bf16* kb = KV + (size_t)(b * SEQ) * C_KV + h * 256 + i * 8; const bf16* rb = KR + (size_t)(b * SEQ) * 64 + i * 4;
        NState S; nst_init(S);
        for (int t0 = 0; t0 < SEQ; t0 += 4) { const bf16* kp = kb + (size_t)(t0 + g) * C_KV; const v4u kk = *(const GAS v4u*)kp, vv = *(const GAS v4u*)(kp + 128);
            const v2u kr = *(const GAS v2u*)(rb + (size_t)(t0 + g) * 64);
            const float d = dot8(q, kk) + qr[0] * bflo(kr.x) + qr[1] * bfhi(kr.x) + qr[2] * bflo(kr.y) + qr[3] * bfhi(kr.y);
            nst_update(S, red16(d), true, vv); }
        nst_finish(S, ATT + (size_t)tok * DM + h * 128, lane);
    }
}

constexpr int N_IN = 57;
struct Args { const float* in[N_IN]; float* out; unsigned char* ws; int ph_lo, ph_hi; };
constexpr int N_PHASES = 1 + 4 * 8 + 3 + 3 + 5 + 3;

__global__ void __launch_bounds__(NWAVES * 64, 2) mega_fwd(Args args) {
    extern __shared__ __attribute__((aligned(16))) unsigned char lds_raw[];
    LAS unsigned char* lds = (LAS unsigned char*)lds_raw;
    volatile LAS unsigned* MISC = (volatile LAS unsigned*)(lds + MISC_OFF);
    const int tid = threadIdx.x, lane = tid & 63, wave = __builtin_amdgcn_readfirstlane(tid >> 6);
    const int G = gridDim.x; const int bx = blockIdx.x; const int vcu = (G % 8 == 0) ? (bx % 8) * (G / 8) + bx / 8 : bx;
    const int gw = vcu * NWAVES + wave, NGW = G * NWAVES;
    const size_t gt = (size_t)vcu * (NWAVES * 64) + tid, NGT = (size_t)G * NWAVES * 64;
    unsigned char* ws = args.ws;
    gu32* ctl = (gu32*)(ws + WS_CTL);
    for (int u = tid; u < (LDS_BYTES - LDSCTL_OFF) / 4; u += NWAVES * 64) ((LAS unsigned*)(lds + LDSCTL_OFF))[u] = 0u;
    __syncthreads();
    XcdBarrier bar; bar.bar = (unsigned*)(ctl + CW_BAR); bar.x = 0; bar.st = nullptr;
    if (!MK_PER_PHASE) bar = xcd_barrier_post((unsigned*)(ctl + CW_BAR), MISC + 8);
    const int lo = args.ph_lo, hi = args.ph_hi;
    int ph = 0;
#define IN_PH() (lo <= ph && ph < hi)
#define SEAM() do { if (!MK_PER_PHASE) { if (lo <= ph && ph + 1 < hi) xcd_barrier(bar); } ++ph; } while (0)

    bf16* WT = (bf16*)(ws + WS_WT); bf16* HB = (bf16*)(ws + WS_HB); unsigned char* R = ws + WS_R;
    float* H32 = args.out;
    LAS float* scr = (LAS float*)(lds + RING_OFF + wave * 16384);

    if (IN_PH()) {
        build_tables(ws, gt, NGT);
        cvt_rows_bf16(args.in[0], HB, (size_t)MTOK * DM / 8, gt, NGT);
        cvt_weight(args.in[1], DM, 2 * DFF, WT, 2 * DFF, 1, scr, gw, NGW, lane);
        cvt_weight(args.in[2], DFF, DM, WT + WT_FFN_OUT, DM, 0, scr, gw, NGW, lane);
    }
    SEAM();

    for (int L = 0; L < DEPTH; ++L) {
        const int kind = (L == 3) ? 0 : L;
        const int base = (L == 0) ? 1 : (L == 1) ? 15 : (L == 2) ? 27 : 43;
        const int nmix = (kind == 0) ? 4 : (kind == 1) ? 2 : 6;
        for (int sub = 0; sub < 3; ++sub) {
            if (sub != 1) {
                if (IN_PH()) {
                    pg8::Gemm g{lnd(HB), lnd(WT), MTOK, 2 * DFF, DM}; pg8::StaticOrder S; S.init(MTOK, 2 * DFF, G, bx);
                    pg8::EpiSwiGLU E{lnd((bf16*)(R + R_ACT)), DFF};
                    pg8::gemm_phase<pg8::EpiSwiGLU, pg8::StaticOrder, PG8_ALIGN, PG8_SP2>(lds + RING_OFF, g, S, E);
                }
                SEAM();
            } else {
                if (IN_PH()) {
                    const int N = (kind == 0) ? A_QKV : (kind == 1) ? B_QKV : C_INP;
                    pg8::Gemm g{lnd(HB), lnd(WT), MTOK, N, DM}; pg8::StaticOrder S; S.init(MTOK, N, G, bx);
                    pg8::EpiBf16 E{lnd((bf16*)(R + 0)), N};
                    pg8::gemm_phase<pg8::EpiBf16, pg8::StaticOrder, PG8_ALIGN, PG8_SP2>(lds + RING_OFF, g, S, E);
                }
                SEAM();
                if (kind == 0) {
                    if (IN_PH()) prep_a((bf16*)(R + RA_QKV), args.in[base + 5], args.in[base + 6], ws, gw, NGW, lane);
                    SEAM();
                    if (IN_PH()) naive_attn_a((const bf16*)(R + RA_QKV), (bf16*)(R + RA_ATT), gw, NGW, lane);
                    SEAM();
                } else if (kind == 1) {
                    if (IN_PH()) prep_b((bf16*)(R + RB_QKV), ws, gw, NGW, lane);
                    SEAM();
                    if (IN_PH()) naive_attn_b((const bf16*)(R + RB_QKV), (bf16*)(R + RB_ATT), gw, NGW, lane);
                    SEAM();
                } else {
                    if (IN_PH()) prep_c1((const bf16*)(R + RC_IN), (bf16*)(R + RC_QN), (bf16*)(R + RC_KVN), (bf16*)(R + RC_KR), args.in[base + 5], args.in[base + 6], ws, gw, NGW, lane);
                    SEAM();
                    if (IN_PH()) {
                        { pg8::Gemm g{lnd((const bf16*)(R + RC_QN)), lnd(WT + WT_C_QUP), MTOK, C_Q, C_QL}; pg8::StaticOrder S; S.init(MTOK, C_Q, G, bx);
                          pg8::EpiBf16 E{lnd((bf16*)(R + RC_Q)), C_Q};
                          pg8::gemm_phase<pg8::EpiBf16, pg8::StaticOrder, PG8_ALIGN, PG8_SP2>(lds + RING_OFF, g, S, E); }
                        { pg8::Gemm g{lnd((const bf16*)(R + RC_KVN)), lnd(WT + WT_C_KVUP), MTOK, C_KV, C_KVL}; pg8::StaticOrder S; S.init(MTOK, C_KV, G, bx);
                          pg8::EpiBf16 E{lnd((bf16*)(R + RC_KV)), C_KV};
                          pg8::gemm_phase<pg8::EpiBf16, pg8::StaticOrder, PG8_ALIGN, PG8_SP2>(lds + RING_OFF, g, S, E); }
                    }
                    SEAM();
                    if (IN_PH()) prep_c2((bf16*)(R + RC_Q), ws, gw, NGW, lane);
                    SEAM();
                    if (IN_PH()) naive_attn_c((const bf16*)(R + RC_Q), (const bf16*)(R + RC_KV), (const bf16*)(R + RC_KR), (bf16*)(R + RC_ATT), gw, NGW, lane);
                    SEAM();
                }
            }
            if (IN_PH()) {
                const bf16* A; const bf16* Bt; int K; float s;
                if (sub != 1) { A = (const bf16*)(R + R_ACT); Bt = WT + WT_FFN_OUT; K = DFF; s = 0.5f; }
                else if (kind == 0) { A = (const bf16*)(R + RA_ATT); Bt = WT + WT_A_OUT; K = DM; s = 1.0f; }
                else if (kind == 1) { A = (const bf16*)(R + RB_ATT); Bt = WT + WT_B_OUT; K = 1024; s = 1.0f; }
                else { A = (const bf16*)(R + RC_ATT); Bt = WT + WT_C_OUT; K = DM; s = 1.0f; }
                pg8::Gemm g{lnd(A), lnd(Bt), MTOK, DM, K}; pg8::StaticOrder S; S.init(MTOK, DM, G, bx);
                pg8::EpiResid E{lnd((L == 0 && sub == 0) ? args.in[0] : (const float*)H32), lnd(H32), DM, ALPHA, s};
                pg8::gemm_phase<pg8::EpiResid, pg8::StaticOrder, PG8_ALIGN, PG8_SP2>(lds + RING_OFF, g, S, E);
            }
            SEAM();
            if (IN_PH()) {
                const int lnidx = (sub == 0) ? base + 2 : (sub == 1) ? base + 4 + nmix : base + 8 + nmix;
                ln_rows(H32, HB, args.in[lnidx], args.in[lnidx + 1], gw, NGW, lane);
                if (sub == 0) {
                    if (kind == 0) { cvt_weight(args.in[base + 4], DM, A_QKV, WT, A_QKV, 0, scr, gw, NGW, lane); cvt_weight(args.in[base + 7], DM, DM, WT + WT_A_OUT, DM, 0, scr, gw, NGW, lane); }
                    else if (kind == 1) { cvt_weight(args.in[base + 4], DM, B_QKV, WT, B_QKV, 0, scr, gw, NGW, lane); cvt_weight(args.in[base + 5], 1024, DM, WT + WT_B_OUT, DM, 0, scr, gw, NGW, lane); }
                    else { cvt_weight(args.in[base + 4], DM, C_IN, WT, C_INP, 0, scr, gw, NGW, lane); cvt_weight(args.in[base + 7], C_QL, C_Q, WT + WT_C_QUP, C_Q, 0, scr, gw, NGW, lane);
                           cvt_weight(args.in[base + 8], C_KVL, C_KV, WT + WT_C_KVUP, C_KV, 0, scr, gw, NGW, lane); cvt_weight(args.in[base + 9], DM, DM, WT + WT_C_OUT, DM, 0, scr, gw, NGW, lane); }
                } else {
                    int wi = -1;
                    if (sub == 1) wi = base + 6 + nmix;
                    else if (L + 1 < DEPTH) wi = ((L + 1 == 1) ? 15 : (L + 1 == 2) ? 27 : 43);
                    if (wi >= 0) { cvt_weight(args.in[wi], DM, 2 * DFF, WT, 2 * DFF, 1, scr, gw, NGW, lane); cvt_weight(args.in[wi + 1], DFF, DM, WT + WT_FFN_OUT, DM, 0, scr, gw, NGW, lane); }
                }
            }
            SEAM();
        }
    }
#undef IN_PH
#undef SEAM
}

extern "C" void kernel_launch(void* const* d_in, const int* in_sizes, int n_in, void* d_out, int out_size, void* d_ws, size_t ws_size, hipStream_t stream) {
    static int grid = 0;
    if (grid == 0) {
        if (n_in != N_IN || in_sizes[0] != MTOK * DM || out_size != MTOK * DM || ws_size < WS_END) {
            fprintf(stderr, "kernel_launch: shape mismatch: n_in %d in0 %d out %d ws %zu (need >= %zu)\n", n_in, n_in > 0 ? in_sizes[0] : -1, out_size, ws_size, (size_t)WS_END); grid = -1; return; }
        int dev = 0, cus = 0, per_cu = 0;
        if (hipGetDevice(&dev) != hipSuccess || hipDeviceGetAttribute(&cus, hipDeviceAttributeMultiprocessorCount, dev) != hipSuccess) { fprintf(stderr, "kernel_launch: device query failed\n"); grid = -1; return; }
        if (hipFuncSetAttribute((const void*)mega_fwd, hipFuncAttributeMaxDynamicSharedMemorySize, LDS_BYTES) != hipSuccess) { fprintf(stderr, "kernel_launch: hipFuncSetAttribute failed\n"); grid = -1; return; }
        if (hipOccupancyMaxActiveBlocksPerMultiprocessor(&per_cu, (const void*)mega_fwd, NWAVES * 64, LDS_BYTES) != hipSuccess || per_cu < 1)
            fprintf(stderr, "kernel_launch: note: occupancy query reports %d workgroups per CU\n", per_cu);
        (void)hipGetLastError();
        grid = cus;
    }
    if (grid < 0) return;
    if (hipMemsetAsync((char*)d_ws + WS_CTL, 0, CTL_ZERO_BYTES, stream) != hipSuccess) { fprintf(stderr, "kernel_launch: memset failed\n"); return; }
    Args a{};
    for (int i = 0; i < N_IN; ++i) a.in[i] = (const float*)d_in[i];
    a.out = (float*)d_out; a.ws = (unsigned char*)d_ws;
#if MK_PER_PHASE
    for (int p = 0; p < N_PHASES; ++p) { a.ph_lo = p; a.ph_hi = p + 1; hipLaunchKernelGGL(mega_fwd, dim3(grid), dim3(NWAVES * 64), LDS_BYTES, stream, a); }
#else
    a.ph_lo = 0; a.ph_hi = N_PHASES;
    hipLaunchKernelGGL(mega_fwd, dim3(grid), dim3(NWAVES * 64), LDS_BYTES, stream, a);
#endif
    const hipError_t le = hipPeekAtLastError();
    if (le != hipSuccess) fprintf(stderr, "kernel_launch: launch failed: %s\n", hipGetErrorName(le));
}
```

```cpp
#include <hip/hip_runtime.h>
#include <cstdio>
#include <cstdint>

#ifndef FAST_A
#define FAST_A 1
#endif
#ifndef FAST_B
#define FAST_B 1
#endif
#ifndef FAST_C
#define FAST_C 1
#endif
#ifndef MK_PER_PHASE
#define MK_PER_PHASE 0
#endif

namespace pg8 {
#define PG8_LAS __attribute__((address_space(3)))
typedef unsigned short bf16_t;
typedef short bf16x8 __attribute__((ext_vector_type(8)));
typedef float f32x4 __attribute__((ext_vector_type(4)));
typedef unsigned u32x4 __attribute__((ext_vector_type(4)));
constexpr int BM = 256, BK = 64, HALF = 128, HTB = HALF * BK * 2  , STAGE_BYTES = 8 * HTB, NXCD = 8, WGM = 8;

__host__ __device__ __forceinline__ int lds_byte(int r, int c) { const int st = (r >> 4) * 2 + (c >> 5), rr = r & 15, cc = c & 31, ob = rr * 64 + cc * 2; return st * 1024 + (ob ^ (((ob >> 9) & 1) << 5)); }
__host__ __device__ __forceinline__ void stage_rc(int b, int& R, int& C) { const int st = b / 1024, sb = b % 1024, swz = sb ^ (((sb >> 9) & 1) << 5); R = (st >> 1) * 16 + swz / 64; C = (st & 1) * 32 + (swz % 64) / 2; }
__host__ __device__ __forceinline__ int perm32(int rho) { const int n = rho >> 4, i = rho & 15; return 8 * (i >> 2) + 4 * n + (i & 3); }

struct Unit { int pm, pn; };
struct Gemm { const bf16_t* A; const bf16_t* Bt; int M, N, K; };

struct StaticOrder {
    int nM, nN, nwg, G, c;
    __host__ __device__ void init(int M, int N, int G_, int c_) { nM = M / BM; nN = N / BM; nwg = nM * nN; G = G_; c = c_; }
    __host__ __device__ bool next(int i, Unit& u) const {
        const long L = (long)i * G + c; if (L >= nwg) return false;
        int wgid = (int)L; { const int q = nwg / NXCD, r = nwg % NXCD, xcd = wgid % NXCD, off = wgid / NXCD; wgid = (xcd < r ? xcd * (q + 1) : r * (q + 1) + (xcd - r) * q) + off; }
        const int nig = WGM * nN, gid = wgid / nig, fm = gid * WGM, gsz = (nM - fm) < WGM ? (nM - fm) : WGM;
        u.pm = fm + ((wgid % nig) % gsz); u.pn = (wgid % nig) / gsz; return true;
    }
    __device__ __forceinline__ void a_ready(const Unit&) const {}
    __device__ __forceinline__ void done(const Unit&) const {}
};

__device__ __forceinline__ unsigned cvt_pk_bf16(float lo, float hi) { unsigned r; asm volatile("v_cvt_pk_bf16_f32 %0, %1, %2" : "=v"(r) : "v"(lo), "v"(hi)); return r; }

struct EpiBf16 {
    static constexpr bool PERM = true, AFTER_DRAIN = false;
    bf16_t* O; int ldc;
    __device__ __forceinline__ void operator()(const f32x4 (&acc)[2][2][4][2], const Unit& u, int wr, int wc, int fr, int fq) const {
        const int row0 = u.pm * BM + wr * 64 + fr; const int col0 = u.pn * BM + wc * 32 + 8 * fq;
#pragma unroll
        for (int ai = 0; ai < 2; ++ai)
#pragma unroll
            for (int m = 0; m < 4; ++m) { bf16_t* rowp = O + (size_t)(row0 + ai * HALF + m * 16) * ldc + col0;
#pragma unroll
                for (int bj = 0; bj < 2; ++bj) { const f32x4 v0 = acc[ai][bj][m][0], v1 = acc[ai][bj][m][1];
                    u32x4 w; w.x = cvt_pk_bf16(v0[0], v0[1]); w.y = cvt_pk_bf16(v0[2], v0[3]); w.z = cvt_pk_bf16(v1[0], v1[1]); w.w = cvt_pk_bf16(v1[2], v1[3]);
                    *(u32x4*)(rowp + bj * HALF) = w; } }
    }
};
__device__ __forceinline__ float silu_mul(float g, float u) { return g * u * __builtin_amdgcn_rcpf(1.0f + __builtin_amdgcn_exp2f(-1.4426950408889634f * g)); }
struct EpiSwiGLU {
    static constexpr bool PERM = true, AFTER_DRAIN = false;
    bf16_t* O; int ldc;
    __device__ __forceinline__ void operator()(const f32x4 (&acc)[2][2][4][2], const Unit& u, int wr, int wc, int fr, int fq) const {
        const int row0 = u.pm * BM + wr * 64 + fr; const int col0 = u.pn * HALF + wc * 32 + 8 * fq;
#pragma unroll
        for (int ai = 0; ai < 2; ++ai)
#pragma unroll
            for (int m = 0; m < 4; ++m) { bf16_t* rowp = O + (size_t)(row0 + ai * HALF + m * 16) * ldc + col0;
                const f32x4 g0 = acc[ai][0][m][0], g1 = acc[ai][0][m][1], u0 = acc[ai][1][m][0], u1 = acc[ai][1][m][1];
                u32x4 w; w.x = cvt_pk_bf16(silu_mul(g0[0], u0[0]), silu_mul(g0[1], u0[1])); w.y = cvt_pk_bf16(silu_mul(g0[2], u0[2]), silu_mul(g0[3], u0[3]));
                w.z = cvt_pk_bf16(silu_mul(g1[0], u1[0]), silu_mul(g1[1], u1[1])); w.w = cvt_pk_bf16(silu_mul(g1[2], u1[2]), silu_mul(g1[3], u1[3]));
                *(u32x4*)rowp = w; }
    }
};
struct EpiResid {
    static constexpr bool PERM = false, AFTER_DRAIN = false;
    const float* hin; float* hout; int ldc; float alpha, s;
    __device__ __forceinline__ void operator()(const f32x4 (&acc)[2][2][4][2], const Unit& u, int wr, int wc, int fr, int fq) const {
        const int row0 = u.pm * BM + wr * 64 + fr, col0 = u.pn * BM + wc * 32 + 4 * fq;
#pragma unroll
        for (int ai = 0; ai < 2; ++ai)
#pragma unroll
            for (int m = 0; m < 4; ++m) { const size_t off = (size_t)(row0 + ai * HALF + m * 16) * ldc + col0;
#pragma unroll
                for (int bj = 0; bj < 2; ++bj)
#pragma unroll
                    for (int n = 0; n < 2; ++n) { const f32x4 hv = *(const f32x4*)(hin + off + bj * HALF + n * 16); *(f32x4*)(hout + off + bj * HALF + n * 16) = hv * alpha + acc[ai][bj][m][n] * s; } }
    }
};

template <class Epi, class Sched, bool ALIGN_EPI = false, bool SP2 = false>
__device__ __forceinline__ void gemm_phase(PG8_LAS unsigned char* lds, const Gemm g, const Sched& S, const Epi& E, int tid_) {
    asm volatile("" : "+v"(tid_));
    const int tid = tid_, wid = __builtin_amdgcn_readfirstlane(tid >> 6), lane = tid & 63, wr = wid >> 2, wc = wid & 3, fr = lane & 15, fq = lane >> 4;
    const int K = g.K, nt = K / BK;
    unsigned voffA[2], voffB[2];
#pragma unroll
    for (int i = 0; i < 2; ++i) { int R, C; stage_rc(tid * 16 + i * 8192, R, C); const int Rb = Epi::PERM ? ((R & ~31) + perm32(R & 31)) : R;
        voffA[i] = (unsigned)(R * K + C) * 2u; voffB[i] = (unsigned)(Rb * K + C) * 2u; }
    const size_t kstep = (size_t)(BK * 2);
    const size_t hstep = (size_t)HALF * K * 2;
    const size_t tstep = 2 * hstep;
    const unsigned ldsw = (unsigned)wid * 1024u;
    const int aoff = lds_byte(wr * 64 + fr, fq * 8), boff = lds_byte(wc * 32 + fr, fq * 8);
#define PG8_SA(b, h) (((b) * 2 + (h)) * HTB)
#define PG8_SB(b, h) ((4 + (b) * 2 + (h)) * HTB)
#define PG8_STAGE(bufoff, gbase, voff) do { _Pragma("unroll") for (int _i = 0; _i < 2; ++_i) \
        __builtin_amdgcn_global_load_lds((const unsigned*)((const char*)(gbase) + (voff)[_i]), (PG8_LAS unsigned*)(lds + (bufoff) + ldsw + _i * 8192), 16, 0, 0); } while (0)
#define PG8_LDA(dst, b, h) do { _Pragma("unroll") for (int m = 0; m < 4; ++m) _Pragma("unroll") for (int k = 0; k < 2; ++k) dst[m][k] = *(const PG8_LAS bf16x8*)(lds + PG8_SA(b, h) + aoff + m * 2048 + k * 1024); } while (0)
#define PG8_LDB(dst, b, h) do { _Pragma("unroll") for (int n = 0; n < 2; ++n) _Pragma("unroll") for (int k = 0; k < 2; ++k) dst[n][k] = *(const PG8_LAS bf16x8*)(lds + PG8_SB(b, h) + boff + n * 2048 + k * 1024); } while (0)
#define PG8_MMA(ai, bj, At, Bt) do { __builtin_amdgcn_s_setprio(1); _Pragma("unroll") for (int m = 0; m < 4; ++m) _Pragma("unroll") for (int n = 0; n < 2; ++n) _Pragma("unroll") for (int k = 0; k < 2; ++k) \
        acc[ai][bj][m][n] = __builtin_amdgcn_mfma_f32_16x16x32_bf16(Bt[n][k], At[m][k], acc[ai][bj][m][n], 0, 0, 0); __builtin_amdgcn_s_setprio(0); } while (0)
#define PG8_WAIT_V(n) asm volatile("s_waitcnt vmcnt(" #n ")" ::: "memory")
#define PG8_WAIT_L(n) asm volatile("s_waitcnt lgkmcnt(" #n ")" ::: "memory")
#define PG8_BAR __builtin_amdgcn_s_barrier()
#define PG8_SCHED __builtin_amdgcn_sched_barrier(0)
    Unit cur, nxt; int ui = 0;
    if (!S.next(0, cur)) return;
    f32x4 acc[2][2][4][2];
#pragma unroll
    for (int a = 0; a < 2; ++a)
#pragma unroll
        for (int b = 0; b < 2; ++b)
#pragma unroll
            for (int m = 0; m < 4; ++m)
#pragma unroll
                for (int n = 0; n < 2; ++n) acc[a][b][m][n] = (f32x4){0.f, 0.f, 0.f, 0.f};
    bf16x8 At[4][2], B0[2][2], B1[2][2];
    const char* cA = (const char*)g.A + (size_t)cur.pm * tstep; const char* cB = (const char*)g.Bt + (size_t)cur.pn * tstep;
    S.a_ready(cur);
    if constexpr (SP2) {
        PG8_STAGE(PG8_SB(0, 0), cB, voffB); PG8_STAGE(PG8_SB(0, 1), cB + hstep, voffB); PG8_STAGE(PG8_SA(0, 0), cA, voffA); PG8_STAGE(PG8_SA(0, 1), cA + hstep, voffA);
        if (wr == 1) PG8_BAR;
        PG8_WAIT_V(2); PG8_BAR;
        PG8_STAGE(PG8_SB(1, 0), cB + kstep, voffB); PG8_STAGE(PG8_SA(1, 0), cA + kstep, voffA); PG8_STAGE(PG8_SB(1, 1), cB + hstep + kstep, voffB);
        PG8_WAIT_V(6); PG8_BAR;
    } else {
        PG8_STAGE(PG8_SB(0, 0), cB, voffB); PG8_STAGE(PG8_SA(0, 0), cA, voffA); PG8_STAGE(PG8_SB(0, 1), cB + hstep, voffB); PG8_STAGE(PG8_SA(0, 1), cA + hstep, voffA);
        if (wr == 1) PG8_BAR;
        PG8_WAIT_V(4); PG8_BAR;
        PG8_STAGE(PG8_SB(1, 0), cB + kstep, voffB); PG8_STAGE(PG8_SA(1, 0), cA + kstep, voffA); PG8_STAGE(PG8_SB(1, 1), cB + hstep + kstep, voffB);
        PG8_WAIT_V(6); PG8_BAR;
    }
    for (;;) {
        const bool has_next = S.next(ui + 1, nxt);
        const char* nA = has_next ? (const char*)g.A + (size_t)nxt.pm * tstep : cA; const char* nB = has_next ? (const char*)g.Bt + (size_t)nxt.pn * tstep : cB;
        for (int t = 0; t < nt; t += 2) {
            const bool last = (t == nt - 2);
            const char* a1 = cA + (size_t)(t + 1) * kstep;
            const char* a2 = last ? nA : cA + (size_t)(t + 2) * kstep; const char* b2 = last ? nB : cB + (size_t)(t + 2) * kstep;
            const char* a3 = a2 + kstep; const char* b3 = b2 + kstep;
            if (last && has_next) S.a_ready(nxt);
            if constexpr (SP2) {
            PG8_LDB(B0, 0, 0); PG8_LDB(B1, 0, 1); PG8_SCHED; PG8_LDA(At, 0, 0); PG8_STAGE(PG8_SA(1, 1), a1 + hstep, voffA);
            PG8_WAIT_V(8); PG8_WAIT_L(0); PG8_BAR; PG8_MMA(0, 0, At, B0); PG8_MMA(0, 1, At, B1); PG8_BAR; PG8_SCHED;
            PG8_LDA(At, 0, 1); PG8_STAGE(PG8_SB(0, 0), b2, voffB); PG8_STAGE(PG8_SB(0, 1), b2 + hstep, voffB); PG8_STAGE(PG8_SA(0, 0), a2, voffA);
            PG8_WAIT_V(8); PG8_WAIT_L(0); PG8_BAR; PG8_MMA(1, 0, At, B0); PG8_MMA(1, 1, At, B1); PG8_BAR; PG8_SCHED;
            PG8_LDB(B0, 1, 0); PG8_LDB(B1, 1, 1); PG8_SCHED; PG8_LDA(At, 1, 0); PG8_STAGE(PG8_SA(0, 1), a2 + hstep, voffA);
            PG8_WAIT_V(8); PG8_WAIT_L(0); PG8_BAR; PG8_MMA(0, 0, At, B0); PG8_MMA(0, 1, At, B1); PG8_BAR; PG8_SCHED;
            PG8_LDA(At, 1, 1); PG8_STAGE(PG8_SB(1, 0), b3, voffB); PG8_STAGE(PG8_SB(1, 1), b3 + hstep, voffB); PG8_STAGE(PG8_SA(1, 0), a3, voffA);
            PG8_WAIT_V(8); PG8_WAIT_L(0); PG8_BAR; PG8_MMA(1, 0, At, B0); PG8_MMA(1, 1, At, B1); PG8_BAR; PG8_SCHED;
            } else {
            PG8_LDB(B0, 0, 0); PG8_SCHED; PG8_LDA(At, 0, 0); PG8_STAGE(PG8_SA(1, 1), a1 + hstep, voffA);
            PG8_WAIT_L(8); PG8_BAR; PG8_WAIT_L(0); PG8_MMA(0, 0, At, B0); PG8_BAR; PG8_SCHED;
            PG8_LDB(B1, 0, 1); PG8_STAGE(PG8_SB(0, 0), b2, voffB);
            PG8_BAR; PG8_WAIT_L(0); PG8_MMA(0, 1, At, B1); PG8_BAR;
            PG8_LDA(At, 0, 1); PG8_STAGE(PG8_SA(0, 0), a2, voffA);
            PG8_BAR; PG8_WAIT_L(0); PG8_MMA(1, 0, At, B0); PG8_BAR; PG8_SCHED;
            PG8_STAGE(PG8_SB(0, 1), b2 + hstep, voffB);
            PG8_WAIT_V(6); PG8_BAR; PG8_MMA(1, 1, At, B1); PG8_BAR;
            PG8_LDB(B0, 1, 0); PG8_SCHED; PG8_LDA(At, 1, 0); PG8_STAGE(PG8_SA(0, 1), a2 + hstep, voffA);
            PG8_WAIT_L(8); PG8_BAR; PG8_WAIT_L(0); PG8_MMA(0, 0, At, B0); PG8_BAR; PG8_SCHED;
            PG8_LDB(B1, 1, 1); PG8_STAGE(PG8_SB(1, 0), b3, voffB);
            PG8_BAR; PG8_WAIT_L(0); PG8_MMA(0, 1, At, B1); PG8_BAR;
            PG8_LDA(At, 1, 1); PG8_STAGE(PG8_SA(1, 0), a3, voffA);
            PG8_BAR; PG8_WAIT_L(0); PG8_MMA(1, 0, At, B0); PG8_BAR; PG8_SCHED;
            PG8_STAGE(PG8_SB(1, 1), b3 + hstep, voffB);
            PG8_WAIT_V(6); PG8_BAR; PG8_MMA(1, 1, At, B1); PG8_BAR;
            }
        }
        if constexpr (ALIGN_EPI) { if (wr == 0) PG8_BAR; }
        if constexpr (!Epi::AFTER_DRAIN) { E(acc, cur, wr, wc, fr, fq); S.done(cur); }
        if (!has_next) break;
#pragma unroll
        for (int a = 0; a < 2; ++a)
#pragma unroll
            for (int b = 0; b < 2; ++b)
#pragma unroll
                for (int m = 0; m < 4; ++m)
#pragma unroll
                    for (int n = 0; n < 2; ++n) acc[a][b][m][n] = (f32x4){0.f, 0.f, 0.f, 0.f};
        cur = nxt; cA = nA; cB = nB; ++ui;
        if constexpr (ALIGN_EPI) { if (wr == 1) PG8_BAR; }
    }
    PG8_WAIT_V(0);
    if constexpr (!ALIGN_EPI) { if (wr == 0) PG8_BAR; }
    PG8_BAR;
#undef PG8_SA
#undef PG8_SB
#undef PG8_STAGE
#undef PG8_LDA
#undef PG8_LDB
#undef PG8_MMA
#undef PG8_WAIT_V
#undef PG8_WAIT_L
#undef PG8_BAR
#undef PG8_SCHED
}
}

#ifndef PG8_SP2
#define PG8_SP2 true
#endif
#ifndef PG8_ALIGN
#define PG8_ALIGN true
#endif

constexpr int NWAVES = 8;
constexpr int BATCH = 16, SEQ = 2048, DM = 2048, DFF = 5632, MTOK = BATCH * SEQ, DEPTH = 4;
constexpr float ALPHA = 1.6817928305074292f;
constexpr float LN_EPS = 1e-5f, RMS_EPS = 1e-6f;
constexpr int A_QKV = 3072, B_QKV = 9216, C_IN = 1344, C_INP = 1536, C_QL = 768, C_KVL = 512, C_Q = 3072, C_KV = 4096;

constexpr size_t MiB = 1u << 20;
constexpr size_t WS_CTL = 0, CTL_ZERO_BYTES = 1 * MiB;
constexpr size_t WS_TABB = 1 * MiB;
constexpr size_t WS_TABC = 2 * MiB;
constexpr size_t WS_TABA = 3 * MiB;
constexpr size_t WS_WT = 8 * MiB;
constexpr size_t WS_HB = 80 * MiB;
constexpr size_t WS_R = 208 * MiB;
constexpr size_t WS_END = WS_R + 900 * MiB;
constexpr size_t WT_FFN_OUT = (size_t)2 * DFF * DM;
constexpr size_t WT_A_OUT = (size_t)A_QKV * DM, WT_B_OUT = (size_t)B_QKV * DM;
constexpr size_t WT_C_QUP = (size_t)C_INP * DM, WT_C_KVUP = WT_C_QUP + (size_t)C_Q * C_QL, WT_C_OUT = WT_C_KVUP + (size_t)C_KV * C_KVL;
constexpr size_t R_ACT = 0;
constexpr size_t RA_QKV = 0, RA_ATT = 192 * MiB;
constexpr size_t RB_QKV = 0, RB_ATT = 576 * MiB, RB_OG = 640 * MiB, RB_LSE = 832 * MiB;
constexpr size_t RC_IN = 0, RC_QN = 96 * MiB, RC_KVN = 144 * MiB, RC_KR = 176 * MiB, RC_Q = 192 * MiB, RC_KV = 384 * MiB, RC_ATT = 640 * MiB;
constexpr int CW_BAR = 4096;

constexpr int RING_OFF = 0, RING_BYTES = 131072;
constexpr int LDSCTL_OFF = RING_BYTES, MISC_OFF = LDSCTL_OFF + 320;
constexpr int LDS_BYTES = 147456;

#define GAS __attribute__((address_space(1)))
#define LAS __attribute__((address_space(3)))
typedef unsigned short bf16;
typedef unsigned v4u __attribute__((ext_vector_type(4)));
typedef unsigned v2u __attribute__((ext_vector_type(2)));
typedef float f32x4 __attribute__((ext_vector_type(4)));
typedef GAS unsigned gu32;
#define RLX_AGENT __ATOMIC_RELAXED, __HIP_MEMORY_SCOPE_AGENT
#define LDS_WAIT() asm volatile("s_waitcnt lgkmcnt(0)" ::: "memory")
#define VM_WAIT() asm volatile("s_waitcnt vmcnt(0)" ::: "memory")
__device__ __forceinline__ unsigned f2bf(float f) { unsigned u = __builtin_bit_cast(unsigned, f); return (u + 0x7fffu + ((u >> 16) & 1u)) >> 16; }
__device__ __forceinline__ unsigned pk2(float lo, float hi) { return f2bf(lo) | (f2bf(hi) << 16); }
__device__ __forceinline__ float bflo(unsigned w) { return __uint_as_float(w << 16); }
__device__ __forceinline__ float bfhi(unsigned w) { return __uint_as_float(w & 0xffff0000u); }
__device__ __forceinline__ float bf1(bf16 b) { return __uint_as_float(((unsigned)b) << 16); }

#define XB_TMO      128
#define XB_XCNT(j)  (256  + 64 * (j))
#define XB_XSUB(j)  (1280 + 64 * (j))
#define XB_XGEN(j)  (2304 + 64 * (j))
#define XB_TOP      3328
#define XB_TOPGEN   3392
#define XCD_BAR_WORDS 3456
#define XB_SPIN_CAP (1u << 22)
__device__ __forceinline__ unsigned xb_ld(unsigned* p)              { return __hip_atomic_load(p, __ATOMIC_RELAXED, __HIP_MEMORY_SCOPE_AGENT); }
__device__ __forceinline__ unsigned xb_add(unsigned* p, unsigned v) { return __hip_atomic_fetch_add(p, v, __ATOMIC_RELAXED, __HIP_MEMORY_SCOPE_AGENT); }
__device__ __forceinline__ unsigned xb_xcc_id() { return (unsigned)__builtin_amdgcn_s_getreg((3 << 11) | 20) & 0xFu; }
#define XB_SPIN(cond, bar) do { unsigned _sp = 0; while (cond) { __builtin_amdgcn_s_sleep(1); \
    if ((++_sp & 255u) == 0u) { if (xb_ld(&(bar)[XB_TMO])) break; if (_sp > XB_SPIN_CAP) { atomicAdd(&(bar)[XB_TMO], 1u); break; } } } } while (0)
struct XcdBarrier { unsigned* bar; unsigned x; volatile LAS unsigned* st; };
__device__ __forceinline__ XcdBarrier xcd_barrier_post(unsigned* bar, volatile LAS unsigned* st) {
    XcdBarrier b; b.bar = bar; b.x = xb_xcc_id(); b.st = st;
    if (threadIdx.x == 0) (void)xb_add(&bar[XB_XCNT(b.x)], 1u);
    return b;
}
__device__ __forceinline__ void xcd_barrier_complete(unsigned* bar, unsigned x, unsigned& nloc, unsigned& nx) {
    const unsigned G = gridDim.x * gridDim.y * gridDim.z;
    unsigned sum, cnt, mine, sp = 0u;
    for (;;) {
        sum = 0u; cnt = 0u; mine = 0u;
#pragma unroll
        for (unsigned j = 0; j < 16; ++j) { const unsigned c = xb_ld(&bar[XB_XCNT(j)]); sum += c; cnt += (c > 0u) ? 1u : 0u; mine = (j == x) ? c : mine; }
        if (sum == G) break;
        __builtin_amdgcn_s_sleep(1);
        if ((++sp & 255u) == 0u) { if (xb_ld(&bar[XB_TMO])) break; if (sp > XB_SPIN_CAP) { atomicAdd(&bar[XB_TMO], 1u); break; } }
    }
    nloc = mine > 0u ? mine : 1u; nx = cnt > 0u ? cnt : 1u;
}
__device__ __forceinline__ void xcd_barrier(const XcdBarrier& b, const int tid) {
    asm volatile("s_waitcnt vmcnt(0)" ::: "memory");
    __syncthreads();
    if (tid == 0) {
        unsigned* bar = b.bar; unsigned bx_ = b.x;
        asm volatile("" : "+s"(bar), "+s"(bx_));
        __builtin_amdgcn_s_waitcnt(0);
        unsigned nloc = b.st[0], nx = b.st[1];
        if (nloc == 0u) { xcd_barrier_complete(bar, bx_, nloc, nx); b.st[0] = nloc; b.st[1] = nx; }
        const unsigned old = xb_add(&bar[XB_XSUB(bx_)], 1u);
        const unsigned gen = old / nloc;
        if (old + 1u == (gen + 1u) * nloc) {
            __builtin_amdgcn_fence(__ATOMIC_RELEASE, "agent");
            asm volatile("s_waitcnt vmcnt(0)" ::: "memory");
            const unsigned og = xb_add(&bar[XB_TOP], 1u);
            const unsigned tg = og / nx;
            if (og + 1u == (tg + 1u) * nx) xb_add(&bar[XB_TOPGEN], 1u);
            else XB_SPIN(xb_ld(&bar[XB_TOPGEN]) == tg, bar);
            __builtin_amdgcn_fence(__ATOMIC_ACQUIRE, "agent");
            xb_add(&bar[XB_XGEN(bx_)], 1u);
            asm volatile("s_waitcnt vmcnt(0)" ::: "memory");
        } else {
            XB_SPIN(xb_ld(&bar[XB_XGEN(bx_)]) == gen, bar);
            __builtin_amdgcn_fence(__ATOMIC_ACQUIRE, "agent");
            asm volatile("s_waitcnt vmcnt(0)" ::: "memory");
        }
    }
    __syncthreads();
}

template <class T> __device__ __forceinline__ T* lnd(T* p) { asm volatile("" : "+s"(p)); return p; }
__device__ __forceinline__ float wave_sum(float v) {
#pragma unroll
    for (int o = 1; o < 64; o <<= 1) v += __shfl_xor(v, o);
    return v;
}
__device__ __forceinline__ void cvt_weight(const float* W, int K, int Nsrc, bf16* WT, int Ndst, int kind, LAS float* scr, int gw, int NGW, int lane) {
    asm volatile("" : "+v"(lane));
    const int nblk = Ndst / 32, nitems = (K / 64) * nblk;
    for (int item = gw; item < nitems; item += NGW) {
        const int kb = item / nblk, nb = item % nblk, k0 = 64 * kb, n0 = 32 * nb;
        int c0;
        if (kind == 1) { const int t = n0 >> 8, r = n0 & 255; c0 = (r >> 7) * DFF + 128 * t + (r & 127); }
        else c0 = (n0 < Nsrc) ? n0 : -1;
        if (c0 >= 0) {
#pragma unroll 8
            for (int i = 0; i < 32; ++i) { const int kk = 2 * i + (lane >> 5); scr[kk * 33 + (lane & 31)] = W[(size_t)(k0 + kk) * Nsrc + c0 + (lane & 31)]; }
        } else {
#pragma unroll 8
            for (int i = 0; i < 32; ++i) { const int kk = 2 * i + (lane >> 5); scr[kk * 33 + (lane & 31)] = 0.f; }
        }
        LDS_WAIT(); asm volatile("" ::: "memory");
        const int c = lane & 7;
#pragma unroll
        for (int j = 0; j < 4; ++j) { const int n = (lane >> 3) + 8 * j; const LAS float* s = scr + (8 * c) * 33 + n;
            v4u o; o.x = pk2(s[0 * 33], s[1 * 33]); o.y = pk2(s[2 * 33], s[3 * 33]); o.z = pk2(s[4 * 33], s[5 * 33]); o.w = pk2(s[6 * 33], s[7 * 33]);
            *(GAS v4u*)(WT + (size_t)(n0 + n) * K + k0 + 8 * c) = o; }
        LDS_WAIT(); asm volatile("" ::: "memory");
    }
}
__device__ __forceinline__ void ln_rows(float* H, bf16* HBo, const float* g, const float* b, int gw, int NGW, int lane) {
    asm volatile("" : "+v"(lane));
    for (int m = gw; m < MTOK; m += NGW) {
        GAS f32x4* xr = (GAS f32x4*)(H + (size_t)m * DM) + 2 * lane;
        f32x4 v[8]; float s = 0.f;
#pragma unroll
        for (int j = 0; j < 4; ++j) { v[2 * j] = xr[128 * j]; v[2 * j + 1] = xr[128 * j + 1]; }
#pragma unroll
        for (int j = 0; j < 8; ++j) s += (v[j].x + v[j].y) + (v[j].z + v[j].w);
        const float mean = wave_sum(s) * (1.f / DM); float s2 = 0.f;
#pragma unroll
        for (int j = 0; j < 8; ++j) { v[j] = v[j] - mean; s2 += (v[j].x * v[j].x + v[j].y * v[j].y) + (v[j].z * v[j].z + v[j].w * v[j].w); }
        const float rstd = 1.f / sqrtf(wave_sum(s2) * (1.f / DM) + LN_EPS);
        GAS v4u* ob = (GAS v4u*)(HBo + (size_t)m * DM) + lane;
#pragma unroll
        for (int j = 0; j < 4; ++j) {
            const f32x4 g0 = *((const f32x4*)g + 128 * j + 2 * lane), g1 = *((const f32x4*)g + 128 * j + 2 * lane + 1);
            const f32x4 b0 = *((const f32x4*)b + 128 * j + 2 * lane), b1 = *((const f32x4*)b + 128 * j + 2 * lane + 1);
            const f32x4 y0 = v[2 * j] * rstd * g0 + b0, y1 = v[2 * j + 1] * rstd * g1 + b1;
            xr[128 * j] = y0; xr[128 * j + 1] = y1;
            v4u o; o.x = pk2(y0.x, y0.y); o.y = pk2(y0.z, y0.w); o.z = pk2(y1.x, y1.y); o.w = pk2(y1.z, y1.w);
            ob[64 * j] = o;
        }
    }
}
__device__ __forceinline__ void cvt_rows_bf16(const float* X, bf16* O, size_t n8, size_t gt, size_t NGT) {
    for (size_t i = gt; i < n8; i += NGT) { const f32x4 a = *((const GAS f32x4*)X + 2 * i), c = *((const GAS f32x4*)X + 2 * i + 1);
        v4u o; o.x = pk2(a.x, a.y); o.y = pk2(a.z, a.w); o.z = pk2(c.x, c.y); o.w = pk2(c.z, c.w); *((GAS v4u*)O + i) = o; }
}
__device__ __forceinline__ void sincos_tab(float ang, float& c, float& s) {
    const double x = (double)ang; const double k = __builtin_rint(x * 0.15915494309189533577); const double r = x - k * 6.28318530717958647692;
    const double r2 = r * r; double sn = 0.0, cs = 0.0;
#pragma unroll
    for (int n = 14; n >= 0; --n) { sn = sn * (-r2) / (double)((2 * n + 2) * (2 * n + 3)) + 1.0; cs = cs * (-r2) / (double)((2 * n + 1) * (2 * n + 2)) + 1.0; }
    s = (float)(sn * r); c = (float)cs;
}
__device__ __forceinline__ void build_tables(unsigned char* ws, size_t gt, size_t NGT) {
    float* cb = (float*)(ws + WS_TABB); float* sb = cb + 2048 * 64;
    for (size_t i = gt; i < 2048 * 64; i += NGT) { const int pos = (int)(i >> 6), f = (int)(i & 63); const float inv = __builtin_amdgcn_exp2f(-13.287712379549449f * ((float)(2 * f) / 128.0f)); float c, s; sincos_tab((float)pos * inv, c, s); cb[i] = c; sb[i] = s; }
    float* cc = (float*)(ws + WS_TABC); float* sc = cc + 2048 * 32;
    for (size_t i = gt; i < 2048 * 32; i += NGT) { const int pos = (int)(i >> 5), f = (int)(i & 31); const float inv = __builtin_amdgcn_exp2f(-13.287712379549449f * ((float)(2 * f) / 64.0f)); float c, s; sincos_tab((float)pos * inv, c, s); cc[i] = c; sc[i] = s; }
    float* ca = (float*)(ws + WS_TABA); float* sa = ca + 64 * 32;
    for (size_t i = gt; i < 64 * 32; i += NGT) { const int pos = (int)(i >> 5), f = (int)(i & 31); const float inv = __builtin_amdgcn_exp2f(-13.287712379549449f * ((float)(2 * f) / 64.0f)); float c, s; sincos_tab((float)pos * inv, c, s); ca[i] = c; sa[i] = s; }
}

__device__ __forceinline__ void prep_a(bf16* QKV, const float* qg, const float* kg, const unsigned char* ws, int gw, int NGW, int lane) {
    asm volatile("" : "+v"(lane));
    const float* ca = (const float*)(ws + WS_TABA); const float* sa = ca + 64 * 32;
    const int half = lane >> 5, i = lane & 31, ia = 64 * half + i, ib = ia + 32;
    const float gqa = qg[ia], gqb = qg[ib], gka = kg[ia], gkb = kg[ib];
    for (int tok = gw; tok < MTOK; tok += NGW) {
        const int s = tok & (SEQ - 1), pos = half ? (s & 63) : (s >> 6);
        const float c = ca[pos * 32 + i], sn = sa[pos * 32 + i];
        bf16* row = QKV + (size_t)tok * A_QKV;
#pragma unroll 4
        for (int h = 0; h < 20; ++h) {
            bf16* p = row + h * 128;
            float a = bf1(p[ia]), b = bf1(p[ib]);
            const float ss = wave_sum(a * a + b * b);
            const float r = 1.f / sqrtf(ss * (1.f / 128.f) + RMS_EPS);
            a = a * r * (h < 16 ? gqa : gka); b = b * r * (h < 16 ? gqb : gkb);
            p[ia] = (bf16)f2bf(a * c - b * sn); p[ib] = (bf16)f2bf(a * sn + b * c);
        }
    }
}
__device__ __forceinline__ void prep_b(bf16* QKV, const unsigned char* ws, int gw, int NGW, int lane) {
    asm volatile("" : "+v"(lane));
    const float* cb = (const float*)(ws + WS_TABB); const float* sb = cb + 2048 * 64;
    for (int tok = gw; tok < MTOK; tok += NGW) {
        const int s = tok & (SEQ - 1);
        const float c = cb[s * 64 + lane], sn = sb[s * 64 + lane];
        bf16* row = QKV + (size_t)tok * B_QKV;
#pragma unroll 4
        for (int j = 0; j < 48; ++j) {
            const int g = j >> 4, t = (j >> 3) & 1, h = j & 7;
            bf16* p = row + g * 3072 + t * 1024 + h * 128;
            const float a = bf1(p[lane]), b = bf1(p[lane + 64]);
            p[lane] = (bf16)f2bf(a * c - b * sn); p[lane + 64] = (bf16)f2bf(a * sn + b * c);
        }
    }
}
__device__ __forceinline__ void prep_c1(const bf16* CIN, bf16* CQN, bf16* CKVN, bf16* KR, const float* qg, const float* kvg, const unsigned char* ws, int gw, int NGW, int lane) {
    asm volatile("" : "+v"(lane));
    const float* cc = (const float*)(ws + WS_TABC); const float* sc = cc + 2048 * 32;
    for (int tok = gw; tok < MTOK; tok += NGW) {
        const bf16* row = CIN + (size_t)tok * C_INP;
        { float v[12]; float ss = 0.f;
#pragma unroll
          for (int j = 0; j < 12; ++j) { v[j] = bf1(row[j * 64 + lane]); ss += v[j] * v[j]; }
          const float r = 1.f / sqrtf(wave_sum(ss) * (1.f / 768.f) + RMS_EPS);
#pragma unroll
          for (int j = 0; j < 12; ++j) CQN[(size_t)tok * C_QL + j * 64 + lane] = (bf16)f2bf(v[j] * r * qg[j * 64 + lane]); }
        { float v[8]; float ss = 0.f;
#pragma unroll
          for (int j = 0; j < 8; ++j) { v[j] = bf1(row[768 + j * 64 + lane]); ss += v[j] * v[j]; }
          const float r = 1.f / sqrtf(wave_sum(ss) * (1.f / 512.f) + RMS_EPS);
#pragma unroll
          for (int j = 0; j < 8; ++j) CKVN[(size_t)tok * C_KVL + j * 64 + lane] = (bf16)f2bf(v[j] * r * kvg[j * 64 + lane]); }
        if (lane < 32) { const int s = tok & (SEQ - 1); const float c = cc[s * 32 + lane], sn = sc[s * 32 + lane];
          const float a = bf1(row[1280 + lane]), b = bf1(row[1280 + 32 + lane]);
          KR[(size_t)tok * 64 + lane] = (bf16)f2bf(a * c - b * sn); KR[(size_t)tok * 64 + 32 + lane] = (bf16)f2bf(a * sn + b * c); }
    }
}
__device__ __forceinline__ void prep_c2(bf16* Q, const unsigned char* ws, int gw, int NGW, int lane) {
    asm volatile("" : "+v"(lane));
    const float* cc = (const float*)(ws + WS_TABC); const float* sc = cc + 2048 * 32;
    const int i = lane & 31, hh = lane >> 5;
    for (int tok = gw; tok < MTOK; tok += NGW) {
        const int s = tok & (SEQ - 1); const float c = cc[s * 32 + i], sn = sc[s * 32 + i];
        bf16* row = Q + (size_t)tok * C_Q;
#pragma unroll
        for (int j = 0; j < 8; ++j) { bf16* p = row + (2 * j + hh) * 192 + 128; const float a = bf1(p[i]), b = bf1(p[i + 32]);
            p[i] = (bf16)f2bf(a * c - b * sn); p[i + 32] = (bf16)f2bf(a * sn + b * c); }
    }
}

struct NState { float m, l, o[8]; };
__device__ __forceinline__ void nst_init(NState& S) { S.m = -1e30f; S.l = 0.f;
#pragma unroll
    for (int j = 0; j < 8; ++j) S.o[j] = 0.f; }
__device__ __forceinline__ void nst_update(NState& S, float s, bool valid, const v4u vv) {
    const float mn = valid ? fmaxf(S.m, s) : S.m; const float al = __builtin_amdgcn_exp2f(S.m - mn); const float p = valid ? __builtin_amdgcn_exp2f(s - mn) : 0.f;
    S.l = S.l * al + p; S.m = mn;
    S.o[0] = S.o[0] * al + p * bflo(vv.x); S.o[1] = S.o[1] * al + p * bfhi(vv.x); S.o[2] = S.o[2] * al + p * bflo(vv.y); S.o[3] = S.o[3] * al + p * bfhi(vv.y);
    S.o[4] = S.o[4] * al + p * bflo(vv.z); S.o[5] = S.o[5] * al + p * bfhi(vv.z); S.o[6] = S.o[6] * al + p * bflo(vv.w); S.o[7] = S.o[7] * al + p * bfhi(vv.w);
}
__device__ __forceinline__ void nst_finish(NState& S, bf16* out, int lane) {
#pragma unroll
    for (int x = 16; x <= 32; x <<= 1) {
        const float m2 = __shfl_xor(S.m, x), l2 = __shfl_xor(S.l, x); const float mn = fmaxf(S.m, m2); const float a = __builtin_amdgcn_exp2f(S.m - mn), b = __builtin_amdgcn_exp2f(m2 - mn);
        S.l = S.l * a + l2 * b; S.m = mn;
#pragma unroll
        for (int j = 0; j < 8; ++j) { const float o2 = __shfl_xor(S.o[j], x); S.o[j] = S.o[j] * a + o2 * b; }
    }
    if (lane < 16) { const float rl = 1.f / S.l; v4u w; w.x = pk2(S.o[0] * rl, S.o[1] * rl); w.y = pk2(S.o[2] * rl, S.o[3] * rl); w.z = pk2(S.o[4] * rl, S.o[5] * rl); w.w = pk2(S.o[6] * rl, S.o[7] * rl);
        *(GAS v4u*)(out + lane * 8) = w; }
}
__device__ __forceinline__ float dot8(const float (&q)[8], const v4u k) {
    return q[0] * bflo(k.x) + q[1] * bfhi(k.x) + q[2] * bflo(k.y) + q[3] * bfhi(k.y) + q[4] * bflo(k.z) + q[5] * bfhi(k.z) + q[6] * bflo(k.w) + q[7] * bfhi(k.w);
}
__device__ __forceinline__ float red16(float s) { s += __shfl_xor(s, 1); s += __shfl_xor(s, 2); s += __shfl_xor(s, 4); s += __shfl_xor(s, 8); return s; }
__device__ __forceinline__ void ldq8(float (&q)[8], const bf16* p, float sc) { const v4u w = *(const GAS v4u*)p;
    q[0] = bflo(w.x) * sc; q[1] = bfhi(w.x) * sc; q[2] = bflo(w.y) * sc; q[3] = bfhi(w.y) * sc; q[4] = bflo(w.z) * sc; q[5] = bfhi(w.z) * sc; q[6] = bflo(w.w) * sc; q[7] = bfhi(w.w) * sc; }

__device__ __forceinline__ void naive_attn_a(const bf16* QKV, bf16* ATT, int gw, int NGW, int lane) {
    asm volatile("" : "+v"(lane));
    const int g = lane >> 4, i = lane & 15; const float sc = 0.08838834764831845f * 1.4426950408889634f;
    for (int p = gw; p < MTOK * 16; p += NGW) {
        const int tok = p >> 4, h = p & 15, b = tok >> 11;
        float q[8]; ldq8(q, QKV + (size_t)tok * A_QKV + h * 128 + i * 8, sc);
        const bf16* kb = QKV + (size_t)(b * SEQ) * A_QKV + 2048 + (h >> 2) * 128 + i * 8;
        NState S; nst_init(S);
        for (int t0 = 0; t0 < SEQ; t0 += 4) { const bf16* kp = kb + (size_t)(t0 + g) * A_QKV; const v4u kk = *(const GAS v4u*)kp, vv = *(const GAS v4u*)(kp + 512);
            nst_update(S, red16(dot8(q, kk)), true, vv); }
        nst_finish(S, ATT + (size_t)tok * DM + h * 128, lane);
    }
}
__device__ __forceinline__ void naive_attn_b(const bf16* QKV, bf16* ATT, int gw, int NGW, int lane) {
    asm volatile("" : "+v"(lane));
    const int g = lane >> 4, i = lane & 15; const float sc = 0.08838834764831845f * 1.4426950408889634f;
    for (int p = gw; p < MTOK * 8; p += NGW) {
        const int tok = p >> 3, h = p & 7, s = tok & (SEQ - 1);
        NState S; nst_init(S);
        for (int grp = 0; grp < 3; ++grp) {
            const int dil = grp == 0 ? 1 : (grp == 1 ? 4 : 16);
            float q[8]; ldq8(q, QKV + (size_t)tok * B_QKV + grp * 3072 + h * 128 + i * 8, sc);
            for (int j0 = -64; j0 <= 64; j0 += 4) { const int j = j0 + g; const int t = s + j * dil; const bool valid = (j <= 64) && (t >= 0) && (t < SEQ);
                const int tc = valid ? t : s; const bf16* kp = QKV + (size_t)(tok - s + tc) * B_QKV + grp * 3072 + 1024 + h * 128 + i * 8;
                const v4u kk = *(const GAS v4u*)kp, vv = *(const GAS v4u*)(kp + 1024);
                nst_update(S, red16(dot8(q, kk)), valid, vv); }
        }
        nst_finish(S, ATT + (size_t)tok * 1024 + h * 128, lane);
    }
}
__device__ __forceinline__ void naive_attn_c(const bf16* Q, const bf16* KV, const bf16* KR, bf16* ATT, int gw, int NGW, int lane) {
    asm volatile("" : "+v"(lane));
    const int g = lane >> 4, i = lane & 15; const float sc = 0.07216878364870322f * 1.4426950408889634f;
    for (int p = gw; p < MTOK * 16; p += NGW) {
        const int tok = p >> 4, h = p & 15, b = tok >> 11;
        float q[8]; ldq8(q, Q + (size_t)tok * C_Q + h * 192 + i * 8, sc);
        float qr[4]; { const v2u w = *(const GAS v2u*)(Q + (size_t)tok * C_Q + h * 192 + 128 + i * 4); qr[0] = bflo(w.x) * sc; qr[1] = bfhi(w.x) * sc; qr[2] = bflo(w.y) * sc; qr[3] = bfhi(w.y) * sc; }
        const bf16* kb = KV + (size_t)(b * SEQ) * C_KV + h * 256 + i * 8; const bf16* rb = KR + (size_t)(b * SEQ) * 64 + i * 4;
        NState S; nst_init(S);
        for (int t0 = 0; t0 < SEQ; t0 += 4) { const bf16* kp = kb + (size_t)(t0 + g) * C_KV; const v4u kk = *(const GAS v4u*)kp, vv = *(const GAS v4u*)(kp + 128);
            const v2u kr = *(const GAS v2u*)(rb + (size_t)(t0 + g) * 64);
            const float d = dot8(q, kk) + qr[0] * bflo(kr.x) + qr[1] * bfhi(kr.x) + qr[2] * bflo(kr.y) + qr[3] * bfhi(kr.y);
            nst_update(S, red16(d), true, vv); }
        nst_finish(S, ATT + (size_t)tok * DM + h * 128, lane);
    }
}


namespace att {
using bf16x8 = __attribute__((ext_vector_type(8))) short;
using s16x4  = __attribute__((ext_vector_type(4))) short;
using f32x16 = __attribute__((ext_vector_type(16))) float;
using u32x4  = __attribute__((ext_vector_type(4))) unsigned;
typedef GAS const unsigned short* gptr;
constexpr int KVBLK = 64, QBLK = 32;
constexpr int SHM_V = 16384, SHM_K = 16384, SHM_KR = 8192;
constexpr int OFF_V = 0, OFF_K = 2 * SHM_V, OFF_KR = OFF_K + 2 * SHM_K, OFF_WS = OFF_KR + 2 * SHM_KR, LDS_ATT = OFF_WS + 8 * 256;
#define KSWZ(row, colB) ((row) * 256 + ((colB) ^ (((row) & 7) << 4)))
#define KSWZ2(row, colB) ((row) * 128 + ((colB) ^ (((row) & 7) << 4)))
#define SBAR() __builtin_amdgcn_sched_barrier(0)
__device__ __forceinline__ int crow(int r, int hi) { return (r & 3) + 8 * (r >> 2) + 4 * hi; }
__device__ __forceinline__ unsigned cvtpk(float lo, float hi) { unsigned r; asm volatile("v_cvt_pk_bf16_f32 %0, %1, %2" : "=v"(r) : "v"(lo), "v"(hi)); return r; }
template <int MODE> __device__ __forceinline__ int tokmap(int p, int logd, int logL) { return MODE == 1 ? (((p & ((1 << logL) - 1)) << logd) | (p >> logL)) : p; }

template <int MODE> __device__ __forceinline__ void partialSM(f32x16& p0, f32x16& p1, float& m_reg, float& mn, float& alpha) {
  constexpr float SCALE = (MODE == 2) ? 0.07216878364870322f : 0.08838834764831845f;
  constexpr float C = SCALE * 1.4426950408889634f;
  float pmax = p0[0];
#pragma unroll
  for (int r = 1; r < 16; ++r) pmax = fmaxf(pmax, p0[r]);
#pragma unroll
  for (int r = 0; r < 16; ++r) pmax = fmaxf(pmax, p1[r]);
  { auto rr = __builtin_amdgcn_permlane32_swap(__float_as_uint(pmax), __float_as_uint(pmax), false, false);
    pmax = fmaxf(__uint_as_float(rr[0]), __uint_as_float(rr[1])); }
  if (__builtin_expect(__all(pmax - m_reg <= 8.f / SCALE), 1)) { mn = m_reg; alpha = 1.f; }
  else { mn = fmaxf(m_reg, pmax); alpha = __builtin_amdgcn_exp2f((m_reg - mn) * C); m_reg = mn; }
  const float mnC = -mn * C;
#pragma unroll
  for (int r = 0; r < 16; ++r) p0[r] = fmaf(p0[r], C, mnC);
#pragma unroll
  for (int r = 0; r < 16; ++r) p1[r] = fmaf(p1[r], C, mnC);
#pragma unroll
  for (int r = 0; r < 16; ++r) p0[r] = __builtin_amdgcn_exp2f(p0[r]);
}
__device__ __forceinline__ void finishSM(f32x16& p0, f32x16& p1, float alpha, float& l_reg, bf16x8& pa0, bf16x8& pa1, bf16x8& pa2, bf16x8& pa3) {
#pragma unroll
  for (int r = 0; r < 16; ++r) p1[r] = __builtin_amdgcn_exp2f(p1[r]);
  float ps = 0;
#pragma unroll
  for (int r = 0; r < 16; ++r) ps += p0[r];
#pragma unroll
  for (int r = 0; r < 16; ++r) ps += p1[r];
  { auto rr = __builtin_amdgcn_permlane32_swap(__float_as_uint(ps), __float_as_uint(ps), false, false);
    ps = __uint_as_float(rr[0]) + __uint_as_float(rr[1]); }
  l_reg = l_reg * alpha + ps;
#define PK4(P, BASE, OUT) do { unsigned a0 = cvtpk(P[BASE + 0], P[BASE + 1]), a1 = cvtpk(P[BASE + 2], P[BASE + 3]);   \
    unsigned b0 = cvtpk(P[BASE + 4], P[BASE + 5]), b1 = cvtpk(P[BASE + 6], P[BASE + 7]);                              \
    auto r0 = __builtin_amdgcn_permlane32_swap(a0, b0, false, false); auto r1 = __builtin_amdgcn_permlane32_swap(a1, b1, false, false); \
    u32x4 w = {r0[0], r1[0], r0[1], r1[1]}; OUT = *reinterpret_cast<bf16x8*>(&w); } while (0)
  PK4(p0, 0, pa0); PK4(p0, 8, pa1); PK4(p1, 0, pa2); PK4(p1, 8, pa3);
#undef PK4
}
template <int MODE> __device__ __forceinline__ void qkt(f32x16& p0, f32x16& p1, const LAS char* Ks, const LAS char* KRs, const bf16x8* qr, int r32, int hi) {
  p0 = f32x16{}; p1 = f32x16{};
#pragma unroll
  for (int d0 = 0; d0 < 8; ++d0) { const int cb = (d0 * 16 + hi * 8) * 2;
    const bf16x8 b0 = *reinterpret_cast<const LAS bf16x8*>(Ks + KSWZ(r32, cb));
    const bf16x8 b1 = *reinterpret_cast<const LAS bf16x8*>(Ks + KSWZ(32 + r32, cb));
    p0 = __builtin_amdgcn_mfma_f32_32x32x16_bf16(b0, qr[d0], p0, 0, 0, 0);
    p1 = __builtin_amdgcn_mfma_f32_32x32x16_bf16(b1, qr[d0], p1, 0, 0, 0); }
  if constexpr (MODE == 2) {
#pragma unroll
    for (int d0 = 0; d0 < 4; ++d0) { const int cb = (d0 * 16 + hi * 8) * 2;
      const bf16x8 b0 = *reinterpret_cast<const LAS bf16x8*>(KRs + KSWZ2(r32, cb));
      const bf16x8 b1 = *reinterpret_cast<const LAS bf16x8*>(KRs + KSWZ2(32 + r32, cb));
      p0 = __builtin_amdgcn_mfma_f32_32x32x16_bf16(b0, qr[8 + d0], p0, 0, 0, 0);
      p1 = __builtin_amdgcn_mfma_f32_32x32x16_bf16(b1, qr[8 + d0], p1, 0, 0, 0); }
  }
}
__device__ __forceinline__ void bmask(f32x16& p0, f32x16& p1, int kb, int qp, int logL, int hi) {
  const int qc = qp >> logL;
#pragma unroll
  for (int r = 0; r < 16; ++r) { const int k0 = kb + crow(r, hi), k1 = k0 + 32; const int d0 = k0 - qp, d1 = k1 - qp;
    const bool v0 = (d0 <= 64) && (d0 >= -64) && ((k0 >> logL) == qc), v1 = (d1 <= 64) && (d1 >= -64) && ((k1 >> logL) == qc);
    p0[r] = v0 ? p0[r] : -3.0e38f; p1[r] = v1 ? p1[r] : -3.0e38f; }
}
__device__ __forceinline__ int v_st(int k, int c) { const int kk = (k & ~0xC) | ((k & 4) << 1) | ((k & 8) >> 1); return ((kk >> 3) * 4 + (c >> 5)) * 512 + ((kk & 7) * 32 + (c & 31)) * 2; }
__device__ __forceinline__ int v_rd_base(int lane) { return ((lane & 3) << 3) | (((lane >> 2) & 3) << 6) | (((lane >> 4) & 1) << 5) | (((lane >> 5) & 1) << 8); }
constexpr int v_rd_off(int d0, int ks, int half) { return d0 * 512 + ks * 4096 + half * 2048; }
template <int OFF> __device__ __forceinline__ s16x4 tr_read(int vb) {
  s16x4 r; asm volatile("ds_read_b64_tr_b16 %0, %1 offset:%2" : "=&v"(r) : "v"(vb), "i"(OFF) : "memory"); return r;
}
template <int D0> __device__ __forceinline__ void pv_one(f32x16& od, int vb, bf16x8 pa0, bf16x8 pa1, bf16x8 pa2, bf16x8 pa3) {
  const s16x4 l0 = tr_read<v_rd_off(D0, 0, 0)>(vb), h0 = tr_read<v_rd_off(D0, 0, 1)>(vb), l1 = tr_read<v_rd_off(D0, 1, 0)>(vb), h1 = tr_read<v_rd_off(D0, 1, 1)>(vb);
  const s16x4 l2 = tr_read<v_rd_off(D0, 2, 0)>(vb), h2 = tr_read<v_rd_off(D0, 2, 1)>(vb), l3 = tr_read<v_rd_off(D0, 3, 0)>(vb), h3 = tr_read<v_rd_off(D0, 3, 1)>(vb);
  asm volatile("s_waitcnt lgkmcnt(0)" ::: "memory"); SBAR();
#define PK(L, H) (bf16x8){L[0], L[1], L[2], L[3], H[0], H[1], H[2], H[3]}
  od = __builtin_amdgcn_mfma_f32_32x32x16_bf16(pa0, PK(l0, h0), od, 0, 0, 0);
  od = __builtin_amdgcn_mfma_f32_32x32x16_bf16(pa1, PK(l1, h1), od, 0, 0, 0);
  od = __builtin_amdgcn_mfma_f32_32x32x16_bf16(pa2, PK(l2, h2), od, 0, 0, 0);
  od = __builtin_amdgcn_mfma_f32_32x32x16_bf16(pa3, PK(l3, h3), od, 0, 0, 0);
#undef PK
}
__device__ __forceinline__ void pv_d0(f32x16* o, int vb, bf16x8 pa0, bf16x8 pa1, bf16x8 pa2, bf16x8 pa3) {
  pv_one<0>(o[0], vb, pa0, pa1, pa2, pa3); pv_one<1>(o[1], vb, pa0, pa1, pa2, pa3); pv_one<2>(o[2], vb, pa0, pa1, pa2, pa3); pv_one<3>(o[3], vb, pa0, pa1, pa2, pa3);
}

template <int MODE>
__device__ __forceinline__ void attn_unit(gptr Qb, gptr Kb, gptr Vb, gptr KRb, GAS unsigned short* Ob, GAS float* lse,
                                          const int p0, const int k0, const int logd, LAS char* lds, const int tid) {
  constexpr int SDEPTH = (MODE == 2) ? 1 : 2;
  constexpr int NQ = (MODE == 2) ? 12 : 8;
  constexpr int ldq = (MODE == 0) ? A_QKV : (MODE == 1) ? B_QKV : C_Q, ldk = (MODE == 0) ? A_QKV : (MODE == 1) ? B_QKV : C_KV, ldo = (MODE == 1) ? 1024 : DM, NT = (MODE == 1) ? 6 : SEQ / 64;
  constexpr float SCALE = (MODE == 2) ? 0.07216878364870322f : 0.08838834764831845f;
  const int wid = tid >> 6, lane = tid & 63, r32 = lane & 31, hi = lane >> 5;
  const int logL = 11 - logd;
  LAS char* V_lds = lds + OFF_V; LAS char* K_lds = lds + OFF_K; LAS char* KR_lds = lds + OFF_KR;
  LAS float* wsl = (LAS float*)(lds + OFF_WS) + wid * 64; LAS float* li_l = wsl; LAS float* al_l = wsl + 32;
  float m_reg = -1e30f, l_reg = 0; f32x16 o[4] = {}; bf16x8 qr[NQ];
  const int qp = p0 + wid * QBLK + r32;
  { gptr Qw = Qb + (unsigned)(tokmap<MODE>(qp, logd, logL) * ldq + hi * 8);
#pragma unroll
    for (int d0 = 0; d0 < NQ; ++d0) qr[d0] = *reinterpret_cast<GAS const bf16x8*>(Qw + d0 * 16); }
  const int sr = tid >> 4, sc = (tid & 15) * 8, vst0 = v_st(sr, sc), vst1 = v_st(32 + sr, sc);
  const int krr = tid >> 3, krc = (tid & 7) * 8;
  const int vb0 = (int)(unsigned)(uintptr_t)V_lds + v_rd_base(lane);
  struct { bf16x8 vs0, vs1, ks0, ks1, kr; } sr_[SDEPTH];
#define SLOAD(i, kk) do { const unsigned t0_ = (unsigned)tokmap<MODE>(k0 + (kk) + sr, logd, logL) * (unsigned)ldk + (unsigned)sc, t1_ = (unsigned)tokmap<MODE>(k0 + (kk) + 32 + sr, logd, logL) * (unsigned)ldk + (unsigned)sc; \
    sr_[i].vs0 = *reinterpret_cast<GAS const bf16x8*>(Vb + t0_); sr_[i].vs1 = *reinterpret_cast<GAS const bf16x8*>(Vb + t1_); \
    sr_[i].ks0 = *reinterpret_cast<GAS const bf16x8*>(Kb + t0_); sr_[i].ks1 = *reinterpret_cast<GAS const bf16x8*>(Kb + t1_); \
    if constexpr (MODE == 2) sr_[i].kr = *reinterpret_cast<GAS const bf16x8*>(KRb + (unsigned)((k0 + (kk) + krr) * 64 + krc)); } while (0)
#define SWRITE(b, i) do { *(LAS bf16x8*)(V_lds + (b) * SHM_V + vst0) = sr_[i].vs0; *(LAS bf16x8*)(V_lds + (b) * SHM_V + vst1) = sr_[i].vs1; const int kc = sc * 2; \
    *(LAS bf16x8*)(K_lds + (b) * SHM_K + KSWZ(sr, kc)) = sr_[i].ks0; *(LAS bf16x8*)(K_lds + (b) * SHM_K + KSWZ(32 + sr, kc)) = sr_[i].ks1; \
    if constexpr (MODE == 2) *(LAS bf16x8*)(KR_lds + (b) * SHM_KR + KSWZ2(krr, krc * 2)) = sr_[i].kr; } while (0)
#define SWAIT() do { if constexpr (SDEPTH == 2) asm volatile("s_waitcnt vmcnt(4)" ::: "memory"); else asm volatile("s_waitcnt vmcnt(0)" ::: "memory"); } while (0)
#define RESC(a) do { if (__any((a) < 1.f)) { if (hi == 0) al_l[r32] = (a); asm volatile("s_waitcnt lgkmcnt(0)" ::: "memory"); \
    _Pragma("unroll") for (int d = 0; d < 4; ++d) _Pragma("unroll") for (int r = 0; r < 16; ++r) o[d][r] *= al_l[crow(r, hi)]; } } while (0)
#define QKT(P0, P1, b, t) do { qkt<MODE>(P0, P1, K_lds + (b) * SHM_K, KR_lds + (b) * SHM_KR, qr, r32, hi); if constexpr (MODE == 1) bmask(P0, P1, k0 + (t) * KVBLK, qp, logL, hi); } while (0)
  bf16x8 pa0, pa1, pa2, pa3;
  if constexpr (MODE == 2) {
    f32x16 pA0, pA1; float mnA, alA;
    SLOAD(0, 0); asm volatile("s_waitcnt vmcnt(0)" ::: "memory"); SWRITE(0, 0); __syncthreads();
    for (int t = 0; t < NT; t += 2) {
      SLOAD(0, (t + 1) * KVBLK); SBAR();
      QKT(pA0, pA1, 0, t); partialSM<MODE>(pA0, pA1, m_reg, mnA, alA); RESC(alA);
      finishSM(pA0, pA1, alA, l_reg, pa0, pa1, pa2, pa3); SBAR();
      pv_d0(o, vb0, pa0, pa1, pa2, pa3);
      SWAIT(); SWRITE(1, 0); __syncthreads();
      if (t + 2 < NT) SLOAD(0, (t + 2) * KVBLK); SBAR();
      QKT(pA0, pA1, 1, t + 1); partialSM<MODE>(pA0, pA1, m_reg, mnA, alA); RESC(alA);
      finishSM(pA0, pA1, alA, l_reg, pa0, pa1, pa2, pa3); SBAR();
      pv_d0(o, vb0 + SHM_V, pa0, pa1, pa2, pa3);
      if (t + 2 < NT) { SWAIT(); SWRITE(0, 0); } __syncthreads();
    }
  } else {
  f32x16 pA0, pA1, pB0, pB1; float mnA, mnB, alA, alB;
  constexpr int SE = 0, SO = SDEPTH - 1;
  SLOAD(SE, 0); asm volatile("s_waitcnt vmcnt(0)" ::: "memory"); SWRITE(0, SE); __syncthreads();
  QKT(pA0, pA1, 0, 0); partialSM<MODE>(pA0, pA1, m_reg, mnA, alA);
  SLOAD(SO, KVBLK); if constexpr (SDEPTH == 2) { if (2 < NT) SLOAD(SE, 2 * KVBLK); }
  SWAIT(); SWRITE(1, SO); __syncthreads();
  for (int j = 1; j + 1 < NT; j += 2) {
    SBAR(); QKT(pB0, pB1, 1, j);
    finishSM(pA0, pA1, alA, l_reg, pa0, pa1, pa2, pa3); SBAR();
    SLOAD(SO, (j + SDEPTH) * KVBLK); SBAR();
    pv_d0(o, vb0, pa0, pa1, pa2, pa3); partialSM<MODE>(pB0, pB1, m_reg, mnB, alB);
    __syncthreads(); SWAIT(); SWRITE(0, SE);
    RESC(alB); __syncthreads();
    SBAR(); QKT(pA0, pA1, 0, j + 1);
    finishSM(pB0, pB1, alB, l_reg, pa0, pa1, pa2, pa3); SBAR();
    if (SDEPTH == 1 || j + 3 < NT) SLOAD(SE, (j + 1 + SDEPTH) * KVBLK); SBAR();
    pv_d0(o, vb0 + SHM_V, pa0, pa1, pa2, pa3); partialSM<MODE>(pA0, pA1, m_reg, mnA, alA);
    __syncthreads(); SWAIT(); SWRITE(1, SO);
    RESC(alA); __syncthreads();
  }
  SBAR(); QKT(pB0, pB1, 1, NT - 1);
  finishSM(pA0, pA1, alA, l_reg, pa0, pa1, pa2, pa3); SBAR();
  pv_d0(o, vb0, pa0, pa1, pa2, pa3); partialSM<MODE>(pB0, pB1, m_reg, mnB, alB);
  __syncthreads(); RESC(alB);
  finishSM(pB0, pB1, alB, l_reg, pa0, pa1, pa2, pa3); SBAR();
  pv_d0(o, vb0 + SHM_V, pa0, pa1, pa2, pa3);
  }
  if (hi == 0) li_l[r32] = l_reg; asm volatile("s_waitcnt lgkmcnt(0)" ::: "memory");
  if constexpr (MODE == 1) { if (hi == 0) lse[(unsigned)(tokmap<MODE>(qp, logd, logL) * 8)] = m_reg * SCALE + __builtin_amdgcn_logf(l_reg) * 0.6931471805599453f; }
#pragma unroll
  for (int r = 0; r < 16; ++r) { const int orow = crow(r, hi); const float rl = __builtin_amdgcn_rcpf(li_l[orow]);
    GAS unsigned short* Ow = Ob + (unsigned)(tokmap<MODE>(p0 + wid * QBLK + orow, logd, logL) * ldo + r32);
#pragma unroll
    for (int d0 = 0; d0 < 4; ++d0) Ow[d0 * 32] = (unsigned short)f2bf(o[d0][r] * rl); }
#undef SLOAD
#undef SWRITE
#undef SWAIT
#undef RESC
#undef QKT
}
}

__device__ __forceinline__ void attn_phase_a(const bf16* QKV, bf16* ATT, LAS char* lds, int G, int bx, int tid) {
    asm volatile("" : "+v"(tid));
    for (int u = bx; u < BATCH * 16 * 8; u += G) {
        int pair, j; if (G == 256) { pair = (u >> 8) * 8 + (bx & 7); j = bx >> 3; } else { pair = u >> 5; j = u & 31; }
        const int b = pair >> 2, kvh = pair & 3, hq = kvh * 4 + (j >> 3), qb = j & 7;
        att::gptr Qb = (att::gptr)(QKV + (size_t)b * SEQ * A_QKV + hq * 128); att::gptr Kb = (att::gptr)(QKV + (size_t)b * SEQ * A_QKV + 2048 + kvh * 128);
        att::attn_unit<0>(Qb, Kb, Kb + 512, Kb, (GAS unsigned short*)(ATT + (size_t)b * SEQ * DM + hq * 128), nullptr, 256 * qb, 0, 0, lds, tid);
        __syncthreads();
    }
}
__device__ __forceinline__ void attn_phase_c(const bf16* Q, const bf16* KV, const bf16* KR, bf16* ATT, LAS char* lds, int G, int bx, int tid) {
    asm volatile("" : "+v"(tid));
    for (int u = bx; u < BATCH * 16 * 8; u += G) {
        int pair, qb; if (G == 256) { pair = ((u >> 8) * 8 + (bx & 7)) * 4 + (bx >> 6); qb = (bx >> 3) & 7; } else { pair = u >> 3; qb = u & 7; }
        const int b = pair >> 4, h = pair & 15;
        att::gptr Qb = (att::gptr)(Q + (size_t)b * SEQ * C_Q + h * 192); att::gptr Kb = (att::gptr)(KV + (size_t)b * SEQ * C_KV + h * 256);
        att::attn_unit<2>(Qb, Kb, Kb + 128, (att::gptr)(KR + (size_t)b * SEQ * 64), (GAS unsigned short*)(ATT + (size_t)b * SEQ * DM + h * 128), nullptr, 256 * qb, 0, 0, lds, tid);
        __syncthreads();
    }
}
__device__ __forceinline__ void attn_phase_b(const bf16* QKV, bf16* OG, float* LSE, LAS char* lds, int G, int bx, int tid) {
    asm volatile("" : "+v"(tid));
    for (int u = bx; u < 3 * BATCH * 8 * 8; u += G) {
        const int qb = u & 7, h = (u >> 3) & 7, b = (u >> 6) & 15, grp = u >> 10, logd = 2 * grp;
        att::gptr Qb = (att::gptr)(QKV + (size_t)b * SEQ * B_QKV + grp * 3072 + h * 128);
        const int p0 = 256 * qb; int k0 = p0 - 64; k0 = k0 < 0 ? 0 : (k0 > SEQ - 384 ? SEQ - 384 : k0);
        att::attn_unit<1>(Qb, Qb + 1024, Qb + 2048, Qb, (GAS unsigned short*)(OG + (size_t)grp * MTOK * 1024 + (size_t)b * SEQ * 1024 + h * 128),
                          (GAS float*)(LSE + ((size_t)grp * MTOK + (size_t)b * SEQ) * 8 + h), p0, k0, logd, lds, tid);
        __syncthreads();
    }
}
__device__ __forceinline__ void merge_b(const bf16* OG, const float* LSE, bf16* ATT, int gw, int NGW, int lane) {
    asm volatile("" : "+v"(lane));
    const int h = lane >> 3, c = (lane & 7) * 16;
    for (int tok = gw; tok < MTOK; tok += NGW) {
        const float l0 = LSE[(size_t)tok * 8 + h], l1 = LSE[((size_t)MTOK + tok) * 8 + h], l2 = LSE[((size_t)2 * MTOK + tok) * 8 + h];
        const float mx = fmaxf(l0, fmaxf(l1, l2)); float w0 = __expf(l0 - mx), w1 = __expf(l1 - mx), w2 = __expf(l2 - mx); const float rs = 1.f / (w0 + w1 + w2); w0 *= rs; w1 *= rs; w2 *= rs;
        const GAS v4u* a = (const GAS v4u*)(OG + (size_t)tok * 1024 + h * 128 + c); const GAS v4u* bq = (const GAS v4u*)(OG + ((size_t)MTOK + tok) * 1024 + h * 128 + c); const GAS v4u* cq = (const GAS v4u*)(OG + ((size_t)2 * MTOK + tok) * 1024 + h * 128 + c);
        GAS v4u* o = (GAS v4u*)(ATT + (size_t)tok * 1024 + h * 128 + c);
#pragma unroll
        for (int i = 0; i < 2; ++i) { const v4u x = a[i], y = bq[i], z = cq[i]; v4u r;
            r.x = pk2(w0 * bflo(x.x) + w1 * bflo(y.x) + w2 * bflo(z.x), w0 * bfhi(x.x) + w1 * bfhi(y.x) + w2 * bfhi(z.x));
            r.y = pk2(w0 * bflo(x.y) + w1 * bflo(y.y) + w2 * bflo(z.y), w0 * bfhi(x.y) + w1 * bfhi(y.y) + w2 * bfhi(z.y));
            r.z = pk2(w0 * bflo(x.z) + w1 * bflo(y.z) + w2 * bflo(z.z), w0 * bfhi(x.z) + w1 * bfhi(y.z) + w2 * bfhi(z.z));
            r.w = pk2(w0 * bflo(x.w) + w1 * bflo(y.w) + w2 * bflo(z.w), w0 * bfhi(x.w) + w1 * bfhi(y.w) + w2 * bfhi(z.w));
            o[i] = r; }
    }
}

constexpr int N_IN = 57;
struct Args { const float* in[N_IN]; float* out; unsigned char* ws; int ph_lo, ph_hi; };
__device__ __forceinline__ const float* arg_in(int idx) {
    typedef __attribute__((address_space(4))) const char* kptr;
    kptr kp = (kptr)__builtin_amdgcn_kernarg_segment_ptr();
    return *(const float* __attribute__((address_space(4))) const*)(kp + 8 * idx);
}
constexpr int N_PHASES = 1 + 4 * 8 + 3 + 3 + 5 + 3 + (FAST_B ? 1 : 0);

__global__ void __launch_bounds__(NWAVES * 64, 2) mega_fwd(Args args) {
    extern __shared__ __attribute__((aligned(16))) unsigned char lds_raw[];
    LAS unsigned char* lds = (LAS unsigned char*)lds_raw;
    volatile LAS unsigned* MISC = (volatile LAS unsigned*)(lds + MISC_OFF);
    const int wave = __builtin_amdgcn_readfirstlane((int)threadIdx.x >> 6);
    unsigned char* const ws0 = args.ws; float* const out0 = args.out; const int G0 = gridDim.x, bx0 = blockIdx.x;
    for (int u = threadIdx.x; u < (LDS_BYTES - LDSCTL_OFF) / 4; u += NWAVES * 64) ((LAS unsigned*)(lds + LDSCTL_OFF))[u] = 0u;
    __syncthreads();
    XcdBarrier bar; bar.bar = (unsigned*)((gu32*)(ws0 + WS_CTL) + CW_BAR); bar.x = 0; bar.st = nullptr;
    if (!MK_PER_PHASE) bar = xcd_barrier_post((unsigned*)((gu32*)(ws0 + WS_CTL) + CW_BAR), MISC + 8);
    const int lo = args.ph_lo, hi = args.ph_hi;
    int ph = 0;
#define IN_PH() (lo <= ph && ph < hi)
#define SEAM() do { if (!MK_PER_PHASE) { if (lo <= ph && ph + 1 < hi) { unsigned ones_ = ~0u; asm volatile("" : "+s"(ones_)); xcd_barrier(bar, wave * 64 + (int)__builtin_amdgcn_mbcnt_hi(ones_, __builtin_amdgcn_mbcnt_lo(ones_, 0u))); } } ++ph; } while (0)
#define PH_VARS unsigned ones_ = ~0u; asm volatile("" : "+s"(ones_)); const int lane = (int)__builtin_amdgcn_mbcnt_hi(ones_, __builtin_amdgcn_mbcnt_lo(ones_, 0u)); const int tid = wave * 64 + lane; (void)lane; \
    unsigned char* ws = lnd(ws0); float* H32 = lnd(out0); bf16* WT = (bf16*)(ws + WS_WT); bf16* HB = (bf16*)(ws + WS_HB); unsigned char* R = ws + WS_R; \
    int G = G0, bx = bx0; asm volatile("" : "+s"(G), "+s"(bx)); const int vcu = (G % 8 == 0) ? (bx % 8) * (G / 8) + bx / 8 : bx; const int gw = vcu * NWAVES + wave, NGW = G * NWAVES; \
    const size_t gt = (size_t)vcu * (NWAVES * 64) + tid, NGT = (size_t)G * NWAVES * 64; LAS float* scr = (LAS float*)(lds + RING_OFF + wave * 16384); \
    (void)H32; (void)WT; (void)HB; (void)R; (void)gw; (void)NGW; (void)gt; (void)NGT; (void)scr;

    if (IN_PH()) { PH_VARS
        build_tables(ws, gt, NGT);
        cvt_rows_bf16(arg_in(0), HB, (size_t)MTOK * DM / 8, gt, NGT);
        cvt_weight(arg_in(1), DM, 2 * DFF, WT, 2 * DFF, 1, scr, gw, NGW, lane);
        cvt_weight(arg_in(2), DFF, DM, WT + WT_FFN_OUT, DM, 0, scr, gw, NGW, lane);
    }
    SEAM();

    for (int L = 0; L < DEPTH; ++L) {
        const int kind = (L == 3) ? 0 : L;
        const int base = (L == 0) ? 1 : (L == 1) ? 15 : (L == 2) ? 27 : 43;
        const int nmix = (kind == 0) ? 4 : (kind == 1) ? 2 : 6;
        for (int sub = 0; sub < 3; ++sub) {
            if (sub != 1) {
                if (IN_PH()) { PH_VARS
                    pg8::Gemm g{lnd(HB), lnd(WT), MTOK, 2 * DFF, DM}; pg8::StaticOrder S; S.init(MTOK, 2 * DFF, G, bx);
                    pg8::EpiSwiGLU E{lnd((bf16*)(R + R_ACT)), DFF};
                    pg8::gemm_phase<pg8::EpiSwiGLU, pg8::StaticOrder, PG8_ALIGN, PG8_SP2>(lds + RING_OFF, g, S, E, tid);
                }
                SEAM();
            } else {
                if (IN_PH()) { PH_VARS
                    const int N = (kind == 0) ? A_QKV : (kind == 1) ? B_QKV : C_INP;
                    pg8::Gemm g{lnd(HB), lnd(WT), MTOK, N, DM}; pg8::StaticOrder S; S.init(MTOK, N, G, bx);
                    pg8::EpiBf16 E{lnd((bf16*)(R + 0)), N};
                    pg8::gemm_phase<pg8::EpiBf16, pg8::StaticOrder, PG8_ALIGN, PG8_SP2>(lds + RING_OFF, g, S, E, tid);
                }
                SEAM();
                if (kind == 0) {
                    if (IN_PH()) { PH_VARS prep_a((bf16*)(R + RA_QKV), arg_in(base + 5), arg_in(base + 6), ws, gw, NGW, lane); }
                    SEAM();
#if FAST_A
                    if (IN_PH()) { PH_VARS attn_phase_a((const bf16*)(R + RA_QKV), (bf16*)(R + RA_ATT), (LAS char*)(lds + RING_OFF), G, bx, tid); }
#else
                    if (IN_PH()) { PH_VARS naive_attn_a((const bf16*)(R + RA_QKV), (bf16*)(R + RA_ATT), gw, NGW, lane); }
#endif
                    SEAM();
                } else if (kind == 1) {
                    if (IN_PH()) { PH_VARS prep_b((bf16*)(R + RB_QKV), ws, gw, NGW, lane); }
                    SEAM();
#if FAST_B
                    if (IN_PH()) { PH_VARS attn_phase_b((const bf16*)(R + RB_QKV), (bf16*)(R + RB_OG), (float*)(R + RB_LSE), (LAS char*)(lds + RING_OFF), G, bx, tid); }
                    SEAM();
                    if (IN_PH()) { PH_VARS merge_b((const bf16*)(R + RB_OG), (const float*)(R + RB_LSE), (bf16*)(R + RB_ATT), gw, NGW, lane); }
#else
                    if (IN_PH()) { PH_VARS naive_attn_b((const bf16*)(R + RB_QKV), (bf16*)(R + RB_ATT), gw, NGW, lane); }
#endif
                    SEAM();
                } else {
                    if (IN_PH()) { PH_VARS prep_c1((const bf16*)(R + RC_IN), (bf16*)(R + RC_QN), (bf16*)(R + RC_KVN), (bf16*)(R + RC_KR), arg_in(base + 5), arg_in(base + 6), ws, gw, NGW, lane); }
                    SEAM();
                    if (IN_PH()) { PH_VARS
                        { pg8::Gemm g{lnd((const bf16*)(R + RC_QN)), lnd(WT + WT_C_QUP), MTOK, C_Q, C_QL}; pg8::StaticOrder S; S.init(MTOK, C_Q, G, bx);
                          pg8::EpiBf16 E{lnd((bf16*)(R + RC_Q)), C_Q};
                          pg8::gemm_phase<pg8::EpiBf16, pg8::StaticOrder, PG8_ALIGN, PG8_SP2>(lds + RING_OFF, g, S, E, tid); }
                        { pg8::Gemm g{lnd((const bf16*)(R + RC_KVN)), lnd(WT + WT_C_KVUP), MTOK, C_KV, C_KVL}; pg8::StaticOrder S; S.init(MTOK, C_KV, G, bx);
                          pg8::EpiBf16 E{lnd((bf16*)(R + RC_KV)), C_KV};
                          pg8::gemm_phase<pg8::EpiBf16, pg8::StaticOrder, PG8_ALIGN, PG8_SP2>(lds + RING_OFF, g, S, E, tid); }
                    }
                    SEAM();
                    if (IN_PH()) { PH_VARS prep_c2((bf16*)(R + RC_Q), ws, gw, NGW, lane); }
                    SEAM();
#if FAST_C
                    if (IN_PH()) { PH_VARS attn_phase_c((const bf16*)(R + RC_Q), (const bf16*)(R + RC_KV), (const bf16*)(R + RC_KR), (bf16*)(R + RC_ATT), (LAS char*)(lds + RING_OFF), G, bx, tid); }
#else
                    if (IN_PH()) { PH_VARS naive_attn_c((const bf16*)(R + RC_Q), (const bf16*)(R + RC_KV), (const bf16*)(R + RC_KR), (bf16*)(R + RC_ATT), gw, NGW, lane); }
#endif
                    SEAM();
                }
            }
            if (IN_PH()) { PH_VARS
                const bf16* A; const bf16* Bt; int K; float s;
                if (sub != 1) { A = (const bf16*)(R + R_ACT); Bt = WT + WT_FFN_OUT; K = DFF; s = 0.5f; }
                else if (kind == 0) { A = (const bf16*)(R + RA_ATT); Bt = WT + WT_A_OUT; K = DM; s = 1.0f; }
                else if (kind == 1) { A = (const bf16*)(R + RB_ATT); Bt = WT + WT_B_OUT; K = 1024; s = 1.0f; }
                else { A = (const bf16*)(R + RC_ATT); Bt = WT + WT_C_OUT; K = DM; s = 1.0f; }
                pg8::Gemm g{lnd(A), lnd(Bt), MTOK, DM, K}; pg8::StaticOrder S; S.init(MTOK, DM, G, bx);
                pg8::EpiResid E{lnd((L == 0 && sub == 0) ? arg_in(0) : (const float*)H32), lnd(H32), DM, ALPHA, s};
                pg8::gemm_phase<pg8::EpiResid, pg8::StaticOrder, PG8_ALIGN, PG8_SP2>(lds + RING_OFF, g, S, E, tid);
            }
            SEAM();
            if (IN_PH()) { PH_VARS
                const int lnidx = (sub == 0) ? base + 2 : (sub == 1) ? base + 4 + nmix : base + 8 + nmix;
                ln_rows(H32, HB, arg_in(lnidx), arg_in(lnidx + 1), gw, NGW, lane);
                if (sub == 0) {
                    if (kind == 0) { cvt_weight(arg_in(base + 4), DM, A_QKV, WT, A_QKV, 0, scr, gw, NGW, lane); cvt_weight(arg_in(base + 7), DM, DM, WT + WT_A_OUT, DM, 0, scr, gw, NGW, lane); }
                    else if (kind == 1) { cvt_weight(arg_in(base + 4), DM, B_QKV, WT, B_QKV, 0, scr, gw, NGW, lane); cvt_weight(arg_in(base + 5), 1024, DM, WT + WT_B_OUT, DM, 0, scr, gw, NGW, lane); }
                    else { cvt_weight(arg_in(base + 4), DM, C_IN, WT, C_INP, 0, scr, gw, NGW, lane); cvt_weight(arg_in(base + 7), C_QL, C_Q, WT + WT_C_QUP, C_Q, 0, scr, gw, NGW, lane);
                           cvt_weight(arg_in(base + 8), C_KVL, C_KV, WT + WT_C_KVUP, C_KV, 0, scr, gw, NGW, lane); cvt_weight(arg_in(base + 9), DM, DM, WT + WT_C_OUT, DM, 0, scr, gw, NGW, lane); }
                } else {
                    int wi = -1;
                    if (sub == 1) wi = base + 6 + nmix;
                    else if (L + 1 < DEPTH) wi = ((L + 1 == 1) ? 15 : (L + 1 == 2) ? 27 : 43);
                    if (wi >= 0) { cvt_weight(arg_in(wi), DM, 2 * DFF, WT, 2 * DFF, 1, scr, gw, NGW, lane); cvt_weight(arg_in(wi + 1), DFF, DM, WT + WT_FFN_OUT, DM, 0, scr, gw, NGW, lane); }
                }
            }
            SEAM();
        }
    }
#undef IN_PH
#undef SEAM
}

extern "C" void kernel_launch(void* const* d_in, const int* in_sizes, int n_in, void* d_out, int out_size, void* d_ws, size_t ws_size, hipStream_t stream) {
    static int grid = 0;
    if (grid == 0) {
        if (n_in != N_IN || in_sizes[0] != MTOK * DM || out_size != MTOK * DM || ws_size < WS_END) {
            fprintf(stderr, "kernel_launch: shape mismatch: n_in %d in0 %d out %d ws %zu (need >= %zu)\n", n_in, n_in > 0 ? in_sizes[0] : -1, out_size, ws_size, (size_t)WS_END); grid = -1; return; }
        int dev = 0, cus = 0, per_cu = 0;
        if (hipGetDevice(&dev) != hipSuccess || hipDeviceGetAttribute(&cus, hipDeviceAttributeMultiprocessorCount, dev) != hipSuccess) { fprintf(stderr, "kernel_launch: device query failed\n"); grid = -1; return; }
        if (hipFuncSetAttribute((const void*)mega_fwd, hipFuncAttributeMaxDynamicSharedMemorySize, LDS_BYTES) != hipSuccess) { fprintf(stderr, "kernel_launch: hipFuncSetAttribute failed\n"); grid = -1; return; }
        if (hipOccupancyMaxActiveBlocksPerMultiprocessor(&per_cu, (const void*)mega_fwd, NWAVES * 64, LDS_BYTES) != hipSuccess || per_cu < 1)
            fprintf(stderr, "kernel_launch: note: occupancy query reports %d workgroups per CU\n", per_cu);
        (void)hipGetLastError();
        grid = cus;
    }
    if (grid < 0) return;
    if (hipMemsetAsync((char*)d_ws + WS_CTL, 0, CTL_ZERO_BYTES, stream) != hipSuccess) { fprintf(stderr, "kernel_launch: memset failed\n"); return; }
    Args a{};
    for (int i = 0; i < N_IN; ++i) a.in[i] = (const float*)d_in[i];
    a.out = (float*)d_out; a.ws = (unsigned char*)d_ws;
#if MK_PER_PHASE
    for (int p = 0; p < N_PHASES; ++p) { a.ph_lo = p; a.ph_hi = p + 1; hipLaunchKernelGGL(mega_fwd, dim3(grid), dim3(NWAVES * 64), LDS_BYTES, stream, a); }
#else
    a.ph_lo = 0; a.ph_hi = N_PHASES;
    hipLaunchKernelGGL(mega_fwd, dim3(grid), dim3(NWAVES * 64), LDS_BYTES, stream, a);
#endif
    const hipError_t le = hipPeekAtLastError();
    if (le != hipSuccess) fprintf(stderr, "kernel_launch: launch failed: %s\n", hipGetErrorName(le));
}
```

```cpp
#include <hip/hip_runtime.h>
#include <cstdio>
#include <cstdint>

#ifndef FAST_A
#define FAST_A 1
#endif
#ifndef FAST_B
#define FAST_B 1
#endif
#ifndef FAST_C
#define FAST_C 1
#endif
#ifndef EXP
#define EXP 0
#endif
#ifndef LAUNCH_TWICE
#define LAUNCH_TWICE 0
#endif
#ifndef REPS
#define REPS 1
#endif
#ifndef PROBE_CAT
#define PROBE_CAT -1
#endif
#ifndef MK_PER_PHASE
#define MK_PER_PHASE 0
#endif

namespace pg8 {
#define PG8_LAS __attribute__((address_space(3)))
typedef unsigned short bf16_t;
typedef short bf16x8 __attribute__((ext_vector_type(8)));
typedef float f32x4 __attribute__((ext_vector_type(4)));
typedef unsigned u32x4 __attribute__((ext_vector_type(4)));
typedef unsigned u32x2 __attribute__((ext_vector_type(2)));
typedef float f32x2_t __attribute__((ext_vector_type(2)));
__device__ __forceinline__ float lo_sc(float d) { return __builtin_amdgcn_fmed3f(d * 512.f, -240.f, 240.f); }
constexpr float LO_SCALE = 512.f, LO_INV = 1.f / 512.f;
constexpr int BM = 256, BK = 64, HALF = 128, HTB = HALF * BK * 2  , STAGE_BYTES = 8 * HTB, NXCD = 8, WGM = 8;

__host__ __device__ __forceinline__ int lds_byte(int r, int c) { const int st = (r >> 4) * 2 + (c >> 5), rr = r & 15, cc = c & 31, ob = rr * 64 + cc * 2; return st * 1024 + (ob ^ (((ob >> 9) & 1) << 5)); }
__host__ __device__ __forceinline__ void stage_rc(int b, int& R, int& C) { const int st = b / 1024, sb = b % 1024, swz = sb ^ (((sb >> 9) & 1) << 5); R = (st >> 1) * 16 + swz / 64; C = (st & 1) * 32 + (swz % 64) / 2; }
__host__ __device__ __forceinline__ int perm32(int rho) { const int n = rho >> 4, i = rho & 15; return 8 * (i >> 2) + 4 * n + (i & 3); }

struct Unit { int pm, pn; };
struct Gemm { const bf16_t* A; const bf16_t* Bt; int M, N, K, lda; };

struct StaticOrder {
    int nM, nN, nwg, G, c;
    __host__ __device__ void init(int M, int N, int G_, int c_) { nM = M / BM; nN = N / BM; nwg = nM * nN; G = G_; c = c_; }
    __host__ __device__ bool next(int i, Unit& u) const {
        const long L = (long)i * G + c; if (L >= nwg) return false;
        int wgid = (int)L; { const int q = nwg / NXCD, r = nwg % NXCD, xcd = wgid % NXCD, off = wgid / NXCD; wgid = (xcd < r ? xcd * (q + 1) : r * (q + 1) + (xcd - r) * q) + off; }
        const int nig = WGM * nN, gid = wgid / nig, fm = gid * WGM, gsz = (nM - fm) < WGM ? (nM - fm) : WGM;
        if (nN == 8 && gsz == WGM) { u.pm = fm + ((wgid % nig) >> 3); u.pn = (wgid % nig) & 7; }
        else { u.pm = fm + ((wgid % nig) % gsz); u.pn = (wgid % nig) / gsz; }
        return true;
    }
    __device__ __forceinline__ void a_ready(const Unit&) const {}
    __device__ __forceinline__ void done(const Unit&) const {}
};

__device__ __forceinline__ unsigned cvt_pk_bf16(float lo, float hi) { unsigned r; asm volatile("v_cvt_pk_bf16_f32 %0, %1, %2" : "=v"(r) : "v"(lo), "v"(hi)); return r; }

struct EpiBf16 {
    static constexpr bool PERM = true, AFTER_DRAIN = false;
    bf16_t* O; int ldc;
    __device__ __forceinline__ void operator()(const f32x4 (&acc)[2][2][4][2], const Unit& u, int wr, int wc, int fr, int fq) const {
        const int row0 = u.pm * BM + wr * 64 + fr; const int col0 = u.pn * BM + wc * 32 + 8 * fq;
#pragma unroll
        for (int ai = 0; ai < 2; ++ai)
#pragma unroll
            for (int m = 0; m < 4; ++m) { bf16_t* rowp = O + (size_t)(row0 + ai * HALF + m * 16) * ldc + col0;
#pragma unroll
                for (int bj = 0; bj < 2; ++bj) { const f32x4 v0 = acc[ai][bj][m][0], v1 = acc[ai][bj][m][1];
                    u32x4 w; w.x = cvt_pk_bf16(v0[0], v0[1]); w.y = cvt_pk_bf16(v0[2], v0[3]); w.z = cvt_pk_bf16(v1[0], v1[1]); w.w = cvt_pk_bf16(v1[2], v1[3]);
                    *(u32x4*)(rowp + bj * HALF) = w; } }
    }
};
__device__ __forceinline__ float silu_mul(float g, float u) { return g * u * __builtin_amdgcn_rcpf(1.0f + __builtin_amdgcn_exp2f(-1.4426950408889634f * g)); }
__device__ __forceinline__ float silu_mul_ps(float gp, float up) { return gp * up * __builtin_amdgcn_rcpf(1.0f + __builtin_amdgcn_exp2f(gp)); }
struct EpiSwiGLU {
    static constexpr bool PERM = true, AFTER_DRAIN = false;
    bf16_t* O; int ldc;
    __device__ __forceinline__ void operator()(const f32x4 (&acc)[2][2][4][2], const Unit& u, int wr, int wc, int fr, int fq) const {
        const int row0 = u.pm * BM + wr * 64 + fr; const int col0 = u.pn * HALF + wc * 32 + 8 * fq;
#pragma unroll
        for (int ai = 0; ai < 2; ++ai)
#pragma unroll
            for (int m = 0; m < 4; ++m) { bf16_t* rowp = O + (size_t)(row0 + ai * HALF + m * 16) * ldc + col0;
                const f32x4 g0 = acc[ai][0][m][0], g1 = acc[ai][0][m][1], u0 = acc[ai][1][m][0], u1 = acc[ai][1][m][1];
                u32x4 w; w.x = cvt_pk_bf16(silu_mul(g0[0], u0[0]), silu_mul(g0[1], u0[1])); w.y = cvt_pk_bf16(silu_mul(g0[2], u0[2]), silu_mul(g0[3], u0[3]));
                w.z = cvt_pk_bf16(silu_mul(g1[0], u1[0]), silu_mul(g1[1], u1[1])); w.w = cvt_pk_bf16(silu_mul(g1[2], u1[2]), silu_mul(g1[3], u1[3]));
                *(u32x4*)rowp = w; }
    }
};
struct EpiResid {
    static constexpr bool PERM = false, AFTER_DRAIN = false;
    const float* hin; float* hout; int ldc; float alpha, s;
    __device__ __forceinline__ void operator()(const f32x4 (&acc)[2][2][4][2], const Unit& u, int wr, int wc, int fr, int fq) const {
        const int row0 = u.pm * BM + wr * 64 + fr, col0 = u.pn * BM + wc * 32 + 4 * fq;
#pragma unroll
        for (int ai = 0; ai < 2; ++ai)
#pragma unroll
            for (int m = 0; m < 4; ++m) { const size_t off = (size_t)(row0 + ai * HALF + m * 16) * ldc + col0;
#pragma unroll
                for (int bj = 0; bj < 2; ++bj)
#pragma unroll
                    for (int n = 0; n < 2; ++n) { const f32x4 hv = *(const f32x4*)(hin + off + bj * HALF + n * 16); *(f32x4*)(hout + off + bj * HALF + n * 16) = hv * alpha + acc[ai][bj][m][n] * s; } }
    }
};


struct RowStat { const float* sum; const float* ssq; float inv_n, eps; int mode; };
__device__ __forceinline__ void row_stat(const RowStat& st, int row, float& rs, float& rm) {
    if (st.mode == 0 || EXP == 1) { rs = 1.f; rm = 0.f; }
    else { const float q = st.ssq[row] * st.inv_n;
        if (st.mode == 1) { const float mean = st.sum[row] * st.inv_n; rs = __builtin_amdgcn_rsqf(q - mean * mean + st.eps); rm = rs * mean; }
        else { rs = __builtin_amdgcn_rsqf(q + st.eps); rm = 0.f; } }
}
__device__ __forceinline__ void row_stat8(const RowStat& st, int row0, float (&rs)[8], float (&rm)[8]) {
    if (st.mode == 0 || EXP == 1) {
#pragma unroll
        for (int i = 0; i < 8; ++i) { rs[i] = 1.f; rm[i] = 0.f; }
    } else {
        float q[8], sm[8];
#pragma unroll
        for (int i = 0; i < 8; ++i) { const int row = row0 + (i >> 2) * HALF + (i & 3) * 16; q[i] = st.ssq[row]; sm[i] = 0.f; }
        if (st.mode == 1) {
#pragma unroll
            for (int i = 0; i < 8; ++i) { const int row = row0 + (i >> 2) * HALF + (i & 3) * 16; sm[i] = st.sum[row]; }
        }
#pragma unroll
        for (int i = 0; i < 8; ++i) { const float mean = sm[i] * st.inv_n; rs[i] = __builtin_amdgcn_rsqf(q[i] * st.inv_n - mean * mean + st.eps); rm[i] = rs[i] * mean; }
    }
}
struct EpiAff {
    static constexpr bool PERM = true, AFTER_DRAIN = false;
    bf16_t* O; int ldc; RowStat st; const float* u; const float* v; float* ssq_out;
    const float* rope;
    __device__ __forceinline__ void operator()(const f32x4 (&acc)[2][2][4][2], const Unit& un, int wr, int wc, int fr, int fq) const {
        const int row0 = un.pm * BM + wr * 64 + fr; const int col0 = un.pn * BM + wc * 32 + 8 * fq;
        f32x4 uu[2][2], vv[2][2];
#pragma unroll
        for (int bj = 0; bj < 2; ++bj)
#pragma unroll
            for (int n = 0; n < 2; ++n) { if (u) { uu[bj][n] = *(const f32x4*)(u + col0 + bj * HALF + 4 * n); vv[bj][n] = *(const f32x4*)(v + col0 + bj * HALF + 4 * n); } else { uu[bj][n] = (f32x4){0.f, 0.f, 0.f, 0.f}; vv[bj][n] = uu[bj][n]; } }
        float* sq = nullptr; if (ssq_out && un.pn < 5) sq = ssq_out + (un.pn < 3 ? 0 : 32768);
        const bool dorope = (rope != nullptr) && ((un.pn % 12) < 8);
        float rs8[8], rm8[8]; row_stat8(st, row0, rs8, rm8);
#pragma unroll
        for (int ai = 0; ai < 2; ++ai)
#pragma unroll
            for (int m = 0; m < 4; ++m) { const int row = row0 + ai * HALF + m * 16; const float rs = rs8[ai * 4 + m], rm = rm8[ai * 4 + m];
                bf16_t* rowp = O + (size_t)row * ldc + col0; float ss = 0.f;
                f32x4 rc = {1.f, 1.f, 1.f, 1.f}, rsn = {0.f, 0.f, 0.f, 0.f};
                if (dorope) { const float* tp = rope + (size_t)(row & 2047) * 64 + wc * 16 + 4 * fq; rc = *(const f32x4*)tp; rsn = *(const f32x4*)(tp + 2048 * 64); }
#pragma unroll
                for (int bj = 0; bj < 2; ++bj) { f32x4 v0 = acc[ai][bj][m][0] * rs + (vv[bj][0] - uu[bj][0] * rm), v1 = acc[ai][bj][m][1] * rs + (vv[bj][1] - uu[bj][1] * rm);
                    if (dorope) { const f32x4 a0 = v0, a1 = v1;
                        v0[0] = a0[0] * rc[0] - a0[1] * rsn[0]; v0[1] = a0[0] * rsn[0] + a0[1] * rc[0]; v0[2] = a0[2] * rc[1] - a0[3] * rsn[1]; v0[3] = a0[2] * rsn[1] + a0[3] * rc[1];
                        v1[0] = a1[0] * rc[2] - a1[1] * rsn[2]; v1[1] = a1[0] * rsn[2] + a1[1] * rc[2]; v1[2] = a1[2] * rc[3] - a1[3] * rsn[3]; v1[3] = a1[2] * rsn[3] + a1[3] * rc[3]; }
                    ss += (v0[0] * v0[0] + v0[1] * v0[1]) + (v0[2] * v0[2] + v0[3] * v0[3]) + (v1[0] * v1[0] + v1[1] * v1[1]) + (v1[2] * v1[2] + v1[3] * v1[3]);
                    u32x4 w; w.x = cvt_pk_bf16(v0[0], v0[1]); w.y = cvt_pk_bf16(v0[2], v0[3]); w.z = cvt_pk_bf16(v1[0], v1[1]); w.w = cvt_pk_bf16(v1[2], v1[3]);
                    *(u32x4*)(rowp + bj * HALF) = w; }
                if (sq) { ss += __shfl_xor(ss, 16); ss += __shfl_xor(ss, 32); if (fq == 0) __hip_atomic_fetch_add(sq + row, ss, __ATOMIC_RELAXED, __HIP_MEMORY_SCOPE_AGENT); } }
    }
};
struct EpiAffA {
    static constexpr bool PERM = true, AFTER_DRAIN = false;
    bf16_t* O; int ldc; RowStat st; const float* u; const float* v; const float* qg; const float* kg; const float* taba; PG8_LAS float* xch;
    __device__ __forceinline__ void operator()(f32x4 (&acc)[2][2][4][2], const Unit& un, int wr, int wc, int fr, int fq) const {
        const int row0 = un.pm * BM + wr * 64 + fr; const int col0 = un.pn * BM + wc * 32 + 8 * fq;
        const bool nr = un.pn < 10;
        { f32x4 uu[2][2], vv[2][2];
#pragma unroll
          for (int bj = 0; bj < 2; ++bj)
#pragma unroll
            for (int n = 0; n < 2; ++n) { uu[bj][n] = *(const f32x4*)(u + col0 + bj * HALF + 4 * n); vv[bj][n] = *(const f32x4*)(v + col0 + bj * HALF + 4 * n); }
          float rs8[8], rm8[8]; row_stat8(st, row0, rs8, rm8);
#pragma unroll
          for (int ai = 0; ai < 2; ++ai)
#pragma unroll
            for (int m = 0; m < 4; ++m) { const float rs = rs8[ai * 4 + m], rm = rm8[ai * 4 + m]; float sq[2];
#pragma unroll
                for (int bj = 0; bj < 2; ++bj) { const f32x4 v0 = acc[ai][bj][m][0] * rs + (vv[bj][0] - uu[bj][0] * rm), v1 = acc[ai][bj][m][1] * rs + (vv[bj][1] - uu[bj][1] * rm);
                    acc[ai][bj][m][0] = v0; acc[ai][bj][m][1] = v1;
                    sq[bj] = (v0[0] * v0[0] + v0[1] * v0[1]) + (v0[2] * v0[2] + v0[3] * v0[3]) + (v1[0] * v1[0] + v1[1] * v1[1]) + (v1[2] * v1[2] + v1[3] * v1[3]); }
                if (nr) { sq[0] += __shfl_xor(sq[0], 16); sq[0] += __shfl_xor(sq[0], 32); sq[1] += __shfl_xor(sq[1], 16); sq[1] += __shfl_xor(sq[1], 32);
                    if (fq == 0) { const int rl = ai * HALF + wr * 64 + m * 16 + fr; xch[(rl * 2 + 0) * 4 + wc] = sq[0]; xch[(rl * 2 + 1) * 4 + wc] = sq[1]; } } }
        }
        if (nr) { asm volatile("s_waitcnt lgkmcnt(0)" ::: "memory"); __builtin_amdgcn_s_barrier(); asm volatile("" ::: "memory"); }
        f32x4 ga = {1.f, 1.f, 1.f, 1.f}, gb = ga;
        const int hf = wc >> 1, ib = (wc & 1) * 16 + 4 * fq;
        if (nr) { const float* gp = (un.pn < 8) ? qg : kg; ga = *(const f32x4*)(gp + 64 * hf + ib); gb = *(const f32x4*)(gp + 64 * hf + ib + 32); }
#pragma unroll
        for (int ai = 0; ai < 2; ++ai)
#pragma unroll
            for (int m = 0; m < 4; ++m) { const int row = row0 + ai * HALF + m * 16; bf16_t* rowp = O + (size_t)row * ldc + col0;
                f32x4 rc = {1.f, 1.f, 1.f, 1.f}, rsn = {0.f, 0.f, 0.f, 0.f};
                if (nr) { const int sp = row & 2047, pos = hf ? (sp & 63) : (sp >> 6); const float* tp = taba + pos * 32 + ib; rc = *(const f32x4*)tp; rsn = *(const f32x4*)(tp + 64 * 32); }
#pragma unroll
                for (int bj = 0; bj < 2; ++bj) { f32x4 v0 = acc[ai][bj][m][0], v1 = acc[ai][bj][m][1];
                    if (nr) { const int rl = ai * HALF + wr * 64 + m * 16 + fr; const f32x4 pp = *(const PG8_LAS f32x4*)(xch + (rl * 2 + bj) * 4);
                        const float rn = __builtin_amdgcn_rsqf(((pp[0] + pp[1]) + (pp[2] + pp[3])) * (1.f / 128.f) + 1e-6f);
                        const float a0 = v0[0] * rn * ga[0], b0 = v0[1] * rn * gb[0], a1 = v0[2] * rn * ga[1], b1 = v0[3] * rn * gb[1], a2 = v1[0] * rn * ga[2], b2 = v1[1] * rn * gb[2], a3 = v1[2] * rn * ga[3], b3 = v1[3] * rn * gb[3];
                        v0[0] = a0 * rc[0] - b0 * rsn[0]; v0[1] = a0 * rsn[0] + b0 * rc[0]; v0[2] = a1 * rc[1] - b1 * rsn[1]; v0[3] = a1 * rsn[1] + b1 * rc[1];
                        v1[0] = a2 * rc[2] - b2 * rsn[2]; v1[1] = a2 * rsn[2] + b2 * rc[2]; v1[2] = a3 * rc[3] - b3 * rsn[3]; v1[3] = a3 * rsn[3] + b3 * rc[3]; }
                    u32x4 w; w.x = cvt_pk_bf16(v0[0], v0[1]); w.y = cvt_pk_bf16(v0[2], v0[3]); w.z = cvt_pk_bf16(v1[0], v1[1]); w.w = cvt_pk_bf16(v1[2], v1[3]);
                    *(u32x4*)(rowp + bj * HALF) = w; } }
    }
};
struct EpiAffSwiGLU {
    static constexpr bool PERM = true, AFTER_DRAIN = false;
    bf16_t* O; int ldc; RowStat st; const float* u; const float* v;
    __device__ __forceinline__ void operator()(const f32x4 (&acc)[2][2][4][2], const Unit& un, int wr, int wc, int fr, int fq) const {
        const int row0 = un.pm * BM + wr * 64 + fr; const int col0 = un.pn * HALF + wc * 32 + 8 * fq, ucol0 = un.pn * BM + wc * 32 + 8 * fq;
        f32x4 uu[2][2], vv[2][2];
#pragma unroll
        for (int bj = 0; bj < 2; ++bj)
#pragma unroll
            for (int n = 0; n < 2; ++n) { uu[bj][n] = *(const f32x4*)(u + ucol0 + bj * HALF + 4 * n); vv[bj][n] = *(const f32x4*)(v + ucol0 + bj * HALF + 4 * n); }
        float rs8[8], rm8[8]; row_stat8(st, row0, rs8, rm8);
#pragma unroll
        for (int ai = 0; ai < 2; ++ai)
#pragma unroll
            for (int m = 0; m < 4; ++m) { const int row = row0 + ai * HALF + m * 16; const float rs = rs8[ai * 4 + m], rm = rm8[ai * 4 + m];
                bf16_t* rowp = O + (size_t)row * ldc + col0;
                const float rsg = rs * -1.4426950408889634f, rsu = rs * -0.6931471805599453f;
                const f32x4 g0 = acc[ai][0][m][0] * rsg + (vv[0][0] - uu[0][0] * rm), g1 = acc[ai][0][m][1] * rsg + (vv[0][1] - uu[0][1] * rm);
                const f32x4 u0 = acc[ai][1][m][0] * rsu + (vv[1][0] - uu[1][0] * rm), u1 = acc[ai][1][m][1] * rsu + (vv[1][1] - uu[1][1] * rm);
                u32x4 w; w.x = cvt_pk_bf16(silu_mul_ps(g0[0], u0[0]), silu_mul_ps(g0[1], u0[1])); w.y = cvt_pk_bf16(silu_mul_ps(g0[2], u0[2]), silu_mul_ps(g0[3], u0[3]));
                w.z = cvt_pk_bf16(silu_mul_ps(g1[0], u1[0]), silu_mul_ps(g1[1], u1[1])); w.w = cvt_pk_bf16(silu_mul_ps(g1[2], u1[2]), silu_mul_ps(g1[3], u1[3]));
                *(u32x4*)rowp = w; }
    }
};
struct EpiResid2 {
    static constexpr bool PERM = true, AFTER_DRAIN = false;
    bf16_t* hi; unsigned char* lo; float* sum_out; float* ssq_out; const float* g; const float* b; RowStat st; int ldc; float alpha, s;
    __device__ __forceinline__ void operator()(const f32x4 (&acc)[2][2][4][2], const Unit& un, int wr, int wc, int fr, int fq) const {
        const int row0 = un.pm * BM + wr * 64 + fr, col0 = un.pn * BM + wc * 32 + 8 * fq;
        f32x4 gg[2][2], bb[2][2];
#pragma unroll
        for (int bj = 0; bj < 2; ++bj)
#pragma unroll
            for (int n = 0; n < 2; ++n) { if (st.mode != 0) { gg[bj][n] = *(const f32x4*)(g + col0 + bj * HALF + 4 * n); bb[bj][n] = *(const f32x4*)(b + col0 + bj * HALF + 4 * n); } else { gg[bj][n] = (f32x4){1.f, 1.f, 1.f, 1.f}; bb[bj][n] = (f32x4){0.f, 0.f, 0.f, 0.f}; } }
        u32x4 x[8][2]; u32x2 xl[8][2]; float q8[8], s8[8];
#define RS2_LOAD(gi) do { const int ai_ = (gi) >> 2, m_ = (gi) & 3; const int row_ = row0 + ai_ * HALF + m_ * 16; const size_t off_ = (size_t)row_ * ldc + col0; \
            _Pragma("unroll") for (int bj = 0; bj < 2; ++bj) { \
                x[gi][bj] = *(const u32x4*)(hi + off_ + bj * HALF); xl[gi][bj] = *(const u32x2*)(lo + off_ + bj * HALF); } \
            q8[gi] = 0.f; s8[gi] = 0.f; if (st.mode == 1 && EXP != 1) { q8[gi] = st.ssq[row_]; s8[gi] = st.sum[row_]; } } while (0)
        RS2_LOAD(0);
#pragma unroll
        for (int gi = 0; gi < 8; ++gi) { const int ai = gi >> 2, m = gi & 3;
            if (gi + 1 < 8) { if (gi == 0) RS2_LOAD(1); else if (gi == 1) RS2_LOAD(2); else if (gi == 2) RS2_LOAD(3); else if (gi == 3) RS2_LOAD(4); else if (gi == 4) RS2_LOAD(5); else if (gi == 5) RS2_LOAD(6); else RS2_LOAD(7); }
            __builtin_amdgcn_sched_barrier(0);
            const int row = row0 + ai * HALF + m * 16; float rs = 1.f, rm = 0.f;
            if (st.mode == 1 && EXP != 1) { const float mean = s8[gi] * st.inv_n; rs = __builtin_amdgcn_rsqf(q8[gi] * st.inv_n - mean * mean + st.eps); rm = rs * mean; }
            const size_t off = (size_t)row * ldc + col0; float sm = 0.f, ss = 0.f;
#pragma unroll
            for (int bj = 0; bj < 2; ++bj) {
                f32x4 x0, x1;
                { const u32x4 hw = x[gi][bj]; const u32x2 lw = xl[gi][bj];
                    const f32x2_t l01 = __builtin_amdgcn_cvt_pk_f32_fp8((int)lw[0], false), l23 = __builtin_amdgcn_cvt_pk_f32_fp8((int)lw[0], true), l45 = __builtin_amdgcn_cvt_pk_f32_fp8((int)lw[1], false), l67 = __builtin_amdgcn_cvt_pk_f32_fp8((int)lw[1], true);
                    x0[0] = __uint_as_float(hw[0] << 16) + l01[0] * LO_INV; x0[1] = __uint_as_float(hw[0] & 0xffff0000u) + l01[1] * LO_INV;
                    x0[2] = __uint_as_float(hw[1] << 16) + l23[0] * LO_INV; x0[3] = __uint_as_float(hw[1] & 0xffff0000u) + l23[1] * LO_INV;
                    x1[0] = __uint_as_float(hw[2] << 16) + l45[0] * LO_INV; x1[1] = __uint_as_float(hw[2] & 0xffff0000u) + l45[1] * LO_INV;
                    x1[2] = __uint_as_float(hw[3] << 16) + l67[0] * LO_INV; x1[3] = __uint_as_float(hw[3] & 0xffff0000u) + l67[1] * LO_INV; }
                const f32x4 h0 = (x0 * rs - rm) * gg[bj][0] + bb[bj][0], h1 = (x1 * rs - rm) * gg[bj][1] + bb[bj][1];
                const f32x4 p0 = h0 * alpha + acc[ai][bj][m][0] * s, p1 = h1 * alpha + acc[ai][bj][m][1] * s;
                u32x4 w; w.x = cvt_pk_bf16(p0[0], p0[1]); w.y = cvt_pk_bf16(p0[2], p0[3]); w.z = cvt_pk_bf16(p1[0], p1[1]); w.w = cvt_pk_bf16(p1[2], p1[3]);
                int l0 = __builtin_amdgcn_cvt_pk_fp8_f32(lo_sc(p0[0] - __uint_as_float(w.x << 16)), lo_sc(p0[1] - __uint_as_float(w.x & 0xffff0000u)), 0, false);
                l0 = __builtin_amdgcn_cvt_pk_fp8_f32(lo_sc(p0[2] - __uint_as_float(w.y << 16)), lo_sc(p0[3] - __uint_as_float(w.y & 0xffff0000u)), l0, true);
                int l1 = __builtin_amdgcn_cvt_pk_fp8_f32(lo_sc(p1[0] - __uint_as_float(w.z << 16)), lo_sc(p1[1] - __uint_as_float(w.z & 0xffff0000u)), 0, false);
                l1 = __builtin_amdgcn_cvt_pk_fp8_f32(lo_sc(p1[2] - __uint_as_float(w.w << 16)), lo_sc(p1[3] - __uint_as_float(w.w & 0xffff0000u)), l1, true);
                *(u32x4*)(hi + off + bj * HALF) = w; *(u32x2*)(lo + off + bj * HALF) = (u32x2){(unsigned)l0, (unsigned)l1};
                sm += ((p0[0] + p0[1]) + (p0[2] + p0[3])) + ((p1[0] + p1[1]) + (p1[2] + p1[3]));
                ss += (p0[0] * p0[0] + p0[1] * p0[1]) + (p0[2] * p0[2] + p0[3] * p0[3]) + (p1[0] * p1[0] + p1[1] * p1[1]) + (p1[2] * p1[2] + p1[3] * p1[3]); }
            sm += __shfl_xor(sm, 16); sm += __shfl_xor(sm, 32); ss += __shfl_xor(ss, 16); ss += __shfl_xor(ss, 32);
            if (fq == 0 && EXP != 1) { __hip_atomic_fetch_add(sum_out + row, sm, __ATOMIC_RELAXED, __HIP_MEMORY_SCOPE_AGENT); __hip_atomic_fetch_add(ssq_out + row, ss, __ATOMIC_RELAXED, __HIP_MEMORY_SCOPE_AGENT); }
        }
#undef RS2_LOAD
    }
};

template <class Epi, class Sched, bool ALIGN_EPI = false, bool SP2 = false>
__device__ __forceinline__ void gemm_phase(PG8_LAS unsigned char* lds, const Gemm g, const Sched& S, const Epi& E, int tid_) {
    asm volatile("" : "+v"(tid_));
    const int tid = tid_, wid = __builtin_amdgcn_readfirstlane(tid >> 6), lane = tid & 63, wr = wid >> 2, wc = wid & 3, fr = lane & 15, fq = lane >> 4;
    const int K = g.K, nt = K / BK;
    unsigned voffA[2], voffB[2];
#pragma unroll
    for (int i = 0; i < 2; ++i) { int R, C; stage_rc(tid * 16 + i * 8192, R, C); const int Rb = Epi::PERM ? ((R & ~31) + perm32(R & 31)) : R;
        voffA[i] = (unsigned)(R * g.lda + C) * 2u; voffB[i] = (unsigned)(Rb * K + C) * 2u; }
    const size_t kstep = (size_t)(BK * 2);
    const size_t hstep = (size_t)HALF * K * 2, hstepA = (size_t)HALF * g.lda * 2;
    const size_t tstep = 2 * hstep, tstepA = 2 * hstepA;
    const unsigned ldsw = (unsigned)wid * 1024u;
    const int aoff = lds_byte(wr * 64 + fr, fq * 8), boff = lds_byte(wc * 32 + fr, fq * 8);
#define PG8_SA(b, h) (((b) * 2 + (h)) * HTB)
#define PG8_SB(b, h) ((4 + (b) * 2 + (h)) * HTB)
#define PG8_STAGE(bufoff, gbase, voff) do { _Pragma("unroll") for (int _i = 0; _i < 2; ++_i) \
        __builtin_amdgcn_global_load_lds((const unsigned*)((const char*)(gbase) + (voff)[_i]), (PG8_LAS unsigned*)(lds + (bufoff) + ldsw + _i * 8192), 16, 0, 0); } while (0)
#define PG8_LDA(dst, b, h) do { _Pragma("unroll") for (int m = 0; m < 4; ++m) _Pragma("unroll") for (int k = 0; k < 2; ++k) dst[m][k] = *(const PG8_LAS bf16x8*)(lds + PG8_SA(b, h) + aoff + m * 2048 + k * 1024); } while (0)
#define PG8_LDB(dst, b, h) do { _Pragma("unroll") for (int n = 0; n < 2; ++n) _Pragma("unroll") for (int k = 0; k < 2; ++k) dst[n][k] = *(const PG8_LAS bf16x8*)(lds + PG8_SB(b, h) + boff + n * 2048 + k * 1024); } while (0)
#define PG8_MMA(ai, bj, At, Bt) do { __builtin_amdgcn_s_setprio(1); _Pragma("unroll") for (int m = 0; m < 4; ++m) _Pragma("unroll") for (int n = 0; n < 2; ++n) _Pragma("unroll") for (int k = 0; k < 2; ++k) \
        acc[ai][bj][m][n] = __builtin_amdgcn_mfma_f32_16x16x32_bf16(Bt[n][k], At[m][k], acc[ai][bj][m][n], 0, 0, 0); __builtin_amdgcn_s_setprio(0); } while (0)
#define PG8_WAIT_V(n) asm volatile("s_waitcnt vmcnt(" #n ")" ::: "memory")
#define PG8_WAIT_L(n) asm volatile("s_waitcnt lgkmcnt(" #n ")" ::: "memory")
#define PG8_BAR __builtin_amdgcn_s_barrier()
#define PG8_SCHED __builtin_amdgcn_sched_barrier(0)
    Unit cur, nxt; int ui = 0;
    if (!S.next(0, cur)) return;
    f32x4 acc[2][2][4][2];
#pragma unroll
    for (int a = 0; a < 2; ++a)
#pragma unroll
        for (int b = 0; b < 2; ++b)
#pragma unroll
            for (int m = 0; m < 4; ++m)
#pragma unroll
                for (int n = 0; n < 2; ++n) acc[a][b][m][n] = (f32x4){0.f, 0.f, 0.f, 0.f};
    bf16x8 At[4][2], B0[2][2], B1[2][2];
    const char* cA = (const char*)g.A + (size_t)cur.pm * tstepA; const char* cB = (const char*)g.Bt + (size_t)cur.pn * tstep;
    S.a_ready(cur);
    if constexpr (SP2) {
        PG8_STAGE(PG8_SB(0, 0), cB, voffB); PG8_STAGE(PG8_SB(0, 1), cB + hstep, voffB); PG8_STAGE(PG8_SA(0, 0), cA, voffA); PG8_STAGE(PG8_SA(0, 1), cA + hstepA, voffA);
        if (wr == 1) PG8_BAR;
        PG8_WAIT_V(2); PG8_BAR;
        PG8_STAGE(PG8_SB(1, 0), cB + kstep, voffB); PG8_STAGE(PG8_SA(1, 0), cA + kstep, voffA); PG8_STAGE(PG8_SB(1, 1), cB + hstep + kstep, voffB);
        PG8_WAIT_V(6); PG8_BAR;
    } else {
        PG8_STAGE(PG8_SB(0, 0), cB, voffB); PG8_STAGE(PG8_SA(0, 0), cA, voffA); PG8_STAGE(PG8_SB(0, 1), cB + hstep, voffB); PG8_STAGE(PG8_SA(0, 1), cA + hstepA, voffA);
        if (wr == 1) PG8_BAR;
        PG8_WAIT_V(4); PG8_BAR;
        PG8_STAGE(PG8_SB(1, 0), cB + kstep, voffB); PG8_STAGE(PG8_SA(1, 0), cA + kstep, voffA); PG8_STAGE(PG8_SB(1, 1), cB + hstep + kstep, voffB);
        PG8_WAIT_V(6); PG8_BAR;
    }
    for (;;) {
        const bool has_next = S.next(ui + 1, nxt);
        const char* nA = has_next ? (const char*)g.A + (size_t)nxt.pm * tstepA : cA; const char* nB = has_next ? (const char*)g.Bt + (size_t)nxt.pn * tstep : cB;
        for (int t = 0; t < nt; t += 2) {
            const bool last = (t == nt - 2);
            const char* a1 = cA + (size_t)(t + 1) * kstep;
            const char* a2 = last ? nA : cA + (size_t)(t + 2) * kstep; const char* b2 = last ? nB : cB + (size_t)(t + 2) * kstep;
            const char* a3 = a2 + kstep; const char* b3 = b2 + kstep;
            if (last && has_next) S.a_ready(nxt);
            if constexpr (SP2) {
            PG8_LDB(B0, 0, 0); PG8_LDB(B1, 0, 1); PG8_SCHED; PG8_LDA(At, 0, 0); PG8_STAGE(PG8_SA(1, 1), a1 + hstepA, voffA);
            PG8_WAIT_V(8); PG8_WAIT_L(0); PG8_BAR; PG8_MMA(0, 0, At, B0); PG8_MMA(0, 1, At, B1); PG8_BAR; PG8_SCHED;
            PG8_LDA(At, 0, 1); PG8_STAGE(PG8_SB(0, 0), b2, voffB); PG8_STAGE(PG8_SB(0, 1), b2 + hstep, voffB); PG8_STAGE(PG8_SA(0, 0), a2, voffA);
            PG8_WAIT_V(8); PG8_WAIT_L(0); PG8_BAR; PG8_MMA(1, 0, At, B0); PG8_MMA(1, 1, At, B1); PG8_BAR; PG8_SCHED;
            PG8_LDB(B0, 1, 0); PG8_LDB(B1, 1, 1); PG8_SCHED; PG8_LDA(At, 1, 0); PG8_STAGE(PG8_SA(0, 1), a2 + hstepA, voffA);
            PG8_WAIT_V(8); PG8_WAIT_L(0); PG8_BAR; PG8_MMA(0, 0, At, B0); PG8_MMA(0, 1, At, B1); PG8_BAR; PG8_SCHED;
            PG8_LDA(At, 1, 1); PG8_STAGE(PG8_SB(1, 0), b3, voffB); PG8_STAGE(PG8_SB(1, 1), b3 + hstep, voffB); PG8_STAGE(PG8_SA(1, 0), a3, voffA);
            PG8_WAIT_V(8); PG8_WAIT_L(0); PG8_BAR; PG8_MMA(1, 0, At, B0); PG8_MMA(1, 1, At, B1); PG8_BAR; PG8_SCHED;
            } else {
            PG8_LDB(B0, 0, 0); PG8_SCHED; PG8_LDA(At, 0, 0); PG8_STAGE(PG8_SA(1, 1), a1 + hstepA, voffA);
            PG8_WAIT_L(8); PG8_BAR; PG8_WAIT_L(0); PG8_MMA(0, 0, At, B0); PG8_BAR; PG8_SCHED;
            PG8_LDB(B1, 0, 1); PG8_STAGE(PG8_SB(0, 0), b2, voffB);
            PG8_BAR; PG8_WAIT_L(0); PG8_MMA(0, 1, At, B1); PG8_BAR;
            PG8_LDA(At, 0, 1); PG8_STAGE(PG8_SA(0, 0), a2, voffA);
            PG8_BAR; PG8_WAIT_L(0); PG8_MMA(1, 0, At, B0); PG8_BAR; PG8_SCHED;
            PG8_STAGE(PG8_SB(0, 1), b2 + hstep, voffB);
            PG8_WAIT_V(6); PG8_BAR; PG8_MMA(1, 1, At, B1); PG8_BAR;
            PG8_LDB(B0, 1, 0); PG8_SCHED; PG8_LDA(At, 1, 0); PG8_STAGE(PG8_SA(0, 1), a2 + hstepA, voffA);
            PG8_WAIT_L(8); PG8_BAR; PG8_WAIT_L(0); PG8_MMA(0, 0, At, B0); PG8_BAR; PG8_SCHED;
            PG8_LDB(B1, 1, 1); PG8_STAGE(PG8_SB(1, 0), b3, voffB);
            PG8_BAR; PG8_WAIT_L(0); PG8_MMA(0, 1, At, B1); PG8_BAR;
            PG8_LDA(At, 1, 1); PG8_STAGE(PG8_SA(1, 0), a3, voffA);
            PG8_BAR; PG8_WAIT_L(0); PG8_MMA(1, 0, At, B0); PG8_BAR; PG8_SCHED;
            PG8_STAGE(PG8_SB(1, 1), b3 + hstep, voffB);
            PG8_WAIT_V(6); PG8_BAR; PG8_MMA(1, 1, At, B1); PG8_BAR;
            }
        }
        if constexpr (ALIGN_EPI) { if (wr == 0) PG8_BAR; }
#if PROBE_CAT == 20 || PROBE_CAT == 21
        { const unsigned long long te0_ = __builtin_amdgcn_s_memrealtime();
          E(acc, cur, wr, wc, fr, fq);
          asm volatile("s_waitcnt vmcnt(0)" ::: "memory");
          if (wid == 0) { volatile PG8_LAS unsigned long long* PRx = (volatile PG8_LAS unsigned long long*)(lds + 131072 + 320 + 64); volatile PG8_LAS unsigned* MISCx = (volatile PG8_LAS unsigned*)(lds + 131072 + 320);
            if (MISCx[22] == (PROBE_CAT == 20 ? 10u : 11u)) PRx[1] = PRx[1] + (__builtin_amdgcn_s_memrealtime() - te0_); } }
#else
        if constexpr (!Epi::AFTER_DRAIN) { E(acc, cur, wr, wc, fr, fq); S.done(cur); }
#endif
        if (!has_next) break;
#pragma unroll
        for (int a = 0; a < 2; ++a)
#pragma unroll
            for (int b = 0; b < 2; ++b)
#pragma unroll
                for (int m = 0; m < 4; ++m)
#pragma unroll
                    for (int n = 0; n < 2; ++n) acc[a][b][m][n] = (f32x4){0.f, 0.f, 0.f, 0.f};
        cur = nxt; cA = nA; cB = nB; ++ui;
        if constexpr (ALIGN_EPI) { if (wr == 1) PG8_BAR; }
    }
    PG8_WAIT_V(0);
    if constexpr (!ALIGN_EPI) { if (wr == 0) PG8_BAR; }
    PG8_BAR;
#undef PG8_SA
#undef PG8_SB
#undef PG8_STAGE
#undef PG8_LDA
#undef PG8_LDB
#undef PG8_MMA
#undef PG8_WAIT_V
#undef PG8_WAIT_L
#undef PG8_BAR
#undef PG8_SCHED
}
}

#ifndef PG8_SP2
#define PG8_SP2 true
#endif
#ifndef PG8_ALIGN
#define PG8_ALIGN true
#endif

constexpr int NWAVES = 8;
constexpr int BATCH = 16, SEQ = 2048, DM = 2048, DFF = 5632, MTOK = BATCH * SEQ, DEPTH = 4;
constexpr float ALPHA = 1.6817928305074292f;
constexpr float LN_EPS = 1e-5f, RMS_EPS = 1e-6f;
constexpr int A_QKV = 3072, B_QKV = 9216, C_IN = 1344, C_INP = 1536, C_QL = 768, C_KVL = 512, C_Q = 3072, C_KV = 4096;

constexpr size_t MiB = 1u << 20;
constexpr size_t WS_CTL = 0, CTL_ZERO_BYTES = 64 * 1024, DEV_ZERO_END = 8 * MiB;
constexpr size_t WS_STAT = 1 * MiB;
constexpr size_t WS_SSQC = 4 * MiB;
constexpr size_t WS_UV = 5 * MiB;
constexpr size_t WS_TABB = 8 * MiB;
constexpr size_t WS_TABC = 9 * MiB;
constexpr size_t WS_TABA = 10 * MiB;
constexpr size_t WS_WT = 12 * MiB;
constexpr size_t WT_BUF = 72 * MiB;
constexpr size_t WS_HB = 156 * MiB;
constexpr size_t WS_LO = 284 * MiB;
constexpr size_t WS_R = 412 * MiB;
constexpr size_t WS_END = WS_R + 900 * MiB;
constexpr int UV_STRIDE = 2 * 11264;
constexpr size_t WT_FFN_OUT = (size_t)2 * DFF * DM;
constexpr size_t WT_A_OUT = (size_t)A_QKV * DM, WT_B_OUT = (size_t)B_QKV * DM;
constexpr size_t WT_C_QUP = (size_t)C_INP * DM, WT_C_KVUP = WT_C_QUP + (size_t)C_Q * C_QL, WT_C_OUT = WT_C_KVUP + (size_t)C_KV * C_KVL;
constexpr size_t R_ACT = 0;
constexpr size_t RA_QKV = 0, RA_ATT = 192 * MiB;
constexpr size_t RB_QKV = 0, RB_ATT = 576 * MiB, RB_OG = 640 * MiB, RB_LSE = 832 * MiB;
constexpr size_t RC_IN = 0, RC_QN = 96 * MiB, RC_KVN = 144 * MiB, RC_KR = 176 * MiB, RC_Q = 192 * MiB, RC_KV = 384 * MiB, RC_ATT = 640 * MiB;
constexpr int CW_BAR = 4096;

constexpr int RING_OFF = 0, RING_BYTES = 131072;
constexpr int LDSCTL_OFF = RING_BYTES, MISC_OFF = LDSCTL_OFF + 320;
constexpr int XCH_OFF = RING_BYTES + 4096;
constexpr int LDS_BYTES = 147456;

#define GAS __attribute__((address_space(1)))
#define LAS __attribute__((address_space(3)))
typedef unsigned short bf16;
typedef unsigned v4u __attribute__((ext_vector_type(4)));
typedef unsigned v2u __attribute__((ext_vector_type(2)));
typedef float f32x4 __attribute__((ext_vector_type(4)));
typedef float f32x2 __attribute__((ext_vector_type(2)));
typedef GAS unsigned gu32;
#define RLX_AGENT __ATOMIC_RELAXED, __HIP_MEMORY_SCOPE_AGENT
#define LDS_WAIT() asm volatile("s_waitcnt lgkmcnt(0)" ::: "memory")
#define VM_WAIT() asm volatile("s_waitcnt vmcnt(0)" ::: "memory")
__device__ __forceinline__ unsigned f2bf(float f) { unsigned u = __builtin_bit_cast(unsigned, f); return (u + 0x7fffu + ((u >> 16) & 1u)) >> 16; }
__device__ __forceinline__ unsigned pk2(float lo, float hi) { return f2bf(lo) | (f2bf(hi) << 16); }
__device__ __forceinline__ float bflo(unsigned w) { return __uint_as_float(w << 16); }
__device__ __forceinline__ float bfhi(unsigned w) { return __uint_as_float(w & 0xffff0000u); }
__device__ __forceinline__ float bf1(bf16 b) { return __uint_as_float(((unsigned)b) << 16); }
__device__ __forceinline__ void unpack8(const v4u w, float (&x)[8]) { x[0] = bflo(w.x); x[1] = bfhi(w.x); x[2] = bflo(w.y); x[3] = bfhi(w.y); x[4] = bflo(w.z); x[5] = bfhi(w.z); x[6] = bflo(w.w); x[7] = bfhi(w.w); }
__device__ __forceinline__ void unpack8_lo(const v2u w, float (&x)[8]) { const f32x2 a = __builtin_amdgcn_cvt_pk_f32_fp8((int)w.x, false), b = __builtin_amdgcn_cvt_pk_f32_fp8((int)w.x, true), c = __builtin_amdgcn_cvt_pk_f32_fp8((int)w.y, false), d = __builtin_amdgcn_cvt_pk_f32_fp8((int)w.y, true);
    x[0] = a[0] * pg8::LO_INV; x[1] = a[1] * pg8::LO_INV; x[2] = b[0] * pg8::LO_INV; x[3] = b[1] * pg8::LO_INV; x[4] = c[0] * pg8::LO_INV; x[5] = c[1] * pg8::LO_INV; x[6] = d[0] * pg8::LO_INV; x[7] = d[1] * pg8::LO_INV; }
__device__ __forceinline__ v2u pack8_lo(float e0, float e1, float e2, float e3, float e4, float e5, float e6, float e7) {
    int a = __builtin_amdgcn_cvt_pk_fp8_f32(pg8::lo_sc(e0), pg8::lo_sc(e1), 0, false); a = __builtin_amdgcn_cvt_pk_fp8_f32(pg8::lo_sc(e2), pg8::lo_sc(e3), a, true);
    int b = __builtin_amdgcn_cvt_pk_fp8_f32(pg8::lo_sc(e4), pg8::lo_sc(e5), 0, false); b = __builtin_amdgcn_cvt_pk_fp8_f32(pg8::lo_sc(e6), pg8::lo_sc(e7), b, true);
    return (v2u){(unsigned)a, (unsigned)b}; }
__device__ __forceinline__ v4u pack8(const float (&x)[8]) { v4u w; w.x = pk2(x[0], x[1]); w.y = pk2(x[2], x[3]); w.z = pk2(x[4], x[5]); w.w = pk2(x[6], x[7]); return w; }

#define XB_TMO      128
#define XB_XCNT(j)  (256  + 64 * (j))
#define XB_XSUB(j)  (1280 + 64 * (j))
#define XB_XGEN(j)  (2304 + 64 * (j))
#define XB_TOP      3328
#define XB_TOPGEN   3392
#define XCD_BAR_WORDS 3456
#define XB_SPIN_CAP (1u << 22)
__device__ __forceinline__ unsigned xb_ld(unsigned* p)              { return __hip_atomic_load(p, __ATOMIC_RELAXED, __HIP_MEMORY_SCOPE_AGENT); }
__device__ __forceinline__ unsigned xb_add(unsigned* p, unsigned v) { return __hip_atomic_fetch_add(p, v, __ATOMIC_RELAXED, __HIP_MEMORY_SCOPE_AGENT); }
__device__ __forceinline__ unsigned xb_xcc_id() { return (unsigned)__builtin_amdgcn_s_getreg((3 << 11) | 20) & 0xFu; }
#define XB_SPIN(cond, bar) do { unsigned _sp = 0; while (cond) { __builtin_amdgcn_s_sleep(1); \
    if ((++_sp & 255u) == 0u) { if (xb_ld(&(bar)[XB_TMO])) break; if (_sp > XB_SPIN_CAP) { atomicAdd(&(bar)[XB_TMO], 1u); break; } } } } while (0)
struct XcdBarrier { unsigned* bar; unsigned x; volatile LAS unsigned* st; };
__device__ __forceinline__ XcdBarrier xcd_barrier_post(unsigned* bar, volatile LAS unsigned* st) {
    XcdBarrier b; b.bar = bar; b.x = xb_xcc_id(); b.st = st;
    if (threadIdx.x == 0) (void)xb_add(&bar[XB_XCNT(b.x)], 1u);
    return b;
}
__device__ __forceinline__ void xcd_barrier_complete(unsigned* bar, unsigned x, unsigned& nloc, unsigned& nx) {
    const unsigned G = gridDim.x * gridDim.y * gridDim.z;
    unsigned sum, cnt, mine, sp = 0u;
    for (;;) {
        sum = 0u; cnt = 0u; mine = 0u;
#pragma unroll
        for (unsigned j = 0; j < 16; ++j) { const unsigned c = xb_ld(&bar[XB_XCNT(j)]); sum += c; cnt += (c > 0u) ? 1u : 0u; mine = (j == x) ? c : mine; }
        if (sum == G) break;
        __builtin_amdgcn_s_sleep(1);
        if ((++sp & 255u) == 0u) { if (xb_ld(&bar[XB_TMO])) break; if (sp > XB_SPIN_CAP) { atomicAdd(&bar[XB_TMO], 1u); break; } }
    }
    nloc = mine > 0u ? mine : 1u; nx = cnt > 0u ? cnt : 1u;
}
__device__ __forceinline__ void xcd_barrier(const XcdBarrier& b, const int tid) {
    asm volatile("s_waitcnt vmcnt(0)" ::: "memory");
    __syncthreads();
    if (tid == 0) {
        unsigned* bar = b.bar; unsigned bx_ = b.x;
        asm volatile("" : "+s"(bar), "+s"(bx_));
        __builtin_amdgcn_s_waitcnt(0);
        unsigned nloc = b.st[0], nx = b.st[1];
        if (nloc == 0u) { xcd_barrier_complete(bar, bx_, nloc, nx); b.st[0] = nloc; b.st[1] = nx; }
        const unsigned old = xb_add(&bar[XB_XSUB(bx_)], 1u);
        const unsigned gen = old / nloc;
        if (old + 1u == (gen + 1u) * nloc) {
            __builtin_amdgcn_fence(__ATOMIC_RELEASE, "agent");
            asm volatile("s_waitcnt vmcnt(0)" ::: "memory");
            const unsigned og = xb_add(&bar[XB_TOP], 1u);
            const unsigned tg = og / nx;
            if (og + 1u == (tg + 1u) * nx) xb_add(&bar[XB_TOPGEN], 1u);
            else XB_SPIN(xb_ld(&bar[XB_TOPGEN]) == tg, bar);
            __builtin_amdgcn_fence(__ATOMIC_ACQUIRE, "agent");
            xb_add(&bar[XB_XGEN(bx_)], 1u);
            asm volatile("s_waitcnt vmcnt(0)" ::: "memory");
        } else {
            XB_SPIN(xb_ld(&bar[XB_XGEN(bx_)]) == gen, bar);
            __builtin_amdgcn_fence(__ATOMIC_ACQUIRE, "agent");
            asm volatile("s_waitcnt vmcnt(0)" ::: "memory");
        }
    }
    __syncthreads();
}

template <class T> __device__ __forceinline__ T* lnd(T* p) { asm volatile("" : "+s"(p)); return p; }
__device__ __forceinline__ float wave_sum(float v) {
#pragma unroll
    for (int o = 1; o < 64; o <<= 1) v += __shfl_xor(v, o);
    return v;
}
__device__ __forceinline__ int cvt_weight(const float* W, int K, int Nsrc, bf16* WT, int Ndst, int kind, const float* gk, const float* bk, float* uo, float* vo, LAS unsigned char* lds, int tile_off, int G, int bx, int tid) {
    asm volatile("" : "+v"(tid));
    const int wave = tid >> 6, lane = tid & 63;
    const int ntn = Ndst / 256, ntiles = (K / 64) * ntn;
    int t = ((bx - tile_off) % G + G) % G;
    f32x4 r[8];
#define CVT_LOAD(tt) do { const int kb_ = (tt) / ntn, tn_ = (tt) % ntn; int c_; \
        if (kind == 1) c_ = (lane < 32) ? (128 * tn_ + 4 * lane) : (DFF + 128 * tn_ + 4 * (lane - 32)); else c_ = 256 * tn_ + 4 * lane; \
        const bool ok_ = (kind == 1) || (c_ < Nsrc); const GAS float* src_ = (const GAS float*)W + (size_t)(64 * kb_ + 8 * wave) * Nsrc + (ok_ ? c_ : 0); \
        if (kind == 3 && tn_ < 10) {   \
            const GAS float* sp_ = (const GAS float*)W + (size_t)(64 * kb_ + 8 * wave) * Nsrc + 256 * tn_ + 128 * (lane >> 5) + 64 * ((lane >> 4) & 1) + 2 * (lane & 15); \
            _Pragma("unroll") for (int i_ = 0; i_ < 8; ++i_) { const f32x2 a_ = __builtin_nontemporal_load((const GAS f32x2*)(sp_ + (size_t)i_ * Nsrc)), b_ = __builtin_nontemporal_load((const GAS f32x2*)(sp_ + (size_t)i_ * Nsrc + 32)); r[i_] = (f32x4){a_.x, b_.x, a_.y, b_.y}; } \
        } else if (kind == 2 && (tn_ % 12) < 8) {   \
            const GAS float* sp_ = (const GAS float*)W + (size_t)(64 * kb_ + 8 * wave) * Nsrc + 256 * tn_ + 128 * (lane >> 5) + 2 * (lane & 31); \
            _Pragma("unroll") for (int i_ = 0; i_ < 8; ++i_) { const f32x2 a_ = __builtin_nontemporal_load((const GAS f32x2*)(sp_ + (size_t)i_ * Nsrc)), b_ = __builtin_nontemporal_load((const GAS f32x2*)(sp_ + (size_t)i_ * Nsrc + 64)); r[i_] = (f32x4){a_.x, b_.x, a_.y, b_.y}; } \
        } else { \
        _Pragma("unroll") for (int i_ = 0; i_ < 8; ++i_) { r[i_] = ok_ ? __builtin_nontemporal_load((const GAS f32x4*)(src_ + (size_t)i_ * Nsrc)) : (f32x4){0.f, 0.f, 0.f, 0.f}; } } } while (0)
    if (t < ntiles) CVT_LOAD(t);
    int buf = 0;
    const int c = lane & 7, nl = lane >> 3;
    for (; t < ntiles; t += G) {
        LAS unsigned char* tb = lds + buf * 65536;
#pragma unroll
        for (int i = 0; i < 8; ++i) { const int k = 8 * wave + i; *(LAS f32x4*)(tb + k * 1024 + ((lane ^ (wave & 7)) << 4)) = r[i]; }
        const int kb = t / ntn, tn = t % ntn, k0 = 64 * kb, n0 = 256 * tn;
        if (t + G < ntiles) CVT_LOAD(t + G);
        __syncthreads();
        f32x4 g0 = {1.f, 1.f, 1.f, 1.f}, g1 = g0, b0 = {0.f, 0.f, 0.f, 0.f}, b1 = b0;
        if (gk) { g0 = *(const GAS f32x4*)(gk + k0 + 8 * c); g1 = *(const GAS f32x4*)(gk + k0 + 8 * c + 4); }
        if (uo && bk) { b0 = *(const GAS f32x4*)(bk + k0 + 8 * c); b1 = *(const GAS f32x4*)(bk + k0 + 8 * c + 4); }
#pragma unroll
        for (int j = 0; j < 4; ++j) { const int n = 32 * wave + 8 * j + nl;
            float w[8];
#pragma unroll
            for (int e = 0; e < 8; ++e) w[e] = *(const LAS float*)(tb + (8 * c + e) * 1024 + ((((n >> 2) ^ c) & 63) << 4) + (n & 3) * 4);
            float us = 0.f, vs = 0.f;
            vs = w[0] * b0[0] + w[1] * b0[1] + w[2] * b0[2] + w[3] * b0[3] + w[4] * b1[0] + w[5] * b1[1] + w[6] * b1[2] + w[7] * b1[3];
            w[0] *= g0[0]; w[1] *= g0[1]; w[2] *= g0[2]; w[3] *= g0[3]; w[4] *= g1[0]; w[5] *= g1[1]; w[6] *= g1[2]; w[7] *= g1[3];
            us = ((w[0] + w[1]) + (w[2] + w[3])) + ((w[4] + w[5]) + (w[6] + w[7]));
            v4u o; o.x = pk2(w[0], w[1]); o.y = pk2(w[2], w[3]); o.z = pk2(w[4], w[5]); o.w = pk2(w[6], w[7]);
            *(GAS v4u*)(WT + (size_t)(n0 + n) * K + k0 + 8 * c) = o;
            if (kind == 1) { const float sc = (n < 128) ? -1.4426950408889634f : -0.6931471805599453f; us *= sc; vs *= sc; }
            if (uo) { us += __shfl_xor(us, 1); us += __shfl_xor(us, 2); us += __shfl_xor(us, 4); vs += __shfl_xor(vs, 1); vs += __shfl_xor(vs, 2); vs += __shfl_xor(vs, 4);
                if (c == 0) { __hip_atomic_fetch_add(uo + n0 + n, us, __ATOMIC_RELAXED, __HIP_MEMORY_SCOPE_AGENT); __hip_atomic_fetch_add(vo + n0 + n, vs, __ATOMIC_RELAXED, __HIP_MEMORY_SCOPE_AGENT); } }
        }
        buf ^= 1;
    }
#undef CVT_LOAD
    __syncthreads();
    return tile_off + ntiles;
}
__device__ __forceinline__ void ln_final(float* H, const bf16* HI, const unsigned char* LOW, const float* sum, const float* ssq, const float* g, const float* b, int gw, int NGW, int lane) {
    asm volatile("" : "+v"(lane));
    for (int m = gw; m < MTOK; m += NGW) {
        const float mean = sum[m] * (1.f / DM); const float rstd = __builtin_amdgcn_rsqf(ssq[m] * (1.f / DM) - mean * mean + LN_EPS);
        const GAS v4u* hr = (const GAS v4u*)(HI + (size_t)m * DM) + lane; const GAS v2u* lr = (const GAS v2u*)(LOW + (size_t)m * DM) + lane;
        GAS f32x4* xr = (GAS f32x4*)(H + (size_t)m * DM) + 2 * lane;
        v4u hv[4]; v2u lv[4];
#pragma unroll
        for (int j = 0; j < 4; ++j) { hv[j] = hr[64 * j]; lv[j] = lr[64 * j]; }
#pragma unroll
        for (int j = 0; j < 4; ++j) { float xh[8], xl[8]; unpack8(hv[j], xh); unpack8_lo(lv[j], xl);
            const f32x4 g0 = *((const GAS f32x4*)g + 128 * j + 2 * lane), g1 = *((const GAS f32x4*)g + 128 * j + 2 * lane + 1), b0 = *((const GAS f32x4*)b + 128 * j + 2 * lane), b1 = *((const GAS f32x4*)b + 128 * j + 2 * lane + 1);
            f32x4 y0, y1;
            y0[0] = ((xh[0] + xl[0]) - mean) * rstd * g0[0] + b0[0]; y0[1] = ((xh[1] + xl[1]) - mean) * rstd * g0[1] + b0[1]; y0[2] = ((xh[2] + xl[2]) - mean) * rstd * g0[2] + b0[2]; y0[3] = ((xh[3] + xl[3]) - mean) * rstd * g0[3] + b0[3];
            y1[0] = ((xh[4] + xl[4]) - mean) * rstd * g1[0] + b1[0]; y1[1] = ((xh[5] + xl[5]) - mean) * rstd * g1[1] + b1[1]; y1[2] = ((xh[6] + xl[6]) - mean) * rstd * g1[2] + b1[2]; y1[3] = ((xh[7] + xl[7]) - mean) * rstd * g1[3] + b1[3];
            xr[128 * j] = y0; xr[128 * j + 1] = y1; }
    }
}
__device__ __forceinline__ void krope_c(const bf16* CIN, bf16* KR, const unsigned char* ws, int gw, int NGW, int lane) {
    asm volatile("" : "+v"(lane));
    const float* cc = (const float*)(ws + WS_TABC); const float* sc = cc + 2048 * 32;
    const int sub = lane >> 3, i = lane & 7, f0 = (i & 3) * 8; const bool lowp = (i & 4) == 0;
    for (int t0 = gw * 8; t0 < MTOK; t0 += NGW * 8) { const int tok = t0 + sub, s = tok & (SEQ - 1);
        float x[8], y[8]; unpack8(*((const GAS v4u*)(CIN + (size_t)tok * C_INP + 1280) + i), x);
#pragma unroll
        for (int e = 0; e < 8; ++e) { const float p = __shfl_xor(x[e], 4); const float c = cc[s * 32 + f0 + e], sn = sc[s * 32 + f0 + e]; y[e] = lowp ? (x[e] * c - p * sn) : (x[e] * c + p * sn); }
        *((GAS v4u*)(KR + (size_t)tok * 64) + i) = pack8(y); }
}
__device__ __forceinline__ void ln_rows(float* H, bf16* HBo, const float* g, const float* b, int gw, int NGW, int lane) {
    asm volatile("" : "+v"(lane));
    for (int m = gw; m < MTOK; m += NGW) {
        GAS f32x4* xr = (GAS f32x4*)(H + (size_t)m * DM) + 2 * lane;
        f32x4 v[8]; float s = 0.f;
#pragma unroll
        for (int j = 0; j < 4; ++j) { v[2 * j] = xr[128 * j]; v[2 * j + 1] = xr[128 * j + 1]; }
#pragma unroll
        for (int j = 0; j < 8; ++j) s += (v[j].x + v[j].y) + (v[j].z + v[j].w);
        const float mean = wave_sum(s) * (1.f / DM); float s2 = 0.f;
#pragma unroll
        for (int j = 0; j < 8; ++j) { v[j] = v[j] - mean; s2 += (v[j].x * v[j].x + v[j].y * v[j].y) + (v[j].z * v[j].z + v[j].w * v[j].w); }
        const float rstd = 1.f / sqrtf(wave_sum(s2) * (1.f / DM) + LN_EPS);
        GAS v4u* ob = (GAS v4u*)(HBo + (size_t)m * DM) + lane;
#pragma unroll
        for (int j = 0; j < 4; ++j) {
            const f32x4 g0 = *((const f32x4*)g + 128 * j + 2 * lane), g1 = *((const f32x4*)g + 128 * j + 2 * lane + 1);
            const f32x4 b0 = *((const f32x4*)b + 128 * j + 2 * lane), b1 = *((const f32x4*)b + 128 * j + 2 * lane + 1);
            const f32x4 y0 = v[2 * j] * rstd * g0 + b0, y1 = v[2 * j + 1] * rstd * g1 + b1;
            xr[128 * j] = y0; xr[128 * j + 1] = y1;
            v4u o; o.x = pk2(y0.x, y0.y); o.y = pk2(y0.z, y0.w); o.z = pk2(y1.x, y1.y); o.w = pk2(y1.z, y1.w);
            ob[64 * j] = o;
        }
    }
}
__device__ __forceinline__ void cvt_rows_bf16(const float* X, bf16* O, unsigned char* OL, size_t n8, size_t gt, size_t NGT) {
    for (size_t i = gt; i < n8; i += NGT) { const f32x4 a = *((const GAS f32x4*)X + 2 * i), c = *((const GAS f32x4*)X + 2 * i + 1);
        v4u o; o.x = pk2(a.x, a.y); o.y = pk2(a.z, a.w); o.z = pk2(c.x, c.y); o.w = pk2(c.z, c.w); *((GAS v4u*)O + i) = o;
        *((GAS v2u*)OL + i) = pack8_lo(a.x - bflo(o.x), a.y - bfhi(o.x), a.z - bflo(o.y), a.w - bfhi(o.y), c.x - bflo(o.z), c.y - bfhi(o.z), c.z - bflo(o.w), c.w - bfhi(o.w)); }
}
__device__ __forceinline__ void sincos_tab(float ang, float& c, float& s) {
    const double x = (double)ang; const double k = __builtin_rint(x * 0.15915494309189533577); const double r = x - k * 6.28318530717958647692;
    const double r2 = r * r; double sn = 0.0, cs = 0.0;
#pragma unroll
    for (int n = 14; n >= 0; --n) { sn = sn * (-r2) / (double)((2 * n + 2) * (2 * n + 3)) + 1.0; cs = cs * (-r2) / (double)((2 * n + 1) * (2 * n + 2)) + 1.0; }
    s = (float)(sn * r); c = (float)cs;
}
__device__ __forceinline__ void build_tables(unsigned char* ws, size_t gt, size_t NGT) {
    float* cb = (float*)(ws + WS_TABB); float* sb = cb + 2048 * 64;
    for (size_t i = gt; i < 2048 * 64; i += NGT) { const int pos = (int)(i >> 6), f = (int)(i & 63); const float inv = __builtin_amdgcn_exp2f(-13.287712379549449f * ((float)(2 * f) / 128.0f)); float c, s; sincos_tab((float)pos * inv, c, s); cb[i] = c; sb[i] = s; }
    float* cc = (float*)(ws + WS_TABC); float* sc = cc + 2048 * 32;
    for (size_t i = gt; i < 2048 * 32; i += NGT) { const int pos = (int)(i >> 5), f = (int)(i & 31); const float inv = __builtin_amdgcn_exp2f(-13.287712379549449f * ((float)(2 * f) / 64.0f)); float c, s; sincos_tab((float)pos * inv, c, s); cc[i] = c; sc[i] = s; }
    float* ca = (float*)(ws + WS_TABA); float* sa = ca + 64 * 32;
    for (size_t i = gt; i < 64 * 32; i += NGT) { const int pos = (int)(i >> 5), f = (int)(i & 31); const float inv = __builtin_amdgcn_exp2f(-13.287712379549449f * ((float)(2 * f) / 64.0f)); float c, s; sincos_tab((float)pos * inv, c, s); ca[i] = c; sa[i] = s; }
}

__device__ __forceinline__ void prep_a(bf16* QKV, const float* qg, const float* kg, const unsigned char* ws, int gw, int NGW, int lane) {
    asm volatile("" : "+v"(lane));
    const float* ca = (const float*)(ws + WS_TABA); const float* sa = ca + 64 * 32;
    const int i = lane & 15, half = i >> 3, f0 = (i & 3) * 8; const bool lowp = (i & 4) == 0;
    float gq[8], gk[8];
#pragma unroll
    for (int e = 0; e < 8; ++e) { gq[e] = qg[i * 8 + e]; gk[e] = kg[i * 8 + e]; }
    for (int tok = gw; tok < MTOK; tok += NGW) {
        const int s = tok & (SEQ - 1), pos = half ? (s & 63) : (s >> 6);
        float c[8], sn[8];
        { const f32x4 c0 = *(const GAS f32x4*)(ca + pos * 32 + f0), c1 = *(const GAS f32x4*)(ca + pos * 32 + f0 + 4), s0 = *(const GAS f32x4*)(sa + pos * 32 + f0), s1 = *(const GAS f32x4*)(sa + pos * 32 + f0 + 4);
          c[0] = c0.x; c[1] = c0.y; c[2] = c0.z; c[3] = c0.w; c[4] = c1.x; c[5] = c1.y; c[6] = c1.z; c[7] = c1.w;
          sn[0] = s0.x; sn[1] = s0.y; sn[2] = s0.z; sn[3] = s0.w; sn[4] = s1.x; sn[5] = s1.y; sn[6] = s1.z; sn[7] = s1.w; }
        GAS v4u* row = (GAS v4u*)(QKV + (size_t)tok * A_QKV) + lane;
        v4u w[5];
#pragma unroll
        for (int j = 0; j < 5; ++j) w[j] = row[64 * j];
#pragma unroll
        for (int j = 0; j < 5; ++j) {
            float x[8]; unpack8(w[j], x); float ss = 0.f;
#pragma unroll
            for (int e = 0; e < 8; ++e) ss += x[e] * x[e];
            ss += __shfl_xor(ss, 1); ss += __shfl_xor(ss, 2); ss += __shfl_xor(ss, 4); ss += __shfl_xor(ss, 8);
            const float r = 1.f / sqrtf(ss * (1.f / 128.f) + RMS_EPS);
            float y[8];
#pragma unroll
            for (int e = 0; e < 8; ++e) { x[e] = x[e] * r * (j < 4 ? gq[e] : gk[e]); const float p = __shfl_xor(x[e], 4); y[e] = lowp ? (x[e] * c[e] - p * sn[e]) : (x[e] * c[e] + p * sn[e]); }
            row[64 * j] = pack8(y);
        }
    }
}
__device__ __forceinline__ void prep_b(bf16* QKV, const unsigned char* ws, int gw, int NGW, int lane) {
    asm volatile("" : "+v"(lane));
    const float* cb = (const float*)(ws + WS_TABB); const float* sb = cb + 2048 * 64;
    const int i = lane & 15, f0 = (i & 7) * 8; const bool lowp = (i & 8) == 0;
    for (int tok = gw; tok < MTOK; tok += NGW) {
        const int s = tok & (SEQ - 1);
        float c[8], sn[8];
        { const f32x4 c0 = *(const GAS f32x4*)(cb + s * 64 + f0), c1 = *(const GAS f32x4*)(cb + s * 64 + f0 + 4), s0 = *(const GAS f32x4*)(sb + s * 64 + f0), s1 = *(const GAS f32x4*)(sb + s * 64 + f0 + 4);
          c[0] = c0.x; c[1] = c0.y; c[2] = c0.z; c[3] = c0.w; c[4] = c1.x; c[5] = c1.y; c[6] = c1.z; c[7] = c1.w;
          sn[0] = s0.x; sn[1] = s0.y; sn[2] = s0.z; sn[3] = s0.w; sn[4] = s1.x; sn[5] = s1.y; sn[6] = s1.z; sn[7] = s1.w; }
#pragma unroll
        for (int g = 0; g < 3; ++g) {
            GAS v4u* row = (GAS v4u*)(QKV + (size_t)tok * B_QKV + g * 3072) + lane;
            v4u w[4];
#pragma unroll
            for (int j = 0; j < 4; ++j) w[j] = row[64 * j];
#pragma unroll
            for (int j = 0; j < 4; ++j) { float x[8], y[8]; unpack8(w[j], x);
#pragma unroll
                for (int e = 0; e < 8; ++e) { const float p = __shfl_xor(x[e], 8); y[e] = lowp ? (x[e] * c[e] - p * sn[e]) : (x[e] * c[e] + p * sn[e]); }
                row[64 * j] = pack8(y); }
        }
    }
}
__device__ __forceinline__ void prep_c1(const bf16* CIN, bf16* CQN, bf16* CKVN, bf16* KR, const float* qg, const float* kvg, const unsigned char* ws, int gw, int NGW, int lane) {
    asm volatile("" : "+v"(lane));
    const float* cc = (const float*)(ws + WS_TABC); const float* sc = cc + 2048 * 32;
    for (int tok = gw; tok < MTOK; tok += NGW) {
        const GAS v4u* row = (const GAS v4u*)(CIN + (size_t)tok * C_INP);
        const v4u a0 = row[lane], a1 = (lane < 32) ? row[64 + lane] : (v4u){0u, 0u, 0u, 0u}, b0 = row[96 + lane], k0 = (lane < 8) ? row[160 + lane] : (v4u){0u, 0u, 0u, 0u};
        float x0[8], x1[8], y0[8], kx[8]; unpack8(a0, x0); unpack8(a1, x1); unpack8(b0, y0); unpack8(k0, kx);
        float sq = 0.f, skv = 0.f;
#pragma unroll
        for (int e = 0; e < 8; ++e) { sq += x0[e] * x0[e] + x1[e] * x1[e]; skv += y0[e] * y0[e]; }
        const float rq = 1.f / sqrtf(wave_sum(sq) * (1.f / 768.f) + RMS_EPS), rkv = 1.f / sqrtf(wave_sum(skv) * (1.f / 512.f) + RMS_EPS);
        { const f32x4 g0 = *(const GAS f32x4*)(qg + lane * 8), g1 = *(const GAS f32x4*)(qg + lane * 8 + 4);
          x0[0] *= rq * g0.x; x0[1] *= rq * g0.y; x0[2] *= rq * g0.z; x0[3] *= rq * g0.w; x0[4] *= rq * g1.x; x0[5] *= rq * g1.y; x0[6] *= rq * g1.z; x0[7] *= rq * g1.w;
          *((GAS v4u*)(CQN + (size_t)tok * C_QL) + lane) = pack8(x0); }
        if (lane < 32) { const f32x4 g0 = *(const GAS f32x4*)(qg + 512 + lane * 8), g1 = *(const GAS f32x4*)(qg + 512 + lane * 8 + 4);
          x1[0] *= rq * g0.x; x1[1] *= rq * g0.y; x1[2] *= rq * g0.z; x1[3] *= rq * g0.w; x1[4] *= rq * g1.x; x1[5] *= rq * g1.y; x1[6] *= rq * g1.z; x1[7] *= rq * g1.w;
          *((GAS v4u*)(CQN + (size_t)tok * C_QL) + 64 + lane) = pack8(x1); }
        { const f32x4 g0 = *(const GAS f32x4*)(kvg + lane * 8), g1 = *(const GAS f32x4*)(kvg + lane * 8 + 4);
          y0[0] *= rkv * g0.x; y0[1] *= rkv * g0.y; y0[2] *= rkv * g0.z; y0[3] *= rkv * g0.w; y0[4] *= rkv * g1.x; y0[5] *= rkv * g1.y; y0[6] *= rkv * g1.z; y0[7] *= rkv * g1.w;
          *((GAS v4u*)(CKVN + (size_t)tok * C_KVL) + lane) = pack8(y0); }
        {
          const int s = tok & (SEQ - 1), f0 = (lane & 3) * 8; const bool lowp = (lane & 4) == 0; float y[8];
#pragma unroll
          for (int e = 0; e < 8; ++e) { const float p = __shfl_xor(kx[e], 4); const float c = cc[s * 32 + f0 + e], sn = sc[s * 32 + f0 + e]; y[e] = lowp ? (kx[e] * c - p * sn) : (kx[e] * c + p * sn); }
          if (lane < 8) *((GAS v4u*)(KR + (size_t)tok * 64) + lane) = pack8(y); }
    }
}
__device__ __forceinline__ void prep_c2(bf16* Q, const unsigned char* ws, int gw, int NGW, int lane) {
    asm volatile("" : "+v"(lane));
    const float* cc = (const float*)(ws + WS_TABC); const float* sc = cc + 2048 * 32;
    const int i = lane & 7, f0 = (i & 3) * 8; const bool lowp = (i & 4) == 0;
    for (int tok = gw; tok < MTOK; tok += NGW) {
        const int s = tok & (SEQ - 1);
        float c[8], sn[8];
        { const f32x4 c0 = *(const GAS f32x4*)(cc + s * 32 + f0), c1 = *(const GAS f32x4*)(cc + s * 32 + f0 + 4), s0 = *(const GAS f32x4*)(sc + s * 32 + f0), s1 = *(const GAS f32x4*)(sc + s * 32 + f0 + 4);
          c[0] = c0.x; c[1] = c0.y; c[2] = c0.z; c[3] = c0.w; c[4] = c1.x; c[5] = c1.y; c[6] = c1.z; c[7] = c1.w;
          sn[0] = s0.x; sn[1] = s0.y; sn[2] = s0.z; sn[3] = s0.w; sn[4] = s1.x; sn[5] = s1.y; sn[6] = s1.z; sn[7] = s1.w; }
#pragma unroll
        for (int j = 0; j < 2; ++j) { const int h = (lane >> 3) + 8 * j;
            GAS v4u* p = (GAS v4u*)(Q + (size_t)tok * C_Q + h * 192 + 128) + i; float x[8], y[8]; unpack8(*p, x);
#pragma unroll
            for (int e = 0; e < 8; ++e) { const float q = __shfl_xor(x[e], 4); y[e] = lowp ? (x[e] * c[e] - q * sn[e]) : (x[e] * c[e] + q * sn[e]); }
            *p = pack8(y); }
    }
}

struct NState { float m, l, o[8]; };
__device__ __forceinline__ void nst_init(NState& S) { S.m = -1e30f; S.l = 0.f;
#pragma unroll
    for (int j = 0; j < 8; ++j) S.o[j] = 0.f; }
__device__ __forceinline__ void nst_update(NState& S, float s, bool valid, const v4u vv) {
    const float mn = valid ? fmaxf(S.m, s) : S.m; const float al = __builtin_amdgcn_exp2f(S.m - mn); const float p = valid ? __builtin_amdgcn_exp2f(s - mn) : 0.f;
    S.l = S.l * al + p; S.m = mn;
    S.o[0] = S.o[0] * al + p * bflo(vv.x); S.o[1] = S.o[1] * al + p * bfhi(vv.x); S.o[2] = S.o[2] * al + p * bflo(vv.y); S.o[3] = S.o[3] * al + p * bfhi(vv.y);
    S.o[4] = S.o[4] * al + p * bflo(vv.z); S.o[5] = S.o[5] * al + p * bfhi(vv.z); S.o[6] = S.o[6] * al + p * bflo(vv.w); S.o[7] = S.o[7] * al + p * bfhi(vv.w);
}
__device__ __forceinline__ void nst_finish(NState& S, bf16* out, int lane) {
#pragma unroll
    for (int x = 16; x <= 32; x <<= 1) {
        const float m2 = __shfl_xor(S.m, x), l2 = __shfl_xor(S.l, x); const float mn = fmaxf(S.m, m2); const float a = __builtin_amdgcn_exp2f(S.m - mn), b = __builtin_amdgcn_exp2f(m2 - mn);
        S.l = S.l * a + l2 * b; S.m = mn;
#pragma unroll
        for (int j = 0; j < 8; ++j) { const float o2 = __shfl_xor(S.o[j], x); S.o[j] = S.o[j] * a + o2 * b; }
    }
    if (lane < 16) { const float rl = 1.f / S.l; v4u w; w.x = pk2(S.o[0] * rl, S.o[1] * rl); w.y = pk2(S.o[2] * rl, S.o[3] * rl); w.z = pk2(S.o[4] * rl, S.o[5] * rl); w.w = pk2(S.o[6] * rl, S.o[7] * rl);
        *(GAS v4u*)(out + lane * 8) = w; }
}
__device__ __forceinline__ float dot8(const float (&q)[8], const v4u k) {
    return q[0] * bflo(k.x) + q[1] * bfhi(k.x) + q[2] * bflo(k.y) + q[3] * bfhi(k.y) + q[4] * bflo(k.z) + q[5] * bfhi(k.z) + q[6] * bflo(k.w) + q[7] * bfhi(k.w);
}
__device__ __forceinline__ float red16(float s) { s += __shfl_xor(s, 1); s += __shfl_xor(s, 2); s += __shfl_xor(s, 4); s += __shfl_xor(s, 8); return s; }
__device__ __forceinline__ void ldq8(float (&q)[8], const bf16* p, float sc) { const v4u w = *(const GAS v4u*)p;
    q[0] = bflo(w.x) * sc; q[1] = bfhi(w.x) * sc; q[2] = bflo(w.y) * sc; q[3] = bfhi(w.y) * sc; q[4] = bflo(w.z) * sc; q[5] = bfhi(w.z) * sc; q[6] = bflo(w.w) * sc; q[7] = bfhi(w.w) * sc; }

__device__ __forceinline__ void naive_attn_a(const bf16* QKV, bf16* ATT, int gw, int NGW, int lane) {
    asm volatile("" : "+v"(lane));
    const int g = lane >> 4, i = lane & 15; const float sc = 0.08838834764831845f * 1.4426950408889634f;
    for (int p = gw; p < MTOK * 16; p += NGW) {
        const int tok = p >> 4, h = p & 15, b = tok >> 11;
        float q[8]; ldq8(q, QKV + (size_t)tok * A_QKV + h * 128 + i * 8, sc);
        const bf16* kb = QKV + (size_t)(b * SEQ) * A_QKV + 2048 + (h >> 2) * 128 + i * 8;
        NState S; nst_init(S);
        for (int t0 = 0; t0 < SEQ; t0 += 4) { const bf16* kp = kb + (size_t)(t0 + g) * A_QKV; const v4u kk = *(const GAS v4u*)kp, vv = *(const GAS v4u*)(kp + 512);
            nst_update(S, red16(dot8(q, kk)), true, vv); }
        nst_finish(S, ATT + (size_t)tok * DM + h * 128, lane);
    }
}
__device__ __forceinline__ void naive_attn_b(const bf16* QKV, bf16* ATT, int gw, int NGW, int lane) {
    asm volatile("" : "+v"(lane));
    const int g = lane >> 4, i = lane & 15; const float sc = 0.08838834764831845f * 1.4426950408889634f;
    for (int p = gw; p < MTOK * 8; p += NGW) {
        const int tok = p >> 3, h = p & 7, s = tok & (SEQ - 1);
        NState S; nst_init(S);
        for (int grp = 0; grp < 3; ++grp) {
            const int dil = grp == 0 ? 1 : (grp == 1 ? 4 : 16);
            float q[8]; ldq8(q, QKV + (size_t)tok * B_QKV + grp * 3072 + h * 128 + i * 8, sc);
            for (int j0 = -64; j0 <= 64; j0 += 4) { const int j = j0 + g; const int t = s + j * dil; const bool valid = (j <= 64) && (t >= 0) && (t < SEQ);
                const int tc = valid ? t : s; const bf16* kp = QKV + (size_t)(tok - s + tc) * B_QKV + grp * 3072 + 1024 + h * 128 + i * 8;
                const v4u kk = *(const GAS v4u*)kp, vv = *(const GAS v4u*)(kp + 1024);
                nst_update(S, red16(dot8(q, kk)), valid, vv); }
        }
        nst_finish(S, ATT + (size_t)tok * 1024 + h * 128, lane);
    }
}
__device__ __forceinline__ void naive_attn_c(const bf16* Q, const bf16* KV, const bf16* KR, bf16* ATT, int gw, int NGW, int lane) {
    asm volatile("" : "+v"(lane));
    const int g = lane >> 4, i = lane & 15; const float sc = 0.07216878364870322f * 1.4426950408889634f;
    for (int p = gw; p < MTOK * 16; p += NGW) {
        const int tok = p >> 4, h = p & 15, b = tok >> 11;
        float q[8]; ldq8(q, Q + (size_t)tok * C_Q + h * 192 + i * 8, sc);
        float qr[4]; { const v2u w = *(const GAS v2u*)(Q + (size_t)tok * C_Q + h * 192 + 128 + i * 4); qr[0] = bflo(w.x) * sc; qr[1] = bfhi(w.x) * sc; qr[2] = bflo(w.y) * sc; qr[3] = bfhi(w.y) * sc; }
        const bf16* kb = KV + (size_t)(b * SEQ) * C_KV + h * 256 + i * 8; const bf16* rb = KR + (size_t)(b * SEQ) * 64 + i * 4;
        NState S; nst_init(S);
        for (int t0 = 0; t0 < SEQ; t0 += 4) { const bf16* kp = kb + (size_t)(t0 + g) * C_KV; const v4u kk = *(const GAS v4u*)kp, vv = *(const GAS v4u*)(kp + 128);
            const v2u kr = *(const GAS v2u*)(rb + (size_t)(t0 + g) * 64);
            const float d = dot8(q, kk) + qr[0] * bflo(kr.x) + qr[1] * bfhi(kr.x) + qr[2] * bflo(kr.y) + qr[3] * bfhi(kr.y);
            nst_update(S, red16(d), true, vv); }
        nst_finish(S, ATT + (size_t)tok * DM + h * 128, lane);
    }
}


namespace att {
using bf16x8 = __attribute__((ext_vector_type(8))) short;
using s16x4  = __attribute__((ext_vector_type(4))) short;
using f32x16 = __attribute__((ext_vector_type(16))) float;
using u32x4  = __attribute__((ext_vector_type(4))) unsigned;
typedef GAS const unsigned short* gptr;
constexpr int KVBLK = 64, QBLK = 32;
constexpr int SHM_V = 16384, SHM_K = 16384, SHM_KR = 8192;
constexpr int OFF_V = 0, OFF_K = 2 * SHM_V, OFF_KR = OFF_K + 2 * SHM_K, OFF_WS = OFF_KR + 2 * SHM_KR, LDS_ATT = OFF_WS + 8 * 256;
#define KSWZ(row, colB) ((row) * 256 + ((colB) ^ (((row) & 7) << 4)))
#define KSWZ2(row, colB) ((row) * 128 + ((colB) ^ (((row) & 7) << 4)))
#define SBAR() __builtin_amdgcn_sched_barrier(0)
__device__ __forceinline__ int crow(int r, int hi) { return (r & 3) + 8 * (r >> 2) + 4 * hi; }
__device__ __forceinline__ unsigned cvtpk(float lo, float hi) { unsigned r; asm volatile("v_cvt_pk_bf16_f32 %0, %1, %2" : "=v"(r) : "v"(lo), "v"(hi)); return r; }
template <int MODE> __device__ __forceinline__ int tokmap(int p, int logd, int logL) { return MODE == 1 ? (((p & ((1 << logL) - 1)) << logd) | (p >> logL)) : p; }

template <int MODE> __device__ __forceinline__ void partialSM(f32x16& p0, f32x16& p1, float& m_reg, float& mn, float& alpha) {
  constexpr float SCALE = (MODE == 2) ? 0.07216878364870322f : 0.08838834764831845f;
  constexpr float C = SCALE * 1.4426950408889634f;
  float pmax = p0[0];
#pragma unroll
  for (int r = 1; r < 16; ++r) pmax = fmaxf(pmax, p0[r]);
#pragma unroll
  for (int r = 0; r < 16; ++r) pmax = fmaxf(pmax, p1[r]);
  { auto rr = __builtin_amdgcn_permlane32_swap(__float_as_uint(pmax), __float_as_uint(pmax), false, false);
    pmax = fmaxf(__uint_as_float(rr[0]), __uint_as_float(rr[1])); }
  if (__builtin_expect(__all(pmax - m_reg <= 8.f / SCALE), 1)) { mn = m_reg; alpha = 1.f; }
  else { mn = fmaxf(m_reg, pmax); alpha = __builtin_amdgcn_exp2f((m_reg - mn) * C); m_reg = mn; }
  const float mnC = -mn * C;
#pragma unroll
  for (int r = 0; r < 16; ++r) p0[r] = fmaf(p0[r], C, mnC);
#pragma unroll
  for (int r = 0; r < 16; ++r) p1[r] = fmaf(p1[r], C, mnC);
#pragma unroll
  for (int r = 0; r < 16; ++r) p0[r] = __builtin_amdgcn_exp2f(p0[r]);
}
__device__ __forceinline__ void finishSM(f32x16& p0, f32x16& p1, float alpha, float& l_reg, bf16x8& pa0, bf16x8& pa1, bf16x8& pa2, bf16x8& pa3) {
#pragma unroll
  for (int r = 0; r < 16; ++r) p1[r] = __builtin_amdgcn_exp2f(p1[r]);
  float ps = 0;
#pragma unroll
  for (int r = 0; r < 16; ++r) ps += p0[r];
#pragma unroll
  for (int r = 0; r < 16; ++r) ps += p1[r];
  { auto rr = __builtin_amdgcn_permlane32_swap(__float_as_uint(ps), __float_as_uint(ps), false, false);
    ps = __uint_as_float(rr[0]) + __uint_as_float(rr[1]); }
  l_reg = l_reg * alpha + ps;
#define PK4(P, BASE, OUT) do { unsigned a0 = cvtpk(P[BASE + 0], P[BASE + 1]), a1 = cvtpk(P[BASE + 2], P[BASE + 3]);   \
    unsigned b0 = cvtpk(P[BASE + 4], P[BASE + 5]), b1 = cvtpk(P[BASE + 6], P[BASE + 7]);                              \
    auto r0 = __builtin_amdgcn_permlane32_swap(a0, b0, false, false); auto r1 = __builtin_amdgcn_permlane32_swap(a1, b1, false, false); \
    u32x4 w = {r0[0], r1[0], r0[1], r1[1]}; OUT = *reinterpret_cast<bf16x8*>(&w); } while (0)
  PK4(p0, 0, pa0); PK4(p0, 8, pa1); PK4(p1, 0, pa2); PK4(p1, 8, pa3);
#undef PK4
}
template <int MODE> __device__ __forceinline__ void qkt(f32x16& p0, f32x16& p1, const LAS char* Ks, const LAS char* KRs, const bf16x8* qr, int r32, int hi) {
  p0 = f32x16{}; p1 = f32x16{};
#pragma unroll
  for (int d0 = 0; d0 < 8; ++d0) { const int cb = (d0 * 16 + hi * 8) * 2;
    const bf16x8 b0 = *reinterpret_cast<const LAS bf16x8*>(Ks + KSWZ(r32, cb));
    const bf16x8 b1 = *reinterpret_cast<const LAS bf16x8*>(Ks + KSWZ(32 + r32, cb));
    p0 = __builtin_amdgcn_mfma_f32_32x32x16_bf16(b0, qr[d0], p0, 0, 0, 0);
    p1 = __builtin_amdgcn_mfma_f32_32x32x16_bf16(b1, qr[d0], p1, 0, 0, 0); }
  if constexpr (MODE == 2) {
#pragma unroll
    for (int d0 = 0; d0 < 4; ++d0) { const int cb = (d0 * 16 + hi * 8) * 2;
      const bf16x8 b0 = *reinterpret_cast<const LAS bf16x8*>(KRs + KSWZ2(r32, cb));
      const bf16x8 b1 = *reinterpret_cast<const LAS bf16x8*>(KRs + KSWZ2(32 + r32, cb));
      p0 = __builtin_amdgcn_mfma_f32_32x32x16_bf16(b0, qr[8 + d0], p0, 0, 0, 0);
      p1 = __builtin_amdgcn_mfma_f32_32x32x16_bf16(b1, qr[8 + d0], p1, 0, 0, 0); }
  }
}
__device__ __forceinline__ void bmask(f32x16& p0, f32x16& p1, int kb, int qp, int logL, int hi) {
  const int qc = qp >> logL;
#pragma unroll
  for (int r = 0; r < 16; ++r) { const int k0 = kb + crow(r, hi), k1 = k0 + 32; const int d0 = k0 - qp, d1 = k1 - qp;
    const bool v0 = (d0 <= 64) && (d0 >= -64) && ((k0 >> logL) == qc), v1 = (d1 <= 64) && (d1 >= -64) && ((k1 >> logL) == qc);
    p0[r] = v0 ? p0[r] : -3.0e38f; p1[r] = v1 ? p1[r] : -3.0e38f; }
}
__device__ __forceinline__ int v_st(int k, int c) { const int kk = (k & ~0xC) | ((k & 4) << 1) | ((k & 8) >> 1); return ((kk >> 3) * 4 + (c >> 5)) * 512 + ((kk & 7) * 32 + (c & 31)) * 2; }
__device__ __forceinline__ int v_rd_base(int lane) { return ((lane & 3) << 3) | (((lane >> 2) & 3) << 6) | (((lane >> 4) & 1) << 5) | (((lane >> 5) & 1) << 8); }
constexpr int v_rd_off(int d0, int ks, int half) { return d0 * 512 + ks * 4096 + half * 2048; }
template <int OFF> __device__ __forceinline__ s16x4 tr_read(int vb) {
  s16x4 r; asm volatile("ds_read_b64_tr_b16 %0, %1 offset:%2" : "=&v"(r) : "v"(vb), "i"(OFF) : "memory"); return r;
}
template <int D0> __device__ __forceinline__ void pv_one(f32x16& od, int vb, bf16x8 pa0, bf16x8 pa1, bf16x8 pa2, bf16x8 pa3) {
  const s16x4 l0 = tr_read<v_rd_off(D0, 0, 0)>(vb), h0 = tr_read<v_rd_off(D0, 0, 1)>(vb), l1 = tr_read<v_rd_off(D0, 1, 0)>(vb), h1 = tr_read<v_rd_off(D0, 1, 1)>(vb);
  const s16x4 l2 = tr_read<v_rd_off(D0, 2, 0)>(vb), h2 = tr_read<v_rd_off(D0, 2, 1)>(vb), l3 = tr_read<v_rd_off(D0, 3, 0)>(vb), h3 = tr_read<v_rd_off(D0, 3, 1)>(vb);
  asm volatile("s_waitcnt lgkmcnt(0)" ::: "memory"); SBAR();
#define PK(L, H) (bf16x8){L[0], L[1], L[2], L[3], H[0], H[1], H[2], H[3]}
  od = __builtin_amdgcn_mfma_f32_32x32x16_bf16(pa0, PK(l0, h0), od, 0, 0, 0);
  od = __builtin_amdgcn_mfma_f32_32x32x16_bf16(pa1, PK(l1, h1), od, 0, 0, 0);
  od = __builtin_amdgcn_mfma_f32_32x32x16_bf16(pa2, PK(l2, h2), od, 0, 0, 0);
  od = __builtin_amdgcn_mfma_f32_32x32x16_bf16(pa3, PK(l3, h3), od, 0, 0, 0);
#undef PK
}
__device__ __forceinline__ void pv_d0(f32x16* o, int vb, bf16x8 pa0, bf16x8 pa1, bf16x8 pa2, bf16x8 pa3) {
  pv_one<0>(o[0], vb, pa0, pa1, pa2, pa3); pv_one<1>(o[1], vb, pa0, pa1, pa2, pa3); pv_one<2>(o[2], vb, pa0, pa1, pa2, pa3); pv_one<3>(o[3], vb, pa0, pa1, pa2, pa3);
}

template <int MODE>
__device__ __forceinline__ void attn_unit(gptr Qb, gptr Kb, gptr Vb, gptr KRb, GAS unsigned short* Ob, GAS float* lse, const GAS float* tabc,
                                          const int p0, const int k0, const int logd, LAS char* lds, const int tid) {
  constexpr int SDEPTH = (MODE == 2) ? 1 : 2;
  constexpr int NQ = (MODE == 2) ? 12 : 8;
  constexpr int ldq = (MODE == 0) ? A_QKV : (MODE == 1) ? B_QKV : C_Q, ldk = (MODE == 0) ? A_QKV : (MODE == 1) ? B_QKV : C_KV, ldo = (MODE == 1) ? 1024 : DM, NT = (MODE == 1) ? 6 : SEQ / 64;
  constexpr float SCALE = (MODE == 2) ? 0.07216878364870322f : 0.08838834764831845f;
  const int wid = tid >> 6, lane = tid & 63, r32 = lane & 31, hi = lane >> 5;
  const int logL = 11 - logd;
  LAS char* V_lds = lds + OFF_V; LAS char* K_lds = lds + OFF_K; LAS char* KR_lds = lds + OFF_KR;
  LAS float* wsl = (LAS float*)(lds + OFF_WS) + wid * 64; LAS float* li_l = wsl; LAS float* al_l = wsl + 32;
  float m_reg = -1e30f, l_reg = 0; f32x16 o[4] = {}; bf16x8 qr[NQ];
  const int qp = p0 + wid * QBLK + r32;
  { gptr Qw = Qb + (unsigned)(tokmap<MODE>(qp, logd, logL) * ldq + hi * 8);
#pragma unroll
    for (int d0 = 0; d0 < NQ; ++d0) qr[d0] = *reinterpret_cast<GAS const bf16x8*>(Qw + d0 * 16); }
  if constexpr (MODE == 2) {
    const GAS float* cc = tabc + qp * 32 + hi * 8; const GAS float* sc = cc + 2048 * 32;
#pragma unroll
    for (int d = 0; d < 2; ++d) { bf16x8 xa = qr[8 + d], xb = qr[10 + d]; float c[8], sn[8];
      { const f32x4 c0 = *(const GAS f32x4*)(cc + 16 * d), c1 = *(const GAS f32x4*)(cc + 16 * d + 4), s0 = *(const GAS f32x4*)(sc + 16 * d), s1 = *(const GAS f32x4*)(sc + 16 * d + 4);
        c[0] = c0.x; c[1] = c0.y; c[2] = c0.z; c[3] = c0.w; c[4] = c1.x; c[5] = c1.y; c[6] = c1.z; c[7] = c1.w; sn[0] = s0.x; sn[1] = s0.y; sn[2] = s0.z; sn[3] = s0.w; sn[4] = s1.x; sn[5] = s1.y; sn[6] = s1.z; sn[7] = s1.w; }
#pragma unroll
      for (int e = 0; e < 8; ++e) { const float a = __uint_as_float(((unsigned)(unsigned short)xa[e]) << 16), b = __uint_as_float(((unsigned)(unsigned short)xb[e]) << 16);
        xa[e] = (short)f2bf(a * c[e] - b * sn[e]); xb[e] = (short)f2bf(a * sn[e] + b * c[e]); }
      qr[8 + d] = xa; qr[10 + d] = xb; } }
  const int sr = tid >> 4, sc = (tid & 15) * 8, vst0 = v_st(sr, sc), vst1 = v_st(32 + sr, sc);
  const int krr = tid >> 3, krc = (tid & 7) * 8;
  const int vb0 = (int)(unsigned)(uintptr_t)V_lds + v_rd_base(lane);
  struct { bf16x8 vs0, vs1, ks0, ks1, kr; } sr_[SDEPTH];
#define SLOAD(i, kk) do { const unsigned t0_ = (unsigned)tokmap<MODE>(k0 + (kk) + sr, logd, logL) * (unsigned)ldk + (unsigned)sc, t1_ = (unsigned)tokmap<MODE>(k0 + (kk) + 32 + sr, logd, logL) * (unsigned)ldk + (unsigned)sc; \
    sr_[i].vs0 = *reinterpret_cast<GAS const bf16x8*>(Vb + t0_); sr_[i].vs1 = *reinterpret_cast<GAS const bf16x8*>(Vb + t1_); \
    sr_[i].ks0 = *reinterpret_cast<GAS const bf16x8*>(Kb + t0_); sr_[i].ks1 = *reinterpret_cast<GAS const bf16x8*>(Kb + t1_); \
    if constexpr (MODE == 2) sr_[i].kr = *reinterpret_cast<GAS const bf16x8*>(KRb + (unsigned)((k0 + (kk) + krr) * 64 + krc)); } while (0)
#define SWRITE(b, i) do { *(LAS bf16x8*)(V_lds + (b) * SHM_V + vst0) = sr_[i].vs0; *(LAS bf16x8*)(V_lds + (b) * SHM_V + vst1) = sr_[i].vs1; const int kc = sc * 2; \
    *(LAS bf16x8*)(K_lds + (b) * SHM_K + KSWZ(sr, kc)) = sr_[i].ks0; *(LAS bf16x8*)(K_lds + (b) * SHM_K + KSWZ(32 + sr, kc)) = sr_[i].ks1; \
    if constexpr (MODE == 2) *(LAS bf16x8*)(KR_lds + (b) * SHM_KR + KSWZ2(krr, krc * 2)) = sr_[i].kr; } while (0)
#define SWAIT() do { if constexpr (SDEPTH == 2) asm volatile("s_waitcnt vmcnt(4)" ::: "memory"); else asm volatile("s_waitcnt vmcnt(0)" ::: "memory"); } while (0)
#define RESC(a) do { if (__any((a) < 1.f)) { if (hi == 0) al_l[r32] = (a); asm volatile("s_waitcnt lgkmcnt(0)" ::: "memory"); \
    _Pragma("unroll") for (int d = 0; d < 4; ++d) _Pragma("unroll") for (int r = 0; r < 16; ++r) o[d][r] *= al_l[crow(r, hi)]; } } while (0)
#define QKT(P0, P1, b, t) do { qkt<MODE>(P0, P1, K_lds + (b) * SHM_K, KR_lds + (b) * SHM_KR, qr, r32, hi); if constexpr (MODE == 1) bmask(P0, P1, k0 + (t) * KVBLK, qp, logL, hi); } while (0)
  bf16x8 pa0, pa1, pa2, pa3;
  if constexpr (MODE == 2) {
    f32x16 pA0, pA1; float mnA, alA;
    SLOAD(0, 0); asm volatile("s_waitcnt vmcnt(0)" ::: "memory"); SWRITE(0, 0); __syncthreads();
    for (int t = 0; t < NT; t += 2) {
      SLOAD(0, (t + 1) * KVBLK); SBAR();
      QKT(pA0, pA1, 0, t); partialSM<MODE>(pA0, pA1, m_reg, mnA, alA); RESC(alA);
      finishSM(pA0, pA1, alA, l_reg, pa0, pa1, pa2, pa3); SBAR();
      pv_d0(o, vb0, pa0, pa1, pa2, pa3);
      SWAIT(); SWRITE(1, 0); __syncthreads();
      if (t + 2 < NT) SLOAD(0, (t + 2) * KVBLK); SBAR();
      QKT(pA0, pA1, 1, t + 1); partialSM<MODE>(pA0, pA1, m_reg, mnA, alA); RESC(alA);
      finishSM(pA0, pA1, alA, l_reg, pa0, pa1, pa2, pa3); SBAR();
      pv_d0(o, vb0 + SHM_V, pa0, pa1, pa2, pa3);
      if (t + 2 < NT) { SWAIT(); SWRITE(0, 0); } __syncthreads();
    }
  } else {
  f32x16 pA0, pA1, pB0, pB1; float mnA, mnB, alA, alB;
  constexpr int SE = 0, SO = SDEPTH - 1;
  SLOAD(SE, 0); asm volatile("s_waitcnt vmcnt(0)" ::: "memory"); SWRITE(0, SE); __syncthreads();
  QKT(pA0, pA1, 0, 0); partialSM<MODE>(pA0, pA1, m_reg, mnA, alA);
  SLOAD(SO, KVBLK); if constexpr (SDEPTH == 2) { if (2 < NT) SLOAD(SE, 2 * KVBLK); }
  SWAIT(); SWRITE(1, SO); __syncthreads();
  for (int j = 1; j + 1 < NT; j += 2) {
    SBAR(); QKT(pB0, pB1, 1, j);
    finishSM(pA0, pA1, alA, l_reg, pa0, pa1, pa2, pa3); SBAR();
    SLOAD(SO, (j + SDEPTH) * KVBLK); SBAR();
    pv_d0(o, vb0, pa0, pa1, pa2, pa3); partialSM<MODE>(pB0, pB1, m_reg, mnB, alB);
    __syncthreads(); SWAIT(); SWRITE(0, SE);
    RESC(alB); __syncthreads();
    SBAR(); QKT(pA0, pA1, 0, j + 1);
    finishSM(pB0, pB1, alB, l_reg, pa0, pa1, pa2, pa3); SBAR();
    if (SDEPTH == 1 || j + 3 < NT) SLOAD(SE, (j + 1 + SDEPTH) * KVBLK); SBAR();
    pv_d0(o, vb0 + SHM_V, pa0, pa1, pa2, pa3); partialSM<MODE>(pA0, pA1, m_reg, mnA, alA);
    __syncthreads(); SWAIT(); SWRITE(1, SO);
    RESC(alA); __syncthreads();
  }
  SBAR(); QKT(pB0, pB1, 1, NT - 1);
  finishSM(pA0, pA1, alA, l_reg, pa0, pa1, pa2, pa3); SBAR();
  pv_d0(o, vb0, pa0, pa1, pa2, pa3); partialSM<MODE>(pB0, pB1, m_reg, mnB, alB);
  __syncthreads(); RESC(alB);
  finishSM(pB0, pB1, alB, l_reg, pa0, pa1, pa2, pa3); SBAR();
  pv_d0(o, vb0 + SHM_V, pa0, pa1, pa2, pa3);
  }
  if (hi == 0) li_l[r32] = l_reg; asm volatile("s_waitcnt lgkmcnt(0)" ::: "memory");
  if constexpr (MODE == 1) { if (hi == 0) lse[(unsigned)(tokmap<MODE>(qp, logd, logL) * 8)] = m_reg * SCALE + __builtin_amdgcn_logf(l_reg) * 0.6931471805599453f; }
#pragma unroll
  for (int r = 0; r < 16; ++r) { const int orow = crow(r, hi); const float rl = __builtin_amdgcn_rcpf(li_l[orow]);
    GAS unsigned short* Ow = Ob + (unsigned)(tokmap<MODE>(p0 + wid * QBLK + orow, logd, logL) * ldo + r32);
#pragma unroll
    for (int d0 = 0; d0 < 4; ++d0) Ow[d0 * 32] = (unsigned short)f2bf(o[d0][r] * rl); }
#undef SLOAD
#undef SWRITE
#undef SWAIT
#undef RESC
#undef QKT
}
}

__device__ __forceinline__ void attn_phase_a(const bf16* QKV, bf16* ATT, LAS char* lds, int G, int bx, int tid) {
    asm volatile("" : "+v"(tid));
    for (int u = bx; u < BATCH * 16 * 8; u += G) {
        int pair, j; if (G == 256) { pair = (u >> 8) * 8 + (bx & 7); j = bx >> 3; } else { pair = u >> 5; j = u & 31; }
        const int b = pair >> 2, kvh = pair & 3, hq = kvh * 4 + (j >> 3), qb = j & 7;
        att::gptr Qb = (att::gptr)(QKV + (size_t)b * SEQ * A_QKV + hq * 128); att::gptr Kb = (att::gptr)(QKV + (size_t)b * SEQ * A_QKV + 2048 + kvh * 128);
        att::attn_unit<0>(Qb, Kb, Kb + 512, Kb, (GAS unsigned short*)(ATT + (size_t)b * SEQ * DM + hq * 128), nullptr, nullptr, 256 * qb, 0, 0, lds, tid);
        __syncthreads();
    }
}
__device__ __forceinline__ void attn_phase_c(const bf16* Q, const bf16* KV, const bf16* KR, bf16* ATT, const float* tabc, LAS char* lds, int G, int bx, int tid) {
    asm volatile("" : "+v"(tid));
    for (int u = bx; u < BATCH * 16 * 8; u += G) {
        int pair, qb; if (G == 256) { pair = ((u >> 8) * 8 + (bx & 7)) * 4 + (bx >> 6); qb = (bx >> 3) & 7; } else { pair = u >> 3; qb = u & 7; }
        const int b = pair >> 4, h = pair & 15;
        att::gptr Qb = (att::gptr)(Q + (size_t)b * SEQ * C_Q + h * 192); att::gptr Kb = (att::gptr)(KV + (size_t)b * SEQ * C_KV + h * 256);
        att::attn_unit<2>(Qb, Kb, Kb + 128, (att::gptr)(KR + (size_t)b * SEQ * 64), (GAS unsigned short*)(ATT + (size_t)b * SEQ * DM + h * 128), nullptr, (const GAS float*)tabc, 256 * qb, 0, 0, lds, tid);
        __syncthreads();
    }
}
__device__ __forceinline__ void attn_phase_b(const bf16* QKV, bf16* OG, float* LSE, LAS char* lds, int G, int bx, int tid) {
    asm volatile("" : "+v"(tid));
    for (int u = bx; u < 3 * BATCH * 8 * 8; u += G) {
        const int qb = u & 7, h = (u >> 3) & 7, b = (u >> 6) & 15, grp = u >> 10, logd = 2 * grp;
        att::gptr Qb = (att::gptr)(QKV + (size_t)b * SEQ * B_QKV + grp * 3072 + h * 128);
        const int p0 = 256 * qb; int k0 = p0 - 64; k0 = k0 < 0 ? 0 : (k0 > SEQ - 384 ? SEQ - 384 : k0);
        att::attn_unit<1>(Qb, Qb + 1024, Qb + 2048, Qb, (GAS unsigned short*)(OG + (size_t)grp * MTOK * 1024 + (size_t)b * SEQ * 1024 + h * 128),
                          (GAS float*)(LSE + ((size_t)grp * MTOK + (size_t)b * SEQ) * 8 + h), nullptr, p0, k0, logd, lds, tid);
        __syncthreads();
    }
}
__device__ __forceinline__ void merge_b(const bf16* OG, const float* LSE, bf16* ATT, int gw, int NGW, int lane) {
    asm volatile("" : "+v"(lane));
    const int h = lane >> 3, c = (lane & 7) * 16;
    for (int tok = gw; tok < MTOK; tok += NGW) {
        const float l0 = LSE[(size_t)tok * 8 + h], l1 = LSE[((size_t)MTOK + tok) * 8 + h], l2 = LSE[((size_t)2 * MTOK + tok) * 8 + h];
        const float mx = fmaxf(l0, fmaxf(l1, l2)); float w0 = __expf(l0 - mx), w1 = __expf(l1 - mx), w2 = __expf(l2 - mx); const float rs = 1.f / (w0 + w1 + w2); w0 *= rs; w1 *= rs; w2 *= rs;
        const GAS v4u* a = (const GAS v4u*)(OG + (size_t)tok * 1024 + h * 128 + c); const GAS v4u* bq = (const GAS v4u*)(OG + ((size_t)MTOK + tok) * 1024 + h * 128 + c); const GAS v4u* cq = (const GAS v4u*)(OG + ((size_t)2 * MTOK + tok) * 1024 + h * 128 + c);
        GAS v4u* o = (GAS v4u*)(ATT + (size_t)tok * 1024 + h * 128 + c);
#pragma unroll
        for (int i = 0; i < 2; ++i) { const v4u x = a[i], y = bq[i], z = cq[i]; v4u r;
            r.x = pk2(w0 * bflo(x.x) + w1 * bflo(y.x) + w2 * bflo(z.x), w0 * bfhi(x.x) + w1 * bfhi(y.x) + w2 * bfhi(z.x));
            r.y = pk2(w0 * bflo(x.y) + w1 * bflo(y.y) + w2 * bflo(z.y), w0 * bfhi(x.y) + w1 * bfhi(y.y) + w2 * bfhi(z.y));
            r.z = pk2(w0 * bflo(x.z) + w1 * bflo(y.z) + w2 * bflo(z.z), w0 * bfhi(x.z) + w1 * bfhi(y.z) + w2 * bfhi(z.z));
            r.w = pk2(w0 * bflo(x.w) + w1 * bflo(y.w) + w2 * bflo(z.w), w0 * bfhi(x.w) + w1 * bfhi(y.w) + w2 * bfhi(z.w));
            o[i] = r; }
    }
}

constexpr int N_IN = 57;
struct Args { const float* in[N_IN]; float* out; unsigned char* ws; int ph_lo, ph_hi; };
__device__ __forceinline__ const float* arg_in(int idx) {
    typedef __attribute__((address_space(4))) const char* kptr;
    kptr kp = (kptr)__builtin_amdgcn_kernarg_segment_ptr();
    return *(const float* __attribute__((address_space(4))) const*)(kp + 8 * idx);
}
constexpr int N_PHASES = 1 + 7 + 8 + 8 + 7 + 1;

#define CVT_NEXT(PM) do { const int pm_ = (PM); \
                if (si + 1 < 3 * DEPTH && EXP != 3 && pm_ != 0) { \
                    const int lncur = (sub == 0) ? base + 2 : (sub == 1) ? base + 4 + nmix : base + 8 + nmix; \
                    const float* gk = arg_in(lncur); const float* bk = arg_in(lncur + 1); bf16* WN = WTB(si + 1); float* un = UVEC(si + 1); float* vn = un + 11264; LAS unsigned char* cl = lds + RING_OFF; int to = 0; \
                    if (sub == 0) { \
                        if (kind == 0) { if (pm_ & 1) to = cvt_weight(arg_in(base + 4), DM, A_QKV, WN, A_QKV, 3, gk, bk, un, vn, cl, to, G, bx, tid); else to = (DM / 64) * (A_QKV / 256); \
                                         if (pm_ & 2) to = cvt_weight(arg_in(base + 7), DM, DM, WN + WT_A_OUT, DM, 0, nullptr, nullptr, nullptr, nullptr, cl, to, G, bx, tid); } \
                        else if (kind == 1) { if (pm_ & 1) to = cvt_weight(arg_in(base + 4), DM, B_QKV, WN, B_QKV, 2, gk, bk, un, vn, cl, to, G, bx, tid); else to = (DM / 64) * (B_QKV / 256); \
                                              if (pm_ & 2) to = cvt_weight(arg_in(base + 5), 1024, DM, WN + WT_B_OUT, DM, 0, nullptr, nullptr, nullptr, nullptr, cl, to, G, bx, tid); } \
                        else { if (pm_ & 1) to = cvt_weight(arg_in(base + 4), DM, C_IN, WN, C_INP, 0, gk, bk, un, vn, cl, to, G, bx, tid); else to = (DM / 64) * (C_INP / 256); \
                               if (pm_ & 2) { to = cvt_weight(arg_in(base + 7), C_QL, C_Q, WN + WT_C_QUP, C_Q, 0, arg_in(base + 5), nullptr, nullptr, nullptr, cl, to, G, bx, tid); \
                               to = cvt_weight(arg_in(base + 8), C_KVL, C_KV, WN + WT_C_KVUP, C_KV, 0, arg_in(base + 6), nullptr, nullptr, nullptr, cl, to, G, bx, tid); \
                               to = cvt_weight(arg_in(base + 9), DM, DM, WN + WT_C_OUT, DM, 0, nullptr, nullptr, nullptr, nullptr, cl, to, G, bx, tid); } } \
                    } else { \
                        const int wi = (sub == 1) ? base + 6 + nmix : ((L + 1 == 1) ? 15 : (L + 1 == 2) ? 27 : 43); \
                        if (pm_ & 1) to = cvt_weight(arg_in(wi), DM, 2 * DFF, WN, 2 * DFF, 1, gk, bk, un, vn, cl, to, G, bx, tid); else to = (DM / 64) * (2 * DFF / 256); \
                        if (pm_ & 2) to = cvt_weight(arg_in(wi + 1), DFF, DM, WN + WT_FFN_OUT, DM, 0, nullptr, nullptr, nullptr, nullptr, cl, to, G, bx, tid); \
                    } \
                    (void)to; \
                } \
 } while (0)
__global__ void __launch_bounds__(NWAVES * 64, 2) mega_fwd(Args args) {
    extern __shared__ __attribute__((aligned(16))) unsigned char lds_raw[];
    LAS unsigned char* lds = (LAS unsigned char*)lds_raw;
    volatile LAS unsigned* MISC = (volatile LAS unsigned*)(lds + MISC_OFF);
    const int wave = __builtin_amdgcn_readfirstlane((int)threadIdx.x >> 6);
    unsigned char* const ws0 = args.ws; float* const out0 = args.out; const int G0 = gridDim.x, bx0 = blockIdx.x;
    for (int u = threadIdx.x; u < (LDS_BYTES - LDSCTL_OFF) / 4; u += NWAVES * 64) ((LAS unsigned*)(lds + LDSCTL_OFF))[u] = 0u;
    __syncthreads();
    XcdBarrier bar; bar.bar = (unsigned*)((gu32*)(ws0 + WS_CTL) + CW_BAR); bar.x = 0; bar.st = nullptr;
    if (!MK_PER_PHASE) bar = xcd_barrier_post((unsigned*)((gu32*)(ws0 + WS_CTL) + CW_BAR), MISC + 8);
    const int lo = args.ph_lo, hi = args.ph_hi;
    int ph = 0;
#define IN_PH() (lo <= ph && ph < hi)
#define SEAM_BAR() do { unsigned ones_ = ~0u; asm volatile("" : "+s"(ones_)); xcd_barrier(bar, wave * 64 + (int)__builtin_amdgcn_mbcnt_hi(ones_, __builtin_amdgcn_mbcnt_lo(ones_, 0u))); } while (0)
#if PROBE_CAT >= 0
    volatile LAS unsigned long long* PR = (volatile LAS unsigned long long*)(lds + MISC_OFF + 64);
    if (threadIdx.x == 0) { const unsigned long long t_ = __builtin_amdgcn_s_memrealtime(); PR[0] = t_; PR[1] = 0ull; PR[2] = t_; MISC[22] = 2u; }
#define SEAM() do { if (wave == 0) { const unsigned long long te_ = __builtin_amdgcn_s_memrealtime(); if (MISC[22] == (unsigned)PROBE_CAT) PR[1] = PR[1] + (te_ - PR[0]); PR[0] = te_; } \
    if (lo <= ph && ph + 1 < hi) SEAM_BAR(); if (wave == 0) { const unsigned long long ta_ = __builtin_amdgcn_s_memrealtime(); if (PROBE_CAT == 4) PR[1] = PR[1] + (ta_ - PR[0]); PR[0] = ta_; } ++ph; } while (0)
#define PCAT(c) do { if (wave == 0) MISC[22] = (unsigned)(c); } while (0)
#else
#define SEAM() do { if (!MK_PER_PHASE) { if (lo <= ph && ph + 1 < hi) SEAM_BAR(); } ++ph; } while (0)
#define PCAT(c) do { } while (0)
#endif
#define PH_VARS unsigned ones_ = ~0u; asm volatile("" : "+s"(ones_)); const int lane = (int)__builtin_amdgcn_mbcnt_hi(ones_, __builtin_amdgcn_mbcnt_lo(ones_, 0u)); const int tid = wave * 64 + lane; (void)lane; \
    unsigned char* ws = lnd(ws0); float* H32 = lnd(out0); bf16* WT0 = (bf16*)(ws + WS_WT); bf16* HB = (bf16*)(ws + WS_HB); unsigned char* LO = ws + WS_LO; unsigned char* R = ws + WS_R; \
    int G = G0, bx = bx0; asm volatile("" : "+s"(G), "+s"(bx)); const int vcu = (G % 8 == 0) ? (bx % 8) * (G / 8) + bx / 8 : bx; const int gw = vcu * NWAVES + wave, NGW = G * NWAVES; \
    const size_t gt = (size_t)vcu * (NWAVES * 64) + tid, NGT = (size_t)G * NWAVES * 64; LAS float* scr = (LAS float*)(lds + RING_OFF + wave * 16384); \
    (void)H32; (void)WT0; (void)HB; (void)LO; (void)R; (void)gw; (void)NGW; (void)gt; (void)NGT; (void)scr;

    for (int rep = 0; rep < REPS; ++rep) {
    PCAT(2);
    if (IN_PH()) { PH_VARS
        for (size_t i = gt; i < (DEV_ZERO_END - CTL_ZERO_BYTES) / 16; i += NGT) ((GAS v4u*)(ws + CTL_ZERO_BYTES))[i] = (v4u){0u, 0u, 0u, 0u};
        build_tables(ws, gt, NGT);
        cvt_rows_bf16(arg_in(0), HB, LO, (size_t)MTOK * DM / 8, gt, NGT);
        { int to = cvt_weight(arg_in(1), DM, 2 * DFF, WT0, 2 * DFF, 1, nullptr, nullptr, nullptr, nullptr, lds + RING_OFF, 0, G, bx, tid);
          (void)cvt_weight(arg_in(2), DFF, DM, WT0 + WT_FFN_OUT, DM, 0, nullptr, nullptr, nullptr, nullptr, lds + RING_OFF, to, G, bx, tid); }
    }
    SEAM();

    for (int L = 0; L < DEPTH; ++L) {
        const int kind = (L == 3) ? 0 : L;
        const int base = (L == 0) ? 1 : (L == 1) ? 15 : (L == 2) ? 27 : 43;
        const int nmix = (kind == 0) ? 4 : (kind == 1) ? 2 : 6;
        for (int sub = 0; sub < 3; ++sub) {
            const int si = L * 3 + sub;
            const int pbase = (L == 0) ? 1 : (L == 1) ? 1 : (L == 2) ? 15 : 27, pkind = (L == 0) ? 0 : (L - 1), pnmix = (pkind == 0) ? 4 : (pkind == 1) ? 2 : 6;
            const int lnprev = (sub == 0) ? pbase + 8 + pnmix : (sub == 1) ? base + 2 : base + 4 + nmix;
#define WTB(i) ((bf16*)(ws + WS_WT + (size_t)((i) & 1) * WT_BUF))
#define STAT_SUM(i) ((float*)(ws + WS_STAT) + (size_t)(i) * 2 * MTOK)
#define UVEC(i) ((float*)(ws + WS_UV) + (size_t)(i) * UV_STRIDE)
#define PREV_STAT() pg8::RowStat{STAT_SUM(si - 1), STAT_SUM(si - 1) + MTOK, 1.f / DM, LN_EPS, si == 0 ? 0 : 1}
            if (sub != 1) {
                PCAT(10);
                if (IN_PH()) { PH_VARS
                    pg8::Gemm g{lnd(HB), lnd(WTB(si)), MTOK, 2 * DFF, DM, DM}; pg8::StaticOrder S; S.init(MTOK, 2 * DFF, G, bx);
                    pg8::EpiAffSwiGLU E{lnd((bf16*)(R + R_ACT)), DFF, PREV_STAT(), UVEC(si), UVEC(si) + 11264};
                    pg8::gemm_phase<pg8::EpiAffSwiGLU, pg8::StaticOrder, PG8_ALIGN, PG8_SP2>(lds + RING_OFF, g, S, E, tid);
                }
                SEAM();
            } else {
                PCAT(12);
                if (IN_PH()) { PH_VARS
                    if (kind == 0) {
                        pg8::Gemm g{lnd(HB), lnd(WTB(si)), MTOK, A_QKV, DM, DM}; pg8::StaticOrder S; S.init(MTOK, A_QKV, G, bx);
                        pg8::EpiAffA E{lnd((bf16*)(R + RA_QKV)), A_QKV, PREV_STAT(), UVEC(si), UVEC(si) + 11264, arg_in(base + 5), arg_in(base + 6), (const float*)(ws + WS_TABA), (LAS float*)(lds + XCH_OFF)};
                        pg8::gemm_phase<pg8::EpiAffA, pg8::StaticOrder, PG8_ALIGN, PG8_SP2>(lds + RING_OFF, g, S, E, tid);
                    } else {
                    const int N = (kind == 1) ? B_QKV : C_INP;
                    pg8::Gemm g{lnd(HB), lnd(WTB(si)), MTOK, N, DM, DM}; pg8::StaticOrder S; S.init(MTOK, N, G, bx);
                    pg8::EpiAff E{lnd((bf16*)(R + 0)), N, PREV_STAT(), UVEC(si), UVEC(si) + 11264, (kind == 2) ? (float*)(ws + WS_SSQC) : (float*)nullptr, (kind == 1) ? (const float*)(ws + WS_TABB) : (const float*)nullptr};
                    pg8::gemm_phase<pg8::EpiAff, pg8::StaticOrder, PG8_ALIGN, PG8_SP2>(lds + RING_OFF, g, S, E, tid);
                    }
                }
                SEAM();
                if (kind == 0) {
                    PCAT(14);
                    if (IN_PH()) { PH_VARS attn_phase_a((const bf16*)(R + RA_QKV), (bf16*)(R + RA_ATT), (LAS char*)(lds + RING_OFF), G, bx, tid); }
                    SEAM();
                } else if (kind == 1) {
                    PCAT(15);
                    if (IN_PH()) { PH_VARS attn_phase_b((const bf16*)(R + RB_QKV), (bf16*)(R + RB_OG), (float*)(R + RB_LSE), (LAS char*)(lds + RING_OFF), G, bx, tid); }
                    SEAM();
                    PCAT(17);
                    if (IN_PH()) { PH_VARS merge_b((const bf16*)(R + RB_OG), (const float*)(R + RB_LSE), (bf16*)(R + RB_ATT), gw, NGW, lane); }
                    SEAM();
                } else {
                    PCAT(12);
                    if (IN_PH()) { PH_VARS
                        krope_c((const bf16*)(R + RC_IN), (bf16*)(R + RC_KR), ws, gw, NGW, lane);
                        { pg8::Gemm g{lnd((const bf16*)(R + RC_IN)), lnd(WTB(si) + WT_C_QUP), MTOK, C_Q, C_QL, C_INP}; pg8::StaticOrder S; S.init(MTOK, C_Q, G, bx);
                          pg8::EpiAff E{lnd((bf16*)(R + RC_Q)), C_Q, pg8::RowStat{nullptr, (const float*)(ws + WS_SSQC), 1.f / C_QL, RMS_EPS, 2}, nullptr, nullptr, nullptr, nullptr};
                          pg8::gemm_phase<pg8::EpiAff, pg8::StaticOrder, PG8_ALIGN, PG8_SP2>(lds + RING_OFF, g, S, E, tid); }
                        { pg8::Gemm g{lnd((const bf16*)(R + RC_IN) + C_QL), lnd(WTB(si) + WT_C_KVUP), MTOK, C_KV, C_KVL, C_INP}; pg8::StaticOrder S; S.init(MTOK, C_KV, G, bx);
                          pg8::EpiAff E{lnd((bf16*)(R + RC_KV)), C_KV, pg8::RowStat{nullptr, (const float*)(ws + WS_SSQC) + MTOK, 1.f / C_KVL, RMS_EPS, 2}, nullptr, nullptr, nullptr, nullptr};
                          pg8::gemm_phase<pg8::EpiAff, pg8::StaticOrder, PG8_ALIGN, PG8_SP2>(lds + RING_OFF, g, S, E, tid); }
                    }
                    SEAM();
                    PCAT(16);
                    if (IN_PH()) { PH_VARS attn_phase_c((const bf16*)(R + RC_Q), (const bf16*)(R + RC_KV), (const bf16*)(R + RC_KR), (bf16*)(R + RC_ATT), (const float*)(ws + WS_TABC), (LAS char*)(lds + RING_OFF), G, bx, tid); }
                    SEAM();
                }
            }
            PCAT(sub == 1 ? 13 : 11);
            if (IN_PH()) { PH_VARS
                const int cls_ = (bx & 7) >> 1; const int pm_before = (cls_ == 0) ? 3 : (cls_ == 1) ? 1 : (cls_ == 2) ? 2 : 0;
                if (pm_before) { CVT_NEXT(pm_before); __syncthreads(); }
                const bf16* A; const bf16* Bt; int K; float s;
                if (sub != 1) { A = (const bf16*)(R + R_ACT); Bt = WTB(si) + WT_FFN_OUT; K = DFF; s = 0.5f; }
                else if (kind == 0) { A = (const bf16*)(R + RA_ATT); Bt = WTB(si) + WT_A_OUT; K = DM; s = 1.0f; }
                else if (kind == 1) { A = (const bf16*)(R + RB_ATT); Bt = WTB(si) + WT_B_OUT; K = 1024; s = 1.0f; }
                else { A = (const bf16*)(R + RC_ATT); Bt = WTB(si) + WT_C_OUT; K = DM; s = 1.0f; }
                pg8::Gemm g{lnd(A), lnd(Bt), MTOK, DM, K, K}; pg8::StaticOrder S; S.init(MTOK, DM, G, bx);
                pg8::EpiResid2 E{lnd(HB), lnd(LO), STAT_SUM(si), STAT_SUM(si) + MTOK, arg_in(lnprev), arg_in(lnprev + 1), PREV_STAT(), DM, ALPHA, s};
                pg8::gemm_phase<pg8::EpiResid2, pg8::StaticOrder, PG8_ALIGN, PG8_SP2>(lds + RING_OFF, g, S, E, tid);
                if (pm_before != 3) { __syncthreads(); CVT_NEXT(3 ^ pm_before); }
            }
            SEAM();
        }
    }
    PCAT(2);
    if (IN_PH()) { PH_VARS ln_final(H32, HB, LO, STAT_SUM(11), STAT_SUM(11) + MTOK, arg_in(55), arg_in(56), gw, NGW, lane); }
    SEAM();
    }
#if PROBE_CAT >= 0
    SEAM_BAR();
    { unsigned on3_ = ~0u; asm volatile("" : "+s"(on3_)); const int ln_ = (int)__builtin_amdgcn_mbcnt_hi(on3_, __builtin_amdgcn_mbcnt_lo(on3_, 0u));
      for (size_t i = (size_t)bx0 * 512 + wave * 64 + ln_; i < (size_t)MTOK * DM / 4; i += (size_t)G0 * 512) ((GAS f32x4*)out0)[i] = (f32x4){16.f, 16.f, 16.f, 16.f}; }
    SEAM_BAR();
    { unsigned on2_ = ~0u; asm volatile("" : "+s"(on2_)); if (bx0 == 0 && wave == 0 && __builtin_amdgcn_mbcnt_hi(on2_, __builtin_amdgcn_mbcnt_lo(on2_, 0u)) == 0u) { const unsigned long long tot = __builtin_amdgcn_s_memrealtime() - PR[2]; out0[0] = (PROBE_CAT == 5) ? ((float)tot * 1e-5f - 15.0f) * 100.0f : (float)PR[1] * ((PROBE_CAT >= 6 && PROBE_CAT != 10) ? 1e-3f : 1e-4f); } }
#endif
#undef IN_PH
#undef SEAM
}

extern "C" void kernel_launch(void* const* d_in, const int* in_sizes, int n_in, void* d_out, int out_size, void* d_ws, size_t ws_size, hipStream_t stream) {
    static int grid = 0;
    if (grid == 0) {
        if (n_in != N_IN || in_sizes[0] != MTOK * DM || out_size != MTOK * DM || ws_size < WS_END) {
            fprintf(stderr, "kernel_launch: shape mismatch: n_in %d in0 %d out %d ws %zu (need >= %zu)\n", n_in, n_in > 0 ? in_sizes[0] : -1, out_size, ws_size, (size_t)WS_END); grid = -1; return; }
        int dev = 0, cus = 0, per_cu = 0;
        if (hipGetDevice(&dev) != hipSuccess || hipDeviceGetAttribute(&cus, hipDeviceAttributeMultiprocessorCount, dev) != hipSuccess) { fprintf(stderr, "kernel_launch: device query failed\n"); grid = -1; return; }
        if (hipFuncSetAttribute((const void*)mega_fwd, hipFuncAttributeMaxDynamicSharedMemorySize, LDS_BYTES) != hipSuccess) { fprintf(stderr, "kernel_launch: hipFuncSetAttribute failed\n"); grid = -1; return; }
        if (hipOccupancyMaxActiveBlocksPerMultiprocessor(&per_cu, (const void*)mega_fwd, NWAVES * 64, LDS_BYTES) != hipSuccess || per_cu < 1)
            fprintf(stderr, "kernel_launch: note: occupancy query reports %d workgroups per CU\n", per_cu);
        (void)hipGetLastError();
        grid = cus;
    }
    if (grid < 0) return;
    if (hipMemsetAsync((char*)d_ws + WS_CTL, 0, CTL_ZERO_BYTES, stream) != hipSuccess) { fprintf(stderr, "kernel_launch: memset failed\n"); return; }
    Args a{};
    for (int i = 0; i < N_IN; ++i) a.in[i] = (const float*)d_in[i];
    a.out = (float*)d_out; a.ws = (unsigned char*)d_ws;
#if MK_PER_PHASE
    for (int p = 0; p < N_PHASES; ++p) { a.ph_lo = p; a.ph_hi = p + 1; hipLaunchKernelGGL(mega_fwd, dim3(grid), dim3(NWAVES * 64), LDS_BYTES, stream, a); }
#else
    a.ph_lo = 0; a.ph_hi = N_PHASES;
    hipLaunchKernelGGL(mega_fwd, dim3(grid), dim3(NWAVES * 64), LDS_BYTES, stream, a);
#if LAUNCH_TWICE
    (void)hipMemsetAsync((char*)d_ws + WS_CTL, 0, CTL_ZERO_BYTES, stream);
    hipLaunchKernelGGL(mega_fwd, dim3(grid), dim3(NWAVES * 64), LDS_BYTES, stream, a);
#endif
#endif
    const hipError_t le = hipPeekAtLastError();
    if (le != hipSuccess) fprintf(stderr, "kernel_launch: launch failed: %s\n", hipGetErrorName(le));
}
```

```cpp
#include <hip/hip_runtime.h>
#include <cstdio>
#include <cstdint>

#ifndef FAST_A
#define FAST_A 1
#endif
#ifndef FAST_B
#define FAST_B 1
#endif
#ifndef FAST_C
#define FAST_C 1
#endif
#ifndef EXP
#define EXP 0
#endif
#ifndef LAUNCH_TWICE
#define LAUNCH_TWICE 0
#endif
#ifndef REPS
#define REPS 1
#endif
#ifndef PROBE_CAT
#define PROBE_CAT -1
#endif
#ifndef MK_PER_PHASE
#define MK_PER_PHASE 0
#endif

namespace pg8 {
#define PG8_LAS __attribute__((address_space(3)))
typedef unsigned short bf16_t;
typedef short bf16x8 __attribute__((ext_vector_type(8)));
typedef float f32x4 __attribute__((ext_vector_type(4)));
typedef unsigned u32x4 __attribute__((ext_vector_type(4)));
typedef unsigned u32x2 __attribute__((ext_vector_type(2)));
typedef float f32x2_t __attribute__((ext_vector_type(2)));
__device__ __forceinline__ float lo_sc(float d) { return __builtin_amdgcn_fmed3f(d * 512.f, -240.f, 240.f); }
constexpr float LO_SCALE = 512.f, LO_INV = 1.f / 512.f;
constexpr int BM = 256, BK = 64, HALF = 128, HTB = HALF * BK * 2  , STAGE_BYTES = 8 * HTB, NXCD = 8, WGM = 8;

__host__ __device__ __forceinline__ int lds_byte(int r, int c) { const int st = (r >> 4) * 2 + (c >> 5), rr = r & 15, cc = c & 31, ob = rr * 64 + cc * 2; return st * 1024 + (ob ^ (((ob >> 9) & 1) << 5)); }
__host__ __device__ __forceinline__ void stage_rc(int b, int& R, int& C) { const int st = b / 1024, sb = b % 1024, swz = sb ^ (((sb >> 9) & 1) << 5); R = (st >> 1) * 16 + swz / 64; C = (st & 1) * 32 + (swz % 64) / 2; }
__host__ __device__ __forceinline__ int perm32(int rho) { const int n = rho >> 4, i = rho & 15; return 8 * (i >> 2) + 4 * n + (i & 3); }

struct Unit { int pm, pn; };
__host__ __device__ __forceinline__ size_t tl_off(int row, int col, int ntk) { return ((((size_t)(row >> 8) * (size_t)ntk + (size_t)(col >> 6)) * 256 + (size_t)(row & 255)) * 64) + (size_t)(col & 63); }
struct Gemm { const bf16_t* A; const bf16_t* Bt; int M, N, K, lda; int tiledA = 0; };

struct StaticOrder {
    int nM, nN, nwg, G, c;
    __host__ __device__ void init(int M, int N, int G_, int c_) { nM = M / BM; nN = N / BM; nwg = nM * nN; G = G_; c = c_; }
    __host__ __device__ bool next(int i, Unit& u) const {
        const long L = (long)i * G + c; if (L >= nwg) return false;
        int wgid = (int)L; { const int q = nwg / NXCD, r = nwg % NXCD, xcd = wgid % NXCD, off = wgid / NXCD; wgid = (xcd < r ? xcd * (q + 1) : r * (q + 1) + (xcd - r) * q) + off; }
        const int nig = WGM * nN, gid = wgid / nig, fm = gid * WGM, gsz = (nM - fm) < WGM ? (nM - fm) : WGM;
        if (nN == 8 && gsz == WGM) { u.pm = fm + ((wgid % nig) >> 3); u.pn = (wgid % nig) & 7; }
        else { u.pm = fm + ((wgid % nig) % gsz); u.pn = (wgid % nig) / gsz; }
        return true;
    }
    __device__ __forceinline__ void a_ready(const Unit&) const {}
    __device__ __forceinline__ void done(const Unit&) const {}
};

__device__ __forceinline__ unsigned cvt_pk_bf16(float lo, float hi) { unsigned r; asm volatile("v_cvt_pk_bf16_f32 %0, %1, %2" : "=v"(r) : "v"(lo), "v"(hi)); return r; }

struct EpiBf16 {
    static constexpr bool PERM = true, AFTER_DRAIN = false;
    bf16_t* O; int ldc;
    __device__ __forceinline__ void operator()(const f32x4 (&acc)[2][2][4][2], const Unit& u, int wr, int wc, int fr, int fq) const {
        const int row0 = u.pm * BM + wr * 64 + fr; const int col0 = u.pn * BM + wc * 32 + 8 * fq;
#pragma unroll
        for (int ai = 0; ai < 2; ++ai)
#pragma unroll
            for (int m = 0; m < 4; ++m) { bf16_t* rowp = O + (size_t)(row0 + ai * HALF + m * 16) * ldc + col0;
#pragma unroll
                for (int bj = 0; bj < 2; ++bj) { const f32x4 v0 = acc[ai][bj][m][0], v1 = acc[ai][bj][m][1];
                    u32x4 w; w.x = cvt_pk_bf16(v0[0], v0[1]); w.y = cvt_pk_bf16(v0[2], v0[3]); w.z = cvt_pk_bf16(v1[0], v1[1]); w.w = cvt_pk_bf16(v1[2], v1[3]);
                    *(u32x4*)(rowp + bj * HALF) = w; } }
    }
};
__device__ __forceinline__ float silu_mul(float g, float u) { return g * u * __builtin_amdgcn_rcpf(1.0f + __builtin_amdgcn_exp2f(-1.4426950408889634f * g)); }
struct EpiSwiGLU {
    static constexpr bool PERM = true, AFTER_DRAIN = false;
    bf16_t* O; int ldc;
    __device__ __forceinline__ void operator()(const f32x4 (&acc)[2][2][4][2], const Unit& u, int wr, int wc, int fr, int fq) const {
        const int row0 = u.pm * BM + wr * 64 + fr; const int col0 = u.pn * HALF + wc * 32 + 8 * fq;
#pragma unroll
        for (int ai = 0; ai < 2; ++ai)
#pragma unroll
            for (int m = 0; m < 4; ++m) { bf16_t* rowp = O + (size_t)(row0 + ai * HALF + m * 16) * ldc + col0;
                const f32x4 g0 = acc[ai][0][m][0], g1 = acc[ai][0][m][1], u0 = acc[ai][1][m][0], u1 = acc[ai][1][m][1];
                u32x4 w; w.x = cvt_pk_bf16(silu_mul(g0[0], u0[0]), silu_mul(g0[1], u0[1])); w.y = cvt_pk_bf16(silu_mul(g0[2], u0[2]), silu_mul(g0[3], u0[3]));
                w.z = cvt_pk_bf16(silu_mul(g1[0], u1[0]), silu_mul(g1[1], u1[1])); w.w = cvt_pk_bf16(silu_mul(g1[2], u1[2]), silu_mul(g1[3], u1[3]));
                *(u32x4*)rowp = w; }
    }
};
struct EpiResid {
    static constexpr bool PERM = false, AFTER_DRAIN = false;
    const float* hin; float* hout; int ldc; float alpha, s;
    __device__ __forceinline__ void operator()(const f32x4 (&acc)[2][2][4][2], const Unit& u, int wr, int wc, int fr, int fq) const {
        const int row0 = u.pm * BM + wr * 64 + fr, col0 = u.pn * BM + wc * 32 + 4 * fq;
#pragma unroll
        for (int ai = 0; ai < 2; ++ai)
#pragma unroll
            for (int m = 0; m < 4; ++m) { const size_t off = (size_t)(row0 + ai * HALF + m * 16) * ldc + col0;
#pragma unroll
                for (int bj = 0; bj < 2; ++bj)
#pragma unroll
                    for (int n = 0; n < 2; ++n) { const f32x4 hv = *(const f32x4*)(hin + off + bj * HALF + n * 16); *(f32x4*)(hout + off + bj * HALF + n * 16) = hv * alpha + acc[ai][bj][m][n] * s; } }
    }
};


struct RowStat { const float* sum; const float* ssq; float inv_n, eps; int mode; };
__device__ __forceinline__ void row_stat(const RowStat& st, int row, float& rs, float& rm) {
    if (st.mode == 0 || EXP == 1) { rs = 1.f; rm = 0.f; }
    else { const float q = st.ssq[row] * st.inv_n;
        if (st.mode == 1) { const float mean = st.sum[row] * st.inv_n; rs = __builtin_amdgcn_rsqf(q - mean * mean + st.eps); rm = rs * mean; }
        else { rs = __builtin_amdgcn_rsqf(q + st.eps); rm = 0.f; } }
}
__device__ __forceinline__ void row_stat8(const RowStat& st, int row0, float (&rs)[8], float (&rm)[8]) {
    if (st.mode == 0 || EXP == 1) {
#pragma unroll
        for (int i = 0; i < 8; ++i) { rs[i] = 1.f; rm[i] = 0.f; }
    } else {
        float q[8], sm[8];
#pragma unroll
        for (int i = 0; i < 8; ++i) { const int row = row0 + (i >> 2) * HALF + (i & 3) * 16; q[i] = st.ssq[row]; sm[i] = 0.f; }
        if (st.mode == 1) {
#pragma unroll
            for (int i = 0; i < 8; ++i) { const int row = row0 + (i >> 2) * HALF + (i & 3) * 16; sm[i] = st.sum[row]; }
        }
#pragma unroll
        for (int i = 0; i < 8; ++i) { const float mean = sm[i] * st.inv_n; rs[i] = __builtin_amdgcn_rsqf(q[i] * st.inv_n - mean * mean + st.eps); rm[i] = rs[i] * mean; }
    }
}
struct EpiAff {
    static constexpr bool PERM = true, AFTER_DRAIN = false;
    bf16_t* O; int ldc; RowStat st; const float* u; const float* v; float* ssq_out;
    const float* rope;
    __device__ __forceinline__ void operator()(const f32x4 (&acc)[2][2][4][2], const Unit& un, int wr, int wc, int fr, int fq) const {
        const int row0 = un.pm * BM + wr * 64 + fr; const int col0 = un.pn * BM + wc * 32 + 8 * fq;
        f32x4 uu[2][2], vv[2][2];
#pragma unroll
        for (int bj = 0; bj < 2; ++bj)
#pragma unroll
            for (int n = 0; n < 2; ++n) { if (u) { uu[bj][n] = *(const f32x4*)(u + col0 + bj * HALF + 4 * n); vv[bj][n] = *(const f32x4*)(v + col0 + bj * HALF + 4 * n); } else { uu[bj][n] = (f32x4){0.f, 0.f, 0.f, 0.f}; vv[bj][n] = uu[bj][n]; } }
        float* sq = nullptr; if (ssq_out && un.pn < 5) sq = ssq_out + (un.pn < 3 ? 0 : 32768);
        const bool dorope = (rope != nullptr) && ((un.pn % 12) < 8);
        float rs8[8], rm8[8]; row_stat8(st, row0, rs8, rm8);
#pragma unroll
        for (int ai = 0; ai < 2; ++ai)
#pragma unroll
            for (int m = 0; m < 4; ++m) { const int row = row0 + ai * HALF + m * 16; const float rs = rs8[ai * 4 + m], rm = rm8[ai * 4 + m];
                bf16_t* rowp = O + (size_t)row * ldc + col0; float ss = 0.f;
                f32x4 rc = {1.f, 1.f, 1.f, 1.f}, rsn = {0.f, 0.f, 0.f, 0.f};
                if (dorope) { const float* tp = rope + (size_t)(row & 2047) * 64 + wc * 16 + 4 * fq; rc = *(const f32x4*)tp; rsn = *(const f32x4*)(tp + 2048 * 64); }
#pragma unroll
                for (int bj = 0; bj < 2; ++bj) { f32x4 v0 = acc[ai][bj][m][0] * rs + (vv[bj][0] - uu[bj][0] * rm), v1 = acc[ai][bj][m][1] * rs + (vv[bj][1] - uu[bj][1] * rm);
                    if (dorope) { const f32x4 a0 = v0, a1 = v1;
                        v0[0] = a0[0] * rc[0] - a0[1] * rsn[0]; v0[1] = a0[0] * rsn[0] + a0[1] * rc[0]; v0[2] = a0[2] * rc[1] - a0[3] * rsn[1]; v0[3] = a0[2] * rsn[1] + a0[3] * rc[1];
                        v1[0] = a1[0] * rc[2] - a1[1] * rsn[2]; v1[1] = a1[0] * rsn[2] + a1[1] * rc[2]; v1[2] = a1[2] * rc[3] - a1[3] * rsn[3]; v1[3] = a1[2] * rsn[3] + a1[3] * rc[3]; }
                    ss += (v0[0] * v0[0] + v0[1] * v0[1]) + (v0[2] * v0[2] + v0[3] * v0[3]) + (v1[0] * v1[0] + v1[1] * v1[1]) + (v1[2] * v1[2] + v1[3] * v1[3]);
                    u32x4 w; w.x = cvt_pk_bf16(v0[0], v0[1]); w.y = cvt_pk_bf16(v0[2], v0[3]); w.z = cvt_pk_bf16(v1[0], v1[1]); w.w = cvt_pk_bf16(v1[2], v1[3]);
                    *(u32x4*)(rowp + bj * HALF) = w; }
                if (sq) { ss += __shfl_xor(ss, 16); ss += __shfl_xor(ss, 32); if (fq == 0) __hip_atomic_fetch_add(sq + row, ss, __ATOMIC_RELAXED, __HIP_MEMORY_SCOPE_AGENT); } }
    }
};
struct EpiAffA {
    static constexpr bool PERM = true, AFTER_DRAIN = false;
    bf16_t* O; int ldc; RowStat st; const float* u; const float* v; const float* qg; const float* kg; const float* taba; PG8_LAS float* xch;
    __device__ __forceinline__ void operator()(f32x4 (&acc)[2][2][4][2], const Unit& un, int wr, int wc, int fr, int fq) const {
        const int row0 = un.pm * BM + wr * 64 + fr; const int col0 = un.pn * BM + wc * 32 + 8 * fq;
        const bool nr = un.pn < 10;
        { f32x4 uu[2][2], vv[2][2];
#pragma unroll
          for (int bj = 0; bj < 2; ++bj)
#pragma unroll
            for (int n = 0; n < 2; ++n) { uu[bj][n] = *(const f32x4*)(u + col0 + bj * HALF + 4 * n); vv[bj][n] = *(const f32x4*)(v + col0 + bj * HALF + 4 * n); }
          float rs8[8], rm8[8]; row_stat8(st, row0, rs8, rm8);
#pragma unroll
          for (int ai = 0; ai < 2; ++ai)
#pragma unroll
            for (int m = 0; m < 4; ++m) { const float rs = rs8[ai * 4 + m], rm = rm8[ai * 4 + m]; float sq[2];
#pragma unroll
                for (int bj = 0; bj < 2; ++bj) { const f32x4 v0 = acc[ai][bj][m][0] * rs + (vv[bj][0] - uu[bj][0] * rm), v1 = acc[ai][bj][m][1] * rs + (vv[bj][1] - uu[bj][1] * rm);
                    acc[ai][bj][m][0] = v0; acc[ai][bj][m][1] = v1;
                    sq[bj] = (v0[0] * v0[0] + v0[1] * v0[1]) + (v0[2] * v0[2] + v0[3] * v0[3]) + (v1[0] * v1[0] + v1[1] * v1[1]) + (v1[2] * v1[2] + v1[3] * v1[3]); }
                if (nr) { sq[0] += __shfl_xor(sq[0], 16); sq[0] += __shfl_xor(sq[0], 32); sq[1] += __shfl_xor(sq[1], 16); sq[1] += __shfl_xor(sq[1], 32);
                    if (fq == 0) { const int rl = ai * HALF + wr * 64 + m * 16 + fr; xch[(rl * 2 + 0) * 4 + wc] = sq[0]; xch[(rl * 2 + 1) * 4 + wc] = sq[1]; } } }
        }
        if (nr) { asm volatile("s_waitcnt lgkmcnt(0)" ::: "memory"); __builtin_amdgcn_s_barrier(); asm volatile("" ::: "memory"); }
        f32x4 ga = {1.f, 1.f, 1.f, 1.f}, gb = ga;
        const int hf = wc >> 1, ib = (wc & 1) * 16 + 4 * fq;
        if (nr) { const float* gp = (un.pn < 8) ? qg : kg; ga = *(const f32x4*)(gp + 64 * hf + ib); gb = *(const f32x4*)(gp + 64 * hf + ib + 32); }
#pragma unroll
        for (int ai = 0; ai < 2; ++ai)
#pragma unroll
            for (int m = 0; m < 4; ++m) { const int row = row0 + ai * HALF + m * 16; bf16_t* rowp = O + (size_t)row * ldc + col0;
                f32x4 rc = {1.f, 1.f, 1.f, 1.f}, rsn = {0.f, 0.f, 0.f, 0.f};
                if (nr) { const int sp = row & 2047, pos = hf ? (sp & 63) : (sp >> 6); const float* tp = taba + pos * 32 + ib; rc = *(const f32x4*)tp; rsn = *(const f32x4*)(tp + 64 * 32); }
#pragma unroll
                for (int bj = 0; bj < 2; ++bj) { f32x4 v0 = acc[ai][bj][m][0], v1 = acc[ai][bj][m][1];
                    if (nr) { const int rl = ai * HALF + wr * 64 + m * 16 + fr; const f32x4 pp = *(const PG8_LAS f32x4*)(xch + (rl * 2 + bj) * 4);
                        const float rn = __builtin_amdgcn_rsqf(((pp[0] + pp[1]) + (pp[2] + pp[3])) * (1.f / 128.f) + 1e-6f);
                        const float a0 = v0[0] * rn * ga[0], b0 = v0[1] * rn * gb[0], a1 = v0[2] * rn * ga[1], b1 = v0[3] * rn * gb[1], a2 = v1[0] * rn * ga[2], b2 = v1[1] * rn * gb[2], a3 = v1[2] * rn * ga[3], b3 = v1[3] * rn * gb[3];
                        v0[0] = a0 * rc[0] - b0 * rsn[0]; v0[1] = a0 * rsn[0] + b0 * rc[0]; v0[2] = a1 * rc[1] - b1 * rsn[1]; v0[3] = a1 * rsn[1] + b1 * rc[1];
                        v1[0] = a2 * rc[2] - b2 * rsn[2]; v1[1] = a2 * rsn[2] + b2 * rc[2]; v1[2] = a3 * rc[3] - b3 * rsn[3]; v1[3] = a3 * rsn[3] + b3 * rc[3]; }
                    u32x4 w; w.x = cvt_pk_bf16(v0[0], v0[1]); w.y = cvt_pk_bf16(v0[2], v0[3]); w.z = cvt_pk_bf16(v1[0], v1[1]); w.w = cvt_pk_bf16(v1[2], v1[3]);
                    *(u32x4*)(rowp + bj * HALF) = w; } }
    }
};
struct EpiAffSwiGLU {
    static constexpr bool PERM = true, AFTER_DRAIN = false;
    bf16_t* O; int ldc; RowStat st; const float* u; const float* v;
    __device__ __forceinline__ void operator()(const f32x4 (&acc)[2][2][4][2], const Unit& un, int wr, int wc, int fr, int fq) const {
        const int row0 = un.pm * BM + wr * 64 + fr; const int col0 = un.pn * HALF + wc * 32 + 8 * fq, ucol0 = un.pn * BM + wc * 32 + 8 * fq;
        f32x4 uu[2][2], vv[2][2];
#pragma unroll
        for (int bj = 0; bj < 2; ++bj)
#pragma unroll
            for (int n = 0; n < 2; ++n) { uu[bj][n] = *(const f32x4*)(u + ucol0 + bj * HALF + 4 * n); vv[bj][n] = *(const f32x4*)(v + ucol0 + bj * HALF + 4 * n); }
        float rs8[8], rm8[8]; row_stat8(st, row0, rs8, rm8);
#pragma unroll
        for (int ai = 0; ai < 2; ++ai)
#pragma unroll
            for (int m = 0; m < 4; ++m) { const int row = row0 + ai * HALF + m * 16; const float rs = rs8[ai * 4 + m], rm = rm8[ai * 4 + m];
                bf16_t* rowp = O + ((((size_t)(row >> 8) * (size_t)(ldc >> 6) + (size_t)(col0 >> 6)) * BM + (size_t)(row & 255)) * BK + (size_t)(col0 & 63));
                const f32x4 g0 = acc[ai][0][m][0] * rs + (vv[0][0] - uu[0][0] * rm), g1 = acc[ai][0][m][1] * rs + (vv[0][1] - uu[0][1] * rm);
                const f32x4 u0 = acc[ai][1][m][0] * rs + (vv[1][0] - uu[1][0] * rm), u1 = acc[ai][1][m][1] * rs + (vv[1][1] - uu[1][1] * rm);
                u32x4 w; w.x = cvt_pk_bf16(silu_mul(g0[0], u0[0]), silu_mul(g0[1], u0[1])); w.y = cvt_pk_bf16(silu_mul(g0[2], u0[2]), silu_mul(g0[3], u0[3]));
                w.z = cvt_pk_bf16(silu_mul(g1[0], u1[0]), silu_mul(g1[1], u1[1])); w.w = cvt_pk_bf16(silu_mul(g1[2], u1[2]), silu_mul(g1[3], u1[3]));
                *(u32x4*)rowp = w; }
    }
};
struct EpiResid2 {
    static constexpr bool PERM = true, AFTER_DRAIN = false;
    bf16_t* hi; unsigned char* lo; float* sum_out; float* ssq_out; const float* g; const float* b; RowStat st; int ldc; float alpha, s;
    __device__ __forceinline__ void operator()(const f32x4 (&acc)[2][2][4][2], const Unit& un, int wr, int wc, int fr, int fq) const {
        const int row0 = un.pm * BM + wr * 64 + fr, col0 = un.pn * BM + wc * 32 + 8 * fq;
        f32x4 gg[2][2], bb[2][2];
#pragma unroll
        for (int bj = 0; bj < 2; ++bj)
#pragma unroll
            for (int n = 0; n < 2; ++n) { if (st.mode != 0) { gg[bj][n] = *(const f32x4*)(g + col0 + bj * HALF + 4 * n); bb[bj][n] = *(const f32x4*)(b + col0 + bj * HALF + 4 * n); } else { gg[bj][n] = (f32x4){1.f, 1.f, 1.f, 1.f}; bb[bj][n] = (f32x4){0.f, 0.f, 0.f, 0.f}; } }
        u32x4 x[8][2]; u32x2 xl[8][2]; float q8[8], s8[8];
#define RS2_LOAD(gi) do { const int ai_ = (gi) >> 2, m_ = (gi) & 3; const int row_ = row0 + ai_ * HALF + m_ * 16; const size_t off_ = tl_off(row_, col0, ldc >> 6); \
            _Pragma("unroll") for (int bj = 0; bj < 2; ++bj) { \
                x[gi][bj] = *(const u32x4*)(hi + off_ + bj * (2 * 256 * 64)); xl[gi][bj] = *(const u32x2*)(lo + off_ + bj * (2 * 256 * 64)); } \
            q8[gi] = 0.f; s8[gi] = 0.f; if (st.mode == 1 && EXP != 1) { q8[gi] = st.ssq[row_]; s8[gi] = st.sum[row_]; } } while (0)
        RS2_LOAD(0);
#pragma unroll
        for (int gi = 0; gi < 8; ++gi) { const int ai = gi >> 2, m = gi & 3;
            if (gi + 1 < 8) { if (gi == 0) RS2_LOAD(1); else if (gi == 1) RS2_LOAD(2); else if (gi == 2) RS2_LOAD(3); else if (gi == 3) RS2_LOAD(4); else if (gi == 4) RS2_LOAD(5); else if (gi == 5) RS2_LOAD(6); else RS2_LOAD(7); }
            __builtin_amdgcn_sched_barrier(0);
            const int row = row0 + ai * HALF + m * 16; float rs = 1.f, rm = 0.f;
            if (st.mode == 1 && EXP != 1) { const float mean = s8[gi] * st.inv_n; rs = __builtin_amdgcn_rsqf(q8[gi] * st.inv_n - mean * mean + st.eps); rm = rs * mean; }
            const size_t off = tl_off(row, col0, ldc >> 6); float sm = 0.f, ss = 0.f;
#pragma unroll
            for (int bj = 0; bj < 2; ++bj) {
                f32x4 x0, x1;
                { const u32x4 hw = x[gi][bj]; const u32x2 lw = xl[gi][bj];
                    const f32x2_t l01 = __builtin_amdgcn_cvt_pk_f32_fp8((int)lw[0], false), l23 = __builtin_amdgcn_cvt_pk_f32_fp8((int)lw[0], true), l45 = __builtin_amdgcn_cvt_pk_f32_fp8((int)lw[1], false), l67 = __builtin_amdgcn_cvt_pk_f32_fp8((int)lw[1], true);
                    x0[0] = __uint_as_float(hw[0] << 16) + l01[0] * LO_INV; x0[1] = __uint_as_float(hw[0] & 0xffff0000u) + l01[1] * LO_INV;
                    x0[2] = __uint_as_float(hw[1] << 16) + l23[0] * LO_INV; x0[3] = __uint_as_float(hw[1] & 0xffff0000u) + l23[1] * LO_INV;
                    x1[0] = __uint_as_float(hw[2] << 16) + l45[0] * LO_INV; x1[1] = __uint_as_float(hw[2] & 0xffff0000u) + l45[1] * LO_INV;
                    x1[2] = __uint_as_float(hw[3] << 16) + l67[0] * LO_INV; x1[3] = __uint_as_float(hw[3] & 0xffff0000u) + l67[1] * LO_INV; }
                const f32x4 h0 = (x0 * rs - rm) * gg[bj][0] + bb[bj][0], h1 = (x1 * rs - rm) * gg[bj][1] + bb[bj][1];
                const f32x4 p0 = h0 * alpha + acc[ai][bj][m][0] * s, p1 = h1 * alpha + acc[ai][bj][m][1] * s;
                u32x4 w; w.x = cvt_pk_bf16(p0[0], p0[1]); w.y = cvt_pk_bf16(p0[2], p0[3]); w.z = cvt_pk_bf16(p1[0], p1[1]); w.w = cvt_pk_bf16(p1[2], p1[3]);
                int l0 = __builtin_amdgcn_cvt_pk_fp8_f32(lo_sc(p0[0] - __uint_as_float(w.x << 16)), lo_sc(p0[1] - __uint_as_float(w.x & 0xffff0000u)), 0, false);
                l0 = __builtin_amdgcn_cvt_pk_fp8_f32(lo_sc(p0[2] - __uint_as_float(w.y << 16)), lo_sc(p0[3] - __uint_as_float(w.y & 0xffff0000u)), l0, true);
                int l1 = __builtin_amdgcn_cvt_pk_fp8_f32(lo_sc(p1[0] - __uint_as_float(w.z << 16)), lo_sc(p1[1] - __uint_as_float(w.z & 0xffff0000u)), 0, false);
                l1 = __builtin_amdgcn_cvt_pk_fp8_f32(lo_sc(p1[2] - __uint_as_float(w.w << 16)), lo_sc(p1[3] - __uint_as_float(w.w & 0xffff0000u)), l1, true);
                *(u32x4*)(hi + off + bj * (2 * 256 * 64)) = w; *(u32x2*)(lo + off + bj * (2 * 256 * 64)) = (u32x2){(unsigned)l0, (unsigned)l1};
                sm += ((p0[0] + p0[1]) + (p0[2] + p0[3])) + ((p1[0] + p1[1]) + (p1[2] + p1[3]));
                ss += (p0[0] * p0[0] + p0[1] * p0[1]) + (p0[2] * p0[2] + p0[3] * p0[3]) + (p1[0] * p1[0] + p1[1] * p1[1]) + (p1[2] * p1[2] + p1[3] * p1[3]); }
            sm += __shfl_xor(sm, 16); sm += __shfl_xor(sm, 32); ss += __shfl_xor(ss, 16); ss += __shfl_xor(ss, 32);
            if (fq == 0 && EXP != 1) { __hip_atomic_fetch_add(sum_out + row, sm, __ATOMIC_RELAXED, __HIP_MEMORY_SCOPE_AGENT); __hip_atomic_fetch_add(ssq_out + row, ss, __ATOMIC_RELAXED, __HIP_MEMORY_SCOPE_AGENT); }
        }
#undef RS2_LOAD
    }
};

template <class Epi, class Sched, bool ALIGN_EPI = false, bool SP2 = false>
__device__ __forceinline__ void gemm_phase(PG8_LAS unsigned char* lds, const Gemm g, const Sched& S, const Epi& E, int tid_) {
    asm volatile("" : "+v"(tid_));
    const int tid = tid_, wid = __builtin_amdgcn_readfirstlane(tid >> 6), lane = tid & 63, wr = wid >> 2, wc = wid & 3, fr = lane & 15, fq = lane >> 4;
    const int K = g.K, nt = K / BK;
    unsigned voffA[2], voffB[2];
#pragma unroll
    for (int i = 0; i < 2; ++i) { int R, C; stage_rc(tid * 16 + i * 8192, R, C); const int Rb = Epi::PERM ? ((R & ~31) + perm32(R & 31)) : R;
        voffA[i] = (unsigned)(R * (g.tiledA ? BK : g.lda) + C) * 2u; voffB[i] = (unsigned)(Rb * K + C) * 2u; }
    const size_t kstep = (size_t)(BK * 2), kstepA = g.tiledA ? (size_t)(BM * BK * 2) : kstep;
    const size_t hstep = (size_t)HALF * K * 2, hstepA = g.tiledA ? (size_t)(HALF * BK * 2) : (size_t)HALF * g.lda * 2;
    const size_t tstep = 2 * hstep, tstepA = g.tiledA ? (size_t)nt * (BM * BK * 2) : 2 * hstepA;
    const unsigned ldsw = (unsigned)wid * 1024u;
    const int aoff = lds_byte(wr * 64 + fr, fq * 8), boff = lds_byte(wc * 32 + fr, fq * 8);
#define PG8_SA(b, h) (((b) * 2 + (h)) * HTB)
#define PG8_SB(b, h) ((4 + (b) * 2 + (h)) * HTB)
#define PG8_STAGE(bufoff, gbase, voff) do { _Pragma("unroll") for (int _i = 0; _i < 2; ++_i) \
        __builtin_amdgcn_global_load_lds((const unsigned*)((const char*)(gbase) + (voff)[_i]), (PG8_LAS unsigned*)(lds + (bufoff) + ldsw + _i * 8192), 16, 0, 0); } while (0)
#define PG8_LDA(dst, b, h) do { _Pragma("unroll") for (int m = 0; m < 4; ++m) _Pragma("unroll") for (int k = 0; k < 2; ++k) dst[m][k] = *(const PG8_LAS bf16x8*)(lds + PG8_SA(b, h) + aoff + m * 2048 + k * 1024); } while (0)
#define PG8_LDB(dst, b, h) do { _Pragma("unroll") for (int n = 0; n < 2; ++n) _Pragma("unroll") for (int k = 0; k < 2; ++k) dst[n][k] = *(const PG8_LAS bf16x8*)(lds + PG8_SB(b, h) + boff + n * 2048 + k * 1024); } while (0)
#define PG8_MMA(ai, bj, At, Bt) do { __builtin_amdgcn_s_setprio(1); _Pragma("unroll") for (int m = 0; m < 4; ++m) _Pragma("unroll") for (int n = 0; n < 2; ++n) _Pragma("unroll") for (int k = 0; k < 2; ++k) \
        acc[ai][bj][m][n] = __builtin_amdgcn_mfma_f32_16x16x32_bf16(Bt[n][k], At[m][k], acc[ai][bj][m][n], 0, 0, 0); __builtin_amdgcn_s_setprio(0); } while (0)
#define PG8_WAIT_V(n) asm volatile("s_waitcnt vmcnt(" #n ")" ::: "memory")
#define PG8_WAIT_L(n) asm volatile("s_waitcnt lgkmcnt(" #n ")" ::: "memory")
#define PG8_BAR __builtin_amdgcn_s_barrier()
#define PG8_SCHED __builtin_amdgcn_sched_barrier(0)
    Unit cur, nxt; int ui = 0;
    if (!S.next(0, cur)) return;
    f32x4 acc[2][2][4][2];
#pragma unroll
    for (int a = 0; a < 2; ++a)
#pragma unroll
        for (int b = 0; b < 2; ++b)
#pragma unroll
            for (int m = 0; m < 4; ++m)
#pragma unroll
                for (int n = 0; n < 2; ++n) acc[a][b][m][n] = (f32x4){0.f, 0.f, 0.f, 0.f};
    bf16x8 At[4][2], B0[2][2], B1[2][2];
    const char* cA = (const char*)g.A + (size_t)cur.pm * tstepA; const char* cB = (const char*)g.Bt + (size_t)cur.pn * tstep;
    S.a_ready(cur);
    if constexpr (SP2) {
        PG8_STAGE(PG8_SB(0, 0), cB, voffB); PG8_STAGE(PG8_SB(0, 1), cB + hstep, voffB); PG8_STAGE(PG8_SA(0, 0), cA, voffA); PG8_STAGE(PG8_SA(0, 1), cA + hstepA, voffA);
        if (wr == 1) PG8_BAR;
        PG8_WAIT_V(2); PG8_BAR;
        PG8_STAGE(PG8_SB(1, 0), cB + kstep, voffB); PG8_STAGE(PG8_SA(1, 0), cA + kstepA, voffA); PG8_STAGE(PG8_SB(1, 1), cB + hstep + kstep, voffB);
        PG8_WAIT_V(6); PG8_BAR;
    } else {
        PG8_STAGE(PG8_SB(0, 0), cB, voffB); PG8_STAGE(PG8_SA(0, 0), cA, voffA); PG8_STAGE(PG8_SB(0, 1), cB + hstep, voffB); PG8_STAGE(PG8_SA(0, 1), cA + hstepA, voffA);
        if (wr == 1) PG8_BAR;
        PG8_WAIT_V(4); PG8_BAR;
        PG8_STAGE(PG8_SB(1, 0), cB + kstep, voffB); PG8_STAGE(PG8_SA(1, 0), cA + kstepA, voffA); PG8_STAGE(PG8_SB(1, 1), cB + hstep + kstep, voffB);
        PG8_WAIT_V(6); PG8_BAR;
    }
    for (;;) {
        const bool has_next = S.next(ui + 1, nxt);
        const char* nA = has_next ? (const char*)g.A + (size_t)nxt.pm * tstepA : cA; const char* nB = has_next ? (const char*)g.Bt + (size_t)nxt.pn * tstep : cB;
        for (int t = 0; t < nt; t += 2) {
            const bool last = (t == nt - 2);
            const char* a1 = cA + (size_t)(t + 1) * kstepA;
            const char* a2 = last ? nA : cA + (size_t)(t + 2) * kstepA; const char* b2 = last ? nB : cB + (size_t)(t + 2) * kstep;
            const char* a3 = a2 + kstepA; const char* b3 = b2 + kstep;
            if (last && has_next) S.a_ready(nxt);
            if constexpr (SP2) {
            PG8_LDB(B0, 0, 0); PG8_LDB(B1, 0, 1); PG8_SCHED; PG8_LDA(At, 0, 0); PG8_STAGE(PG8_SA(1, 1), a1 + hstepA, voffA);
            PG8_WAIT_V(8); PG8_WAIT_L(0); PG8_BAR; PG8_MMA(0, 0, At, B0); PG8_MMA(0, 1, At, B1); PG8_BAR; PG8_SCHED;
            PG8_LDA(At, 0, 1); PG8_STAGE(PG8_SB(0, 0), b2, voffB); PG8_STAGE(PG8_SB(0, 1), b2 + hstep, voffB); PG8_STAGE(PG8_SA(0, 0), a2, voffA);
            PG8_WAIT_V(8); PG8_WAIT_L(0); PG8_BAR; PG8_MMA(1, 0, At, B0); PG8_MMA(1, 1, At, B1); PG8_BAR; PG8_SCHED;
            PG8_LDB(B0, 1, 0); PG8_LDB(B1, 1, 1); PG8_SCHED; PG8_LDA(At, 1, 0); PG8_STAGE(PG8_SA(0, 1), a2 + hstepA, voffA);
            PG8_WAIT_V(8); PG8_WAIT_L(0); PG8_BAR; PG8_MMA(0, 0, At, B0); PG8_MMA(0, 1, At, B1); PG8_BAR; PG8_SCHED;
            PG8_LDA(At, 1, 1); PG8_STAGE(PG8_SB(1, 0), b3, voffB); PG8_STAGE(PG8_SB(1, 1), b3 + hstep, voffB); PG8_STAGE(PG8_SA(1, 0), a3, voffA);
            PG8_WAIT_V(8); PG8_WAIT_L(0); PG8_BAR; PG8_MMA(1, 0, At, B0); PG8_MMA(1, 1, At, B1); PG8_BAR; PG8_SCHED;
            } else {
            PG8_LDB(B0, 0, 0); PG8_SCHED; PG8_LDA(At, 0, 0); PG8_STAGE(PG8_SA(1, 1), a1 + hstepA, voffA);
            PG8_WAIT_L(8); PG8_BAR; PG8_WAIT_L(0); PG8_MMA(0, 0, At, B0); PG8_BAR; PG8_SCHED;
            PG8_LDB(B1, 0, 1); PG8_STAGE(PG8_SB(0, 0), b2, voffB);
            PG8_BAR; PG8_WAIT_L(0); PG8_MMA(0, 1, At, B1); PG8_BAR;
            PG8_LDA(At, 0, 1); PG8_STAGE(PG8_SA(0, 0), a2, voffA);
            PG8_BAR; PG8_WAIT_L(0); PG8_MMA(1, 0, At, B0); PG8_BAR; PG8_SCHED;
            PG8_STAGE(PG8_SB(0, 1), b2 + hstep, voffB);
            PG8_WAIT_V(6); PG8_BAR; PG8_MMA(1, 1, At, B1); PG8_BAR;
            PG8_LDB(B0, 1, 0); PG8_SCHED; PG8_LDA(At, 1, 0); PG8_STAGE(PG8_SA(0, 1), a2 + hstepA, voffA);
            PG8_WAIT_L(8); PG8_BAR; PG8_WAIT_L(0); PG8_MMA(0, 0, At, B0); PG8_BAR; PG8_SCHED;
            PG8_LDB(B1, 1, 1); PG8_STAGE(PG8_SB(1, 0), b3, voffB);
            PG8_BAR; PG8_WAIT_L(0); PG8_MMA(0, 1, At, B1); PG8_BAR;
            PG8_LDA(At, 1, 1); PG8_STAGE(PG8_SA(1, 0), a3, voffA);
            PG8_BAR; PG8_WAIT_L(0); PG8_MMA(1, 0, At, B0); PG8_BAR; PG8_SCHED;
            PG8_STAGE(PG8_SB(1, 1), b3 + hstep, voffB);
            PG8_WAIT_V(6); PG8_BAR; PG8_MMA(1, 1, At, B1); PG8_BAR;
            }
        }
        if constexpr (ALIGN_EPI) { if (wr == 0) PG8_BAR; }
#if PROBE_CAT == 20 || PROBE_CAT == 21
        { const unsigned long long te0_ = __builtin_amdgcn_s_memrealtime();
          E(acc, cur, wr, wc, fr, fq);
          asm volatile("s_waitcnt vmcnt(0)" ::: "memory");
          if (wid == 0) { volatile PG8_LAS unsigned long long* PRx = (volatile PG8_LAS unsigned long long*)(lds + 131072 + 320 + 64); volatile PG8_LAS unsigned* MISCx = (volatile PG8_LAS unsigned*)(lds + 131072 + 320);
            if (MISCx[22] == (PROBE_CAT == 20 ? 10u : 11u)) PRx[1] = PRx[1] + (__builtin_amdgcn_s_memrealtime() - te0_); } }
#else
        if constexpr (!Epi::AFTER_DRAIN) { E(acc, cur, wr, wc, fr, fq); S.done(cur); }
#endif
        if (!has_next) break;
#pragma unroll
        for (int a = 0; a < 2; ++a)
#pragma unroll
            for (int b = 0; b < 2; ++b)
#pragma unroll
                for (int m = 0; m < 4; ++m)
#pragma unroll
                    for (int n = 0; n < 2; ++n) acc[a][b][m][n] = (f32x4){0.f, 0.f, 0.f, 0.f};
        cur = nxt; cA = nA; cB = nB; ++ui;
        if constexpr (ALIGN_EPI) { if (wr == 1) PG8_BAR; }
    }
    PG8_WAIT_V(0);
    if constexpr (!ALIGN_EPI) { if (wr == 0) PG8_BAR; }
    PG8_BAR;
#undef PG8_SA
#undef PG8_SB
#undef PG8_STAGE
#undef PG8_LDA
#undef PG8_LDB
#undef PG8_MMA
#undef PG8_WAIT_V
#undef PG8_WAIT_L
#undef PG8_BAR
#undef PG8_SCHED
}
}

#ifndef PG8_SP2
#define PG8_SP2 true
#endif
#ifndef PG8_ALIGN
#define PG8_ALIGN true
#endif

constexpr int NWAVES = 8;
constexpr int BATCH = 16, SEQ = 2048, DM = 2048, DFF = 5632, MTOK = BATCH * SEQ, DEPTH = 4;
constexpr float ALPHA = 1.6817928305074292f;
constexpr float LN_EPS = 1e-5f, RMS_EPS = 1e-6f;
constexpr int A_QKV = 3072, B_QKV = 9216, C_IN = 1344, C_INP = 1536, C_QL = 768, C_KVL = 512, C_Q = 3072, C_KV = 4096;

constexpr size_t MiB = 1u << 20;
constexpr size_t WS_CTL = 0, CTL_ZERO_BYTES = 64 * 1024, DEV_ZERO_END = 8 * MiB;
constexpr size_t WS_STAT = 1 * MiB;
constexpr size_t WS_SSQC = 4 * MiB;
constexpr size_t WS_UV = 5 * MiB;
constexpr size_t WS_TABB = 8 * MiB;
constexpr size_t WS_TABC = 9 * MiB;
constexpr size_t WS_TABA = 10 * MiB;
constexpr size_t WS_WT = 12 * MiB;
constexpr size_t WT_BUF = 72 * MiB;
constexpr size_t WS_HB = 156 * MiB;
constexpr size_t WS_LO = 284 * MiB;
constexpr size_t WS_R = 412 * MiB;
constexpr size_t WS_END = WS_R + 900 * MiB;
constexpr int UV_STRIDE = 2 * 11264;
constexpr size_t WT_FFN_OUT = (size_t)2 * DFF * DM;
constexpr size_t WT_A_OUT = (size_t)A_QKV * DM, WT_B_OUT = (size_t)B_QKV * DM;
constexpr size_t WT_C_QUP = (size_t)C_INP * DM, WT_C_KVUP = WT_C_QUP + (size_t)C_Q * C_QL, WT_C_OUT = WT_C_KVUP + (size_t)C_KV * C_KVL;
constexpr size_t R_ACT = 0;
constexpr size_t RA_QKV = 0, RA_ATT = 192 * MiB;
constexpr size_t RB_QKV = 0, RB_ATT = 576 * MiB, RB_OG = 640 * MiB, RB_LSE = 832 * MiB;
constexpr size_t RC_IN = 0, RC_QN = 96 * MiB, RC_KVN = 144 * MiB, RC_KR = 176 * MiB, RC_Q = 192 * MiB, RC_KV = 384 * MiB, RC_ATT = 640 * MiB;
constexpr int CW_BAR = 4096;

constexpr int RING_OFF = 0, RING_BYTES = 131072;
constexpr int LDSCTL_OFF = RING_BYTES, MISC_OFF = LDSCTL_OFF + 320;
constexpr int XCH_OFF = RING_BYTES + 4096;
constexpr int LDS_BYTES = 147456;

#define GAS __attribute__((address_space(1)))
#define LAS __attribute__((address_space(3)))
typedef unsigned short bf16;
typedef unsigned v4u __attribute__((ext_vector_type(4)));
typedef unsigned v2u __attribute__((ext_vector_type(2)));
typedef float f32x4 __attribute__((ext_vector_type(4)));
typedef float f32x2 __attribute__((ext_vector_type(2)));
typedef GAS unsigned gu32;
#define RLX_AGENT __ATOMIC_RELAXED, __HIP_MEMORY_SCOPE_AGENT
#define LDS_WAIT() asm volatile("s_waitcnt lgkmcnt(0)" ::: "memory")
#define VM_WAIT() asm volatile("s_waitcnt vmcnt(0)" ::: "memory")
__device__ __forceinline__ unsigned f2bf(float f) { unsigned u = __builtin_bit_cast(unsigned, f); return (u + 0x7fffu + ((u >> 16) & 1u)) >> 16; }
__device__ __forceinline__ unsigned pk2(float lo, float hi) { return f2bf(lo) | (f2bf(hi) << 16); }
__device__ __forceinline__ float bflo(unsigned w) { return __uint_as_float(w << 16); }
__device__ __forceinline__ float bfhi(unsigned w) { return __uint_as_float(w & 0xffff0000u); }
__device__ __forceinline__ float bf1(bf16 b) { return __uint_as_float(((unsigned)b) << 16); }
__device__ __forceinline__ void unpack8(const v4u w, float (&x)[8]) { x[0] = bflo(w.x); x[1] = bfhi(w.x); x[2] = bflo(w.y); x[3] = bfhi(w.y); x[4] = bflo(w.z); x[5] = bfhi(w.z); x[6] = bflo(w.w); x[7] = bfhi(w.w); }
__device__ __forceinline__ void unpack8_lo(const v2u w, float (&x)[8]) { const f32x2 a = __builtin_amdgcn_cvt_pk_f32_fp8((int)w.x, false), b = __builtin_amdgcn_cvt_pk_f32_fp8((int)w.x, true), c = __builtin_amdgcn_cvt_pk_f32_fp8((int)w.y, false), d = __builtin_amdgcn_cvt_pk_f32_fp8((int)w.y, true);
    x[0] = a[0] * pg8::LO_INV; x[1] = a[1] * pg8::LO_INV; x[2] = b[0] * pg8::LO_INV; x[3] = b[1] * pg8::LO_INV; x[4] = c[0] * pg8::LO_INV; x[5] = c[1] * pg8::LO_INV; x[6] = d[0] * pg8::LO_INV; x[7] = d[1] * pg8::LO_INV; }
__device__ __forceinline__ v2u pack8_lo(float e0, float e1, float e2, float e3, float e4, float e5, float e6, float e7) {
    int a = __builtin_amdgcn_cvt_pk_fp8_f32(pg8::lo_sc(e0), pg8::lo_sc(e1), 0, false); a = __builtin_amdgcn_cvt_pk_fp8_f32(pg8::lo_sc(e2), pg8::lo_sc(e3), a, true);
    int b = __builtin_amdgcn_cvt_pk_fp8_f32(pg8::lo_sc(e4), pg8::lo_sc(e5), 0, false); b = __builtin_amdgcn_cvt_pk_fp8_f32(pg8::lo_sc(e6), pg8::lo_sc(e7), b, true);
    return (v2u){(unsigned)a, (unsigned)b}; }
__device__ __forceinline__ v4u pack8(const float (&x)[8]) { v4u w; w.x = pk2(x[0], x[1]); w.y = pk2(x[2], x[3]); w.z = pk2(x[4], x[5]); w.w = pk2(x[6], x[7]); return w; }

#define XB_TMO      128
#define XB_XCNT(j)  (256  + 64 * (j))
#define XB_XSUB(j)  (1280 + 64 * (j))
#define XB_XGEN(j)  (2304 + 64 * (j))
#define XB_TOP      3328
#define XB_TOPGEN   3392
#define XCD_BAR_WORDS 3456
#define XB_SPIN_CAP (1u << 22)
__device__ __forceinline__ unsigned xb_ld(unsigned* p)              { return __hip_atomic_load(p, __ATOMIC_RELAXED, __HIP_MEMORY_SCOPE_AGENT); }
__device__ __forceinline__ unsigned xb_add(unsigned* p, unsigned v) { return __hip_atomic_fetch_add(p, v, __ATOMIC_RELAXED, __HIP_MEMORY_SCOPE_AGENT); }
__device__ __forceinline__ unsigned xb_xcc_id() { return (unsigned)__builtin_amdgcn_s_getreg((3 << 11) | 20) & 0xFu; }
#define XB_SPIN(cond, bar) do { unsigned _sp = 0; while (cond) { __builtin_amdgcn_s_sleep(1); \
    if ((++_sp & 255u) == 0u) { if (xb_ld(&(bar)[XB_TMO])) break; if (_sp > XB_SPIN_CAP) { atomicAdd(&(bar)[XB_TMO], 1u); break; } } } } while (0)
struct XcdBarrier { unsigned* bar; unsigned x; volatile LAS unsigned* st; };
__device__ __forceinline__ XcdBarrier xcd_barrier_post(unsigned* bar, volatile LAS unsigned* st) {
    XcdBarrier b; b.bar = bar; b.x = xb_xcc_id(); b.st = st;
    if (threadIdx.x == 0) (void)xb_add(&bar[XB_XCNT(b.x)], 1u);
    return b;
}
__device__ __forceinline__ void xcd_barrier_complete(unsigned* bar, unsigned x, unsigned& nloc, unsigned& nx) {
    const unsigned G = gridDim.x * gridDim.y * gridDim.z;
    unsigned sum, cnt, mine, sp = 0u;
    for (;;) {
        sum = 0u; cnt = 0u; mine = 0u;
#pragma unroll
        for (unsigned j = 0; j < 16; ++j) { const unsigned c = xb_ld(&bar[XB_XCNT(j)]); sum += c; cnt += (c > 0u) ? 1u : 0u; mine = (j == x) ? c : mine; }
        if (sum == G) break;
        __builtin_amdgcn_s_sleep(1);
        if ((++sp & 255u) == 0u) { if (xb_ld(&bar[XB_TMO])) break; if (sp > XB_SPIN_CAP) { atomicAdd(&bar[XB_TMO], 1u); break; } }
    }
    nloc = mine > 0u ? mine : 1u; nx = cnt > 0u ? cnt : 1u;
}
__device__ __forceinline__ void xcd_barrier(const XcdBarrier& b, const int tid) {
    asm volatile("s_waitcnt vmcnt(0)" ::: "memory");
    __syncthreads();
    if (tid == 0) {
        unsigned* bar = b.bar; unsigned bx_ = b.x;
        asm volatile("" : "+s"(bar), "+s"(bx_));
        __builtin_amdgcn_s_waitcnt(0);
        unsigned nloc = b.st[0], nx = b.st[1];
        if (nloc == 0u) { xcd_barrier_complete(bar, bx_, nloc, nx); b.st[0] = nloc; b.st[1] = nx; }
        const unsigned old = xb_add(&bar[XB_XSUB(bx_)], 1u);
        const unsigned gen = old / nloc;
        if (old + 1u == (gen + 1u) * nloc) {
            __builtin_amdgcn_fence(__ATOMIC_RELEASE, "agent");
            asm volatile("s_waitcnt vmcnt(0)" ::: "memory");
            const unsigned og = xb_add(&bar[XB_TOP], 1u);
            const unsigned tg = og / nx;
            if (og + 1u == (tg + 1u) * nx) xb_add(&bar[XB_TOPGEN], 1u);
            else XB_SPIN(xb_ld(&bar[XB_TOPGEN]) == tg, bar);
            __builtin_amdgcn_fence(__ATOMIC_ACQUIRE, "agent");
            xb_add(&bar[XB_XGEN(bx_)], 1u);
            asm volatile("s_waitcnt vmcnt(0)" ::: "memory");
        } else {
            XB_SPIN(xb_ld(&bar[XB_XGEN(bx_)]) == gen, bar);
            __builtin_amdgcn_fence(__ATOMIC_ACQUIRE, "agent");
            asm volatile("s_waitcnt vmcnt(0)" ::: "memory");
        }
    }
    __syncthreads();
}

template <class T> __device__ __forceinline__ T* lnd(T* p) { asm volatile("" : "+s"(p)); return p; }
__device__ __forceinline__ float wave_sum(float v) {
#pragma unroll
    for (int o = 1; o < 64; o <<= 1) v += __shfl_xor(v, o);
    return v;
}
__device__ __forceinline__ int cvt_weight(const float* W, int K, int Nsrc, bf16* WT, int Ndst, int kind, const float* gk, const float* bk, float* uo, float* vo, LAS unsigned char* lds, int tile_off, int G, int bx, int tid) {
    asm volatile("" : "+v"(tid));
    const int wave = tid >> 6, lane = tid & 63;
    const int ntn = Ndst / 256, ntiles = (K / 64) * ntn;
    int t = ((bx - tile_off) % G + G) % G;
    f32x4 r[8];
#define CVT_LOAD(tt) do { const int kb_ = (tt) / ntn, tn_ = (tt) % ntn; int c_; \
        if (kind == 1) c_ = (lane < 32) ? (128 * tn_ + 4 * lane) : (DFF + 128 * tn_ + 4 * (lane - 32)); else c_ = 256 * tn_ + 4 * lane; \
        const bool ok_ = (kind == 1) || (c_ < Nsrc); const GAS float* src_ = (const GAS float*)W + (size_t)(64 * kb_ + 8 * wave) * Nsrc + (ok_ ? c_ : 0); \
        if (kind == 3 && tn_ < 10) {   \
            const GAS float* sp_ = (const GAS float*)W + (size_t)(64 * kb_ + 8 * wave) * Nsrc + 256 * tn_ + 128 * (lane >> 5) + 64 * ((lane >> 4) & 1) + 2 * (lane & 15); \
            _Pragma("unroll") for (int i_ = 0; i_ < 8; ++i_) { const f32x2 a_ = __builtin_nontemporal_load((const GAS f32x2*)(sp_ + (size_t)i_ * Nsrc)), b_ = __builtin_nontemporal_load((const GAS f32x2*)(sp_ + (size_t)i_ * Nsrc + 32)); r[i_] = (f32x4){a_.x, b_.x, a_.y, b_.y}; } \
        } else if (kind == 2 && (tn_ % 12) < 8) {   \
            const GAS float* sp_ = (const GAS float*)W + (size_t)(64 * kb_ + 8 * wave) * Nsrc + 256 * tn_ + 128 * (lane >> 5) + 2 * (lane & 31); \
            _Pragma("unroll") for (int i_ = 0; i_ < 8; ++i_) { const f32x2 a_ = __builtin_nontemporal_load((const GAS f32x2*)(sp_ + (size_t)i_ * Nsrc)), b_ = __builtin_nontemporal_load((const GAS f32x2*)(sp_ + (size_t)i_ * Nsrc + 64)); r[i_] = (f32x4){a_.x, b_.x, a_.y, b_.y}; } \
        } else { \
        _Pragma("unroll") for (int i_ = 0; i_ < 8; ++i_) { r[i_] = ok_ ? __builtin_nontemporal_load((const GAS f32x4*)(src_ + (size_t)i_ * Nsrc)) : (f32x4){0.f, 0.f, 0.f, 0.f}; } } } while (0)
    if (t < ntiles) CVT_LOAD(t);
    int buf = 0;
    const int c = lane & 7, nl = lane >> 3;
    for (; t < ntiles; t += G) {
        LAS unsigned char* tb = lds + buf * 65536;
#pragma unroll
        for (int i = 0; i < 8; ++i) { const int k = 8 * wave + i; *(LAS f32x4*)(tb + k * 1024 + ((lane ^ (wave & 7)) << 4)) = r[i]; }
        const int kb = t / ntn, tn = t % ntn, k0 = 64 * kb, n0 = 256 * tn;
        if (t + G < ntiles) CVT_LOAD(t + G);
        __syncthreads();
        f32x4 g0 = {1.f, 1.f, 1.f, 1.f}, g1 = g0, b0 = {0.f, 0.f, 0.f, 0.f}, b1 = b0;
        if (gk) { g0 = *(const GAS f32x4*)(gk + k0 + 8 * c); g1 = *(const GAS f32x4*)(gk + k0 + 8 * c + 4); }
        if (uo && bk) { b0 = *(const GAS f32x4*)(bk + k0 + 8 * c); b1 = *(const GAS f32x4*)(bk + k0 + 8 * c + 4); }
#pragma unroll
        for (int j = 0; j < 4; ++j) { const int n = 32 * wave + 8 * j + nl;
            float w[8];
#pragma unroll
            for (int e = 0; e < 8; ++e) w[e] = *(const LAS float*)(tb + (8 * c + e) * 1024 + ((((n >> 2) ^ c) & 63) << 4) + (n & 3) * 4);
            float us = 0.f, vs = 0.f;
            vs = w[0] * b0[0] + w[1] * b0[1] + w[2] * b0[2] + w[3] * b0[3] + w[4] * b1[0] + w[5] * b1[1] + w[6] * b1[2] + w[7] * b1[3];
            w[0] *= g0[0]; w[1] *= g0[1]; w[2] *= g0[2]; w[3] *= g0[3]; w[4] *= g1[0]; w[5] *= g1[1]; w[6] *= g1[2]; w[7] *= g1[3];
            us = ((w[0] + w[1]) + (w[2] + w[3])) + ((w[4] + w[5]) + (w[6] + w[7]));
            v4u o; o.x = pk2(w[0], w[1]); o.y = pk2(w[2], w[3]); o.z = pk2(w[4], w[5]); o.w = pk2(w[6], w[7]);
            *(GAS v4u*)(WT + (size_t)(n0 + n) * K + k0 + 8 * c) = o;
            if (uo) { us += __shfl_xor(us, 1); us += __shfl_xor(us, 2); us += __shfl_xor(us, 4); vs += __shfl_xor(vs, 1); vs += __shfl_xor(vs, 2); vs += __shfl_xor(vs, 4);
                if (c == 0) { __hip_atomic_fetch_add(uo + n0 + n, us, __ATOMIC_RELAXED, __HIP_MEMORY_SCOPE_AGENT); __hip_atomic_fetch_add(vo + n0 + n, vs, __ATOMIC_RELAXED, __HIP_MEMORY_SCOPE_AGENT); } }
        }
        buf ^= 1;
    }
#undef CVT_LOAD
    __syncthreads();
    return tile_off + ntiles;
}
__device__ __forceinline__ void ln_final(float* H, const bf16* HI, const unsigned char* LOW, const float* sum, const float* ssq, const float* g, const float* b, size_t gt, size_t NGT) {
    for (size_t q = gt; q < (size_t)MTOK * DM / 8; q += NGT) {
        const int blk = (int)(q >> 11), r = (int)((q & 2047) >> 3), ch = (int)(q & 7); const int m = (blk >> 5) * 256 + r, col = (blk & 31) * 64 + ch * 8;
        const float mean = sum[m] * (1.f / DM); const float rstd = __builtin_amdgcn_rsqf(ssq[m] * (1.f / DM) - mean * mean + LN_EPS);
        const v4u hv = *((const GAS v4u*)HI + q); const v2u lv = *((const GAS v2u*)LOW + q);
        float xh[8], xl[8]; unpack8(hv, xh); unpack8_lo(lv, xl);
        const f32x4 g0 = *(const GAS f32x4*)(g + col), g1 = *(const GAS f32x4*)(g + col + 4), b0 = *(const GAS f32x4*)(b + col), b1 = *(const GAS f32x4*)(b + col + 4);
        f32x4 y0, y1;
        y0[0] = ((xh[0] + xl[0]) - mean) * rstd * g0[0] + b0[0]; y0[1] = ((xh[1] + xl[1]) - mean) * rstd * g0[1] + b0[1]; y0[2] = ((xh[2] + xl[2]) - mean) * rstd * g0[2] + b0[2]; y0[3] = ((xh[3] + xl[3]) - mean) * rstd * g0[3] + b0[3];
        y1[0] = ((xh[4] + xl[4]) - mean) * rstd * g1[0] + b1[0]; y1[1] = ((xh[5] + xl[5]) - mean) * rstd * g1[1] + b1[1]; y1[2] = ((xh[6] + xl[6]) - mean) * rstd * g1[2] + b1[2]; y1[3] = ((xh[7] + xl[7]) - mean) * rstd * g1[3] + b1[3];
        GAS f32x4* xr = (GAS f32x4*)(H + (size_t)m * DM + col); xr[0] = y0; xr[1] = y1;
    }
}
__device__ __forceinline__ void krope_c(const bf16* CIN, bf16* KR, const unsigned char* ws, int gw, int NGW, int lane) {
    asm volatile("" : "+v"(lane));
    const float* cc = (const float*)(ws + WS_TABC); const float* sc = cc + 2048 * 32;
    const int sub = lane >> 3, i = lane & 7, f0 = (i & 3) * 8; const bool lowp = (i & 4) == 0;
    for (int t0 = gw * 8; t0 < MTOK; t0 += NGW * 8) { const int tok = t0 + sub, s = tok & (SEQ - 1);
        float x[8], y[8]; unpack8(*((const GAS v4u*)(CIN + (size_t)tok * C_INP + 1280) + i), x);
#pragma unroll
        for (int e = 0; e < 8; ++e) { const float p = __shfl_xor(x[e], 4); const float c = cc[s * 32 + f0 + e], sn = sc[s * 32 + f0 + e]; y[e] = lowp ? (x[e] * c - p * sn) : (x[e] * c + p * sn); }
        *((GAS v4u*)(KR + (size_t)tok * 64) + i) = pack8(y); }
}
__device__ __forceinline__ void ln_rows(float* H, bf16* HBo, const float* g, const float* b, int gw, int NGW, int lane) {
    asm volatile("" : "+v"(lane));
    for (int m = gw; m < MTOK; m += NGW) {
        GAS f32x4* xr = (GAS f32x4*)(H + (size_t)m * DM) + 2 * lane;
        f32x4 v[8]; float s = 0.f;
#pragma unroll
        for (int j = 0; j < 4; ++j) { v[2 * j] = xr[128 * j]; v[2 * j + 1] = xr[128 * j + 1]; }
#pragma unroll
        for (int j = 0; j < 8; ++j) s += (v[j].x + v[j].y) + (v[j].z + v[j].w);
        const float mean = wave_sum(s) * (1.f / DM); float s2 = 0.f;
#pragma unroll
        for (int j = 0; j < 8; ++j) { v[j] = v[j] - mean; s2 += (v[j].x * v[j].x + v[j].y * v[j].y) + (v[j].z * v[j].z + v[j].w * v[j].w); }
        const float rstd = 1.f / sqrtf(wave_sum(s2) * (1.f / DM) + LN_EPS);
        GAS v4u* ob = (GAS v4u*)(HBo + (size_t)m * DM) + lane;
#pragma unroll
        for (int j = 0; j < 4; ++j) {
            const f32x4 g0 = *((const f32x4*)g + 128 * j + 2 * lane), g1 = *((const f32x4*)g + 128 * j + 2 * lane + 1);
            const f32x4 b0 = *((const f32x4*)b + 128 * j + 2 * lane), b1 = *((const f32x4*)b + 128 * j + 2 * lane + 1);
            const f32x4 y0 = v[2 * j] * rstd * g0 + b0, y1 = v[2 * j + 1] * rstd * g1 + b1;
            xr[128 * j] = y0; xr[128 * j + 1] = y1;
            v4u o; o.x = pk2(y0.x, y0.y); o.y = pk2(y0.z, y0.w); o.z = pk2(y1.x, y1.y); o.w = pk2(y1.z, y1.w);
            ob[64 * j] = o;
        }
    }
}
__device__ __forceinline__ void cvt_rows_bf16(const float* X, bf16* O, unsigned char* OL, size_t n8, size_t gt, size_t NGT) {
    for (size_t i = gt; i < n8; i += NGT) { const f32x4 a = *((const GAS f32x4*)X + 2 * i), c = *((const GAS f32x4*)X + 2 * i + 1);
        v4u o; o.x = pk2(a.x, a.y); o.y = pk2(a.z, a.w); o.z = pk2(c.x, c.y); o.w = pk2(c.z, c.w); const size_t to_ = pg8::tl_off((int)((i * 8) / DM), (int)((i * 8) % DM), DM / 64); *(GAS v4u*)(O + to_) = o;
        *(GAS v2u*)(OL + to_) = pack8_lo(a.x - bflo(o.x), a.y - bfhi(o.x), a.z - bflo(o.y), a.w - bfhi(o.y), c.x - bflo(o.z), c.y - bfhi(o.z), c.z - bflo(o.w), c.w - bfhi(o.w)); }
}
__device__ __forceinline__ void sincos_tab(float ang, float& c, float& s) {
    const double x = (double)ang; const double k = __builtin_rint(x * 0.15915494309189533577); const double r = x - k * 6.28318530717958647692;
    const double r2 = r * r; double sn = 0.0, cs = 0.0;
#pragma unroll
    for (int n = 14; n >= 0; --n) { sn = sn * (-r2) / (double)((2 * n + 2) * (2 * n + 3)) + 1.0; cs = cs * (-r2) / (double)((2 * n + 1) * (2 * n + 2)) + 1.0; }
    s = (float)(sn * r); c = (float)cs;
}
__device__ __forceinline__ void build_tables(unsigned char* ws, size_t gt, size_t NGT) {
    float* cb = (float*)(ws + WS_TABB); float* sb = cb + 2048 * 64;
    for (size_t i = gt; i < 2048 * 64; i += NGT) { const int pos = (int)(i >> 6), f = (int)(i & 63); const float inv = __builtin_amdgcn_exp2f(-13.287712379549449f * ((float)(2 * f) / 128.0f)); float c, s; sincos_tab((float)pos * inv, c, s); cb[i] = c; sb[i] = s; }
    float* cc = (float*)(ws + WS_TABC); float* sc = cc + 2048 * 32;
    for (size_t i = gt; i < 2048 * 32; i += NGT) { const int pos = (int)(i >> 5), f = (int)(i & 31); const float inv = __builtin_amdgcn_exp2f(-13.287712379549449f * ((float)(2 * f) / 64.0f)); float c, s; sincos_tab((float)pos * inv, c, s); cc[i] = c; sc[i] = s; }
    float* ca = (float*)(ws + WS_TABA); float* sa = ca + 64 * 32;
    for (size_t i = gt; i < 64 * 32; i += NGT) { const int pos = (int)(i >> 5), f = (int)(i & 31); const float inv = __builtin_amdgcn_exp2f(-13.287712379549449f * ((float)(2 * f) / 64.0f)); float c, s; sincos_tab((float)pos * inv, c, s); ca[i] = c; sa[i] = s; }
}

__device__ __forceinline__ void prep_a(bf16* QKV, const float* qg, const float* kg, const unsigned char* ws, int gw, int NGW, int lane) {
    asm volatile("" : "+v"(lane));
    const float* ca = (const float*)(ws + WS_TABA); const float* sa = ca + 64 * 32;
    const int i = lane & 15, half = i >> 3, f0 = (i & 3) * 8; const bool lowp = (i & 4) == 0;
    float gq[8], gk[8];
#pragma unroll
    for (int e = 0; e < 8; ++e) { gq[e] = qg[i * 8 + e]; gk[e] = kg[i * 8 + e]; }
    for (int tok = gw; tok < MTOK; tok += NGW) {
        const int s = tok & (SEQ - 1), pos = half ? (s & 63) : (s >> 6);
        float c[8], sn[8];
        { const f32x4 c0 = *(const GAS f32x4*)(ca + pos * 32 + f0), c1 = *(const GAS f32x4*)(ca + pos * 32 + f0 + 4), s0 = *(const GAS f32x4*)(sa + pos * 32 + f0), s1 = *(const GAS f32x4*)(sa + pos * 32 + f0 + 4);
          c[0] = c0.x; c[1] = c0.y; c[2] = c0.z; c[3] = c0.w; c[4] = c1.x; c[5] = c1.y; c[6] = c1.z; c[7] = c1.w;
          sn[0] = s0.x; sn[1] = s0.y; sn[2] = s0.z; sn[3] = s0.w; sn[4] = s1.x; sn[5] = s1.y; sn[6] = s1.z; sn[7] = s1.w; }
        GAS v4u* row = (GAS v4u*)(QKV + (size_t)tok * A_QKV) + lane;
        v4u w[5];
#pragma unroll
        for (int j = 0; j < 5; ++j) w[j] = row[64 * j];
#pragma unroll
        for (int j = 0; j < 5; ++j) {
            float x[8]; unpack8(w[j], x); float ss = 0.f;
#pragma unroll
            for (int e = 0; e < 8; ++e) ss += x[e] * x[e];
            ss += __shfl_xor(ss, 1); ss += __shfl_xor(ss, 2); ss += __shfl_xor(ss, 4); ss += __shfl_xor(ss, 8);
            const float r = 1.f / sqrtf(ss * (1.f / 128.f) + RMS_EPS);
            float y[8];
#pragma unroll
            for (int e = 0; e < 8; ++e) { x[e] = x[e] * r * (j < 4 ? gq[e] : gk[e]); const float p = __shfl_xor(x[e], 4); y[e] = lowp ? (x[e] * c[e] - p * sn[e]) : (x[e] * c[e] + p * sn[e]); }
            row[64 * j] = pack8(y);
        }
    }
}
__device__ __forceinline__ void prep_b(bf16* QKV, const unsigned char* ws, int gw, int NGW, int lane) {
    asm volatile("" : "+v"(lane));
    const float* cb = (const float*)(ws + WS_TABB); const float* sb = cb + 2048 * 64;
    const int i = lane & 15, f0 = (i & 7) * 8; const bool lowp = (i & 8) == 0;
    for (int tok = gw; tok < MTOK; tok += NGW) {
        const int s = tok & (SEQ - 1);
        float c[8], sn[8];
        { const f32x4 c0 = *(const GAS f32x4*)(cb + s * 64 + f0), c1 = *(const GAS f32x4*)(cb + s * 64 + f0 + 4), s0 = *(const GAS f32x4*)(sb + s * 64 + f0), s1 = *(const GAS f32x4*)(sb + s * 64 + f0 + 4);
          c[0] = c0.x; c[1] = c0.y; c[2] = c0.z; c[3] = c0.w; c[4] = c1.x; c[5] = c1.y; c[6] = c1.z; c[7] = c1.w;
          sn[0] = s0.x; sn[1] = s0.y; sn[2] = s0.z; sn[3] = s0.w; sn[4] = s1.x; sn[5] = s1.y; sn[6] = s1.z; sn[7] = s1.w; }
#pragma unroll
        for (int g = 0; g < 3; ++g) {
            GAS v4u* row = (GAS v4u*)(QKV + (size_t)tok * B_QKV + g * 3072) + lane;
            v4u w[4];
#pragma unroll
            for (int j = 0; j < 4; ++j) w[j] = row[64 * j];
#pragma unroll
            for (int j = 0; j < 4; ++j) { float x[8], y[8]; unpack8(w[j], x);
#pragma unroll
                for (int e = 0; e < 8; ++e) { const float p = __shfl_xor(x[e], 8); y[e] = lowp ? (x[e] * c[e] - p * sn[e]) : (x[e] * c[e] + p * sn[e]); }
                row[64 * j] = pack8(y); }
        }
    }
}
__device__ __forceinline__ void prep_c1(const bf16* CIN, bf16* CQN, bf16* CKVN, bf16* KR, const float* qg, const float* kvg, const unsigned char* ws, int gw, int NGW, int lane) {
    asm volatile("" : "+v"(lane));
    const float* cc = (const float*)(ws + WS_TABC); const float* sc = cc + 2048 * 32;
    for (int tok = gw; tok < MTOK; tok += NGW) {
        const GAS v4u* row = (const GAS v4u*)(CIN + (size_t)tok * C_INP);
        const v4u a0 = row[lane], a1 = (lane < 32) ? row[64 + lane] : (v4u){0u, 0u, 0u, 0u}, b0 = row[96 + lane], k0 = (lane < 8) ? row[160 + lane] : (v4u){0u, 0u, 0u, 0u};
        float x0[8], x1[8], y0[8], kx[8]; unpack8(a0, x0); unpack8(a1, x1); unpack8(b0, y0); unpack8(k0, kx);
        float sq = 0.f, skv = 0.f;
#pragma unroll
        for (int e = 0; e < 8; ++e) { sq += x0[e] * x0[e] + x1[e] * x1[e]; skv += y0[e] * y0[e]; }
        const float rq = 1.f / sqrtf(wave_sum(sq) * (1.f / 768.f) + RMS_EPS), rkv = 1.f / sqrtf(wave_sum(skv) * (1.f / 512.f) + RMS_EPS);
        { const f32x4 g0 = *(const GAS f32x4*)(qg + lane * 8), g1 = *(const GAS f32x4*)(qg + lane * 8 + 4);
          x0[0] *= rq * g0.x; x0[1] *= rq * g0.y; x0[2] *= rq * g0.z; x0[3] *= rq * g0.w; x0[4] *= rq * g1.x; x0[5] *= rq * g1.y; x0[6] *= rq * g1.z; x0[7] *= rq * g1.w;
          *((GAS v4u*)(CQN + (size_t)tok * C_QL) + lane) = pack8(x0); }
        if (lane < 32) { const f32x4 g0 = *(const GAS f32x4*)(qg + 512 + lane * 8), g1 = *(const GAS f32x4*)(qg + 512 + lane * 8 + 4);
          x1[0] *= rq * g0.x; x1[1] *= rq * g0.y; x1[2] *= rq * g0.z; x1[3] *= rq * g0.w; x1[4] *= rq * g1.x; x1[5] *= rq * g1.y; x1[6] *= rq * g1.z; x1[7] *= rq * g1.w;
          *((GAS v4u*)(CQN + (size_t)tok * C_QL) + 64 + lane) = pack8(x1); }
        { const f32x4 g0 = *(const GAS f32x4*)(kvg + lane * 8), g1 = *(const GAS f32x4*)(kvg + lane * 8 + 4);
          y0[0] *= rkv * g0.x; y0[1] *= rkv * g0.y; y0[2] *= rkv * g0.z; y0[3] *= rkv * g0.w; y0[4] *= rkv * g1.x; y0[5] *= rkv * g1.y; y0[6] *= rkv * g1.z; y0[7] *= rkv * g1.w;
          *((GAS v4u*)(CKVN + (size_t)tok * C_KVL) + lane) = pack8(y0); }
        {
          const int s = tok & (SEQ - 1), f0 = (lane & 3) * 8; const bool lowp = (lane & 4) == 0; float y[8];
#pragma unroll
          for (int e = 0; e < 8; ++e) { const float p = __shfl_xor(kx[e], 4); const float c = cc[s * 32 + f0 + e], sn = sc[s * 32 + f0 + e]; y[e] = lowp ? (kx[e] * c - p * sn) : (kx[e] * c + p * sn); }
          if (lane < 8) *((GAS v4u*)(KR + (size_t)tok * 64) + lane) = pack8(y); }
    }
}
__device__ __forceinline__ void prep_c2(bf16* Q, const unsigned char* ws, int gw, int NGW, int lane) {
    asm volatile("" : "+v"(lane));
    const float* cc = (const float*)(ws + WS_TABC); const float* sc = cc + 2048 * 32;
    const int i = lane & 7, f0 = (i & 3) * 8; const bool lowp = (i & 4) == 0;
    for (int tok = gw; tok < MTOK; tok += NGW) {
        const int s = tok & (SEQ - 1);
        float c[8], sn[8];
        { const f32x4 c0 = *(const GAS f32x4*)(cc + s * 32 + f0), c1 = *(const GAS f32x4*)(cc + s * 32 + f0 + 4), s0 = *(const GAS f32x4*)(sc + s * 32 + f0), s1 = *(const GAS f32x4*)(sc + s * 32 + f0 + 4);
          c[0] = c0.x; c[1] = c0.y; c[2] = c0.z; c[3] = c0.w; c[4] = c1.x; c[5] = c1.y; c[6] = c1.z; c[7] = c1.w;
          sn[0] = s0.x; sn[1] = s0.y; sn[2] = s0.z; sn[3] = s0.w; sn[4] = s1.x; sn[5] = s1.y; sn[6] = s1.z; sn[7] = s1.w; }
#pragma unroll
        for (int j = 0; j < 2; ++j) { const int h = (lane >> 3) + 8 * j;
            GAS v4u* p = (GAS v4u*)(Q + (size_t)tok * C_Q + h * 192 + 128) + i; float x[8], y[8]; unpack8(*p, x);
#pragma unroll
            for (int e = 0; e < 8; ++e) { const float q = __shfl_xor(x[e], 4); y[e] = lowp ? (x[e] * c[e] - q * sn[e]) : (x[e] * c[e] + q * sn[e]); }
            *p = pack8(y); }
    }
}

struct NState { float m, l, o[8]; };
__device__ __forceinline__ void nst_init(NState& S) { S.m = -1e30f; S.l = 0.f;
#pragma unroll
    for (int j = 0; j < 8; ++j) S.o[j] = 0.f; }
__device__ __forceinline__ void nst_update(NState& S, float s, bool valid, const v4u vv) {
    const float mn = valid ? fmaxf(S.m, s) : S.m; const float al = __builtin_amdgcn_exp2f(S.m - mn); const float p = valid ? __builtin_amdgcn_exp2f(s - mn) : 0.f;
    S.l = S.l * al + p; S.m = mn;
    S.o[0] = S.o[0] * al + p * bflo(vv.x); S.o[1] = S.o[1] * al + p * bfhi(vv.x); S.o[2] = S.o[2] * al + p * bflo(vv.y); S.o[3] = S.o[3] * al + p * bfhi(vv.y);
    S.o[4] = S.o[4] * al + p * bflo(vv.z); S.o[5] = S.o[5] * al + p * bfhi(vv.z); S.o[6] = S.o[6] * al + p * bflo(vv.w); S.o[7] = S.o[7] * al + p * bfhi(vv.w);
}
__device__ __forceinline__ void nst_finish(NState& S, bf16* out, int lane) {
#pragma unroll
    for (int x = 16; x <= 32; x <<= 1) {
        const float m2 = __shfl_xor(S.m, x), l2 = __shfl_xor(S.l, x); const float mn = fmaxf(S.m, m2); const float a = __builtin_amdgcn_exp2f(S.m - mn), b = __builtin_amdgcn_exp2f(m2 - mn);
        S.l = S.l * a + l2 * b; S.m = mn;
#pragma unroll
        for (int j = 0; j < 8; ++j) { const float o2 = __shfl_xor(S.o[j], x); S.o[j] = S.o[j] * a + o2 * b; }
    }
    if (lane < 16) { const float rl = 1.f / S.l; v4u w; w.x = pk2(S.o[0] * rl, S.o[1] * rl); w.y = pk2(S.o[2] * rl, S.o[3] * rl); w.z = pk2(S.o[4] * rl, S.o[5] * rl); w.w = pk2(S.o[6] * rl, S.o[7] * rl);
        *(GAS v4u*)(out + lane * 8) = w; }
}
__device__ __forceinline__ float dot8(const float (&q)[8], const v4u k) {
    return q[0] * bflo(k.x) + q[1] * bfhi(k.x) + q[2] * bflo(k.y) + q[3] * bfhi(k.y) + q[4] * bflo(k.z) + q[5] * bfhi(k.z) + q[6] * bflo(k.w) + q[7] * bfhi(k.w);
}
__device__ __forceinline__ float red16(float s) { s += __shfl_xor(s, 1); s += __shfl_xor(s, 2); s += __shfl_xor(s, 4); s += __shfl_xor(s, 8); return s; }
__device__ __forceinline__ void ldq8(float (&q)[8], const bf16* p, float sc) { const v4u w = *(const GAS v4u*)p;
    q[0] = bflo(w.x) * sc; q[1] = bfhi(w.x) * sc; q[2] = bflo(w.y) * sc; q[3] = bfhi(w.y) * sc; q[4] = bflo(w.z) * sc; q[5] = bfhi(w.z) * sc; q[6] = bflo(w.w) * sc; q[7] = bfhi(w.w) * sc; }

__device__ __forceinline__ void naive_attn_a(const bf16* QKV, bf16* ATT, int gw, int NGW, int lane) {
    asm volatile("" : "+v"(lane));
    const int g = lane >> 4, i = lane & 15; const float sc = 0.08838834764831845f * 1.4426950408889634f;
    for (int p = gw; p < MTOK * 16; p += NGW) {
        const int tok = p >> 4, h = p & 15, b = tok >> 11;
        float q[8]; ldq8(q, QKV + (size_t)tok * A_QKV + h * 128 + i * 8, sc);
        const bf16* kb = QKV + (size_t)(b * SEQ) * A_QKV + 2048 + (h >> 2) * 128 + i * 8;
        NState S; nst_init(S);
        for (int t0 = 0; t0 < SEQ; t0 += 4) { const bf16* kp = kb + (size_t)(t0 + g) * A_QKV; const v4u kk = *(const GAS v4u*)kp, vv = *(const GAS v4u*)(kp + 512);
            nst_update(S, red16(dot8(q, kk)), true, vv); }
        nst_finish(S, ATT + (size_t)tok * DM + h * 128, lane);
    }
}
__device__ __forceinline__ void naive_attn_b(const bf16* QKV, bf16* ATT, int gw, int NGW, int lane) {
    asm volatile("" : "+v"(lane));
    const int g = lane >> 4, i = lane & 15; const float sc = 0.08838834764831845f * 1.4426950408889634f;
    for (int p = gw; p < MTOK * 8; p += NGW) {
        const int tok = p >> 3, h = p & 7, s = tok & (SEQ - 1);
        NState S; nst_init(S);
        for (int grp = 0; grp < 3; ++grp) {
            const int dil = grp == 0 ? 1 : (grp == 1 ? 4 : 16);
            float q[8]; ldq8(q, QKV + (size_t)tok * B_QKV + grp * 3072 + h * 128 + i * 8, sc);
            for (int j0 = -64; j0 <= 64; j0 += 4) { const int j = j0 + g; const int t = s + j * dil; const bool valid = (j <= 64) && (t >= 0) && (t < SEQ);
                const int tc = valid ? t : s; const bf16* kp = QKV + (size_t)(tok - s + tc) * B_QKV + grp * 3072 + 1024 + h * 128 + i * 8;
                const v4u kk = *(const GAS v4u*)kp, vv = *(const GAS v4u*)(kp + 1024);
                nst_update(S, red16(dot8(q, kk)), valid, vv); }
        }
        nst_finish(S, ATT + (size_t)tok * 1024 + h * 128, lane);
    }
}
__device__ __forceinline__ void naive_attn_c(const bf16* Q, const bf16* KV, const bf16* KR, bf16* ATT, int gw, int NGW, int lane) {
    asm volatile("" : "+v"(lane));
    const int g = lane >> 4, i = lane & 15; const float sc = 0.07216878364870322f * 1.4426950408889634f;
    for (int p = gw; p < MTOK * 16; p += NGW) {
        const int tok = p >> 4, h = p & 15, b = tok >> 11;
        float q[8]; ldq8(q, Q + (size_t)tok * C_Q + h * 192 + i * 8, sc);
        float qr[4]; { const v2u w = *(const GAS v2u*)(Q + (size_t)tok * C_Q + h * 192 + 128 + i * 4); qr[0] = bflo(w.x) * sc; qr[1] = bfhi(w.x) * sc; qr[2] = bflo(w.y) * sc; qr[3] = bfhi(w.y) * sc; }
        const bf16* kb = KV + (size_t)(b * SEQ) * C_KV + h * 256 + i * 8; const bf16* rb = KR + (size_t)(b * SEQ) * 64 + i * 4;
        NState S; nst_init(S);
        for (int t0 = 0; t0 < SEQ; t0 += 4) { const bf16* kp = kb + (size_t)(t0 + g) * C_KV; const v4u kk = *(const GAS v4u*)kp, vv = *(const GAS v4u*)(kp + 128);
            const v2u kr = *(const GAS v2u*)(rb + (size_t)(t0 + g) * 64);
            const float d = dot8(q, kk) + qr[0] * bflo(kr.x) + qr[1] * bfhi(kr.x) + qr[2] * bflo(kr.y) + qr[3] * bfhi(kr.y);
            nst_update(S, red16(d), true, vv); }
        nst_finish(S, ATT + (size_t)tok * DM + h * 128, lane);
    }
}


namespace att {
using bf16x8 = __attribute__((ext_vector_type(8))) short;
using s16x4  = __attribute__((ext_vector_type(4))) short;
using f32x16 = __attribute__((ext_vector_type(16))) float;
using u32x4  = __attribute__((ext_vector_type(4))) unsigned;
typedef GAS const unsigned short* gptr;
constexpr int KVBLK = 64, QBLK = 32;
constexpr int SHM_V = 16384, SHM_K = 16384, SHM_KR = 8192;
constexpr int OFF_V = 0, OFF_K = 2 * SHM_V, OFF_KR = OFF_K + 2 * SHM_K, OFF_WS = OFF_KR + 2 * SHM_KR, LDS_ATT = OFF_WS + 8 * 256;
#define KSWZ(row, colB) ((row) * 256 + ((colB) ^ (((row) & 7) << 4)))
#define KSWZ2(row, colB) ((row) * 128 + ((colB) ^ (((row) & 7) << 4)))
#define SBAR() __builtin_amdgcn_sched_barrier(0)
__device__ __forceinline__ int crow(int r, int hi) { return (r & 3) + 8 * (r >> 2) + 4 * hi; }
__device__ __forceinline__ unsigned cvtpk(float lo, float hi) { unsigned r; asm volatile("v_cvt_pk_bf16_f32 %0, %1, %2" : "=v"(r) : "v"(lo), "v"(hi)); return r; }
template <int MODE> __device__ __forceinline__ int tokmap(int p, int logd, int logL) { return MODE == 1 ? (((p & ((1 << logL) - 1)) << logd) | (p >> logL)) : p; }

template <int MODE> __device__ __forceinline__ void partialSM(f32x16& p0, f32x16& p1, float& m_reg, float& mn, float& alpha) {
  constexpr float SCALE = (MODE == 2) ? 0.07216878364870322f : 0.08838834764831845f;
  constexpr float C = SCALE * 1.4426950408889634f;
  float pmax = p0[0];
#pragma unroll
  for (int r = 1; r < 16; ++r) pmax = fmaxf(pmax, p0[r]);
#pragma unroll
  for (int r = 0; r < 16; ++r) pmax = fmaxf(pmax, p1[r]);
  { auto rr = __builtin_amdgcn_permlane32_swap(__float_as_uint(pmax), __float_as_uint(pmax), false, false);
    pmax = fmaxf(__uint_as_float(rr[0]), __uint_as_float(rr[1])); }
  if (__builtin_expect(__all(pmax - m_reg <= 8.f / SCALE), 1)) { mn = m_reg; alpha = 1.f; }
  else { mn = fmaxf(m_reg, pmax); alpha = __builtin_amdgcn_exp2f((m_reg - mn) * C); m_reg = mn; }
  const float mnC = -mn * C;
#pragma unroll
  for (int r = 0; r < 16; ++r) p0[r] = fmaf(p0[r], C, mnC);
#pragma unroll
  for (int r = 0; r < 16; ++r) p1[r] = fmaf(p1[r], C, mnC);
#pragma unroll
  for (int r = 0; r < 16; ++r) p0[r] = __builtin_amdgcn_exp2f(p0[r]);
}
__device__ __forceinline__ void finishSM(f32x16& p0, f32x16& p1, float alpha, float& l_reg, bf16x8& pa0, bf16x8& pa1, bf16x8& pa2, bf16x8& pa3) {
#pragma unroll
  for (int r = 0; r < 16; ++r) p1[r] = __builtin_amdgcn_exp2f(p1[r]);
  float ps = 0;
#pragma unroll
  for (int r = 0; r < 16; ++r) ps += p0[r];
#pragma unroll
  for (int r = 0; r < 16; ++r) ps += p1[r];
  { auto rr = __builtin_amdgcn_permlane32_swap(__float_as_uint(ps), __float_as_uint(ps), false, false);
    ps = __uint_as_float(rr[0]) + __uint_as_float(rr[1]); }
  l_reg = l_reg * alpha + ps;
#define PK4(P, BASE, OUT) do { unsigned a0 = cvtpk(P[BASE + 0], P[BASE + 1]), a1 = cvtpk(P[BASE + 2], P[BASE + 3]);   \
    unsigned b0 = cvtpk(P[BASE + 4], P[BASE + 5]), b1 = cvtpk(P[BASE + 6], P[BASE + 7]);                              \
    auto r0 = __builtin_amdgcn_permlane32_swap(a0, b0, false, false); auto r1 = __builtin_amdgcn_permlane32_swap(a1, b1, false, false); \
    u32x4 w = {r0[0], r1[0], r0[1], r1[1]}; OUT = *reinterpret_cast<bf16x8*>(&w); } while (0)
  PK4(p0, 0, pa0); PK4(p0, 8, pa1); PK4(p1, 0, pa2); PK4(p1, 8, pa3);
#undef PK4
}
template <int MODE> __device__ __forceinline__ void qkt(f32x16& p0, f32x16& p1, const LAS char* Ks, const LAS char* KRs, const bf16x8* qr, int r32, int hi) {
  p0 = f32x16{}; p1 = f32x16{};
#pragma unroll
  for (int d0 = 0; d0 < 8; ++d0) { const int cb = (d0 * 16 + hi * 8) * 2;
    const bf16x8 b0 = *reinterpret_cast<const LAS bf16x8*>(Ks + KSWZ(r32, cb));
    const bf16x8 b1 = *reinterpret_cast<const LAS bf16x8*>(Ks + KSWZ(32 + r32, cb));
    p0 = __builtin_amdgcn_mfma_f32_32x32x16_bf16(b0, qr[d0], p0, 0, 0, 0);
    p1 = __builtin_amdgcn_mfma_f32_32x32x16_bf16(b1, qr[d0], p1, 0, 0, 0); }
  if constexpr (MODE == 2) {
#pragma unroll
    for (int d0 = 0; d0 < 4; ++d0) { const int cb = (d0 * 16 + hi * 8) * 2;
      const bf16x8 b0 = *reinterpret_cast<const LAS bf16x8*>(KRs + KSWZ2(r32, cb));
      const bf16x8 b1 = *reinterpret_cast<const LAS bf16x8*>(KRs + KSWZ2(32 + r32, cb));
      p0 = __builtin_amdgcn_mfma_f32_32x32x16_bf16(b0, qr[8 + d0], p0, 0, 0, 0);
      p1 = __builtin_amdgcn_mfma_f32_32x32x16_bf16(b1, qr[8 + d0], p1, 0, 0, 0); }
  }
}
__device__ __forceinline__ void bmask(f32x16& p0, f32x16& p1, int kb, int qp, int logL, int hi) {
  const int qc = qp >> logL;
#pragma unroll
  for (int r = 0; r < 16; ++r) { const int k0 = kb + crow(r, hi), k1 = k0 + 32; const int d0 = k0 - qp, d1 = k1 - qp;
    const bool v0 = (d0 <= 64) && (d0 >= -64) && ((k0 >> logL) == qc), v1 = (d1 <= 64) && (d1 >= -64) && ((k1 >> logL) == qc);
    p0[r] = v0 ? p0[r] : -3.0e38f; p1[r] = v1 ? p1[r] : -3.0e38f; }
}
__device__ __forceinline__ int v_st(int k, int c) { const int kk = (k & ~0xC) | ((k & 4) << 1) | ((k & 8) >> 1); return ((kk >> 3) * 4 + (c >> 5)) * 512 + ((kk & 7) * 32 + (c & 31)) * 2; }
__device__ __forceinline__ int v_rd_base(int lane) { return ((lane & 3) << 3) | (((lane >> 2) & 3) << 6) | (((lane >> 4) & 1) << 5) | (((lane >> 5) & 1) << 8); }
constexpr int v_rd_off(int d0, int ks, int half) { return d0 * 512 + ks * 4096 + half * 2048; }
template <int OFF> __device__ __forceinline__ s16x4 tr_read(int vb) {
  s16x4 r; asm volatile("ds_read_b64_tr_b16 %0, %1 offset:%2" : "=&v"(r) : "v"(vb), "i"(OFF) : "memory"); return r;
}
template <int D0> __device__ __forceinline__ void pv_one(f32x16& od, int vb, bf16x8 pa0, bf16x8 pa1, bf16x8 pa2, bf16x8 pa3) {
  const s16x4 l0 = tr_read<v_rd_off(D0, 0, 0)>(vb), h0 = tr_read<v_rd_off(D0, 0, 1)>(vb), l1 = tr_read<v_rd_off(D0, 1, 0)>(vb), h1 = tr_read<v_rd_off(D0, 1, 1)>(vb);
  const s16x4 l2 = tr_read<v_rd_off(D0, 2, 0)>(vb), h2 = tr_read<v_rd_off(D0, 2, 1)>(vb), l3 = tr_read<v_rd_off(D0, 3, 0)>(vb), h3 = tr_read<v_rd_off(D0, 3, 1)>(vb);
  asm volatile("s_waitcnt lgkmcnt(0)" ::: "memory"); SBAR();
#define PK(L, H) (bf16x8){L[0], L[1], L[2], L[3], H[0], H[1], H[2], H[3]}
  od = __builtin_amdgcn_mfma_f32_32x32x16_bf16(pa0, PK(l0, h0), od, 0, 0, 0);
  od = __builtin_amdgcn_mfma_f32_32x32x16_bf16(pa1, PK(l1, h1), od, 0, 0, 0);
  od = __builtin_amdgcn_mfma_f32_32x32x16_bf16(pa2, PK(l2, h2), od, 0, 0, 0);
  od = __builtin_amdgcn_mfma_f32_32x32x16_bf16(pa3, PK(l3, h3), od, 0, 0, 0);
#undef PK
}
__device__ __forceinline__ void pv_d0(f32x16* o, int vb, bf16x8 pa0, bf16x8 pa1, bf16x8 pa2, bf16x8 pa3) {
  pv_one<0>(o[0], vb, pa0, pa1, pa2, pa3); pv_one<1>(o[1], vb, pa0, pa1, pa2, pa3); pv_one<2>(o[2], vb, pa0, pa1, pa2, pa3); pv_one<3>(o[3], vb, pa0, pa1, pa2, pa3);
}

template <int MODE>
__device__ __forceinline__ void attn_unit(gptr Qb, gptr Kb, gptr Vb, gptr KRb, GAS unsigned short* Ob, GAS float* lse, const GAS float* tabc,
                                          const int p0, const int k0, const int logd, LAS char* lds, const int tid) {
  constexpr int SDEPTH = (MODE == 2) ? 1 : 2;
  constexpr int NQ = (MODE == 2) ? 12 : 8;
  constexpr int ldq = (MODE == 0) ? A_QKV : (MODE == 1) ? B_QKV : C_Q, ldk = (MODE == 0) ? A_QKV : (MODE == 1) ? B_QKV : C_KV, ldo = (MODE == 1) ? 1024 : DM, NT = (MODE == 1) ? 6 : SEQ / 64;
  constexpr float SCALE = (MODE == 2) ? 0.07216878364870322f : 0.08838834764831845f;
  const int wid = tid >> 6, lane = tid & 63, r32 = lane & 31, hi = lane >> 5;
  const int logL = 11 - logd;
  LAS char* V_lds = lds + OFF_V; LAS char* K_lds = lds + OFF_K; LAS char* KR_lds = lds + OFF_KR;
  LAS float* wsl = (LAS float*)(lds + OFF_WS) + wid * 64; LAS float* li_l = wsl; LAS float* al_l = wsl + 32;
  float m_reg = -1e30f, l_reg = 0; f32x16 o[4] = {}; bf16x8 qr[NQ];
  const int qp = p0 + wid * QBLK + r32;
  { gptr Qw = Qb + (unsigned)(tokmap<MODE>(qp, logd, logL) * ldq + hi * 8);
#pragma unroll
    for (int d0 = 0; d0 < NQ; ++d0) qr[d0] = *reinterpret_cast<GAS const bf16x8*>(Qw + d0 * 16); }
  if constexpr (MODE == 2) {
    const GAS float* cc = tabc + qp * 32 + hi * 8; const GAS float* sc = cc + 2048 * 32;
#pragma unroll
    for (int d = 0; d < 2; ++d) { bf16x8 xa = qr[8 + d], xb = qr[10 + d]; float c[8], sn[8];
      { const f32x4 c0 = *(const GAS f32x4*)(cc + 16 * d), c1 = *(const GAS f32x4*)(cc + 16 * d + 4), s0 = *(const GAS f32x4*)(sc + 16 * d), s1 = *(const GAS f32x4*)(sc + 16 * d + 4);
        c[0] = c0.x; c[1] = c0.y; c[2] = c0.z; c[3] = c0.w; c[4] = c1.x; c[5] = c1.y; c[6] = c1.z; c[7] = c1.w; sn[0] = s0.x; sn[1] = s0.y; sn[2] = s0.z; sn[3] = s0.w; sn[4] = s1.x; sn[5] = s1.y; sn[6] = s1.z; sn[7] = s1.w; }
#pragma unroll
      for (int e = 0; e < 8; ++e) { const float a = __uint_as_float(((unsigned)(unsigned short)xa[e]) << 16), b = __uint_as_float(((unsigned)(unsigned short)xb[e]) << 16);
        xa[e] = (short)f2bf(a * c[e] - b * sn[e]); xb[e] = (short)f2bf(a * sn[e] + b * c[e]); }
      qr[8 + d] = xa; qr[10 + d] = xb; } }
  const int sr = tid >> 4, sc = (tid & 15) * 8, vst0 = v_st(sr, sc), vst1 = v_st(32 + sr, sc);
  const int krr = tid >> 3, krc = (tid & 7) * 8;
  const int vb0 = (int)(unsigned)(uintptr_t)V_lds + v_rd_base(lane);
  struct { bf16x8 vs0, vs1, ks0, ks1, kr; } sr_[SDEPTH];
#define SLOAD(i, kk) do { const unsigned t0_ = (unsigned)tokmap<MODE>(k0 + (kk) + sr, logd, logL) * (unsigned)ldk + (unsigned)sc, t1_ = (unsigned)tokmap<MODE>(k0 + (kk) + 32 + sr, logd, logL) * (unsigned)ldk + (unsigned)sc; \
    sr_[i].vs0 = *reinterpret_cast<GAS const bf16x8*>(Vb + t0_); sr_[i].vs1 = *reinterpret_cast<GAS const bf16x8*>(Vb + t1_); \
    sr_[i].ks0 = *reinterpret_cast<GAS const bf16x8*>(Kb + t0_); sr_[i].ks1 = *reinterpret_cast<GAS const bf16x8*>(Kb + t1_); \
    if constexpr (MODE == 2) sr_[i].kr = *reinterpret_cast<GAS const bf16x8*>(KRb + (unsigned)((k0 + (kk) + krr) * 64 + krc)); } while (0)
#define SWRITE(b, i) do { *(LAS bf16x8*)(V_lds + (b) * SHM_V + vst0) = sr_[i].vs0; *(LAS bf16x8*)(V_lds + (b) * SHM_V + vst1) = sr_[i].vs1; const int kc = sc * 2; \
    *(LAS bf16x8*)(K_lds + (b) * SHM_K + KSWZ(sr, kc)) = sr_[i].ks0; *(LAS bf16x8*)(K_lds + (b) * SHM_K + KSWZ(32 + sr, kc)) = sr_[i].ks1; \
    if constexpr (MODE == 2) *(LAS bf16x8*)(KR_lds + (b) * SHM_KR + KSWZ2(krr, krc * 2)) = sr_[i].kr; } while (0)
#define SWAIT() do { if constexpr (SDEPTH == 2) asm volatile("s_waitcnt vmcnt(4)" ::: "memory"); else asm volatile("s_waitcnt vmcnt(0)" ::: "memory"); } while (0)
#define RESC(a) do { if (__any((a) < 1.f)) { if (hi == 0) al_l[r32] = (a); asm volatile("s_waitcnt lgkmcnt(0)" ::: "memory"); \
    _Pragma("unroll") for (int d = 0; d < 4; ++d) _Pragma("unroll") for (int r = 0; r < 16; ++r) o[d][r] *= al_l[crow(r, hi)]; } } while (0)
#define QKT(P0, P1, b, t) do { qkt<MODE>(P0, P1, K_lds + (b) * SHM_K, KR_lds + (b) * SHM_KR, qr, r32, hi); if constexpr (MODE == 1) bmask(P0, P1, k0 + (t) * KVBLK, qp, logL, hi); } while (0)
  bf16x8 pa0, pa1, pa2, pa3;
  if constexpr (MODE == 2) {
    f32x16 pA0, pA1; float mnA, alA;
    SLOAD(0, 0); asm volatile("s_waitcnt vmcnt(0)" ::: "memory"); SWRITE(0, 0); __syncthreads();
    for (int t = 0; t < NT; t += 2) {
      SLOAD(0, (t + 1) * KVBLK); SBAR();
      QKT(pA0, pA1, 0, t); partialSM<MODE>(pA0, pA1, m_reg, mnA, alA); RESC(alA);
      finishSM(pA0, pA1, alA, l_reg, pa0, pa1, pa2, pa3); SBAR();
      pv_d0(o, vb0, pa0, pa1, pa2, pa3);
      SWAIT(); SWRITE(1, 0); __syncthreads();
      if (t + 2 < NT) SLOAD(0, (t + 2) * KVBLK); SBAR();
      QKT(pA0, pA1, 1, t + 1); partialSM<MODE>(pA0, pA1, m_reg, mnA, alA); RESC(alA);
      finishSM(pA0, pA1, alA, l_reg, pa0, pa1, pa2, pa3); SBAR();
      pv_d0(o, vb0 + SHM_V, pa0, pa1, pa2, pa3);
      if (t + 2 < NT) { SWAIT(); SWRITE(0, 0); } __syncthreads();
    }
  } else {
  f32x16 pA0, pA1, pB0, pB1; float mnA, mnB, alA, alB;
  constexpr int SE = 0, SO = SDEPTH - 1;
  SLOAD(SE, 0); asm volatile("s_waitcnt vmcnt(0)" ::: "memory"); SWRITE(0, SE); __syncthreads();
  QKT(pA0, pA1, 0, 0); partialSM<MODE>(pA0, pA1, m_reg, mnA, alA);
  SLOAD(SO, KVBLK); if constexpr (SDEPTH == 2) { if (2 < NT) SLOAD(SE, 2 * KVBLK); }
  SWAIT(); SWRITE(1, SO); __syncthreads();
  for (int j = 1; j + 1 < NT; j += 2) {
    SBAR(); QKT(pB0, pB1, 1, j);
    finishSM(pA0, pA1, alA, l_reg, pa0, pa1, pa2, pa3); SBAR();
    SLOAD(SO, (j + SDEPTH) * KVBLK); SBAR();
    pv_d0(o, vb0, pa0, pa1, pa2, pa3); partialSM<MODE>(pB0, pB1, m_reg, mnB, alB);
    __syncthreads(); SWAIT(); SWRITE(0, SE);
    RESC(alB); __syncthreads();
    SBAR(); QKT(pA0, pA1, 0, j + 1);
    finishSM(pB0, pB1, alB, l_reg, pa0, pa1, pa2, pa3); SBAR();
    if (SDEPTH == 1 || j + 3 < NT) SLOAD(SE, (j + 1 + SDEPTH) * KVBLK); SBAR();
    pv_d0(o, vb0 + SHM_V, pa0, pa1, pa2, pa3); partialSM<MODE>(pA0, pA1, m_reg, mnA, alA);
    __syncthreads(); SWAIT(); SWRITE(1, SO);
    RESC(alA); __syncthreads();
  }
  SBAR(); QKT(pB0, pB1, 1, NT - 1);
  finishSM(pA0, pA1, alA, l_reg, pa0, pa1, pa2, pa3); SBAR();
  pv_d0(o, vb0, pa0, pa1, pa2, pa3); partialSM<MODE>(pB0, pB1, m_reg, mnB, alB);
  __syncthreads(); RESC(alB);
  finishSM(pB0, pB1, alB, l_reg, pa0, pa1, pa2, pa3); SBAR();
  pv_d0(o, vb0 + SHM_V, pa0, pa1, pa2, pa3);
  }
  if (hi == 0) li_l[r32] = l_reg; asm volatile("s_waitcnt lgkmcnt(0)" ::: "memory");
  if constexpr (MODE == 1) { if (hi == 0) lse[(unsigned)(tokmap<MODE>(qp, logd, logL) * 8)] = m_reg * SCALE + __builtin_amdgcn_logf(l_reg) * 0.6931471805599453f; }
#pragma unroll
  for (int r = 0; r < 16; ++r) { const int orow = crow(r, hi); const float rl = __builtin_amdgcn_rcpf(li_l[orow]);
    GAS unsigned short* Ow = Ob + (unsigned)(tokmap<MODE>(p0 + wid * QBLK + orow, logd, logL) * ldo + r32);
#pragma unroll
    for (int d0 = 0; d0 < 4; ++d0) Ow[d0 * 32] = (unsigned short)f2bf(o[d0][r] * rl); }
#undef SLOAD
#undef SWRITE
#undef SWAIT
#undef RESC
#undef QKT
}
}

__device__ __forceinline__ void attn_phase_a(const bf16* QKV, bf16* ATT, LAS char* lds, int G, int bx, int tid) {
    asm volatile("" : "+v"(tid));
    for (int u = bx; u < BATCH * 16 * 8; u += G) {
        int pair, j; if (G == 256) { pair = (u >> 8) * 8 + (bx & 7); j = bx >> 3; } else { pair = u >> 5; j = u & 31; }
        const int b = pair >> 2, kvh = pair & 3, hq = kvh * 4 + (j >> 3), qb = j & 7;
        att::gptr Qb = (att::gptr)(QKV + (size_t)b * SEQ * A_QKV + hq * 128); att::gptr Kb = (att::gptr)(QKV + (size_t)b * SEQ * A_QKV + 2048 + kvh * 128);
        att::attn_unit<0>(Qb, Kb, Kb + 512, Kb, (GAS unsigned short*)(ATT + (size_t)b * SEQ * DM + hq * 128), nullptr, nullptr, 256 * qb, 0, 0, lds, tid);
        __syncthreads();
    }
}
__device__ __forceinline__ void attn_phase_c(const bf16* Q, const bf16* KV, const bf16* KR, bf16* ATT, const float* tabc, LAS char* lds, int G, int bx, int tid) {
    asm volatile("" : "+v"(tid));
    for (int u = bx; u < BATCH * 16 * 8; u += G) {
        int pair, qb; if (G == 256) { pair = ((u >> 8) * 8 + (bx & 7)) * 4 + (bx >> 6); qb = (bx >> 3) & 7; } else { pair = u >> 3; qb = u & 7; }
        const int b = pair >> 4, h = pair & 15;
        att::gptr Qb = (att::gptr)(Q + (size_t)b * SEQ * C_Q + h * 192); att::gptr Kb = (att::gptr)(KV + (size_t)b * SEQ * C_KV + h * 256);
        att::attn_unit<2>(Qb, Kb, Kb + 128, (att::gptr)(KR + (size_t)b * SEQ * 64), (GAS unsigned short*)(ATT + (size_t)b * SEQ * DM + h * 128), nullptr, (const GAS float*)tabc, 256 * qb, 0, 0, lds, tid);
        __syncthreads();
    }
}
__device__ __forceinline__ void attn_phase_b(const bf16* QKV, bf16* OG, float* LSE, LAS char* lds, int G, int bx, int tid) {
    asm volatile("" : "+v"(tid));
    for (int u = bx; u < 3 * BATCH * 8 * 8; u += G) {
        const int qb = u & 7, h = (u >> 3) & 7, b = (u >> 6) & 15, grp = u >> 10, logd = 2 * grp;
        att::gptr Qb = (att::gptr)(QKV + (size_t)b * SEQ * B_QKV + grp * 3072 + h * 128);
        const int p0 = 256 * qb; int k0 = p0 - 64; k0 = k0 < 0 ? 0 : (k0 > SEQ - 384 ? SEQ - 384 : k0);
        att::attn_unit<1>(Qb, Qb + 1024, Qb + 2048, Qb, (GAS unsigned short*)(OG + (size_t)grp * MTOK * 1024 + (size_t)b * SEQ * 1024 + h * 128),
                          (GAS float*)(LSE + ((size_t)grp * MTOK + (size_t)b * SEQ) * 8 + h), nullptr, p0, k0, logd, lds, tid);
        __syncthreads();
    }
}
__device__ __forceinline__ void merge_b(const bf16* OG, const float* LSE, bf16* ATT, int gw, int NGW, int lane) {
    asm volatile("" : "+v"(lane));
    const int h = lane >> 3, c = (lane & 7) * 16;
    for (int tok = gw; tok < MTOK; tok += NGW) {
        const float l0 = LSE[(size_t)tok * 8 + h], l1 = LSE[((size_t)MTOK + tok) * 8 + h], l2 = LSE[((size_t)2 * MTOK + tok) * 8 + h];
        const float mx = fmaxf(l0, fmaxf(l1, l2)); float w0 = __expf(l0 - mx), w1 = __expf(l1 - mx), w2 = __expf(l2 - mx); const float rs = 1.f / (w0 + w1 + w2); w0 *= rs; w1 *= rs; w2 *= rs;
        const GAS v4u* a = (const GAS v4u*)(OG + (size_t)tok * 1024 + h * 128 + c); const GAS v4u* bq = (const GAS v4u*)(OG + ((size_t)MTOK + tok) * 1024 + h * 128 + c); const GAS v4u* cq = (const GAS v4u*)(OG + ((size_t)2 * MTOK + tok) * 1024 + h * 128 + c);
        GAS v4u* o = (GAS v4u*)(ATT + (size_t)tok * 1024 + h * 128 + c);
#pragma unroll
        for (int i = 0; i < 2; ++i) { const v4u x = a[i], y = bq[i], z = cq[i]; v4u r;
            r.x = pk2(w0 * bflo(x.x) + w1 * bflo(y.x) + w2 * bflo(z.x), w0 * bfhi(x.x) + w1 * bfhi(y.x) + w2 * bfhi(z.x));
            r.y = pk2(w0 * bflo(x.y) + w1 * bflo(y.y) + w2 * bflo(z.y), w0 * bfhi(x.y) + w1 * bfhi(y.y) + w2 * bfhi(z.y));
            r.z = pk2(w0 * bflo(x.z) + w1 * bflo(y.z) + w2 * bflo(z.z), w0 * bfhi(x.z) + w1 * bfhi(y.z) + w2 * bfhi(z.z));
            r.w = pk2(w0 * bflo(x.w) + w1 * bflo(y.w) + w2 * bflo(z.w), w0 * bfhi(x.w) + w1 * bfhi(y.w) + w2 * bfhi(z.w));
            o[i] = r; }
    }
}

constexpr int N_IN = 57;
struct Args { const float* in[N_IN]; float* out; unsigned char* ws; int ph_lo, ph_hi; };
__device__ __forceinline__ const float* arg_in(int idx) {
    typedef __attribute__((address_space(4))) const char* kptr;
    kptr kp = (kptr)__builtin_amdgcn_kernarg_segment_ptr();
    return *(const float* __attribute__((address_space(4))) const*)(kp + 8 * idx);
}
constexpr int N_PHASES = 1 + 7 + 8 + 8 + 7 + 1;

#define CVT_NEXT(PM) do { const int pm_ = (PM); \
                if (si + 1 < 3 * DEPTH && EXP != 3 && pm_ != 0) { \
                    const int lncur = (sub == 0) ? base + 2 : (sub == 1) ? base + 4 + nmix : base + 8 + nmix; \
                    const float* gk = arg_in(lncur); const float* bk = arg_in(lncur + 1); bf16* WN = WTB(si + 1); float* un = UVEC(si + 1); float* vn = un + 11264; LAS unsigned char* cl = lds + RING_OFF; int to = 0; \
                    if (sub == 0) { \
                        if (kind == 0) { if (pm_ & 1) to = cvt_weight(arg_in(base + 4), DM, A_QKV, WN, A_QKV, 3, gk, bk, un, vn, cl, to, G, bx, tid); else to = (DM / 64) * (A_QKV / 256); \
                                         if (pm_ & 2) to = cvt_weight(arg_in(base + 7), DM, DM, WN + WT_A_OUT, DM, 0, nullptr, nullptr, nullptr, nullptr, cl, to, G, bx, tid); } \
                        else if (kind == 1) { if (pm_ & 1) to = cvt_weight(arg_in(base + 4), DM, B_QKV, WN, B_QKV, 2, gk, bk, un, vn, cl, to, G, bx, tid); else to = (DM / 64) * (B_QKV / 256); \
                                              if (pm_ & 2) to = cvt_weight(arg_in(base + 5), 1024, DM, WN + WT_B_OUT, DM, 0, nullptr, nullptr, nullptr, nullptr, cl, to, G, bx, tid); } \
                        else { if (pm_ & 1) to = cvt_weight(arg_in(base + 4), DM, C_IN, WN, C_INP, 0, gk, bk, un, vn, cl, to, G, bx, tid); else to = (DM / 64) * (C_INP / 256); \
                               if (pm_ & 2) { to = cvt_weight(arg_in(base + 7), C_QL, C_Q, WN + WT_C_QUP, C_Q, 0, arg_in(base + 5), nullptr, nullptr, nullptr, cl, to, G, bx, tid); \
                               to = cvt_weight(arg_in(base + 8), C_KVL, C_KV, WN + WT_C_KVUP, C_KV, 0, arg_in(base + 6), nullptr, nullptr, nullptr, cl, to, G, bx, tid); \
                               to = cvt_weight(arg_in(base + 9), DM, DM, WN + WT_C_OUT, DM, 0, nullptr, nullptr, nullptr, nullptr, cl, to, G, bx, tid); } } \
                    } else { \
                        const int wi = (sub == 1) ? base + 6 + nmix : ((L + 1 == 1) ? 15 : (L + 1 == 2) ? 27 : 43); \
                        if (pm_ & 1) to = cvt_weight(arg_in(wi), DM, 2 * DFF, WN, 2 * DFF, 1, gk, bk, un, vn, cl, to, G, bx, tid); else to = (DM / 64) * (2 * DFF / 256); \
                        if (pm_ & 2) to = cvt_weight(arg_in(wi + 1), DFF, DM, WN + WT_FFN_OUT, DM, 0, nullptr, nullptr, nullptr, nullptr, cl, to, G, bx, tid); \
                    } \
                    (void)to; \
                } \
 } while (0)
__global__ void __launch_bounds__(NWAVES * 64, 2) mega_fwd(Args args) {
    extern __shared__ __attribute__((aligned(16))) unsigned char lds_raw[];
    LAS unsigned char* lds = (LAS unsigned char*)lds_raw;
    volatile LAS unsigned* MISC = (volatile LAS unsigned*)(lds + MISC_OFF);
    const int wave = __builtin_amdgcn_readfirstlane((int)threadIdx.x >> 6);
    unsigned char* const ws0 = args.ws; float* const out0 = args.out; const int G0 = gridDim.x, bx0 = blockIdx.x;
    for (int u = threadIdx.x; u < (LDS_BYTES - LDSCTL_OFF) / 4; u += NWAVES * 64) ((LAS unsigned*)(lds + LDSCTL_OFF))[u] = 0u;
    __syncthreads();
    XcdBarrier bar; bar.bar = (unsigned*)((gu32*)(ws0 + WS_CTL) + CW_BAR); bar.x = 0; bar.st = nullptr;
    if (!MK_PER_PHASE) bar = xcd_barrier_post((unsigned*)((gu32*)(ws0 + WS_CTL) + CW_BAR), MISC + 8);
    const int lo = args.ph_lo, hi = args.ph_hi;
    int ph = 0;
#define IN_PH() (lo <= ph && ph < hi)
#define SEAM_BAR() do { unsigned ones_ = ~0u; asm volatile("" : "+s"(ones_)); xcd_barrier(bar, wave * 64 + (int)__builtin_amdgcn_mbcnt_hi(ones_, __builtin_amdgcn_mbcnt_lo(ones_, 0u))); } while (0)
#if PROBE_CAT >= 0
    volatile LAS unsigned long long* PR = (volatile LAS unsigned long long*)(lds + MISC_OFF + 64);
    if (threadIdx.x == 0) { const unsigned long long t_ = __builtin_amdgcn_s_memrealtime(); PR[0] = t_; PR[1] = 0ull; PR[2] = t_; MISC[22] = 2u; }
#define SEAM() do { if (wave == 0) { const unsigned long long te_ = __builtin_amdgcn_s_memrealtime(); if (MISC[22] == (unsigned)PROBE_CAT) PR[1] = PR[1] + (te_ - PR[0]); PR[0] = te_; } \
    if (lo <= ph && ph + 1 < hi) SEAM_BAR(); if (wave == 0) { const unsigned long long ta_ = __builtin_amdgcn_s_memrealtime(); if (PROBE_CAT == 4) PR[1] = PR[1] + (ta_ - PR[0]); PR[0] = ta_; } ++ph; } while (0)
#define PCAT(c) do { if (wave == 0) MISC[22] = (unsigned)(c); } while (0)
#else
#define SEAM() do { if (!MK_PER_PHASE) { if (lo <= ph && ph + 1 < hi) SEAM_BAR(); } ++ph; } while (0)
#define PCAT(c) do { } while (0)
#endif
#define PH_VARS unsigned ones_ = ~0u; asm volatile("" : "+s"(ones_)); const int lane = (int)__builtin_amdgcn_mbcnt_hi(ones_, __builtin_amdgcn_mbcnt_lo(ones_, 0u)); const int tid = wave * 64 + lane; (void)lane; \
    unsigned char* ws = lnd(ws0); float* H32 = lnd(out0); bf16* WT0 = (bf16*)(ws + WS_WT); bf16* HB = (bf16*)(ws + WS_HB); unsigned char* LO = ws + WS_LO; unsigned char* R = ws + WS_R; \
    int G = G0, bx = bx0; asm volatile("" : "+s"(G), "+s"(bx)); const int vcu = (G % 8 == 0) ? (bx % 8) * (G / 8) + bx / 8 : bx; const int gw = vcu * NWAVES + wave, NGW = G * NWAVES; \
    const size_t gt = (size_t)vcu * (NWAVES * 64) + tid, NGT = (size_t)G * NWAVES * 64; LAS float* scr = (LAS float*)(lds + RING_OFF + wave * 16384); \
    (void)H32; (void)WT0; (void)HB; (void)LO; (void)R; (void)gw; (void)NGW; (void)gt; (void)NGT; (void)scr;

    for (int rep = 0; rep < REPS; ++rep) {
    PCAT(2);
    if (IN_PH()) { PH_VARS
        for (size_t i = gt; i < (DEV_ZERO_END - CTL_ZERO_BYTES) / 16; i += NGT) ((GAS v4u*)(ws + CTL_ZERO_BYTES))[i] = (v4u){0u, 0u, 0u, 0u};
        build_tables(ws, gt, NGT);
        cvt_rows_bf16(arg_in(0), HB, LO, (size_t)MTOK * DM / 8, gt, NGT);
        { int to = cvt_weight(arg_in(1), DM, 2 * DFF, WT0, 2 * DFF, 1, nullptr, nullptr, nullptr, nullptr, lds + RING_OFF, 0, G, bx, tid);
          (void)cvt_weight(arg_in(2), DFF, DM, WT0 + WT_FFN_OUT, DM, 0, nullptr, nullptr, nullptr, nullptr, lds + RING_OFF, to, G, bx, tid); }
    }
    SEAM();

    for (int L = 0; L < DEPTH; ++L) {
        const int kind = (L == 3) ? 0 : L;
        const int base = (L == 0) ? 1 : (L == 1) ? 15 : (L == 2) ? 27 : 43;
        const int nmix = (kind == 0) ? 4 : (kind == 1) ? 2 : 6;
        for (int sub = 0; sub < 3; ++sub) {
            const int si = L * 3 + sub;
            const int pbase = (L == 0) ? 1 : (L == 1) ? 1 : (L == 2) ? 15 : 27, pkind = (L == 0) ? 0 : (L - 1), pnmix = (pkind == 0) ? 4 : (pkind == 1) ? 2 : 6;
            const int lnprev = (sub == 0) ? pbase + 8 + pnmix : (sub == 1) ? base + 2 : base + 4 + nmix;
#define WTB(i) ((bf16*)(ws + WS_WT + (size_t)((i) & 1) * WT_BUF))
#define STAT_SUM(i) ((float*)(ws + WS_STAT) + (size_t)(i) * 2 * MTOK)
#define UVEC(i) ((float*)(ws + WS_UV) + (size_t)(i) * UV_STRIDE)
#define PREV_STAT() pg8::RowStat{STAT_SUM(si - 1), STAT_SUM(si - 1) + MTOK, 1.f / DM, LN_EPS, si == 0 ? 0 : 1}
            if (sub != 1) {
                PCAT(10);
                if (IN_PH()) { PH_VARS
                    pg8::Gemm g{lnd(HB), lnd(WTB(si)), MTOK, 2 * DFF, DM, DM, 1}; pg8::StaticOrder S; S.init(MTOK, 2 * DFF, G, bx);
                    pg8::EpiAffSwiGLU E{lnd((bf16*)(R + R_ACT)), DFF, PREV_STAT(), UVEC(si), UVEC(si) + 11264};
                    pg8::gemm_phase<pg8::EpiAffSwiGLU, pg8::StaticOrder, PG8_ALIGN, PG8_SP2>(lds + RING_OFF, g, S, E, tid);
                }
                SEAM();
            } else {
                PCAT(12);
                if (IN_PH()) { PH_VARS
                    if (kind == 0) {
                        pg8::Gemm g{lnd(HB), lnd(WTB(si)), MTOK, A_QKV, DM, DM, 1}; pg8::StaticOrder S; S.init(MTOK, A_QKV, G, bx);
                        pg8::EpiAffA E{lnd((bf16*)(R + RA_QKV)), A_QKV, PREV_STAT(), UVEC(si), UVEC(si) + 11264, arg_in(base + 5), arg_in(base + 6), (const float*)(ws + WS_TABA), (LAS float*)(lds + XCH_OFF)};
                        pg8::gemm_phase<pg8::EpiAffA, pg8::StaticOrder, PG8_ALIGN, PG8_SP2>(lds + RING_OFF, g, S, E, tid);
                    } else {
                    const int N = (kind == 1) ? B_QKV : C_INP;
                    pg8::Gemm g{lnd(HB), lnd(WTB(si)), MTOK, N, DM, DM, 1}; pg8::StaticOrder S; S.init(MTOK, N, G, bx);
                    pg8::EpiAff E{lnd((bf16*)(R + 0)), N, PREV_STAT(), UVEC(si), UVEC(si) + 11264, (kind == 2) ? (float*)(ws + WS_SSQC) : (float*)nullptr, (kind == 1) ? (const float*)(ws + WS_TABB) : (const float*)nullptr};
                    pg8::gemm_phase<pg8::EpiAff, pg8::StaticOrder, PG8_ALIGN, PG8_SP2>(lds + RING_OFF, g, S, E, tid);
                    }
                }
                SEAM();
                if (kind == 0) {
                    PCAT(14);
                    if (IN_PH()) { PH_VARS attn_phase_a((const bf16*)(R + RA_QKV), (bf16*)(R + RA_ATT), (LAS char*)(lds + RING_OFF), G, bx, tid); }
                    SEAM();
                } else if (kind == 1) {
                    PCAT(15);
                    if (IN_PH()) { PH_VARS attn_phase_b((const bf16*)(R + RB_QKV), (bf16*)(R + RB_OG), (float*)(R + RB_LSE), (LAS char*)(lds + RING_OFF), G, bx, tid); }
                    SEAM();
                    PCAT(17);
                    if (IN_PH()) { PH_VARS merge_b((const bf16*)(R + RB_OG), (const float*)(R + RB_LSE), (bf16*)(R + RB_ATT), gw, NGW, lane); }
                    SEAM();
                } else {
                    PCAT(12);
                    if (IN_PH()) { PH_VARS
                        krope_c((const bf16*)(R + RC_IN), (bf16*)(R + RC_KR), ws, gw, NGW, lane);
                        { pg8::Gemm g{lnd((const bf16*)(R + RC_IN)), lnd(WTB(si) + WT_C_QUP), MTOK, C_Q, C_QL, C_INP}; pg8::StaticOrder S; S.init(MTOK, C_Q, G, bx);
                          pg8::EpiAff E{lnd((bf16*)(R + RC_Q)), C_Q, pg8::RowStat{nullptr, (const float*)(ws + WS_SSQC), 1.f / C_QL, RMS_EPS, 2}, nullptr, nullptr, nullptr, nullptr};
                          pg8::gemm_phase<pg8::EpiAff, pg8::StaticOrder, PG8_ALIGN, PG8_SP2>(lds + RING_OFF, g, S, E, tid); }
                        { pg8::Gemm g{lnd((const bf16*)(R + RC_IN) + C_QL), lnd(WTB(si) + WT_C_KVUP), MTOK, C_KV, C_KVL, C_INP}; pg8::StaticOrder S; S.init(MTOK, C_KV, G, bx);
                          pg8::EpiAff E{lnd((bf16*)(R + RC_KV)), C_KV, pg8::RowStat{nullptr, (const float*)(ws + WS_SSQC) + MTOK, 1.f / C_KVL, RMS_EPS, 2}, nullptr, nullptr, nullptr, nullptr};
                          pg8::gemm_phase<pg8::EpiAff, pg8::StaticOrder, PG8_ALIGN, PG8_SP2>(lds + RING_OFF, g, S, E, tid); }
                    }
                    SEAM();
                    PCAT(16);
                    if (IN_PH()) { PH_VARS attn_phase_c((const bf16*)(R + RC_Q), (const bf16*)(R + RC_KV), (const bf16*)(R + RC_KR), (bf16*)(R + RC_ATT), (const float*)(ws + WS_TABC), (LAS char*)(lds + RING_OFF), G, bx, tid); }
                    SEAM();
                }
            }
            PCAT(sub == 1 ? 13 : 11);
            if (IN_PH()) { PH_VARS
                const int cls_ = (bx & 7) >> 1; const int pm_before = (cls_ == 0) ? 3 : (cls_ == 1) ? 1 : (cls_ == 2) ? 2 : 0;
                if (pm_before) { CVT_NEXT(pm_before); __syncthreads(); }
                const bf16* A; const bf16* Bt; int K; float s;
                if (sub != 1) { A = (const bf16*)(R + R_ACT); Bt = WTB(si) + WT_FFN_OUT; K = DFF; s = 0.5f; }
                else if (kind == 0) { A = (const bf16*)(R + RA_ATT); Bt = WTB(si) + WT_A_OUT; K = DM; s = 1.0f; }
                else if (kind == 1) { A = (const bf16*)(R + RB_ATT); Bt = WTB(si) + WT_B_OUT; K = 1024; s = 1.0f; }
                else { A = (const bf16*)(R + RC_ATT); Bt = WTB(si) + WT_C_OUT; K = DM; s = 1.0f; }
                pg8::Gemm g{lnd(A), lnd(Bt), MTOK, DM, K, K, (sub != 1) ? 1 : 0}; pg8::StaticOrder S; S.init(MTOK, DM, G, bx);
                pg8::EpiResid2 E{lnd(HB), lnd(LO), STAT_SUM(si), STAT_SUM(si) + MTOK, arg_in(lnprev), arg_in(lnprev + 1), PREV_STAT(), DM, ALPHA, s};
                pg8::gemm_phase<pg8::EpiResid2, pg8::StaticOrder, PG8_ALIGN, PG8_SP2>(lds + RING_OFF, g, S, E, tid);
                if (pm_before != 3) { __syncthreads(); CVT_NEXT(3 ^ pm_before); }
            }
            SEAM();
        }
    }
    PCAT(2);
    if (IN_PH()) { PH_VARS ln_final(H32, HB, LO, STAT_SUM(11), STAT_SUM(11) + MTOK, arg_in(55), arg_in(56), gt, NGT); }
    SEAM();
    }
#if PROBE_CAT >= 0
    SEAM_BAR();
    { unsigned on3_ = ~0u; asm volatile("" : "+s"(on3_)); const int ln_ = (int)__builtin_amdgcn_mbcnt_hi(on3_, __builtin_amdgcn_mbcnt_lo(on3_, 0u));
      for (size_t i = (size_t)bx0 * 512 + wave * 64 + ln_; i < (size_t)MTOK * DM / 4; i += (size_t)G0 * 512) ((GAS f32x4*)out0)[i] = (f32x4){16.f, 16.f, 16.f, 16.f}; }
    SEAM_BAR();
    { unsigned on2_ = ~0u; asm volatile("" : "+s"(on2_)); if (bx0 == 0 && wave == 0 && __builtin_amdgcn_mbcnt_hi(on2_, __builtin_amdgcn_mbcnt_lo(on2_, 0u)) == 0u) { const unsigned long long tot = __builtin_amdgcn_s_memrealtime() - PR[2]; out0[0] = (PROBE_CAT == 5) ? ((float)tot * 1e-5f - 15.0f) * 100.0f : (float)PR[1] * ((PROBE_CAT >= 6 && PROBE_CAT != 10) ? 1e-3f : 1e-4f); } }
#endif
#undef IN_PH
#undef SEAM
}

extern "C" void kernel_launch(void* const* d_in, const int* in_sizes, int n_in, void* d_out, int out_size, void* d_ws, size_t ws_size, hipStream_t stream) {
    static int grid = 0;
    if (grid == 0) {
        if (n_in != N_IN || in_sizes[0] != MTOK * DM || out_size != MTOK * DM || ws_size < WS_END) {
            fprintf(stderr, "kernel_launch: shape mismatch: n_in %d in0 %d out %d ws %zu (need >= %zu)\n", n_in, n_in > 0 ? in_sizes[0] : -1, out_size, ws_size, (size_t)WS_END); grid = -1; return; }
        int dev = 0, cus = 0, per_cu = 0;
        if (hipGetDevice(&dev) != hipSuccess || hipDeviceGetAttribute(&cus, hipDeviceAttributeMultiprocessorCount, dev) != hipSuccess) { fprintf(stderr, "kernel_launch: device query failed\n"); grid = -1; return; }
        if (hipFuncSetAttribute((const void*)mega_fwd, hipFuncAttributeMaxDynamicSharedMemorySize, LDS_BYTES) != hipSuccess) { fprintf(stderr, "kernel_launch: hipFuncSetAttribute failed\n"); grid = -1; return; }
        if (hipOccupancyMaxActiveBlocksPerMultiprocessor(&per_cu, (const void*)mega_fwd, NWAVES * 64, LDS_BYTES) != hipSuccess || per_cu < 1)
            fprintf(stderr, "kernel_launch: note: occupancy query reports %d workgroups per CU\n", per_cu);
        (void)hipGetLastError();
        grid = cus;
    }
    if (grid < 0) return;
    if (hipMemsetAsync((char*)d_ws + WS_CTL, 0, CTL_ZERO_BYTES, stream) != hipSuccess) { fprintf(stderr, "kernel_launch: memset failed\n"); return; }
    Args a{};
    for (int i = 0; i < N_IN; ++i) a.in[i] = (const float*)d_in[i];
    a.out = (float*)d_out; a.ws = (unsigned char*)d_ws;
#if MK_PER_PHASE
    for (int p = 0; p < N_PHASES; ++p) { a.ph_lo = p; a.ph_hi = p + 1; hipLaunchKernelGGL(mega_fwd, dim3(grid), dim3(NWAVES * 64), LDS_BYTES, stream, a); }
#else
    a.ph_lo = 0; a.ph_hi = N_PHASES;
    hipLaunchKernelGGL(mega_fwd, dim3(grid), dim3(NWAVES * 64), LDS_BYTES, stream, a);
#if LAUNCH_TWICE
    (void)hipMemsetAsync((char*)d_ws + WS_CTL, 0, CTL_ZERO_BYTES, stream);
    hipLaunchKernelGGL(mega_fwd, dim3(grid), dim3(NWAVES * 64), LDS_BYTES, stream, a);
#endif
#endif
    const hipError_t le = hipPeekAtLastError();
    if (le != hipSuccess) fprintf(stderr, "kernel_launch: launch failed: %s\n", hipGetErrorName(le));
}
```

```cpp
#include <hip/hip_runtime.h>
#include <cstdio>
#include <cstdint>

#ifndef FAST_A
#define FAST_A 1
#endif
#ifndef FAST_B
#define FAST_B 1
#endif
#ifndef FAST_C
#define FAST_C 1
#endif
#ifndef EXP
#define EXP 0
#endif
#ifndef LAUNCH_TWICE
#define LAUNCH_TWICE 0
#endif
#ifndef REPS
#define REPS 1
#endif
#ifndef PROBE_CAT
#define PROBE_CAT -1
#endif
#ifndef MK_PER_PHASE
#define MK_PER_PHASE 0
#endif

namespace pg8 {
#define PG8_LAS __attribute__((address_space(3)))
typedef unsigned short bf16_t;
typedef short bf16x8 __attribute__((ext_vector_type(8)));
typedef float f32x4 __attribute__((ext_vector_type(4)));
typedef unsigned u32x4 __attribute__((ext_vector_type(4)));
typedef unsigned u32x2 __attribute__((ext_vector_type(2)));
typedef float f32x2_t __attribute__((ext_vector_type(2)));
__device__ __forceinline__ float lo_sc(float d) { return __builtin_amdgcn_fmed3f(d * 512.f, -240.f, 240.f); }
constexpr float LO_SCALE = 512.f, LO_INV = 1.f / 512.f;
constexpr int BM = 256, BK = 64, HALF = 128, HTB = HALF * BK * 2  , STAGE_BYTES = 8 * HTB, NXCD = 8, WGM = 8;

__host__ __device__ __forceinline__ int lds_byte(int r, int c) { const int st = (r >> 4) * 2 + (c >> 5), rr = r & 15, cc = c & 31, ob = rr * 64 + cc * 2; return st * 1024 + (ob ^ (((ob >> 9) & 1) << 5)); }
__host__ __device__ __forceinline__ void stage_rc(int b, int& R, int& C) { const int st = b / 1024, sb = b % 1024, swz = sb ^ (((sb >> 9) & 1) << 5); R = (st >> 1) * 16 + swz / 64; C = (st & 1) * 32 + (swz % 64) / 2; }
__host__ __device__ __forceinline__ int perm32(int rho) { const int n = rho >> 4, i = rho & 15; return 8 * (i >> 2) + 4 * n + (i & 3); }

struct Unit { int pm, pn; };
__host__ __device__ __forceinline__ size_t tl_off(int row, int col, int ntk) { return ((((size_t)(row >> 8) * (size_t)ntk + (size_t)(col >> 6)) * 256 + (size_t)(row & 255)) * 64) + (size_t)(col & 63); }
__host__ __device__ __forceinline__ size_t tl_off32(int row, int col, int ntk) { return (((((size_t)(row >> 8) * (size_t)ntk + (size_t)(col >> 6)) * 2 + (size_t)((col >> 5) & 1)) * 256 + (size_t)(row & 255)) * 32) + (size_t)(col & 31); }
struct Gemm { const bf16_t* A; const bf16_t* Bt; int M, N, K, lda; int tiledA = 0; };

struct StaticOrder {
    int nM, nN, nwg, G, c;
    __host__ __device__ void init(int M, int N, int G_, int c_) { nM = M / BM; nN = N / BM; nwg = nM * nN; G = G_; c = c_; }
    __host__ __device__ bool next(int i, Unit& u) const {
        const long L = (long)i * G + c; if (L >= nwg) return false;
        int wgid = (int)L; { const int q = nwg / NXCD, r = nwg % NXCD, xcd = wgid % NXCD, off = wgid / NXCD; wgid = (xcd < r ? xcd * (q + 1) : r * (q + 1) + (xcd - r) * q) + off; }
        const int nig = WGM * nN, gid = wgid / nig, fm = gid * WGM, gsz = (nM - fm) < WGM ? (nM - fm) : WGM;
        if (nN == 8 && gsz == WGM) { u.pm = fm + ((wgid % nig) >> 3); u.pn = (wgid % nig) & 7; }
        else { u.pm = fm + ((wgid % nig) % gsz); u.pn = (wgid % nig) / gsz; }
        return true;
    }
    __device__ __forceinline__ void a_ready(const Unit&) const {}
    __device__ __forceinline__ void done(const Unit&) const {}
};

__device__ __forceinline__ unsigned cvt_pk_bf16(float lo, float hi) { unsigned r; asm volatile("v_cvt_pk_bf16_f32 %0, %1, %2" : "=v"(r) : "v"(lo), "v"(hi)); return r; }

struct EpiBf16 {
    static constexpr bool PERM = true, AFTER_DRAIN = false;
    bf16_t* O; int ldc;
    __device__ __forceinline__ void operator()(const f32x4 (&acc)[2][2][4][2], const Unit& u, int wr, int wc, int fr, int fq) const {
        const int row0 = u.pm * BM + wr * 64 + fr; const int col0 = u.pn * BM + wc * 32 + 8 * fq;
#pragma unroll
        for (int ai = 0; ai < 2; ++ai)
#pragma unroll
            for (int m = 0; m < 4; ++m) { bf16_t* rowp = O + (size_t)(row0 + ai * HALF + m * 16) * ldc + col0;
#pragma unroll
                for (int bj = 0; bj < 2; ++bj) { const f32x4 v0 = acc[ai][bj][m][0], v1 = acc[ai][bj][m][1];
                    u32x4 w; w.x = cvt_pk_bf16(v0[0], v0[1]); w.y = cvt_pk_bf16(v0[2], v0[3]); w.z = cvt_pk_bf16(v1[0], v1[1]); w.w = cvt_pk_bf16(v1[2], v1[3]);
                    *(u32x4*)(rowp + bj * HALF) = w; } }
    }
};
__device__ __forceinline__ float silu_mul(float g, float u) { return g * u * __builtin_amdgcn_rcpf(1.0f + __builtin_amdgcn_exp2f(-1.4426950408889634f * g)); }
struct EpiSwiGLU {
    static constexpr bool PERM = true, AFTER_DRAIN = false;
    bf16_t* O; int ldc;
    __device__ __forceinline__ void operator()(const f32x4 (&acc)[2][2][4][2], const Unit& u, int wr, int wc, int fr, int fq) const {
        const int row0 = u.pm * BM + wr * 64 + fr; const int col0 = u.pn * HALF + wc * 32 + 8 * fq;
#pragma unroll
        for (int ai = 0; ai < 2; ++ai)
#pragma unroll
            for (int m = 0; m < 4; ++m) { bf16_t* rowp = O + (size_t)(row0 + ai * HALF + m * 16) * ldc + col0;
                const f32x4 g0 = acc[ai][0][m][0], g1 = acc[ai][0][m][1], u0 = acc[ai][1][m][0], u1 = acc[ai][1][m][1];
                u32x4 w; w.x = cvt_pk_bf16(silu_mul(g0[0], u0[0]), silu_mul(g0[1], u0[1])); w.y = cvt_pk_bf16(silu_mul(g0[2], u0[2]), silu_mul(g0[3], u0[3]));
                w.z = cvt_pk_bf16(silu_mul(g1[0], u1[0]), silu_mul(g1[1], u1[1])); w.w = cvt_pk_bf16(silu_mul(g1[2], u1[2]), silu_mul(g1[3], u1[3]));
                *(u32x4*)rowp = w; }
    }
};
struct EpiResid {
    static constexpr bool PERM = false, AFTER_DRAIN = false;
    const float* hin; float* hout; int ldc; float alpha, s;
    __device__ __forceinline__ void operator()(const f32x4 (&acc)[2][2][4][2], const Unit& u, int wr, int wc, int fr, int fq) const {
        const int row0 = u.pm * BM + wr * 64 + fr, col0 = u.pn * BM + wc * 32 + 4 * fq;
#pragma unroll
        for (int ai = 0; ai < 2; ++ai)
#pragma unroll
            for (int m = 0; m < 4; ++m) { const size_t off = (size_t)(row0 + ai * HALF + m * 16) * ldc + col0;
#pragma unroll
                for (int bj = 0; bj < 2; ++bj)
#pragma unroll
                    for (int n = 0; n < 2; ++n) { const f32x4 hv = *(const f32x4*)(hin + off + bj * HALF + n * 16); *(f32x4*)(hout + off + bj * HALF + n * 16) = hv * alpha + acc[ai][bj][m][n] * s; } }
    }
};


struct RowStat { const float* sum; const float* ssq; float inv_n, eps; int mode; };
__device__ __forceinline__ void row_stat(const RowStat& st, int row, float& rs, float& rm) {
    if (st.mode == 0 || EXP == 1) { rs = 1.f; rm = 0.f; }
    else { const float q = st.ssq[row] * st.inv_n;
        if (st.mode == 1) { const float mean = st.sum[row] * st.inv_n; rs = __builtin_amdgcn_rsqf(q - mean * mean + st.eps); rm = rs * mean; }
        else { rs = __builtin_amdgcn_rsqf(q + st.eps); rm = 0.f; } }
}
__device__ __forceinline__ void row_stat8(const RowStat& st, int row0, float (&rs)[8], float (&rm)[8]) {
    if (st.mode == 0 || EXP == 1) {
#pragma unroll
        for (int i = 0; i < 8; ++i) { rs[i] = 1.f; rm[i] = 0.f; }
    } else {
        float q[8], sm[8];
#pragma unroll
        for (int i = 0; i < 8; ++i) { const int row = row0 + (i >> 2) * HALF + (i & 3) * 16; q[i] = st.ssq[row]; sm[i] = 0.f; }
        if (st.mode == 1) {
#pragma unroll
            for (int i = 0; i < 8; ++i) { const int row = row0 + (i >> 2) * HALF + (i & 3) * 16; sm[i] = st.sum[row]; }
        }
#pragma unroll
        for (int i = 0; i < 8; ++i) { const float mean = sm[i] * st.inv_n; rs[i] = __builtin_amdgcn_rsqf(q[i] * st.inv_n - mean * mean + st.eps); rm[i] = rs[i] * mean; }
    }
}
struct EpiAff {
    static constexpr bool PERM = true, AFTER_DRAIN = false;
    bf16_t* O; int ldc; RowStat st; const float* u; const float* v; float* ssq_out;
    const float* rope;
    __device__ __forceinline__ void operator()(const f32x4 (&acc)[2][2][4][2], const Unit& un, int wr, int wc, int fr, int fq) const {
        const int row0 = un.pm * BM + wr * 64 + fr; const int col0 = un.pn * BM + wc * 32 + 8 * fq;
        f32x4 uu[2][2], vv[2][2];
#pragma unroll
        for (int bj = 0; bj < 2; ++bj)
#pragma unroll
            for (int n = 0; n < 2; ++n) { if (u) { uu[bj][n] = *(const f32x4*)(u + col0 + bj * HALF + 4 * n); vv[bj][n] = *(const f32x4*)(v + col0 + bj * HALF + 4 * n); } else { uu[bj][n] = (f32x4){0.f, 0.f, 0.f, 0.f}; vv[bj][n] = uu[bj][n]; } }
        float* sq = nullptr; if (ssq_out && un.pn < 5) sq = ssq_out + (un.pn < 3 ? 0 : 32768);
        const bool dorope = (rope != nullptr) && ((un.pn % 12) < 8);
        float rs8[8], rm8[8]; row_stat8(st, row0, rs8, rm8);
#pragma unroll
        for (int ai = 0; ai < 2; ++ai)
#pragma unroll
            for (int m = 0; m < 4; ++m) { const int row = row0 + ai * HALF + m * 16; const float rs = rs8[ai * 4 + m], rm = rm8[ai * 4 + m];
                bf16_t* rowp = O + (size_t)row * ldc + col0; float ss = 0.f;
                f32x4 rc = {1.f, 1.f, 1.f, 1.f}, rsn = {0.f, 0.f, 0.f, 0.f};
                if (dorope) { const float* tp = rope + (size_t)(row & 2047) * 64 + wc * 16 + 4 * fq; rc = *(const f32x4*)tp; rsn = *(const f32x4*)(tp + 2048 * 64); }
#pragma unroll
                for (int bj = 0; bj < 2; ++bj) { f32x4 v0 = acc[ai][bj][m][0] * rs + (vv[bj][0] - uu[bj][0] * rm), v1 = acc[ai][bj][m][1] * rs + (vv[bj][1] - uu[bj][1] * rm);
                    if (dorope) { const f32x4 a0 = v0, a1 = v1;
                        v0[0] = a0[0] * rc[0] - a0[1] * rsn[0]; v0[1] = a0[0] * rsn[0] + a0[1] * rc[0]; v0[2] = a0[2] * rc[1] - a0[3] * rsn[1]; v0[3] = a0[2] * rsn[1] + a0[3] * rc[1];
                        v1[0] = a1[0] * rc[2] - a1[1] * rsn[2]; v1[1] = a1[0] * rsn[2] + a1[1] * rc[2]; v1[2] = a1[2] * rc[3] - a1[3] * rsn[3]; v1[3] = a1[2] * rsn[3] + a1[3] * rc[3]; }
                    ss += (v0[0] * v0[0] + v0[1] * v0[1]) + (v0[2] * v0[2] + v0[3] * v0[3]) + (v1[0] * v1[0] + v1[1] * v1[1]) + (v1[2] * v1[2] + v1[3] * v1[3]);
                    u32x4 w; w.x = cvt_pk_bf16(v0[0], v0[1]); w.y = cvt_pk_bf16(v0[2], v0[3]); w.z = cvt_pk_bf16(v1[0], v1[1]); w.w = cvt_pk_bf16(v1[2], v1[3]);
                    *(u32x4*)(rowp + bj * HALF) = w; }
                if (sq) { ss += __shfl_xor(ss, 16); ss += __shfl_xor(ss, 32); if (fq == 0) __hip_atomic_fetch_add(sq + row, ss, __ATOMIC_RELAXED, __HIP_MEMORY_SCOPE_AGENT); } }
    }
};
struct EpiAffA {
    static constexpr bool PERM = true, AFTER_DRAIN = false;
    bf16_t* O; int ldc; RowStat st; const float* u; const float* v; const float* qg; const float* kg; const float* taba; PG8_LAS float* xch;
    __device__ __forceinline__ void operator()(f32x4 (&acc)[2][2][4][2], const Unit& un, int wr, int wc, int fr, int fq) const {
        const int row0 = un.pm * BM + wr * 64 + fr; const int col0 = un.pn * BM + wc * 32 + 8 * fq;
        const bool nr = un.pn < 10;
        { f32x4 uu[2][2], vv[2][2];
#pragma unroll
          for (int bj = 0; bj < 2; ++bj)
#pragma unroll
            for (int n = 0; n < 2; ++n) { uu[bj][n] = *(const f32x4*)(u + col0 + bj * HALF + 4 * n); vv[bj][n] = *(const f32x4*)(v + col0 + bj * HALF + 4 * n); }
          float rs8[8], rm8[8]; row_stat8(st, row0, rs8, rm8);
#pragma unroll
          for (int ai = 0; ai < 2; ++ai)
#pragma unroll
            for (int m = 0; m < 4; ++m) { const float rs = rs8[ai * 4 + m], rm = rm8[ai * 4 + m]; float sq[2];
#pragma unroll
                for (int bj = 0; bj < 2; ++bj) { const f32x4 v0 = acc[ai][bj][m][0] * rs + (vv[bj][0] - uu[bj][0] * rm), v1 = acc[ai][bj][m][1] * rs + (vv[bj][1] - uu[bj][1] * rm);
                    acc[ai][bj][m][0] = v0; acc[ai][bj][m][1] = v1;
                    sq[bj] = (v0[0] * v0[0] + v0[1] * v0[1]) + (v0[2] * v0[2] + v0[3] * v0[3]) + (v1[0] * v1[0] + v1[1] * v1[1]) + (v1[2] * v1[2] + v1[3] * v1[3]); }
                if (nr) { sq[0] += __shfl_xor(sq[0], 16); sq[0] += __shfl_xor(sq[0], 32); sq[1] += __shfl_xor(sq[1], 16); sq[1] += __shfl_xor(sq[1], 32);
                    if (fq == 0) { const int rl = ai * HALF + wr * 64 + m * 16 + fr; xch[(rl * 2 + 0) * 4 + wc] = sq[0]; xch[(rl * 2 + 1) * 4 + wc] = sq[1]; } } }
        }
        if (nr) { asm volatile("s_waitcnt lgkmcnt(0)" ::: "memory"); __builtin_amdgcn_s_barrier(); asm volatile("" ::: "memory"); }
        f32x4 ga = {1.f, 1.f, 1.f, 1.f}, gb = ga;
        const int hf = wc >> 1, ib = (wc & 1) * 16 + 4 * fq;
        if (nr) { const float* gp = (un.pn < 8) ? qg : kg; ga = *(const f32x4*)(gp + 64 * hf + ib); gb = *(const f32x4*)(gp + 64 * hf + ib + 32); }
#pragma unroll
        for (int ai = 0; ai < 2; ++ai)
#pragma unroll
            for (int m = 0; m < 4; ++m) { const int row = row0 + ai * HALF + m * 16; bf16_t* rowp = O + (size_t)row * ldc + col0;
                f32x4 rc = {1.f, 1.f, 1.f, 1.f}, rsn = {0.f, 0.f, 0.f, 0.f};
                if (nr) { const int sp = row & 2047, pos = hf ? (sp & 63) : (sp >> 6); const float* tp = taba + pos * 32 + ib; rc = *(const f32x4*)tp; rsn = *(const f32x4*)(tp + 64 * 32); }
#pragma unroll
                for (int bj = 0; bj < 2; ++bj) { f32x4 v0 = acc[ai][bj][m][0], v1 = acc[ai][bj][m][1];
                    if (nr) { const int rl = ai * HALF + wr * 64 + m * 16 + fr; const f32x4 pp = *(const PG8_LAS f32x4*)(xch + (rl * 2 + bj) * 4);
                        const float rn = __builtin_amdgcn_rsqf(((pp[0] + pp[1]) + (pp[2] + pp[3])) * (1.f / 128.f) + 1e-6f);
                        const float a0 = v0[0] * rn * ga[0], b0 = v0[1] * rn * gb[0], a1 = v0[2] * rn * ga[1], b1 = v0[3] * rn * gb[1], a2 = v1[0] * rn * ga[2], b2 = v1[1] * rn * gb[2], a3 = v1[2] * rn * ga[3], b3 = v1[3] * rn * gb[3];
                        v0[0] = a0 * rc[0] - b0 * rsn[0]; v0[1] = a0 * rsn[0] + b0 * rc[0]; v0[2] = a1 * rc[1] - b1 * rsn[1]; v0[3] = a1 * rsn[1] + b1 * rc[1];
                        v1[0] = a2 * rc[2] - b2 * rsn[2]; v1[1] = a2 * rsn[2] + b2 * rc[2]; v1[2] = a3 * rc[3] - b3 * rsn[3]; v1[3] = a3 * rsn[3] + b3 * rc[3]; }
                    u32x4 w; w.x = cvt_pk_bf16(v0[0], v0[1]); w.y = cvt_pk_bf16(v0[2], v0[3]); w.z = cvt_pk_bf16(v1[0], v1[1]); w.w = cvt_pk_bf16(v1[2], v1[3]);
                    *(u32x4*)(rowp + bj * HALF) = w; } }
    }
};
struct EpiAffSwiGLU {
    static constexpr bool PERM = true, AFTER_DRAIN = false;
    bf16_t* O; int ldc; RowStat st; const float* u; const float* v;
    __device__ __forceinline__ void operator()(const f32x4 (&acc)[2][2][4][2], const Unit& un, int wr, int wc, int fr, int fq) const {
        const int row0 = un.pm * BM + wr * 64 + fr; const int col0 = un.pn * HALF + wc * 32 + 8 * fq, ucol0 = un.pn * BM + wc * 32 + 8 * fq;
        f32x4 uu[2][2], vv[2][2];
#pragma unroll
        for (int bj = 0; bj < 2; ++bj)
#pragma unroll
            for (int n = 0; n < 2; ++n) { uu[bj][n] = *(const f32x4*)(u + ucol0 + bj * HALF + 4 * n); vv[bj][n] = *(const f32x4*)(v + ucol0 + bj * HALF + 4 * n); }
        float rs8[8], rm8[8]; row_stat8(st, row0, rs8, rm8);
#pragma unroll
        for (int ai = 0; ai < 2; ++ai)
#pragma unroll
            for (int m = 0; m < 4; ++m) { const int row = row0 + ai * HALF + m * 16; const float rs = rs8[ai * 4 + m], rm = rm8[ai * 4 + m];
                bf16_t* rowp = O + ((((size_t)(row >> 8) * (size_t)(ldc >> 6) + (size_t)(col0 >> 6)) * BM + (size_t)(row & 255)) * BK + (size_t)(col0 & 63));
                const f32x4 g0 = acc[ai][0][m][0] * rs + (vv[0][0] - uu[0][0] * rm), g1 = acc[ai][0][m][1] * rs + (vv[0][1] - uu[0][1] * rm);
                const f32x4 u0 = acc[ai][1][m][0] * rs + (vv[1][0] - uu[1][0] * rm), u1 = acc[ai][1][m][1] * rs + (vv[1][1] - uu[1][1] * rm);
                u32x4 w; w.x = cvt_pk_bf16(silu_mul(g0[0], u0[0]), silu_mul(g0[1], u0[1])); w.y = cvt_pk_bf16(silu_mul(g0[2], u0[2]), silu_mul(g0[3], u0[3]));
                w.z = cvt_pk_bf16(silu_mul(g1[0], u1[0]), silu_mul(g1[1], u1[1])); w.w = cvt_pk_bf16(silu_mul(g1[2], u1[2]), silu_mul(g1[3], u1[3]));
                *(u32x4*)rowp = w; }
    }
};
struct EpiResid2 {
    static constexpr bool PERM = true, AFTER_DRAIN = false;
    bf16_t* hi; unsigned char* lo; float* sum_out; float* ssq_out; const float* g; const float* b; RowStat st; int ldc; float alpha, s;
    __device__ __forceinline__ void operator()(const f32x4 (&acc)[2][2][4][2], const Unit& un, int wr, int wc, int fr, int fq) const {
        const int row0 = un.pm * BM + wr * 64 + fr, col0 = un.pn * BM + wc * 32 + 8 * fq;
        f32x4 gg[2][2], bb[2][2];
#pragma unroll
        for (int bj = 0; bj < 2; ++bj)
#pragma unroll
            for (int n = 0; n < 2; ++n) { if (st.mode != 0) { gg[bj][n] = *(const f32x4*)(g + col0 + bj * HALF + 4 * n); bb[bj][n] = *(const f32x4*)(b + col0 + bj * HALF + 4 * n); } else { gg[bj][n] = (f32x4){1.f, 1.f, 1.f, 1.f}; bb[bj][n] = (f32x4){0.f, 0.f, 0.f, 0.f}; } }
        u32x4 x[8][2]; u32x2 xl[8][2]; float q8[8], s8[8];
#define RS2_LOAD(gi) do { const int ai_ = (gi) >> 2, m_ = (gi) & 3; const int row_ = row0 + ai_ * HALF + m_ * 16; const size_t off_ = tl_off32(row_, col0, ldc >> 6); \
            _Pragma("unroll") for (int bj = 0; bj < 2; ++bj) { \
                x[gi][bj] = *(const u32x4*)(hi + off_ + bj * (2 * 256 * 64)); xl[gi][bj] = *(const u32x2*)(lo + off_ + bj * (2 * 256 * 64)); } \
            q8[gi] = 0.f; s8[gi] = 0.f; if (st.mode == 1 && EXP != 1) { q8[gi] = st.ssq[row_]; s8[gi] = st.sum[row_]; } } while (0)
        RS2_LOAD(0);
#pragma unroll
        for (int gi = 0; gi < 8; ++gi) { const int ai = gi >> 2, m = gi & 3;
            if (gi + 1 < 8) { if (gi == 0) RS2_LOAD(1); else if (gi == 1) RS2_LOAD(2); else if (gi == 2) RS2_LOAD(3); else if (gi == 3) RS2_LOAD(4); else if (gi == 4) RS2_LOAD(5); else if (gi == 5) RS2_LOAD(6); else RS2_LOAD(7); }
            __builtin_amdgcn_sched_barrier(0);
            const int row = row0 + ai * HALF + m * 16; float rs = 1.f, rm = 0.f;
            if (st.mode == 1 && EXP != 1) { const float mean = s8[gi] * st.inv_n; rs = __builtin_amdgcn_rsqf(q8[gi] * st.inv_n - mean * mean + st.eps); rm = rs * mean; }
            const size_t off = tl_off32(row, col0, ldc >> 6); float sm = 0.f, ss = 0.f;
#pragma unroll
            for (int bj = 0; bj < 2; ++bj) {
                f32x4 x0, x1;
                { const u32x4 hw = x[gi][bj]; const u32x2 lw = xl[gi][bj];
                    const f32x2_t l01 = __builtin_amdgcn_cvt_pk_f32_fp8((int)lw[0], false), l23 = __builtin_amdgcn_cvt_pk_f32_fp8((int)lw[0], true), l45 = __builtin_amdgcn_cvt_pk_f32_fp8((int)lw[1], false), l67 = __builtin_amdgcn_cvt_pk_f32_fp8((int)lw[1], true);
                    x0[0] = __uint_as_float(hw[0] << 16) + l01[0] * LO_INV; x0[1] = __uint_as_float(hw[0] & 0xffff0000u) + l01[1] * LO_INV;
                    x0[2] = __uint_as_float(hw[1] << 16) + l23[0] * LO_INV; x0[3] = __uint_as_float(hw[1] & 0xffff0000u) + l23[1] * LO_INV;
                    x1[0] = __uint_as_float(hw[2] << 16) + l45[0] * LO_INV; x1[1] = __uint_as_float(hw[2] & 0xffff0000u) + l45[1] * LO_INV;
                    x1[2] = __uint_as_float(hw[3] << 16) + l67[0] * LO_INV; x1[3] = __uint_as_float(hw[3] & 0xffff0000u) + l67[1] * LO_INV; }
                const f32x4 h0 = (x0 * rs - rm) * gg[bj][0] + bb[bj][0], h1 = (x1 * rs - rm) * gg[bj][1] + bb[bj][1];
                const f32x4 p0 = h0 * alpha + acc[ai][bj][m][0] * s, p1 = h1 * alpha + acc[ai][bj][m][1] * s;
                u32x4 w; w.x = cvt_pk_bf16(p0[0], p0[1]); w.y = cvt_pk_bf16(p0[2], p0[3]); w.z = cvt_pk_bf16(p1[0], p1[1]); w.w = cvt_pk_bf16(p1[2], p1[3]);
                int l0 = __builtin_amdgcn_cvt_pk_fp8_f32(lo_sc(p0[0] - __uint_as_float(w.x << 16)), lo_sc(p0[1] - __uint_as_float(w.x & 0xffff0000u)), 0, false);
                l0 = __builtin_amdgcn_cvt_pk_fp8_f32(lo_sc(p0[2] - __uint_as_float(w.y << 16)), lo_sc(p0[3] - __uint_as_float(w.y & 0xffff0000u)), l0, true);
                int l1 = __builtin_amdgcn_cvt_pk_fp8_f32(lo_sc(p1[0] - __uint_as_float(w.z << 16)), lo_sc(p1[1] - __uint_as_float(w.z & 0xffff0000u)), 0, false);
                l1 = __builtin_amdgcn_cvt_pk_fp8_f32(lo_sc(p1[2] - __uint_as_float(w.w << 16)), lo_sc(p1[3] - __uint_as_float(w.w & 0xffff0000u)), l1, true);
                *(u32x4*)(hi + off + bj * (2 * 256 * 64)) = w; *(u32x2*)(lo + off + bj * (2 * 256 * 64)) = (u32x2){(unsigned)l0, (unsigned)l1};
                sm += ((p0[0] + p0[1]) + (p0[2] + p0[3])) + ((p1[0] + p1[1]) + (p1[2] + p1[3]));
                ss += (p0[0] * p0[0] + p0[1] * p0[1]) + (p0[2] * p0[2] + p0[3] * p0[3]) + (p1[0] * p1[0] + p1[1] * p1[1]) + (p1[2] * p1[2] + p1[3] * p1[3]); }
            sm += __shfl_xor(sm, 16); sm += __shfl_xor(sm, 32); ss += __shfl_xor(ss, 16); ss += __shfl_xor(ss, 32);
            if (fq == 0 && EXP != 1) { __hip_atomic_fetch_add(sum_out + row, sm, __ATOMIC_RELAXED, __HIP_MEMORY_SCOPE_AGENT); __hip_atomic_fetch_add(ssq_out + row, ss, __ATOMIC_RELAXED, __HIP_MEMORY_SCOPE_AGENT); }
        }
#undef RS2_LOAD
    }
};

template <class Epi, class Sched, bool ALIGN_EPI = false, bool SP2 = false>
__device__ __forceinline__ void gemm_phase(PG8_LAS unsigned char* lds, const Gemm g, const Sched& S, const Epi& E, int tid_) {
    asm volatile("" : "+v"(tid_));
    const int tid = tid_, wid = __builtin_amdgcn_readfirstlane(tid >> 6), lane = tid & 63, wr = wid >> 2, wc = wid & 3, fr = lane & 15, fq = lane >> 4;
    const int K = g.K, nt = K / BK;
    unsigned voffA[2], voffB[2];
#pragma unroll
    for (int i = 0; i < 2; ++i) { int R, C; stage_rc(tid * 16 + i * 8192, R, C); const int Rb = Epi::PERM ? ((R & ~31) + perm32(R & 31)) : R;
        voffA[i] = (g.tiledA == 2) ? (unsigned)((C >> 5) * (BM * 32) + R * 32 + (C & 31)) * 2u : (unsigned)(R * (g.tiledA ? BK : g.lda) + C) * 2u; voffB[i] = (unsigned)(Rb * BK + C) * 2u; }
    const size_t kstepR = (size_t)(BK * 2), kstep = (size_t)(BM * BK * 2)  , kstepA = g.tiledA ? (size_t)(BM * BK * 2) : kstepR;
    const size_t hstep = (size_t)(HALF * BK * 2), hstepA = (g.tiledA == 2) ? (size_t)(HALF * 32 * 2) : g.tiledA ? (size_t)(HALF * BK * 2) : (size_t)HALF * g.lda * 2;
    const size_t tstep = (size_t)nt * (BM * BK * 2), tstepA = g.tiledA ? (size_t)nt * (BM * BK * 2) : 2 * hstepA;
    const unsigned ldsw = (unsigned)wid * 1024u;
    const int aoff = lds_byte(wr * 64 + fr, fq * 8), boff = lds_byte(wc * 32 + fr, fq * 8);
#define PG8_SA(b, h) (((b) * 2 + (h)) * HTB)
#define PG8_SB(b, h) ((4 + (b) * 2 + (h)) * HTB)
#define PG8_STAGE(bufoff, gbase, voff) do { _Pragma("unroll") for (int _i = 0; _i < 2; ++_i) \
        __builtin_amdgcn_global_load_lds((const unsigned*)((const char*)(gbase) + (voff)[_i]), (PG8_LAS unsigned*)(lds + (bufoff) + ldsw + _i * 8192), 16, 0, 0); } while (0)
#define PG8_LDA(dst, b, h) do { _Pragma("unroll") for (int m = 0; m < 4; ++m) _Pragma("unroll") for (int k = 0; k < 2; ++k) dst[m][k] = *(const PG8_LAS bf16x8*)(lds + PG8_SA(b, h) + aoff + m * 2048 + k * 1024); } while (0)
#define PG8_LDB(dst, b, h) do { _Pragma("unroll") for (int n = 0; n < 2; ++n) _Pragma("unroll") for (int k = 0; k < 2; ++k) dst[n][k] = *(const PG8_LAS bf16x8*)(lds + PG8_SB(b, h) + boff + n * 2048 + k * 1024); } while (0)
#define PG8_MMA(ai, bj, At, Bt) do { __builtin_amdgcn_s_setprio(1); _Pragma("unroll") for (int m = 0; m < 4; ++m) _Pragma("unroll") for (int n = 0; n < 2; ++n) _Pragma("unroll") for (int k = 0; k < 2; ++k) \
        acc[ai][bj][m][n] = __builtin_amdgcn_mfma_f32_16x16x32_bf16(Bt[n][k], At[m][k], acc[ai][bj][m][n], 0, 0, 0); __builtin_amdgcn_s_setprio(0); } while (0)
#define PG8_WAIT_V(n) asm volatile("s_waitcnt vmcnt(" #n ")" ::: "memory")
#define PG8_WAIT_L(n) asm volatile("s_waitcnt lgkmcnt(" #n ")" ::: "memory")
#define PG8_BAR __builtin_amdgcn_s_barrier()
#define PG8_SCHED __builtin_amdgcn_sched_barrier(0)
    Unit cur, nxt; int ui = 0;
    if (!S.next(0, cur)) return;
    f32x4 acc[2][2][4][2];
#pragma unroll
    for (int a = 0; a < 2; ++a)
#pragma unroll
        for (int b = 0; b < 2; ++b)
#pragma unroll
            for (int m = 0; m < 4; ++m)
#pragma unroll
                for (int n = 0; n < 2; ++n) acc[a][b][m][n] = (f32x4){0.f, 0.f, 0.f, 0.f};
    bf16x8 At[4][2], B0[2][2], B1[2][2];
    const char* cA = (const char*)g.A + (size_t)cur.pm * tstepA; const char* cB = (const char*)g.Bt + (size_t)cur.pn * tstep;
    S.a_ready(cur);
    if constexpr (SP2) {
        PG8_STAGE(PG8_SB(0, 0), cB, voffB); PG8_STAGE(PG8_SB(0, 1), cB + hstep, voffB); PG8_STAGE(PG8_SA(0, 0), cA, voffA); PG8_STAGE(PG8_SA(0, 1), cA + hstepA, voffA);
        if (wr == 1) PG8_BAR;
        PG8_WAIT_V(2); PG8_BAR;
        PG8_STAGE(PG8_SB(1, 0), cB + kstep, voffB); PG8_STAGE(PG8_SA(1, 0), cA + kstepA, voffA); PG8_STAGE(PG8_SB(1, 1), cB + hstep + kstep, voffB);
        PG8_WAIT_V(6); PG8_BAR;
    } else {
        PG8_STAGE(PG8_SB(0, 0), cB, voffB); PG8_STAGE(PG8_SA(0, 0), cA, voffA); PG8_STAGE(PG8_SB(0, 1), cB + hstep, voffB); PG8_STAGE(PG8_SA(0, 1), cA + hstepA, voffA);
        if (wr == 1) PG8_BAR;
        PG8_WAIT_V(4); PG8_BAR;
        PG8_STAGE(PG8_SB(1, 0), cB + kstep, voffB); PG8_STAGE(PG8_SA(1, 0), cA + kstepA, voffA); PG8_STAGE(PG8_SB(1, 1), cB + hstep + kstep, voffB);
        PG8_WAIT_V(6); PG8_BAR;
    }
    for (;;) {
        const bool has_next = S.next(ui + 1, nxt);
        const char* nA = has_next ? (const char*)g.A + (size_t)nxt.pm * tstepA : cA; const char* nB = has_next ? (const char*)g.Bt + (size_t)nxt.pn * tstep : cB;
        for (int t = 0; t < nt; t += 2) {
            const bool last = (t == nt - 2);
            const char* a1 = cA + (size_t)(t + 1) * kstepA;
            const char* a2 = last ? nA : cA + (size_t)(t + 2) * kstepA; const char* b2 = last ? nB : cB + (size_t)(t + 2) * kstep;
            const char* a3 = a2 + kstepA; const char* b3 = b2 + kstep;
            if (last && has_next) S.a_ready(nxt);
            if constexpr (SP2) {
            PG8_LDB(B0, 0, 0); PG8_LDB(B1, 0, 1); PG8_SCHED; PG8_LDA(At, 0, 0); PG8_STAGE(PG8_SA(1, 1), a1 + hstepA, voffA);
            PG8_WAIT_V(8); PG8_WAIT_L(0); PG8_BAR; PG8_MMA(0, 0, At, B0); PG8_MMA(0, 1, At, B1); PG8_BAR; PG8_SCHED;
            PG8_LDA(At, 0, 1); PG8_STAGE(PG8_SB(0, 0), b2, voffB); PG8_STAGE(PG8_SB(0, 1), b2 + hstep, voffB); PG8_STAGE(PG8_SA(0, 0), a2, voffA);
            PG8_WAIT_V(8); PG8_WAIT_L(0); PG8_BAR; PG8_MMA(1, 0, At, B0); PG8_MMA(1, 1, At, B1); PG8_BAR; PG8_SCHED;
            PG8_LDB(B0, 1, 0); PG8_LDB(B1, 1, 1); PG8_SCHED; PG8_LDA(At, 1, 0); PG8_STAGE(PG8_SA(0, 1), a2 + hstepA, voffA);
            PG8_WAIT_V(8); PG8_WAIT_L(0); PG8_BAR; PG8_MMA(0, 0, At, B0); PG8_MMA(0, 1, At, B1); PG8_BAR; PG8_SCHED;
            PG8_LDA(At, 1, 1); PG8_STAGE(PG8_SB(1, 0), b3, voffB); PG8_STAGE(PG8_SB(1, 1), b3 + hstep, voffB); PG8_STAGE(PG8_SA(1, 0), a3, voffA);
            PG8_WAIT_V(8); PG8_WAIT_L(0); PG8_BAR; PG8_MMA(1, 0, At, B0); PG8_MMA(1, 1, At, B1); PG8_BAR; PG8_SCHED;
            } else {
            PG8_LDB(B0, 0, 0); PG8_SCHED; PG8_LDA(At, 0, 0); PG8_STAGE(PG8_SA(1, 1), a1 + hstepA, voffA);
            PG8_WAIT_L(8); PG8_BAR; PG8_WAIT_L(0); PG8_MMA(0, 0, At, B0); PG8_BAR; PG8_SCHED;
            PG8_LDB(B1, 0, 1); PG8_STAGE(PG8_SB(0, 0), b2, voffB);
            PG8_BAR; PG8_WAIT_L(0); PG8_MMA(0, 1, At, B1); PG8_BAR;
            PG8_LDA(At, 0, 1); PG8_STAGE(PG8_SA(0, 0), a2, voffA);
            PG8_BAR; PG8_WAIT_L(0); PG8_MMA(1, 0, At, B0); PG8_BAR; PG8_SCHED;
            PG8_STAGE(PG8_SB(0, 1), b2 + hstep, voffB);
            PG8_WAIT_V(6); PG8_BAR; PG8_MMA(1, 1, At, B1); PG8_BAR;
            PG8_LDB(B0, 1, 0); PG8_SCHED; PG8_LDA(At, 1, 0); PG8_STAGE(PG8_SA(0, 1), a2 + hstepA, voffA);
            PG8_WAIT_L(8); PG8_BAR; PG8_WAIT_L(0); PG8_MMA(0, 0, At, B0); PG8_BAR; PG8_SCHED;
            PG8_LDB(B1, 1, 1); PG8_STAGE(PG8_SB(1, 0), b3, voffB);
            PG8_BAR; PG8_WAIT_L(0); PG8_MMA(0, 1, At, B1); PG8_BAR;
            PG8_LDA(At, 1, 1); PG8_STAGE(PG8_SA(1, 0), a3, voffA);
            PG8_BAR; PG8_WAIT_L(0); PG8_MMA(1, 0, At, B0); PG8_BAR; PG8_SCHED;
            PG8_STAGE(PG8_SB(1, 1), b3 + hstep, voffB);
            PG8_WAIT_V(6); PG8_BAR; PG8_MMA(1, 1, At, B1); PG8_BAR;
            }
        }
        if constexpr (ALIGN_EPI) { if (wr == 0) PG8_BAR; }
#if PROBE_CAT == 20 || PROBE_CAT == 21
        { const unsigned long long te0_ = __builtin_amdgcn_s_memrealtime();
          E(acc, cur, wr, wc, fr, fq);
          asm volatile("s_waitcnt vmcnt(0)" ::: "memory");
          if (wid == 0) { volatile PG8_LAS unsigned long long* PRx = (volatile PG8_LAS unsigned long long*)(lds + 131072 + 320 + 64); volatile PG8_LAS unsigned* MISCx = (volatile PG8_LAS unsigned*)(lds + 131072 + 320);
            if (MISCx[22] == (PROBE_CAT == 20 ? 10u : 11u)) PRx[1] = PRx[1] + (__builtin_amdgcn_s_memrealtime() - te0_); } }
#else
        if constexpr (!Epi::AFTER_DRAIN) { E(acc, cur, wr, wc, fr, fq); S.done(cur); }
#endif
        if (!has_next) break;
#pragma unroll
        for (int a = 0; a < 2; ++a)
#pragma unroll
            for (int b = 0; b < 2; ++b)
#pragma unroll
                for (int m = 0; m < 4; ++m)
#pragma unroll
                    for (int n = 0; n < 2; ++n) acc[a][b][m][n] = (f32x4){0.f, 0.f, 0.f, 0.f};
        cur = nxt; cA = nA; cB = nB; ++ui;
        if constexpr (ALIGN_EPI) { if (wr == 1) PG8_BAR; }
    }
    PG8_WAIT_V(0);
    if constexpr (!ALIGN_EPI) { if (wr == 0) PG8_BAR; }
    PG8_BAR;
#undef PG8_SA
#undef PG8_SB
#undef PG8_STAGE
#undef PG8_LDA
#undef PG8_LDB
#undef PG8_MMA
#undef PG8_WAIT_V
#undef PG8_WAIT_L
#undef PG8_BAR
#undef PG8_SCHED
}
}

#ifndef PG8_SP2
#define PG8_SP2 true
#endif
#ifndef PG8_ALIGN
#define PG8_ALIGN true
#endif

constexpr int NWAVES = 8;
constexpr int BATCH = 16, SEQ = 2048, DM = 2048, DFF = 5632, MTOK = BATCH * SEQ, DEPTH = 4;
constexpr float ALPHA = 1.6817928305074292f;
constexpr float LN_EPS = 1e-5f, RMS_EPS = 1e-6f;
constexpr int A_QKV = 3072, B_QKV = 9216, C_IN = 1344, C_INP = 1536, C_QL = 768, C_KVL = 512, C_Q = 3072, C_KV = 4096;

constexpr size_t MiB = 1u << 20;
constexpr size_t WS_CTL = 0, CTL_ZERO_BYTES = 64 * 1024, DEV_ZERO_END = 8 * MiB;
constexpr size_t WS_STAT = 1 * MiB;
constexpr size_t WS_SSQC = 4 * MiB;
constexpr size_t WS_UV = 5 * MiB;
constexpr size_t WS_TABB = 8 * MiB;
constexpr size_t WS_TABC = 9 * MiB;
constexpr size_t WS_TABA = 10 * MiB;
constexpr size_t WS_WT = 12 * MiB;
constexpr size_t WT_BUF = 72 * MiB;
constexpr size_t WS_HB = 156 * MiB;
constexpr size_t WS_LO = 284 * MiB;
constexpr size_t WS_R = 412 * MiB;
constexpr size_t WS_END = WS_R + 900 * MiB;
constexpr int UV_STRIDE = 2 * 11264;
constexpr size_t WT_FFN_OUT = (size_t)2 * DFF * DM;
constexpr size_t WT_A_OUT = (size_t)A_QKV * DM, WT_B_OUT = (size_t)B_QKV * DM;
constexpr size_t WT_C_QUP = (size_t)C_INP * DM, WT_C_KVUP = WT_C_QUP + (size_t)C_Q * C_QL, WT_C_OUT = WT_C_KVUP + (size_t)C_KV * C_KVL;
constexpr size_t R_ACT = 0;
constexpr size_t RA_QKV = 0, RA_ATT = 192 * MiB;
constexpr size_t RB_QKV = 0, RB_ATT = 576 * MiB, RB_OG = 640 * MiB, RB_LSE = 832 * MiB;
constexpr size_t RC_IN = 0, RC_QN = 96 * MiB, RC_KVN = 144 * MiB, RC_KR = 176 * MiB, RC_Q = 192 * MiB, RC_KV = 384 * MiB, RC_ATT = 640 * MiB;
constexpr int CW_BAR = 4096;

constexpr int RING_OFF = 0, RING_BYTES = 131072;
constexpr int LDSCTL_OFF = RING_BYTES, MISC_OFF = LDSCTL_OFF + 320;
constexpr int XCH_OFF = RING_BYTES + 4096;
constexpr int LDS_BYTES = 147456;

#define GAS __attribute__((address_space(1)))
#define LAS __attribute__((address_space(3)))
typedef unsigned short bf16;
typedef unsigned v4u __attribute__((ext_vector_type(4)));
typedef unsigned v2u __attribute__((ext_vector_type(2)));
typedef float f32x4 __attribute__((ext_vector_type(4)));
typedef float f32x2 __attribute__((ext_vector_type(2)));
typedef GAS unsigned gu32;
#define RLX_AGENT __ATOMIC_RELAXED, __HIP_MEMORY_SCOPE_AGENT
#define LDS_WAIT() asm volatile("s_waitcnt lgkmcnt(0)" ::: "memory")
#define VM_WAIT() asm volatile("s_waitcnt vmcnt(0)" ::: "memory")
__device__ __forceinline__ unsigned f2bf(float f) { unsigned u = __builtin_bit_cast(unsigned, f); return (u + 0x7fffu + ((u >> 16) & 1u)) >> 16; }
__device__ __forceinline__ unsigned pk2(float lo, float hi) { return f2bf(lo) | (f2bf(hi) << 16); }
__device__ __forceinline__ float bflo(unsigned w) { return __uint_as_float(w << 16); }
__device__ __forceinline__ float bfhi(unsigned w) { return __uint_as_float(w & 0xffff0000u); }
__device__ __forceinline__ float bf1(bf16 b) { return __uint_as_float(((unsigned)b) << 16); }
__device__ __forceinline__ void unpack8(const v4u w, float (&x)[8]) { x[0] = bflo(w.x); x[1] = bfhi(w.x); x[2] = bflo(w.y); x[3] = bfhi(w.y); x[4] = bflo(w.z); x[5] = bfhi(w.z); x[6] = bflo(w.w); x[7] = bfhi(w.w); }
__device__ __forceinline__ void unpack8_lo(const v2u w, float (&x)[8]) { const f32x2 a = __builtin_amdgcn_cvt_pk_f32_fp8((int)w.x, false), b = __builtin_amdgcn_cvt_pk_f32_fp8((int)w.x, true), c = __builtin_amdgcn_cvt_pk_f32_fp8((int)w.y, false), d = __builtin_amdgcn_cvt_pk_f32_fp8((int)w.y, true);
    x[0] = a[0] * pg8::LO_INV; x[1] = a[1] * pg8::LO_INV; x[2] = b[0] * pg8::LO_INV; x[3] = b[1] * pg8::LO_INV; x[4] = c[0] * pg8::LO_INV; x[5] = c[1] * pg8::LO_INV; x[6] = d[0] * pg8::LO_INV; x[7] = d[1] * pg8::LO_INV; }
__device__ __forceinline__ v2u pack8_lo(float e0, float e1, float e2, float e3, float e4, float e5, float e6, float e7) {
    int a = __builtin_amdgcn_cvt_pk_fp8_f32(pg8::lo_sc(e0), pg8::lo_sc(e1), 0, false); a = __builtin_amdgcn_cvt_pk_fp8_f32(pg8::lo_sc(e2), pg8::lo_sc(e3), a, true);
    int b = __builtin_amdgcn_cvt_pk_fp8_f32(pg8::lo_sc(e4), pg8::lo_sc(e5), 0, false); b = __builtin_amdgcn_cvt_pk_fp8_f32(pg8::lo_sc(e6), pg8::lo_sc(e7), b, true);
    return (v2u){(unsigned)a, (unsigned)b}; }
__device__ __forceinline__ v4u pack8(const float (&x)[8]) { v4u w; w.x = pk2(x[0], x[1]); w.y = pk2(x[2], x[3]); w.z = pk2(x[4], x[5]); w.w = pk2(x[6], x[7]); return w; }

#define XB_TMO      128
#define XB_XCNT(j)  (256  + 64 * (j))
#define XB_XSUB(j)  (1280 + 64 * (j))
#define XB_XGEN(j)  (2304 + 64 * (j))
#define XB_TOP      3328
#define XB_TOPGEN   3392
#define XCD_BAR_WORDS 3456
#define XB_SPIN_CAP (1u << 22)
__device__ __forceinline__ unsigned xb_ld(unsigned* p)              { return __hip_atomic_load(p, __ATOMIC_RELAXED, __HIP_MEMORY_SCOPE_AGENT); }
__device__ __forceinline__ unsigned xb_add(unsigned* p, unsigned v) { return __hip_atomic_fetch_add(p, v, __ATOMIC_RELAXED, __HIP_MEMORY_SCOPE_AGENT); }
__device__ __forceinline__ unsigned xb_xcc_id() { return (unsigned)__builtin_amdgcn_s_getreg((3 << 11) | 20) & 0xFu; }
#define XB_SPIN(cond, bar) do { unsigned _sp = 0; while (cond) { __builtin_amdgcn_s_sleep(1); \
    if ((++_sp & 255u) == 0u) { if (xb_ld(&(bar)[XB_TMO])) break; if (_sp > XB_SPIN_CAP) { atomicAdd(&(bar)[XB_TMO], 1u); break; } } } } while (0)
struct XcdBarrier { unsigned* bar; unsigned x; volatile LAS unsigned* st; };
__device__ __forceinline__ XcdBarrier xcd_barrier_post(unsigned* bar, volatile LAS unsigned* st) {
    XcdBarrier b; b.bar = bar; b.x = xb_xcc_id(); b.st = st;
    if (threadIdx.x == 0) (void)xb_add(&bar[XB_XCNT(b.x)], 1u);
    return b;
}
__device__ __forceinline__ void xcd_barrier_complete(unsigned* bar, unsigned x, unsigned& nloc, unsigned& nx) {
    const unsigned G = gridDim.x * gridDim.y * gridDim.z;
    unsigned sum, cnt, mine, sp = 0u;
    for (;;) {
        sum = 0u; cnt = 0u; mine = 0u;
#pragma unroll
        for (unsigned j = 0; j < 16; ++j) { const unsigned c = xb_ld(&bar[XB_XCNT(j)]); sum += c; cnt += (c > 0u) ? 1u : 0u; mine = (j == x) ? c : mine; }
        if (sum == G) break;
        __builtin_amdgcn_s_sleep(1);
        if ((++sp & 255u) == 0u) { if (xb_ld(&bar[XB_TMO])) break; if (sp > XB_SPIN_CAP) { atomicAdd(&bar[XB_TMO], 1u); break; } }
    }
    nloc = mine > 0u ? mine : 1u; nx = cnt > 0u ? cnt : 1u;
}
__device__ __forceinline__ void xcd_barrier(const XcdBarrier& b, const int tid) {
    asm volatile("s_waitcnt vmcnt(0)" ::: "memory");
    __syncthreads();
    if (tid == 0) {
        unsigned* bar = b.bar; unsigned bx_ = b.x;
        asm volatile("" : "+s"(bar), "+s"(bx_));
        __builtin_amdgcn_s_waitcnt(0);
        unsigned nloc = b.st[0], nx = b.st[1];
        if (nloc == 0u) { xcd_barrier_complete(bar, bx_, nloc, nx); b.st[0] = nloc; b.st[1] = nx; }
        const unsigned old = xb_add(&bar[XB_XSUB(bx_)], 1u);
        const unsigned gen = old / nloc;
        if (old + 1u == (gen + 1u) * nloc) {
            __builtin_amdgcn_fence(__ATOMIC_RELEASE, "agent");
            asm volatile("s_waitcnt vmcnt(0)" ::: "memory");
            const unsigned og = xb_add(&bar[XB_TOP], 1u);
            const unsigned tg = og / nx;
            if (og + 1u == (tg + 1u) * nx) xb_add(&bar[XB_TOPGEN], 1u);
            else XB_SPIN(xb_ld(&bar[XB_TOPGEN]) == tg, bar);
            __builtin_amdgcn_fence(__ATOMIC_ACQUIRE, "agent");
            xb_add(&bar[XB_XGEN(bx_)], 1u);
            asm volatile("s_waitcnt vmcnt(0)" ::: "memory");
        } else {
            XB_SPIN(xb_ld(&bar[XB_XGEN(bx_)]) == gen, bar);
            __builtin_amdgcn_fence(__ATOMIC_ACQUIRE, "agent");
            asm volatile("s_waitcnt vmcnt(0)" ::: "memory");
        }
    }
    __syncthreads();
}

template <class T> __device__ __forceinline__ T* lnd(T* p) { asm volatile("" : "+s"(p)); return p; }
__device__ __forceinline__ float wave_sum(float v) {
#pragma unroll
    for (int o = 1; o < 64; o <<= 1) v += __shfl_xor(v, o);
    return v;
}
__device__ __forceinline__ int cvt_weight(const float* W, int K, int Nsrc, bf16* WT, int Ndst, int kind, const float* gk, const float* bk, float* uo, float* vo, LAS unsigned char* lds, int tile_off, int G, int bx, int tid) {
    asm volatile("" : "+v"(tid));
    const int wave = tid >> 6, lane = tid & 63;
    const int ntn = Ndst / 256, ntiles = (K / 64) * ntn;
    int t = ((bx - tile_off) % G + G) % G;
    f32x4 r[8];
#define CVT_LOAD(tt) do { const int kb_ = (tt) / ntn, tn_ = (tt) % ntn; int c_; \
        if (kind == 1) c_ = (lane < 32) ? (128 * tn_ + 4 * lane) : (DFF + 128 * tn_ + 4 * (lane - 32)); else c_ = 256 * tn_ + 4 * lane; \
        const bool ok_ = (kind == 1) || (c_ < Nsrc); const GAS float* src_ = (const GAS float*)W + (size_t)(64 * kb_ + 8 * wave) * Nsrc + (ok_ ? c_ : 0); \
        if (kind == 3 && tn_ < 10) {   \
            const GAS float* sp_ = (const GAS float*)W + (size_t)(64 * kb_ + 8 * wave) * Nsrc + 256 * tn_ + 128 * (lane >> 5) + 64 * ((lane >> 4) & 1) + 2 * (lane & 15); \
            _Pragma("unroll") for (int i_ = 0; i_ < 8; ++i_) { const f32x2 a_ = __builtin_nontemporal_load((const GAS f32x2*)(sp_ + (size_t)i_ * Nsrc)), b_ = __builtin_nontemporal_load((const GAS f32x2*)(sp_ + (size_t)i_ * Nsrc + 32)); r[i_] = (f32x4){a_.x, b_.x, a_.y, b_.y}; } \
        } else if (kind == 2 && (tn_ % 12) < 8) {   \
            const GAS float* sp_ = (const GAS float*)W + (size_t)(64 * kb_ + 8 * wave) * Nsrc + 256 * tn_ + 128 * (lane >> 5) + 2 * (lane & 31); \
            _Pragma("unroll") for (int i_ = 0; i_ < 8; ++i_) { const f32x2 a_ = __builtin_nontemporal_load((const GAS f32x2*)(sp_ + (size_t)i_ * Nsrc)), b_ = __builtin_nontemporal_load((const GAS f32x2*)(sp_ + (size_t)i_ * Nsrc + 64)); r[i_] = (f32x4){a_.x, b_.x, a_.y, b_.y}; } \
        } else { \
        _Pragma("unroll") for (int i_ = 0; i_ < 8; ++i_) { r[i_] = ok_ ? __builtin_nontemporal_load((const GAS f32x4*)(src_ + (size_t)i_ * Nsrc)) : (f32x4){0.f, 0.f, 0.f, 0.f}; } } } while (0)
    if (t < ntiles) CVT_LOAD(t);
    int buf = 0;
    const int c = lane & 7, nl = lane >> 3;
    for (; t < ntiles; t += G) {
        LAS unsigned char* tb = lds + buf * 65536;
#pragma unroll
        for (int i = 0; i < 8; ++i) { const int k = 8 * wave + i; *(LAS f32x4*)(tb + k * 1024 + ((lane ^ (wave & 7)) << 4)) = r[i]; }
        const int kb = t / ntn, tn = t % ntn, k0 = 64 * kb, n0 = 256 * tn;
        if (t + G < ntiles) CVT_LOAD(t + G);
        __syncthreads();
        f32x4 g0 = {1.f, 1.f, 1.f, 1.f}, g1 = g0, b0 = {0.f, 0.f, 0.f, 0.f}, b1 = b0;
        if (gk) { g0 = *(const GAS f32x4*)(gk + k0 + 8 * c); g1 = *(const GAS f32x4*)(gk + k0 + 8 * c + 4); }
        if (uo && bk) { b0 = *(const GAS f32x4*)(bk + k0 + 8 * c); b1 = *(const GAS f32x4*)(bk + k0 + 8 * c + 4); }
#pragma unroll
        for (int j = 0; j < 4; ++j) { const int n = 32 * wave + 8 * j + nl;
            float w[8];
#pragma unroll
            for (int e = 0; e < 8; ++e) w[e] = *(const LAS float*)(tb + (8 * c + e) * 1024 + ((((n >> 2) ^ c) & 63) << 4) + (n & 3) * 4);
            float us = 0.f, vs = 0.f;
            vs = w[0] * b0[0] + w[1] * b0[1] + w[2] * b0[2] + w[3] * b0[3] + w[4] * b1[0] + w[5] * b1[1] + w[6] * b1[2] + w[7] * b1[3];
            w[0] *= g0[0]; w[1] *= g0[1]; w[2] *= g0[2]; w[3] *= g0[3]; w[4] *= g1[0]; w[5] *= g1[1]; w[6] *= g1[2]; w[7] *= g1[3];
            us = ((w[0] + w[1]) + (w[2] + w[3])) + ((w[4] + w[5]) + (w[6] + w[7]));
            v4u o; o.x = pk2(w[0], w[1]); o.y = pk2(w[2], w[3]); o.z = pk2(w[4], w[5]); o.w = pk2(w[6], w[7]);
            *(GAS v4u*)(WT + ((size_t)tn * (size_t)(K / 64) + (size_t)kb) * (256 * 64) + (size_t)n * 64 + 8 * c) = o;
            if (uo) { us += __shfl_xor(us, 1); us += __shfl_xor(us, 2); us += __shfl_xor(us, 4); vs += __shfl_xor(vs, 1); vs += __shfl_xor(vs, 2); vs += __shfl_xor(vs, 4);
                if (c == 0) { __hip_atomic_fetch_add(uo + n0 + n, us, __ATOMIC_RELAXED, __HIP_MEMORY_SCOPE_AGENT); __hip_atomic_fetch_add(vo + n0 + n, vs, __ATOMIC_RELAXED, __HIP_MEMORY_SCOPE_AGENT); } }
        }
        buf ^= 1;
    }
#undef CVT_LOAD
    __syncthreads();
    return tile_off + ntiles;
}
__device__ __forceinline__ void ln_final(float* H, const bf16* HI, const unsigned char* LOW, const float* sum, const float* ssq, const float* g, const float* b, size_t gt, size_t NGT) {
    for (size_t q = gt; q < (size_t)MTOK * DM / 8; q += NGT) {
        const int sb = (int)(q >> 10), r = (int)((q & 1023) >> 2), ch = (int)(q & 3); const int m = (sb >> 6) * 256 + r, col = ((sb >> 1) & 31) * 64 + (sb & 1) * 32 + ch * 8;
        const float mean = sum[m] * (1.f / DM); const float rstd = __builtin_amdgcn_rsqf(ssq[m] * (1.f / DM) - mean * mean + LN_EPS);
        const v4u hv = *((const GAS v4u*)HI + q); const v2u lv = *((const GAS v2u*)LOW + q);
        float xh[8], xl[8]; unpack8(hv, xh); unpack8_lo(lv, xl);
        const f32x4 g0 = *(const GAS f32x4*)(g + col), g1 = *(const GAS f32x4*)(g + col + 4), b0 = *(const GAS f32x4*)(b + col), b1 = *(const GAS f32x4*)(b + col + 4);
        f32x4 y0, y1;
        y0[0] = ((xh[0] + xl[0]) - mean) * rstd * g0[0] + b0[0]; y0[1] = ((xh[1] + xl[1]) - mean) * rstd * g0[1] + b0[1]; y0[2] = ((xh[2] + xl[2]) - mean) * rstd * g0[2] + b0[2]; y0[3] = ((xh[3] + xl[3]) - mean) * rstd * g0[3] + b0[3];
        y1[0] = ((xh[4] + xl[4]) - mean) * rstd * g1[0] + b1[0]; y1[1] = ((xh[5] + xl[5]) - mean) * rstd * g1[1] + b1[1]; y1[2] = ((xh[6] + xl[6]) - mean) * rstd * g1[2] + b1[2]; y1[3] = ((xh[7] + xl[7]) - mean) * rstd * g1[3] + b1[3];
        GAS f32x4* xr = (GAS f32x4*)(H + (size_t)m * DM + col); xr[0] = y0; xr[1] = y1;
    }
}
__device__ __forceinline__ void krope_c(const bf16* CIN, bf16* KR, const unsigned char* ws, int gw, int NGW, int lane) {
    asm volatile("" : "+v"(lane));
    const float* cc = (const float*)(ws + WS_TABC); const float* sc = cc + 2048 * 32;
    const int sub = lane >> 3, i = lane & 7, f0 = (i & 3) * 8; const bool lowp = (i & 4) == 0;
    for (int t0 = gw * 8; t0 < MTOK; t0 += NGW * 8) { const int tok = t0 + sub, s = tok & (SEQ - 1);
        float x[8], y[8]; unpack8(*((const GAS v4u*)(CIN + (size_t)tok * C_INP + 1280) + i), x);
#pragma unroll
        for (int e = 0; e < 8; ++e) { const float p = __shfl_xor(x[e], 4); const float c = cc[s * 32 + f0 + e], sn = sc[s * 32 + f0 + e]; y[e] = lowp ? (x[e] * c - p * sn) : (x[e] * c + p * sn); }
        *((GAS v4u*)(KR + (size_t)tok * 64) + i) = pack8(y); }
}
__device__ __forceinline__ void ln_rows(float* H, bf16* HBo, const float* g, const float* b, int gw, int NGW, int lane) {
    asm volatile("" : "+v"(lane));
    for (int m = gw; m < MTOK; m += NGW) {
        GAS f32x4* xr = (GAS f32x4*)(H + (size_t)m * DM) + 2 * lane;
        f32x4 v[8]; float s = 0.f;
#pragma unroll
        for (int j = 0; j < 4; ++j) { v[2 * j] = xr[128 * j]; v[2 * j + 1] = xr[128 * j + 1]; }
#pragma unroll
        for (int j = 0; j < 8; ++j) s += (v[j].x + v[j].y) + (v[j].z + v[j].w);
        const float mean = wave_sum(s) * (1.f / DM); float s2 = 0.f;
#pragma unroll
        for (int j = 0; j < 8; ++j) { v[j] = v[j] - mean; s2 += (v[j].x * v[j].x + v[j].y * v[j].y) + (v[j].z * v[j].z + v[j].w * v[j].w); }
        const float rstd = 1.f / sqrtf(wave_sum(s2) * (1.f / DM) + LN_EPS);
        GAS v4u* ob = (GAS v4u*)(HBo + (size_t)m * DM) + lane;
#pragma unroll
        for (int j = 0; j < 4; ++j) {
            const f32x4 g0 = *((const f32x4*)g + 128 * j + 2 * lane), g1 = *((const f32x4*)g + 128 * j + 2 * lane + 1);
            const f32x4 b0 = *((const f32x4*)b + 128 * j + 2 * lane), b1 = *((const f32x4*)b + 128 * j + 2 * lane + 1);
            const f32x4 y0 = v[2 * j] * rstd * g0 + b0, y1 = v[2 * j + 1] * rstd * g1 + b1;
            xr[128 * j] = y0; xr[128 * j + 1] = y1;
            v4u o; o.x = pk2(y0.x, y0.y); o.y = pk2(y0.z, y0.w); o.z = pk2(y1.x, y1.y); o.w = pk2(y1.z, y1.w);
            ob[64 * j] = o;
        }
    }
}
__device__ __forceinline__ void cvt_rows_bf16(const float* X, bf16* O, unsigned char* OL, size_t n8, size_t gt, size_t NGT) {
    for (size_t i = gt; i < n8; i += NGT) { const f32x4 a = *((const GAS f32x4*)X + 2 * i), c = *((const GAS f32x4*)X + 2 * i + 1);
        v4u o; o.x = pk2(a.x, a.y); o.y = pk2(a.z, a.w); o.z = pk2(c.x, c.y); o.w = pk2(c.z, c.w); const size_t to_ = pg8::tl_off32((int)((i * 8) / DM), (int)((i * 8) % DM), DM / 64); *(GAS v4u*)(O + to_) = o;
        *(GAS v2u*)(OL + to_) = pack8_lo(a.x - bflo(o.x), a.y - bfhi(o.x), a.z - bflo(o.y), a.w - bfhi(o.y), c.x - bflo(o.z), c.y - bfhi(o.z), c.z - bflo(o.w), c.w - bfhi(o.w)); }
}
__device__ __forceinline__ void sincos_tab(float ang, float& c, float& s) {
    const double x = (double)ang; const double k = __builtin_rint(x * 0.15915494309189533577); const double r = x - k * 6.28318530717958647692;
    const double r2 = r * r; double sn = 0.0, cs = 0.0;
#pragma unroll
    for (int n = 14; n >= 0; --n) { sn = sn * (-r2) / (double)((2 * n + 2) * (2 * n + 3)) + 1.0; cs = cs * (-r2) / (double)((2 * n + 1) * (2 * n + 2)) + 1.0; }
    s = (float)(sn * r); c = (float)cs;
}
__device__ __forceinline__ void build_tables(unsigned char* ws, size_t gt, size_t NGT) {
    float* cb = (float*)(ws + WS_TABB); float* sb = cb + 2048 * 64;
    for (size_t i = gt; i < 2048 * 64; i += NGT) { const int pos = (int)(i >> 6), f = (int)(i & 63); const float inv = __builtin_amdgcn_exp2f(-13.287712379549449f * ((float)(2 * f) / 128.0f)); float c, s; sincos_tab((float)pos * inv, c, s); cb[i] = c; sb[i] = s; }
    float* cc = (float*)(ws + WS_TABC); float* sc = cc + 2048 * 32;
    for (size_t i = gt; i < 2048 * 32; i += NGT) { const int pos = (int)(i >> 5), f = (int)(i & 31); const float inv = __builtin_amdgcn_exp2f(-13.287712379549449f * ((float)(2 * f) / 64.0f)); float c, s; sincos_tab((float)pos * inv, c, s); cc[i] = c; sc[i] = s; }
    float* ca = (float*)(ws + WS_TABA); float* sa = ca + 64 * 32;
    for (size_t i = gt; i < 64 * 32; i += NGT) { const int pos = (int)(i >> 5), f = (int)(i & 31); const float inv = __builtin_amdgcn_exp2f(-13.287712379549449f * ((float)(2 * f) / 64.0f)); float c, s; sincos_tab((float)pos * inv, c, s); ca[i] = c; sa[i] = s; }
}

__device__ __forceinline__ void prep_a(bf16* QKV, const float* qg, const float* kg, const unsigned char* ws, int gw, int NGW, int lane) {
    asm volatile("" : "+v"(lane));
    const float* ca = (const float*)(ws + WS_TABA); const float* sa = ca + 64 * 32;
    const int i = lane & 15, half = i >> 3, f0 = (i & 3) * 8; const bool lowp = (i & 4) == 0;
    float gq[8], gk[8];
#pragma unroll
    for (int e = 0; e < 8; ++e) { gq[e] = qg[i * 8 + e]; gk[e] = kg[i * 8 + e]; }
    for (int tok = gw; tok < MTOK; tok += NGW) {
        const int s = tok & (SEQ - 1), pos = half ? (s & 63) : (s >> 6);
        float c[8], sn[8];
        { const f32x4 c0 = *(const GAS f32x4*)(ca + pos * 32 + f0), c1 = *(const GAS f32x4*)(ca + pos * 32 + f0 + 4), s0 = *(const GAS f32x4*)(sa + pos * 32 + f0), s1 = *(const GAS f32x4*)(sa + pos * 32 + f0 + 4);
          c[0] = c0.x; c[1] = c0.y; c[2] = c0.z; c[3] = c0.w; c[4] = c1.x; c[5] = c1.y; c[6] = c1.z; c[7] = c1.w;
          sn[0] = s0.x; sn[1] = s0.y; sn[2] = s0.z; sn[3] = s0.w; sn[4] = s1.x; sn[5] = s1.y; sn[6] = s1.z; sn[7] = s1.w; }
        GAS v4u* row = (GAS v4u*)(QKV + (size_t)tok * A_QKV) + lane;
        v4u w[5];
#pragma unroll
        for (int j = 0; j < 5; ++j) w[j] = row[64 * j];
#pragma unroll
        for (int j = 0; j < 5; ++j) {
            float x[8]; unpack8(w[j], x); float ss = 0.f;
#pragma unroll
            for (int e = 0; e < 8; ++e) ss += x[e] * x[e];
            ss += __shfl_xor(ss, 1); ss += __shfl_xor(ss, 2); ss += __shfl_xor(ss, 4); ss += __shfl_xor(ss, 8);
            const float r = 1.f / sqrtf(ss * (1.f / 128.f) + RMS_EPS);
            float y[8];
#pragma unroll
            for (int e = 0; e < 8; ++e) { x[e] = x[e] * r * (j < 4 ? gq[e] : gk[e]); const float p = __shfl_xor(x[e], 4); y[e] = lowp ? (x[e] * c[e] - p * sn[e]) : (x[e] * c[e] + p * sn[e]); }
            row[64 * j] = pack8(y);
        }
    }
}
__device__ __forceinline__ void prep_b(bf16* QKV, const unsigned char* ws, int gw, int NGW, int lane) {
    asm volatile("" : "+v"(lane));
    const float* cb = (const float*)(ws + WS_TABB); const float* sb = cb + 2048 * 64;
    const int i = lane & 15, f0 = (i & 7) * 8; const bool lowp = (i & 8) == 0;
    for (int tok = gw; tok < MTOK; tok += NGW) {
        const int s = tok & (SEQ - 1);
        float c[8], sn[8];
        { const f32x4 c0 = *(const GAS f32x4*)(cb + s * 64 + f0), c1 = *(const GAS f32x4*)(cb + s * 64 + f0 + 4), s0 = *(const GAS f32x4*)(sb + s * 64 + f0), s1 = *(const GAS f32x4*)(sb + s * 64 + f0 + 4);
          c[0] = c0.x; c[1] = c0.y; c[2] = c0.z; c[3] = c0.w; c[4] = c1.x; c[5] = c1.y; c[6] = c1.z; c[7] = c1.w;
          sn[0] = s0.x; sn[1] = s0.y; sn[2] = s0.z; sn[3] = s0.w; sn[4] = s1.x; sn[5] = s1.y; sn[6] = s1.z; sn[7] = s1.w; }
#pragma unroll
        for (int g = 0; g < 3; ++g) {
            GAS v4u* row = (GAS v4u*)(QKV + (size_t)tok * B_QKV + g * 3072) + lane;
            v4u w[4];
#pragma unroll
            for (int j = 0; j < 4; ++j) w[j] = row[64 * j];
#pragma unroll
            for (int j = 0; j < 4; ++j) { float x[8], y[8]; unpack8(w[j], x);
#pragma unroll
                for (int e = 0; e < 8; ++e) { const float p = __shfl_xor(x[e], 8); y[e] = lowp ? (x[e] * c[e] - p * sn[e]) : (x[e] * c[e] + p * sn[e]); }
                row[64 * j] = pack8(y); }
        }
    }
}
__device__ __forceinline__ void prep_c1(const bf16* CIN, bf16* CQN, bf16* CKVN, bf16* KR, const float* qg, const float* kvg, const unsigned char* ws, int gw, int NGW, int lane) {
    asm volatile("" : "+v"(lane));
    const float* cc = (const float*)(ws + WS_TABC); const float* sc = cc + 2048 * 32;
    for (int tok = gw; tok < MTOK; tok += NGW) {
        const GAS v4u* row = (const GAS v4u*)(CIN + (size_t)tok * C_INP);
        const v4u a0 = row[lane], a1 = (lane < 32) ? row[64 + lane] : (v4u){0u, 0u, 0u, 0u}, b0 = row[96 + lane], k0 = (lane < 8) ? row[160 + lane] : (v4u){0u, 0u, 0u, 0u};
        float x0[8], x1[8], y0[8], kx[8]; unpack8(a0, x0); unpack8(a1, x1); unpack8(b0, y0); unpack8(k0, kx);
        float sq = 0.f, skv = 0.f;
#pragma unroll
        for (int e = 0; e < 8; ++e) { sq += x0[e] * x0[e] + x1[e] * x1[e]; skv += y0[e] * y0[e]; }
        const float rq = 1.f / sqrtf(wave_sum(sq) * (1.f / 768.f) + RMS_EPS), rkv = 1.f / sqrtf(wave_sum(skv) * (1.f / 512.f) + RMS_EPS);
        { const f32x4 g0 = *(const GAS f32x4*)(qg + lane * 8), g1 = *(const GAS f32x4*)(qg + lane * 8 + 4);
          x0[0] *= rq * g0.x; x0[1] *= rq * g0.y; x0[2] *= rq * g0.z; x0[3] *= rq * g0.w; x0[4] *= rq * g1.x; x0[5] *= rq * g1.y; x0[6] *= rq * g1.z; x0[7] *= rq * g1.w;
          *((GAS v4u*)(CQN + (size_t)tok * C_QL) + lane) = pack8(x0); }
        if (lane < 32) { const f32x4 g0 = *(const GAS f32x4*)(qg + 512 + lane * 8), g1 = *(const GAS f32x4*)(qg + 512 + lane * 8 + 4);
          x1[0] *= rq * g0.x; x1[1] *= rq * g0.y; x1[2] *= rq * g0.z; x1[3] *= rq * g0.w; x1[4] *= rq * g1.x; x1[5] *= rq * g1.y; x1[6] *= rq * g1.z; x1[7] *= rq * g1.w;
          *((GAS v4u*)(CQN + (size_t)tok * C_QL) + 64 + lane) = pack8(x1); }
        { const f32x4 g0 = *(const GAS f32x4*)(kvg + lane * 8), g1 = *(const GAS f32x4*)(kvg + lane * 8 + 4);
          y0[0] *= rkv * g0.x; y0[1] *= rkv * g0.y; y0[2] *= rkv * g0.z; y0[3] *= rkv * g0.w; y0[4] *= rkv * g1.x; y0[5] *= rkv * g1.y; y0[6] *= rkv * g1.z; y0[7] *= rkv * g1.w;
          *((GAS v4u*)(CKVN + (size_t)tok * C_KVL) + lane) = pack8(y0); }
        {
          const int s = tok & (SEQ - 1), f0 = (lane & 3) * 8; const bool lowp = (lane & 4) == 0; float y[8];
#pragma unroll
          for (int e = 0; e < 8; ++e) { const float p = __shfl_xor(kx[e], 4); const float c = cc[s * 32 + f0 + e], sn = sc[s * 32 + f0 + e]; y[e] = lowp ? (kx[e] * c - p * sn) : (kx[e] * c + p * sn); }
          if (lane < 8) *((GAS v4u*)(KR + (size_t)tok * 64) + lane) = pack8(y); }
    }
}
__device__ __forceinline__ void prep_c2(bf16* Q, const unsigned char* ws, int gw, int NGW, int lane) {
    asm volatile("" : "+v"(lane));
    const float* cc = (const float*)(ws + WS_TABC); const float* sc = cc + 2048 * 32;
    const int i = lane & 7, f0 = (i & 3) * 8; const bool lowp = (i & 4) == 0;
    for (int tok = gw; tok < MTOK; tok += NGW) {
        const int s = tok & (SEQ - 1);
        float c[8], sn[8];
        { const f32x4 c0 = *(const GAS f32x4*)(cc + s * 32 + f0), c1 = *(const GAS f32x4*)(cc + s * 32 + f0 + 4), s0 = *(const GAS f32x4*)(sc + s * 32 + f0), s1 = *(const GAS f32x4*)(sc + s * 32 + f0 + 4);
          c[0] = c0.x; c[1] = c0.y; c[2] = c0.z; c[3] = c0.w; c[4] = c1.x; c[5] = c1.y; c[6] = c1.z; c[7] = c1.w;
          sn[0] = s0.x; sn[1] = s0.y; sn[2] = s0.z; sn[3] = s0.w; sn[4] = s1.x; sn[5] = s1.y; sn[6] = s1.z; sn[7] = s1.w; }
#pragma unroll
        for (int j = 0; j < 2; ++j) { const int h = (lane >> 3) + 8 * j;
            GAS v4u* p = (GAS v4u*)(Q + (size_t)tok * C_Q + h * 192 + 128) + i; float x[8], y[8]; unpack8(*p, x);
#pragma unroll
            for (int e = 0; e < 8; ++e) { const float q = __shfl_xor(x[e], 4); y[e] = lowp ? (x[e] * c[e] - q * sn[e]) : (x[e] * c[e] + q * sn[e]); }
            *p = pack8(y); }
    }
}

struct NState { float m, l, o[8]; };
__device__ __forceinline__ void nst_init(NState& S) { S.m = -1e30f; S.l = 0.f;
#pragma unroll
    for (int j = 0; j < 8; ++j) S.o[j] = 0.f; }
__device__ __forceinline__ void nst_update(NState& S, float s, bool valid, const v4u vv) {
    const float mn = valid ? fmaxf(S.m, s) : S.m; const float al = __builtin_amdgcn_exp2f(S.m - mn); const float p = valid ? __builtin_amdgcn_exp2f(s - mn) : 0.f;
    S.l = S.l * al + p; S.m = mn;
    S.o[0] = S.o[0] * al + p * bflo(vv.x); S.o[1] = S.o[1] * al + p * bfhi(vv.x); S.o[2] = S.o[2] * al + p * bflo(vv.y); S.o[3] = S.o[3] * al + p * bfhi(vv.y);
    S.o[4] = S.o[4] * al + p * bflo(vv.z); S.o[5] = S.o[5] * al + p * bfhi(vv.z); S.o[6] = S.o[6] * al + p * bflo(vv.w); S.o[7] = S.o[7] * al + p * bfhi(vv.w);
}
__device__ __forceinline__ void nst_finish(NState& S, bf16* out, int lane) {
#pragma unroll
    for (int x = 16; x <= 32; x <<= 1) {
        const float m2 = __shfl_xor(S.m, x), l2 = __shfl_xor(S.l, x); const float mn = fmaxf(S.m, m2); const float a = __builtin_amdgcn_exp2f(S.m - mn), b = __builtin_amdgcn_exp2f(m2 - mn);
        S.l = S.l * a + l2 * b; S.m = mn;
#pragma unroll
        for (int j = 0; j < 8; ++j) { const float o2 = __shfl_xor(S.o[j], x); S.o[j] = S.o[j] * a + o2 * b; }
    }
    if (lane < 16) { const float rl = 1.f / S.l; v4u w; w.x = pk2(S.o[0] * rl, S.o[1] * rl); w.y = pk2(S.o[2] * rl, S.o[3] * rl); w.z = pk2(S.o[4] * rl, S.o[5] * rl); w.w = pk2(S.o[6] * rl, S.o[7] * rl);
        *(GAS v4u*)(out + lane * 8) = w; }
}
__device__ __forceinline__ float dot8(const float (&q)[8], const v4u k) {
    return q[0] * bflo(k.x) + q[1] * bfhi(k.x) + q[2] * bflo(k.y) + q[3] * bfhi(k.y) + q[4] * bflo(k.z) + q[5] * bfhi(k.z) + q[6] * bflo(k.w) + q[7] * bfhi(k.w);
}
__device__ __forceinline__ float red16(float s) { s += __shfl_xor(s, 1); s += __shfl_xor(s, 2); s += __shfl_xor(s, 4); s += __shfl_xor(s, 8); return s; }
__device__ __forceinline__ void ldq8(float (&q)[8], const bf16* p, float sc) { const v4u w = *(const GAS v4u*)p;
    q[0] = bflo(w.x) * sc; q[1] = bfhi(w.x) * sc; q[2] = bflo(w.y) * sc; q[3] = bfhi(w.y) * sc; q[4] = bflo(w.z) * sc; q[5] = bfhi(w.z) * sc; q[6] = bflo(w.w) * sc; q[7] = bfhi(w.w) * sc; }

__device__ __forceinline__ void naive_attn_a(const bf16* QKV, bf16* ATT, int gw, int NGW, int lane) {
    asm volatile("" : "+v"(lane));
    const int g = lane >> 4, i = lane & 15; const float sc = 0.08838834764831845f * 1.4426950408889634f;
    for (int p = gw; p < MTOK * 16; p += NGW) {
        const int tok = p >> 4, h = p & 15, b = tok >> 11;
        float q[8]; ldq8(q, QKV + (size_t)tok * A_QKV + h * 128 + i * 8, sc);
        const bf16* kb = QKV + (size_t)(b * SEQ) * A_QKV + 2048 + (h >> 2) * 128 + i * 8;
        NState S; nst_init(S);
        for (int t0 = 0; t0 < SEQ; t0 += 4) { const bf16* kp = kb + (size_t)(t0 + g) * A_QKV; const v4u kk = *(const GAS v4u*)kp, vv = *(const GAS v4u*)(kp + 512);
            nst_update(S, red16(dot8(q, kk)), true, vv); }
        nst_finish(S, ATT + (size_t)tok * DM + h * 128, lane);
    }
}
__device__ __forceinline__ void naive_attn_b(const bf16* QKV, bf16* ATT, int gw, int NGW, int lane) {
    asm volatile("" : "+v"(lane));
    const int g = lane >> 4, i = lane & 15; const float sc = 0.08838834764831845f * 1.4426950408889634f;
    for (int p = gw; p < MTOK * 8; p += NGW) {
        const int tok = p >> 3, h = p & 7, s = tok & (SEQ - 1);
        NState S; nst_init(S);
        for (int grp = 0; grp < 3; ++grp) {
            const int dil = grp == 0 ? 1 : (grp == 1 ? 4 : 16);
            float q[8]; ldq8(q, QKV + (size_t)tok * B_QKV + grp * 3072 + h * 128 + i * 8, sc);
            for (int j0 = -64; j0 <= 64; j0 += 4) { const int j = j0 + g; const int t = s + j * dil; const bool valid = (j <= 64) && (t >= 0) && (t < SEQ);
                const int tc = valid ? t : s; const bf16* kp = QKV + (size_t)(tok - s + tc) * B_QKV + grp * 3072 + 1024 + h * 128 + i * 8;
                const v4u kk = *(const GAS v4u*)kp, vv = *(const GAS v4u*)(kp + 1024);
                nst_update(S, red16(dot8(q, kk)), valid, vv); }
        }
        nst_finish(S, ATT + (size_t)tok * 1024 + h * 128, lane);
    }
}
__device__ __forceinline__ void naive_attn_c(const bf16* Q, const bf16* KV, const bf16* KR, bf16* ATT, int gw, int NGW, int lane) {
    asm volatile("" : "+v"(lane));
    const int g = lane >> 4, i = lane & 15; const float sc = 0.07216878364870322f * 1.4426950408889634f;
    for (int p = gw; p < MTOK * 16; p += NGW) {
        const int tok = p >> 4, h = p & 15, b = tok >> 11;
        float q[8]; ldq8(q, Q + (size_t)tok * C_Q + h * 192 + i * 8, sc);
        float qr[4]; { const v2u w = *(const GAS v2u*)(Q + (size_t)tok * C_Q + h * 192 + 128 + i * 4); qr[0] = bflo(w.x) * sc; qr[1] = bfhi(w.x) * sc; qr[2] = bflo(w.y) * sc; qr[3] = bfhi(w.y) * sc; }
        const bf16* kb = KV + (size_t)(b * SEQ) * C_KV + h * 256 + i * 8; const bf16* rb = KR + (size_t)(b * SEQ) * 64 + i * 4;
        NState S; nst_init(S);
        for (int t0 = 0; t0 < SEQ; t0 += 4) { const bf16* kp = kb + (size_t)(t0 + g) * C_KV; const v4u kk = *(const GAS v4u*)kp, vv = *(const GAS v4u*)(kp + 128);
            const v2u kr = *(const GAS v2u*)(rb + (size_t)(t0 + g) * 64);
            const float d = dot8(q, kk) + qr[0] * bflo(kr.x) + qr[1] * bfhi(kr.x) + qr[2] * bflo(kr.y) + qr[3] * bfhi(kr.y);
            nst_update(S, red16(d), true, vv); }
        nst_finish(S, ATT + (size_t)tok * DM + h * 128, lane);
    }
}


namespace att {
using bf16x8 = __attribute__((ext_vector_type(8))) short;
using s16x4  = __attribute__((ext_vector_type(4))) short;
using f32x16 = __attribute__((ext_vector_type(16))) float;
using u32x4  = __attribute__((ext_vector_type(4))) unsigned;
typedef GAS const unsigned short* gptr;
constexpr int KVBLK = 64, QBLK = 32;
constexpr int SHM_V = 16384, SHM_K = 16384, SHM_KR = 8192;
constexpr int OFF_V = 0, OFF_K = 2 * SHM_V, OFF_KR = OFF_K + 2 * SHM_K, OFF_WS = OFF_KR + 2 * SHM_KR, LDS_ATT = OFF_WS + 8 * 256;
#define KSWZ(row, colB) ((row) * 256 + ((colB) ^ (((row) & 7) << 4)))
#define KSWZ2(row, colB) ((row) * 128 + ((colB) ^ (((row) & 7) << 4)))
#define SBAR() __builtin_amdgcn_sched_barrier(0)
__device__ __forceinline__ int crow(int r, int hi) { return (r & 3) + 8 * (r >> 2) + 4 * hi; }
__device__ __forceinline__ unsigned cvtpk(float lo, float hi) { unsigned r; asm volatile("v_cvt_pk_bf16_f32 %0, %1, %2" : "=v"(r) : "v"(lo), "v"(hi)); return r; }
template <int MODE> __device__ __forceinline__ int tokmap(int p, int logd, int logL) { return MODE == 1 ? (((p & ((1 << logL) - 1)) << logd) | (p >> logL)) : p; }

template <int MODE> __device__ __forceinline__ void partialSM(f32x16& p0, f32x16& p1, float& m_reg, float& mn, float& alpha) {
  constexpr float SCALE = (MODE == 2) ? 0.07216878364870322f : 0.08838834764831845f;
  constexpr float C = SCALE * 1.4426950408889634f;
  float pmax = p0[0];
#pragma unroll
  for (int r = 1; r < 16; ++r) pmax = fmaxf(pmax, p0[r]);
#pragma unroll
  for (int r = 0; r < 16; ++r) pmax = fmaxf(pmax, p1[r]);
  { auto rr = __builtin_amdgcn_permlane32_swap(__float_as_uint(pmax), __float_as_uint(pmax), false, false);
    pmax = fmaxf(__uint_as_float(rr[0]), __uint_as_float(rr[1])); }
  if (__builtin_expect(__all(pmax - m_reg <= 8.f / SCALE), 1)) { mn = m_reg; alpha = 1.f; }
  else { mn = fmaxf(m_reg, pmax); alpha = __builtin_amdgcn_exp2f((m_reg - mn) * C); m_reg = mn; }
  const float mnC = -mn * C;
#pragma unroll
  for (int r = 0; r < 16; ++r) p0[r] = fmaf(p0[r], C, mnC);
#pragma unroll
  for (int r = 0; r < 16; ++r) p1[r] = fmaf(p1[r], C, mnC);
#pragma unroll
  for (int r = 0; r < 16; ++r) p0[r] = __builtin_amdgcn_exp2f(p0[r]);
}
__device__ __forceinline__ void finishSM(f32x16& p0, f32x16& p1, float alpha, float& l_reg, bf16x8& pa0, bf16x8& pa1, bf16x8& pa2, bf16x8& pa3) {
#pragma unroll
  for (int r = 0; r < 16; ++r) p1[r] = __builtin_amdgcn_exp2f(p1[r]);
  float ps = 0;
#pragma unroll
  for (int r = 0; r < 16; ++r) ps += p0[r];
#pragma unroll
  for (int r = 0; r < 16; ++r) ps += p1[r];
  { auto rr = __builtin_amdgcn_permlane32_swap(__float_as_uint(ps), __float_as_uint(ps), false, false);
    ps = __uint_as_float(rr[0]) + __uint_as_float(rr[1]); }
  l_reg = l_reg * alpha + ps;
#define PK4(P, BASE, OUT) do { unsigned a0 = cvtpk(P[BASE + 0], P[BASE + 1]), a1 = cvtpk(P[BASE + 2], P[BASE + 3]);   \
    unsigned b0 = cvtpk(P[BASE + 4], P[BASE + 5]), b1 = cvtpk(P[BASE + 6], P[BASE + 7]);                              \
    auto r0 = __builtin_amdgcn_permlane32_swap(a0, b0, false, false); auto r1 = __builtin_amdgcn_permlane32_swap(a1, b1, false, false); \
    u32x4 w = {r0[0], r1[0], r0[1], r1[1]}; OUT = *reinterpret_cast<bf16x8*>(&w); } while (0)
  PK4(p0, 0, pa0); PK4(p0, 8, pa1); PK4(p1, 0, pa2); PK4(p1, 8, pa3);
#undef PK4
}
template <int MODE> __device__ __forceinline__ void qkt(f32x16& p0, f32x16& p1, const LAS char* Ks, const LAS char* KRs, const bf16x8* qr, int r32, int hi) {
  p0 = f32x16{}; p1 = f32x16{};
#pragma unroll
  for (int d0 = 0; d0 < 8; ++d0) { const int cb = (d0 * 16 + hi * 8) * 2;
    const bf16x8 b0 = *reinterpret_cast<const LAS bf16x8*>(Ks + KSWZ(r32, cb));
    const bf16x8 b1 = *reinterpret_cast<const LAS bf16x8*>(Ks + KSWZ(32 + r32, cb));
    p0 = __builtin_amdgcn_mfma_f32_32x32x16_bf16(b0, qr[d0], p0, 0, 0, 0);
    p1 = __builtin_amdgcn_mfma_f32_32x32x16_bf16(b1, qr[d0], p1, 0, 0, 0); }
  if constexpr (MODE == 2) {
#pragma unroll
    for (int d0 = 0; d0 < 4; ++d0) { const int cb = (d0 * 16 + hi * 8) * 2;
      const bf16x8 b0 = *reinterpret_cast<const LAS bf16x8*>(KRs + KSWZ2(r32, cb));
      const bf16x8 b1 = *reinterpret_cast<const LAS bf16x8*>(KRs + KSWZ2(32 + r32, cb));
      p0 = __builtin_amdgcn_mfma_f32_32x32x16_bf16(b0, qr[8 + d0], p0, 0, 0, 0);
      p1 = __builtin_amdgcn_mfma_f32_32x32x16_bf16(b1, qr[8 + d0], p1, 0, 0, 0); }
  }
}
__device__ __forceinline__ void bmask(f32x16& p0, f32x16& p1, int kb, int qp, int logL, int hi) {
  const int qc = qp >> logL;
#pragma unroll
  for (int r = 0; r < 16; ++r) { const int k0 = kb + crow(r, hi), k1 = k0 + 32; const int d0 = k0 - qp, d1 = k1 - qp;
    const bool v0 = (d0 <= 64) && (d0 >= -64) && ((k0 >> logL) == qc), v1 = (d1 <= 64) && (d1 >= -64) && ((k1 >> logL) == qc);
    p0[r] = v0 ? p0[r] : -3.0e38f; p1[r] = v1 ? p1[r] : -3.0e38f; }
}
__device__ __forceinline__ int v_st(int k, int c) { const int kk = (k & ~0xC) | ((k & 4) << 1) | ((k & 8) >> 1); return ((kk >> 3) * 4 + (c >> 5)) * 512 + ((kk & 7) * 32 + (c & 31)) * 2; }
__device__ __forceinline__ int v_rd_base(int lane) { return ((lane & 3) << 3) | (((lane >> 2) & 3) << 6) | (((lane >> 4) & 1) << 5) | (((lane >> 5) & 1) << 8); }
constexpr int v_rd_off(int d0, int ks, int half) { return d0 * 512 + ks * 4096 + half * 2048; }
template <int OFF> __device__ __forceinline__ s16x4 tr_read(int vb) {
  s16x4 r; asm volatile("ds_read_b64_tr_b16 %0, %1 offset:%2" : "=&v"(r) : "v"(vb), "i"(OFF) : "memory"); return r;
}
template <int D0> __device__ __forceinline__ void pv_one(f32x16& od, int vb, bf16x8 pa0, bf16x8 pa1, bf16x8 pa2, bf16x8 pa3) {
  const s16x4 l0 = tr_read<v_rd_off(D0, 0, 0)>(vb), h0 = tr_read<v_rd_off(D0, 0, 1)>(vb), l1 = tr_read<v_rd_off(D0, 1, 0)>(vb), h1 = tr_read<v_rd_off(D0, 1, 1)>(vb);
  const s16x4 l2 = tr_read<v_rd_off(D0, 2, 0)>(vb), h2 = tr_read<v_rd_off(D0, 2, 1)>(vb), l3 = tr_read<v_rd_off(D0, 3, 0)>(vb), h3 = tr_read<v_rd_off(D0, 3, 1)>(vb);
  asm volatile("s_waitcnt lgkmcnt(0)" ::: "memory"); SBAR();
#define PK(L, H) (bf16x8){L[0], L[1], L[2], L[3], H[0], H[1], H[2], H[3]}
  od = __builtin_amdgcn_mfma_f32_32x32x16_bf16(pa0, PK(l0, h0), od, 0, 0, 0);
  od = __builtin_amdgcn_mfma_f32_32x32x16_bf16(pa1, PK(l1, h1), od, 0, 0, 0);
  od = __builtin_amdgcn_mfma_f32_32x32x16_bf16(pa2, PK(l2, h2), od, 0, 0, 0);
  od = __builtin_amdgcn_mfma_f32_32x32x16_bf16(pa3, PK(l3, h3), od, 0, 0, 0);
#undef PK
}
__device__ __forceinline__ void pv_d0(f32x16* o, int vb, bf16x8 pa0, bf16x8 pa1, bf16x8 pa2, bf16x8 pa3) {
  pv_one<0>(o[0], vb, pa0, pa1, pa2, pa3); pv_one<1>(o[1], vb, pa0, pa1, pa2, pa3); pv_one<2>(o[2], vb, pa0, pa1, pa2, pa3); pv_one<3>(o[3], vb, pa0, pa1, pa2, pa3);
}

template <int MODE>
__device__ __forceinline__ void attn_unit(gptr Qb, gptr Kb, gptr Vb, gptr KRb, GAS unsigned short* Ob, GAS float* lse, const GAS float* tabc,
                                          const int p0, const int k0, const int logd, LAS char* lds, const int tid) {
  constexpr int SDEPTH = (MODE == 2) ? 1 : 2;
  constexpr int NQ = (MODE == 2) ? 12 : 8;
  constexpr int ldq = (MODE == 0) ? A_QKV : (MODE == 1) ? B_QKV : C_Q, ldk = (MODE == 0) ? A_QKV : (MODE == 1) ? B_QKV : C_KV, ldo = (MODE == 1) ? 1024 : DM, NT = (MODE == 1) ? 6 : SEQ / 64;
  constexpr float SCALE = (MODE == 2) ? 0.07216878364870322f : 0.08838834764831845f;
  const int wid = tid >> 6, lane = tid & 63, r32 = lane & 31, hi = lane >> 5;
  const int logL = 11 - logd;
  LAS char* V_lds = lds + OFF_V; LAS char* K_lds = lds + OFF_K; LAS char* KR_lds = lds + OFF_KR;
  LAS float* wsl = (LAS float*)(lds + OFF_WS) + wid * 64; LAS float* li_l = wsl; LAS float* al_l = wsl + 32;
  float m_reg = -1e30f, l_reg = 0; f32x16 o[4] = {}; bf16x8 qr[NQ];
  const int qp = p0 + wid * QBLK + r32;
  { gptr Qw = Qb + (unsigned)(tokmap<MODE>(qp, logd, logL) * ldq + hi * 8);
#pragma unroll
    for (int d0 = 0; d0 < NQ; ++d0) qr[d0] = *reinterpret_cast<GAS const bf16x8*>(Qw + d0 * 16); }
  if constexpr (MODE == 2) {
    const GAS float* cc = tabc + qp * 32 + hi * 8; const GAS float* sc = cc + 2048 * 32;
#pragma unroll
    for (int d = 0; d < 2; ++d) { bf16x8 xa = qr[8 + d], xb = qr[10 + d]; float c[8], sn[8];
      { const f32x4 c0 = *(const GAS f32x4*)(cc + 16 * d), c1 = *(const GAS f32x4*)(cc + 16 * d + 4), s0 = *(const GAS f32x4*)(sc + 16 * d), s1 = *(const GAS f32x4*)(sc + 16 * d + 4);
        c[0] = c0.x; c[1] = c0.y; c[2] = c0.z; c[3] = c0.w; c[4] = c1.x; c[5] = c1.y; c[6] = c1.z; c[7] = c1.w; sn[0] = s0.x; sn[1] = s0.y; sn[2] = s0.z; sn[3] = s0.w; sn[4] = s1.x; sn[5] = s1.y; sn[6] = s1.z; sn[7] = s1.w; }
#pragma unroll
      for (int e = 0; e < 8; ++e) { const float a = __uint_as_float(((unsigned)(unsigned short)xa[e]) << 16), b = __uint_as_float(((unsigned)(unsigned short)xb[e]) << 16);
        xa[e] = (short)f2bf(a * c[e] - b * sn[e]); xb[e] = (short)f2bf(a * sn[e] + b * c[e]); }
      qr[8 + d] = xa; qr[10 + d] = xb; } }
  const int sr = tid >> 4, sc = (tid & 15) * 8, vst0 = v_st(sr, sc), vst1 = v_st(32 + sr, sc);
  const int krr = tid >> 3, krc = (tid & 7) * 8;
  const int vb0 = (int)(unsigned)(uintptr_t)V_lds + v_rd_base(lane);
  struct { bf16x8 vs0, vs1, ks0, ks1, kr; } sr_[SDEPTH];
#define SLOAD(i, kk) do { const unsigned t0_ = (unsigned)tokmap<MODE>(k0 + (kk) + sr, logd, logL) * (unsigned)ldk + (unsigned)sc, t1_ = (unsigned)tokmap<MODE>(k0 + (kk) + 32 + sr, logd, logL) * (unsigned)ldk + (unsigned)sc; \
    sr_[i].vs0 = *reinterpret_cast<GAS const bf16x8*>(Vb + t0_); sr_[i].vs1 = *reinterpret_cast<GAS const bf16x8*>(Vb + t1_); \
    sr_[i].ks0 = *reinterpret_cast<GAS const bf16x8*>(Kb + t0_); sr_[i].ks1 = *reinterpret_cast<GAS const bf16x8*>(Kb + t1_); \
    if constexpr (MODE == 2) sr_[i].kr = *reinterpret_cast<GAS const bf16x8*>(KRb + (unsigned)((k0 + (kk) + krr) * 64 + krc)); } while (0)
#define SWRITE(b, i) do { *(LAS bf16x8*)(V_lds + (b) * SHM_V + vst0) = sr_[i].vs0; *(LAS bf16x8*)(V_lds + (b) * SHM_V + vst1) = sr_[i].vs1; const int kc = sc * 2; \
    *(LAS bf16x8*)(K_lds + (b) * SHM_K + KSWZ(sr, kc)) = sr_[i].ks0; *(LAS bf16x8*)(K_lds + (b) * SHM_K + KSWZ(32 + sr, kc)) = sr_[i].ks1; \
    if constexpr (MODE == 2) *(LAS bf16x8*)(KR_lds + (b) * SHM_KR + KSWZ2(krr, krc * 2)) = sr_[i].kr; } while (0)
#define SWAIT() do { if constexpr (SDEPTH == 2) asm volatile("s_waitcnt vmcnt(4)" ::: "memory"); else asm volatile("s_waitcnt vmcnt(0)" ::: "memory"); } while (0)
#define RESC(a) do { if (__any((a) < 1.f)) { if (hi == 0) al_l[r32] = (a); asm volatile("s_waitcnt lgkmcnt(0)" ::: "memory"); \
    _Pragma("unroll") for (int d = 0; d < 4; ++d) _Pragma("unroll") for (int r = 0; r < 16; ++r) o[d][r] *= al_l[crow(r, hi)]; } } while (0)
#define QKT(P0, P1, b, t) do { qkt<MODE>(P0, P1, K_lds + (b) * SHM_K, KR_lds + (b) * SHM_KR, qr, r32, hi); if constexpr (MODE == 1) bmask(P0, P1, k0 + (t) * KVBLK, qp, logL, hi); } while (0)
  bf16x8 pa0, pa1, pa2, pa3;
  if constexpr (MODE == 2) {
    f32x16 pA0, pA1; float mnA, alA;
    SLOAD(0, 0); asm volatile("s_waitcnt vmcnt(0)" ::: "memory"); SWRITE(0, 0); __syncthreads();
    for (int t = 0; t < NT; t += 2) {
      SLOAD(0, (t + 1) * KVBLK); SBAR();
      QKT(pA0, pA1, 0, t); partialSM<MODE>(pA0, pA1, m_reg, mnA, alA); RESC(alA);
      finishSM(pA0, pA1, alA, l_reg, pa0, pa1, pa2, pa3); SBAR();
      pv_d0(o, vb0, pa0, pa1, pa2, pa3);
      SWAIT(); SWRITE(1, 0); __syncthreads();
      if (t + 2 < NT) SLOAD(0, (t + 2) * KVBLK); SBAR();
      QKT(pA0, pA1, 1, t + 1); partialSM<MODE>(pA0, pA1, m_reg, mnA, alA); RESC(alA);
      finishSM(pA0, pA1, alA, l_reg, pa0, pa1, pa2, pa3); SBAR();
      pv_d0(o, vb0 + SHM_V, pa0, pa1, pa2, pa3);
      if (t + 2 < NT) { SWAIT(); SWRITE(0, 0); } __syncthreads();
    }
  } else {
  f32x16 pA0, pA1, pB0, pB1; float mnA, mnB, alA, alB;
  constexpr int SE = 0, SO = SDEPTH - 1;
  SLOAD(SE, 0); asm volatile("s_waitcnt vmcnt(0)" ::: "memory"); SWRITE(0, SE); __syncthreads();
  QKT(pA0, pA1, 0, 0); partialSM<MODE>(pA0, pA1, m_reg, mnA, alA);
  SLOAD(SO, KVBLK); if constexpr (SDEPTH == 2) { if (2 < NT) SLOAD(SE, 2 * KVBLK); }
  SWAIT(); SWRITE(1, SO); __syncthreads();
  for (int j = 1; j + 1 < NT; j += 2) {
    SBAR(); QKT(pB0, pB1, 1, j);
    finishSM(pA0, pA1, alA, l_reg, pa0, pa1, pa2, pa3); SBAR();
    SLOAD(SO, (j + SDEPTH) * KVBLK); SBAR();
    pv_d0(o, vb0, pa0, pa1, pa2, pa3); partialSM<MODE>(pB0, pB1, m_reg, mnB, alB);
    __syncthreads(); SWAIT(); SWRITE(0, SE);
    RESC(alB); __syncthreads();
    SBAR(); QKT(pA0, pA1, 0, j + 1);
    finishSM(pB0, pB1, alB, l_reg, pa0, pa1, pa2, pa3); SBAR();
    if (SDEPTH == 1 || j + 3 < NT) SLOAD(SE, (j + 1 + SDEPTH) * KVBLK); SBAR();
    pv_d0(o, vb0 + SHM_V, pa0, pa1, pa2, pa3); partialSM<MODE>(pA0, pA1, m_reg, mnA, alA);
    __syncthreads(); SWAIT(); SWRITE(1, SO);
    RESC(alA); __syncthreads();
  }
  SBAR(); QKT(pB0, pB1, 1, NT - 1);
  finishSM(pA0, pA1, alA, l_reg, pa0, pa1, pa2, pa3); SBAR();
  pv_d0(o, vb0, pa0, pa1, pa2, pa3); partialSM<MODE>(pB0, pB1, m_reg, mnB, alB);
  __syncthreads(); RESC(alB);
  finishSM(pB0, pB1, alB, l_reg, pa0, pa1, pa2, pa3); SBAR();
  pv_d0(o, vb0 + SHM_V, pa0, pa1, pa2, pa3);
  }
  if (hi == 0) li_l[r32] = l_reg; asm volatile("s_waitcnt lgkmcnt(0)" ::: "memory");
  if constexpr (MODE == 1) { if (hi == 0) lse[(unsigned)(tokmap<MODE>(qp, logd, logL) * 8)] = m_reg * SCALE + __builtin_amdgcn_logf(l_reg) * 0.6931471805599453f; }
#pragma unroll
  for (int r = 0; r < 16; ++r) { const int orow = crow(r, hi); const float rl = __builtin_amdgcn_rcpf(li_l[orow]);
    GAS unsigned short* Ow = Ob + (unsigned)(tokmap<MODE>(p0 + wid * QBLK + orow, logd, logL) * ldo + r32);
#pragma unroll
    for (int d0 = 0; d0 < 4; ++d0) Ow[d0 * 32] = (unsigned short)f2bf(o[d0][r] * rl); }
#undef SLOAD
#undef SWRITE
#undef SWAIT
#undef RESC
#undef QKT
}
}

__device__ __forceinline__ void attn_phase_a(const bf16* QKV, bf16* ATT, LAS char* lds, int G, int bx, int tid) {
    asm volatile("" : "+v"(tid));
    for (int u = bx; u < BATCH * 16 * 8; u += G) {
        int pair, j; if (G == 256) { pair = (u >> 8) * 8 + (bx & 7); j = bx >> 3; } else { pair = u >> 5; j = u & 31; }
        const int b = pair >> 2, kvh = pair & 3, hq = kvh * 4 + (j >> 3), qb = j & 7;
        att::gptr Qb = (att::gptr)(QKV + (size_t)b * SEQ * A_QKV + hq * 128); att::gptr Kb = (att::gptr)(QKV + (size_t)b * SEQ * A_QKV + 2048 + kvh * 128);
        att::attn_unit<0>(Qb, Kb, Kb + 512, Kb, (GAS unsigned short*)(ATT + (size_t)b * SEQ * DM + hq * 128), nullptr, nullptr, 256 * qb, 0, 0, lds, tid);
        __syncthreads();
    }
}
__device__ __forceinline__ void attn_phase_c(const bf16* Q, const bf16* KV, const bf16* KR, bf16* ATT, const float* tabc, LAS char* lds, int G, int bx, int tid) {
    asm volatile("" : "+v"(tid));
    for (int u = bx; u < BATCH * 16 * 8; u += G) {
        int pair, qb; if (G == 256) { pair = ((u >> 8) * 8 + (bx & 7)) * 4 + (bx >> 6); qb = (bx >> 3) & 7; } else { pair = u >> 3; qb = u & 7; }
        const int b = pair >> 4, h = pair & 15;
        att::gptr Qb = (att::gptr)(Q + (size_t)b * SEQ * C_Q + h * 192); att::gptr Kb = (att::gptr)(KV + (size_t)b * SEQ * C_KV + h * 256);
        att::attn_unit<2>(Qb, Kb, Kb + 128, (att::gptr)(KR + (size_t)b * SEQ * 64), (GAS unsigned short*)(ATT + (size_t)b * SEQ * DM + h * 128), nullptr, (const GAS float*)tabc, 256 * qb, 0, 0, lds, tid);
        __syncthreads();
    }
}
__device__ __forceinline__ void attn_phase_b(const bf16* QKV, bf16* OG, float* LSE, LAS char* lds, int G, int bx, int tid) {
    asm volatile("" : "+v"(tid));
    for (int u = bx; u < 3 * BATCH * 8 * 8; u += G) {
        const int qb = u & 7, h = (u >> 3) & 7, b = (u >> 6) & 15, grp = u >> 10, logd = 2 * grp;
        att::gptr Qb = (att::gptr)(QKV + (size_t)b * SEQ * B_QKV + grp * 3072 + h * 128);
        const int p0 = 256 * qb; int k0 = p0 - 64; k0 = k0 < 0 ? 0 : (k0 > SEQ - 384 ? SEQ - 384 : k0);
        att::attn_unit<1>(Qb, Qb + 1024, Qb + 2048, Qb, (GAS unsigned short*)(OG + (size_t)grp * MTOK * 1024 + (size_t)b * SEQ * 1024 + h * 128),
                          (GAS float*)(LSE + ((size_t)grp * MTOK + (size_t)b * SEQ) * 8 + h), nullptr, p0, k0, logd, lds, tid);
        __syncthreads();
    }
}
__device__ __forceinline__ void merge_b(const bf16* OG, const float* LSE, bf16* ATT, int gw, int NGW, int lane) {
    asm volatile("" : "+v"(lane));
    const int h = lane >> 3, c = (lane & 7) * 16;
    for (int tok = gw; tok < MTOK; tok += NGW) {
        const float l0 = LSE[(size_t)tok * 8 + h], l1 = LSE[((size_t)MTOK + tok) * 8 + h], l2 = LSE[((size_t)2 * MTOK + tok) * 8 + h];
        const float mx = fmaxf(l0, fmaxf(l1, l2)); float w0 = __expf(l0 - mx), w1 = __expf(l1 - mx), w2 = __expf(l2 - mx); const float rs = 1.f / (w0 + w1 + w2); w0 *= rs; w1 *= rs; w2 *= rs;
        const GAS v4u* a = (const GAS v4u*)(OG + (size_t)tok * 1024 + h * 128 + c); const GAS v4u* bq = (const GAS v4u*)(OG + ((size_t)MTOK + tok) * 1024 + h * 128 + c); const GAS v4u* cq = (const GAS v4u*)(OG + ((size_t)2 * MTOK + tok) * 1024 + h * 128 + c);
        GAS v4u* o = (GAS v4u*)(ATT + (size_t)tok * 1024 + h * 128 + c);
#pragma unroll
        for (int i = 0; i < 2; ++i) { const v4u x = a[i], y = bq[i], z = cq[i]; v4u r;
            r.x = pk2(w0 * bflo(x.x) + w1 * bflo(y.x) + w2 * bflo(z.x), w0 * bfhi(x.x) + w1 * bfhi(y.x) + w2 * bfhi(z.x));
            r.y = pk2(w0 * bflo(x.y) + w1 * bflo(y.y) + w2 * bflo(z.y), w0 * bfhi(x.y) + w1 * bfhi(y.y) + w2 * bfhi(z.y));
            r.z = pk2(w0 * bflo(x.z) + w1 * bflo(y.z) + w2 * bflo(z.z), w0 * bfhi(x.z) + w1 * bfhi(y.z) + w2 * bfhi(z.z));
            r.w = pk2(w0 * bflo(x.w) + w1 * bflo(y.w) + w2 * bflo(z.w), w0 * bfhi(x.w) + w1 * bfhi(y.w) + w2 * bfhi(z.w));
            o[i] = r; }
    }
}

constexpr int N_IN = 57;
struct Args { const float* in[N_IN]; float* out; unsigned char* ws; int ph_lo, ph_hi; };
__device__ __forceinline__ const float* arg_in(int idx) {
    typedef __attribute__((address_space(4))) const char* kptr;
    kptr kp = (kptr)__builtin_amdgcn_kernarg_segment_ptr();
    return *(const float* __attribute__((address_space(4))) const*)(kp + 8 * idx);
}
constexpr int N_PHASES = 1 + 7 + 8 + 8 + 7 + 1;

#define CVT_NEXT(PM) do { const int pm_ = (PM); \
                if (si + 1 < 3 * DEPTH && EXP != 3 && pm_ != 0) { \
                    const int lncur = (sub == 0) ? base + 2 : (sub == 1) ? base + 4 + nmix : base + 8 + nmix; \
                    const float* gk = arg_in(lncur); const float* bk = arg_in(lncur + 1); bf16* WN = WTB(si + 1); float* un = UVEC(si + 1); float* vn = un + 11264; LAS unsigned char* cl = lds + RING_OFF; int to = 0; \
                    if (sub == 0) { \
                        if (kind == 0) { if (pm_ & 1) to = cvt_weight(arg_in(base + 4), DM, A_QKV, WN, A_QKV, 3, gk, bk, un, vn, cl, to, G, bx, tid); else to = (DM / 64) * (A_QKV / 256); \
                                         if (pm_ & 2) to = cvt_weight(arg_in(base + 7), DM, DM, WN + WT_A_OUT, DM, 0, nullptr, nullptr, nullptr, nullptr, cl, to, G, bx, tid); } \
                        else if (kind == 1) { if (pm_ & 1) to = cvt_weight(arg_in(base + 4), DM, B_QKV, WN, B_QKV, 2, gk, bk, un, vn, cl, to, G, bx, tid); else to = (DM / 64) * (B_QKV / 256); \
                                              if (pm_ & 2) to = cvt_weight(arg_in(base + 5), 1024, DM, WN + WT_B_OUT, DM, 0, nullptr, nullptr, nullptr, nullptr, cl, to, G, bx, tid); } \
                        else { if (pm_ & 1) to = cvt_weight(arg_in(base + 4), DM, C_IN, WN, C_INP, 0, gk, bk, un, vn, cl, to, G, bx, tid); else to = (DM / 64) * (C_INP / 256); \
                               if (pm_ & 2) { to = cvt_weight(arg_in(base + 7), C_QL, C_Q, WN + WT_C_QUP, C_Q, 0, arg_in(base + 5), nullptr, nullptr, nullptr, cl, to, G, bx, tid); \
                               to = cvt_weight(arg_in(base + 8), C_KVL, C_KV, WN + WT_C_KVUP, C_KV, 0, arg_in(base + 6), nullptr, nullptr, nullptr, cl, to, G, bx, tid); \
                               to = cvt_weight(arg_in(base + 9), DM, DM, WN + WT_C_OUT, DM, 0, nullptr, nullptr, nullptr, nullptr, cl, to, G, bx, tid); } } \
                    } else { \
                        const int wi = (sub == 1) ? base + 6 + nmix : ((L + 1 == 1) ? 15 : (L + 1 == 2) ? 27 : 43); \
                        if (pm_ & 1) to = cvt_weight(arg_in(wi), DM, 2 * DFF, WN, 2 * DFF, 1, gk, bk, un, vn, cl, to, G, bx, tid); else to = (DM / 64) * (2 * DFF / 256); \
                        if (pm_ & 2) to = cvt_weight(arg_in(wi + 1), DFF, DM, WN + WT_FFN_OUT, DM, 0, nullptr, nullptr, nullptr, nullptr, cl, to, G, bx, tid); \
                    } \
                    (void)to; \
                } \
 } while (0)
__global__ void __launch_bounds__(NWAVES * 64, 2) mega_fwd(Args args) {
    extern __shared__ __attribute__((aligned(16))) unsigned char lds_raw[];
    LAS unsigned char* lds = (LAS unsigned char*)lds_raw;
    volatile LAS unsigned* MISC = (volatile LAS unsigned*)(lds + MISC_OFF);
    const int wave = __builtin_amdgcn_readfirstlane((int)threadIdx.x >> 6);
    unsigned char* const ws0 = args.ws; float* const out0 = args.out; const int G0 = gridDim.x, bx0 = blockIdx.x;
    for (int u = threadIdx.x; u < (LDS_BYTES - LDSCTL_OFF) / 4; u += NWAVES * 64) ((LAS unsigned*)(lds + LDSCTL_OFF))[u] = 0u;
    __syncthreads();
    XcdBarrier bar; bar.bar = (unsigned*)((gu32*)(ws0 + WS_CTL) + CW_BAR); bar.x = 0; bar.st = nullptr;
    if (!MK_PER_PHASE) bar = xcd_barrier_post((unsigned*)((gu32*)(ws0 + WS_CTL) + CW_BAR), MISC + 8);
    const int lo = args.ph_lo, hi = args.ph_hi;
    int ph = 0;
#define IN_PH() (lo <= ph && ph < hi)
#define SEAM_BAR() do { unsigned ones_ = ~0u; asm volatile("" : "+s"(ones_)); xcd_barrier(bar, wave * 64 + (int)__builtin_amdgcn_mbcnt_hi(ones_, __builtin_amdgcn_mbcnt_lo(ones_, 0u))); } while (0)
#if PROBE_CAT >= 0
    volatile LAS unsigned long long* PR = (volatile LAS unsigned long long*)(lds + MISC_OFF + 64);
    if (threadIdx.x == 0) { const unsigned long long t_ = __builtin_amdgcn_s_memrealtime(); PR[0] = t_; PR[1] = 0ull; PR[2] = t_; MISC[22] = 2u; }
#define SEAM() do { if (wave == 0) { const unsigned long long te_ = __builtin_amdgcn_s_memrealtime(); if (MISC[22] == (unsigned)PROBE_CAT) PR[1] = PR[1] + (te_ - PR[0]); PR[0] = te_; } \
    if (lo <= ph && ph + 1 < hi) SEAM_BAR(); if (wave == 0) { const unsigned long long ta_ = __builtin_amdgcn_s_memrealtime(); if (PROBE_CAT == 4) PR[1] = PR[1] + (ta_ - PR[0]); PR[0] = ta_; } ++ph; } while (0)
#define PCAT(c) do { if (wave == 0) MISC[22] = (unsigned)(c); } while (0)
#else
#define SEAM() do { if (!MK_PER_PHASE) { if (lo <= ph && ph + 1 < hi) SEAM_BAR(); } ++ph; } while (0)
#define PCAT(c) do { } while (0)
#endif
#define PH_VARS unsigned ones_ = ~0u; asm volatile("" : "+s"(ones_)); const int lane = (int)__builtin_amdgcn_mbcnt_hi(ones_, __builtin_amdgcn_mbcnt_lo(ones_, 0u)); const int tid = wave * 64 + lane; (void)lane; \
    unsigned char* ws = lnd(ws0); float* H32 = lnd(out0); bf16* WT0 = (bf16*)(ws + WS_WT); bf16* HB = (bf16*)(ws + WS_HB); unsigned char* LO = ws + WS_LO; unsigned char* R = ws + WS_R; \
    int G = G0, bx = bx0; asm volatile("" : "+s"(G), "+s"(bx)); const int vcu = (G % 8 == 0) ? (bx % 8) * (G / 8) + bx / 8 : bx; const int gw = vcu * NWAVES + wave, NGW = G * NWAVES; \
    const size_t gt = (size_t)vcu * (NWAVES * 64) + tid, NGT = (size_t)G * NWAVES * 64; LAS float* scr = (LAS float*)(lds + RING_OFF + wave * 16384); \
    (void)H32; (void)WT0; (void)HB; (void)LO; (void)R; (void)gw; (void)NGW; (void)gt; (void)NGT; (void)scr;

    for (int rep = 0; rep < REPS; ++rep) {
    PCAT(2);
    if (IN_PH()) { PH_VARS
        for (size_t i = gt; i < (DEV_ZERO_END - CTL_ZERO_BYTES) / 16; i += NGT) ((GAS v4u*)(ws + CTL_ZERO_BYTES))[i] = (v4u){0u, 0u, 0u, 0u};
        build_tables(ws, gt, NGT);
        cvt_rows_bf16(arg_in(0), HB, LO, (size_t)MTOK * DM / 8, gt, NGT);
        { int to = cvt_weight(arg_in(1), DM, 2 * DFF, WT0, 2 * DFF, 1, nullptr, nullptr, nullptr, nullptr, lds + RING_OFF, 0, G, bx, tid);
          (void)cvt_weight(arg_in(2), DFF, DM, WT0 + WT_FFN_OUT, DM, 0, nullptr, nullptr, nullptr, nullptr, lds + RING_OFF, to, G, bx, tid); }
    }
    SEAM();

    for (int L = 0; L < DEPTH; ++L) {
        const int kind = (L == 3) ? 0 : L;
        const int base = (L == 0) ? 1 : (L == 1) ? 15 : (L == 2) ? 27 : 43;
        const int nmix = (kind == 0) ? 4 : (kind == 1) ? 2 : 6;
        for (int sub = 0; sub < 3; ++sub) {
            const int si = L * 3 + sub;
            const int pbase = (L == 0) ? 1 : (L == 1) ? 1 : (L == 2) ? 15 : 27, pkind = (L == 0) ? 0 : (L - 1), pnmix = (pkind == 0) ? 4 : (pkind == 1) ? 2 : 6;
            const int lnprev = (sub == 0) ? pbase + 8 + pnmix : (sub == 1) ? base + 2 : base + 4 + nmix;
#define WTB(i) ((bf16*)(ws + WS_WT + (size_t)((i) & 1) * WT_BUF))
#define STAT_SUM(i) ((float*)(ws + WS_STAT) + (size_t)(i) * 2 * MTOK)
#define UVEC(i) ((float*)(ws + WS_UV) + (size_t)(i) * UV_STRIDE)
#define PREV_STAT() pg8::RowStat{STAT_SUM(si - 1), STAT_SUM(si - 1) + MTOK, 1.f / DM, LN_EPS, si == 0 ? 0 : 1}
            if (sub != 1) {
                PCAT(10);
                if (IN_PH()) { PH_VARS
                    pg8::Gemm g{lnd(HB), lnd(WTB(si)), MTOK, 2 * DFF, DM, DM, 2}; pg8::StaticOrder S; S.init(MTOK, 2 * DFF, G, bx);
                    pg8::EpiAffSwiGLU E{lnd((bf16*)(R + R_ACT)), DFF, PREV_STAT(), UVEC(si), UVEC(si) + 11264};
                    pg8::gemm_phase<pg8::EpiAffSwiGLU, pg8::StaticOrder, PG8_ALIGN, PG8_SP2>(lds + RING_OFF, g, S, E, tid);
                }
                SEAM();
            } else {
                PCAT(12);
                if (IN_PH()) { PH_VARS
                    if (kind == 0) {
                        pg8::Gemm g{lnd(HB), lnd(WTB(si)), MTOK, A_QKV, DM, DM, 2}; pg8::StaticOrder S; S.init(MTOK, A_QKV, G, bx);
                        pg8::EpiAffA E{lnd((bf16*)(R + RA_QKV)), A_QKV, PREV_STAT(), UVEC(si), UVEC(si) + 11264, arg_in(base + 5), arg_in(base + 6), (const float*)(ws + WS_TABA), (LAS float*)(lds + XCH_OFF)};
                        pg8::gemm_phase<pg8::EpiAffA, pg8::StaticOrder, PG8_ALIGN, PG8_SP2>(lds + RING_OFF, g, S, E, tid);
                    } else {
                    const int N = (kind == 1) ? B_QKV : C_INP;
                    pg8::Gemm g{lnd(HB), lnd(WTB(si)), MTOK, N, DM, DM, 2}; pg8::StaticOrder S; S.init(MTOK, N, G, bx);
                    pg8::EpiAff E{lnd((bf16*)(R + 0)), N, PREV_STAT(), UVEC(si), UVEC(si) + 11264, (kind == 2) ? (float*)(ws + WS_SSQC) : (float*)nullptr, (kind == 1) ? (const float*)(ws + WS_TABB) : (const float*)nullptr};
                    pg8::gemm_phase<pg8::EpiAff, pg8::StaticOrder, PG8_ALIGN, PG8_SP2>(lds + RING_OFF, g, S, E, tid);
                    }
                }
                SEAM();
                if (kind == 0) {
                    PCAT(14);
                    if (IN_PH()) { PH_VARS attn_phase_a((const bf16*)(R + RA_QKV), (bf16*)(R + RA_ATT), (LAS char*)(lds + RING_OFF), G, bx, tid); }
                    SEAM();
                } else if (kind == 1) {
                    PCAT(15);
                    if (IN_PH()) { PH_VARS attn_phase_b((const bf16*)(R + RB_QKV), (bf16*)(R + RB_OG), (float*)(R + RB_LSE), (LAS char*)(lds + RING_OFF), G, bx, tid); }
                    SEAM();
                    PCAT(17);
                    if (IN_PH()) { PH_VARS merge_b((const bf16*)(R + RB_OG), (const float*)(R + RB_LSE), (bf16*)(R + RB_ATT), gw, NGW, lane); }
                    SEAM();
                } else {
                    PCAT(12);
                    if (IN_PH()) { PH_VARS
                        krope_c((const bf16*)(R + RC_IN), (bf16*)(R + RC_KR), ws, gw, NGW, lane);
                        { pg8::Gemm g{lnd((const bf16*)(R + RC_IN)), lnd(WTB(si) + WT_C_QUP), MTOK, C_Q, C_QL, C_INP}; pg8::StaticOrder S; S.init(MTOK, C_Q, G, bx);
                          pg8::EpiAff E{lnd((bf16*)(R + RC_Q)), C_Q, pg8::RowStat{nullptr, (const float*)(ws + WS_SSQC), 1.f / C_QL, RMS_EPS, 2}, nullptr, nullptr, nullptr, nullptr};
                          pg8::gemm_phase<pg8::EpiAff, pg8::StaticOrder, PG8_ALIGN, PG8_SP2>(lds + RING_OFF, g, S, E, tid); }
                        { pg8::Gemm g{lnd((const bf16*)(R + RC_IN) + C_QL), lnd(WTB(si) + WT_C_KVUP), MTOK, C_KV, C_KVL, C_INP}; pg8::StaticOrder S; S.init(MTOK, C_KV, G, bx);
                          pg8::EpiAff E{lnd((bf16*)(R + RC_KV)), C_KV, pg8::RowStat{nullptr, (const float*)(ws + WS_SSQC) + MTOK, 1.f / C_KVL, RMS_EPS, 2}, nullptr, nullptr, nullptr, nullptr};
                          pg8::gemm_phase<pg8::EpiAff, pg8::StaticOrder, PG8_ALIGN, PG8_SP2>(lds + RING_OFF, g, S, E, tid); }
                    }
                    SEAM();
                    PCAT(16);
                    if (IN_PH()) { PH_VARS attn_phase_c((const bf16*)(R + RC_Q), (const bf16*)(R + RC_KV), (const bf16*)(R + RC_KR), (bf16*)(R + RC_ATT), (const float*)(ws + WS_TABC), (LAS char*)(lds + RING_OFF), G, bx, tid); }
                    SEAM();
                }
            }
            PCAT(sub == 1 ? 13 : 11);
            if (IN_PH()) { PH_VARS
                const int cls_ = (bx & 7) >> 1; const int pm_before = (cls_ == 0) ? 3 : (cls_ == 1) ? 1 : (cls_ == 2) ? 2 : 0;
                if (pm_before) { CVT_NEXT(pm_before); __syncthreads(); }
                const bf16* A; const bf16* Bt; int K; float s;
                if (sub != 1) { A = (const bf16*)(R + R_ACT); Bt = WTB(si) + WT_FFN_OUT; K = DFF; s = 0.5f; }
                else if (kind == 0) { A = (const bf16*)(R + RA_ATT); Bt = WTB(si) + WT_A_OUT; K = DM; s = 1.0f; }
                else if (kind == 1) { A = (const bf16*)(R + RB_ATT); Bt = WTB(si) + WT_B_OUT; K = 1024; s = 1.0f; }
                else { A = (const bf16*)(R + RC_ATT); Bt = WTB(si) + WT_C_OUT; K = DM; s = 1.0f; }
                pg8::Gemm g{lnd(A), lnd(Bt), MTOK, DM, K, K, (sub != 1) ? 1 : 0}; pg8::StaticOrder S; S.init(MTOK, DM, G, bx);
                pg8::EpiResid2 E{lnd(HB), lnd(LO), STAT_SUM(si), STAT_SUM(si) + MTOK, arg_in(lnprev), arg_in(lnprev + 1), PREV_STAT(), DM, ALPHA, s};
                pg8::gemm_phase<pg8::EpiResid2, pg8::StaticOrder, PG8_ALIGN, PG8_SP2>(lds + RING_OFF, g, S, E, tid);
                if (pm_before != 3) { __syncthreads(); CVT_NEXT(3 ^ pm_before); }
            }
            SEAM();
        }
    }
    PCAT(2);
    if (IN_PH()) { PH_VARS ln_final(H32, HB, LO, STAT_SUM(11), STAT_SUM(11) + MTOK, arg_in(55), arg_in(56), gt, NGT); }
    SEAM();
    }
#if PROBE_CAT >= 0
    SEAM_BAR();
    { unsigned on3_ = ~0u; asm volatile("" : "+s"(on3_)); const int ln_ = (int)__builtin_amdgcn_mbcnt_hi(on3_, __builtin_amdgcn_mbcnt_lo(on3_, 0u));
      for (size_t i = (size_t)bx0 * 512 + wave * 64 + ln_; i < (size_t)MTOK * DM / 4; i += (size_t)G0 * 512) ((GAS f32x4*)out0)[i] = (f32x4){16.f, 16.f, 16.f, 16.f}; }
    SEAM_BAR();
    { unsigned on2_ = ~0u; asm volatile("" : "+s"(on2_)); if (bx0 == 0 && wave == 0 && __builtin_amdgcn_mbcnt_hi(on2_, __builtin_amdgcn_mbcnt_lo(on2_, 0u)) == 0u) { const unsigned long long tot = __builtin_amdgcn_s_memrealtime() - PR[2]; out0[0] = (PROBE_CAT == 5) ? ((float)tot * 1e-5f - 15.0f) * 100.0f : (float)PR[1] * ((PROBE_CAT >= 6 && PROBE_CAT != 10) ? 1e-3f : 1e-4f); } }
#endif
#undef IN_PH
#undef SEAM
}

extern "C" void kernel_launch(void* const* d_in, const int* in_sizes, int n_in, void* d_out, int out_size, void* d_ws, size_t ws_size, hipStream_t stream) {
    static int grid = 0;
    if (grid == 0) {
        if (n_in != N_IN || in_sizes[0] != MTOK * DM || out_size != MTOK * DM || ws_size < WS_END) {
            fprintf(stderr, "kernel_launch: shape mismatch: n_in %d in0 %d out %d ws %zu (need >= %zu)\n", n_in, n_in > 0 ? in_sizes[0] : -1, out_size, ws_size, (size_t)WS_END); grid = -1; return; }
        int dev = 0, cus = 0, per_cu = 0;
        if (hipGetDevice(&dev) != hipSuccess || hipDeviceGetAttribute(&cus, hipDeviceAttributeMultiprocessorCount, dev) != hipSuccess) { fprintf(stderr, "kernel_launch: device query failed\n"); grid = -1; return; }
        if (hipFuncSetAttribute((const void*)mega_fwd, hipFuncAttributeMaxDynamicSharedMemorySize, LDS_BYTES) != hipSuccess) { fprintf(stderr, "kernel_launch: hipFuncSetAttribute failed\n"); grid = -1; return; }
        if (hipOccupancyMaxActiveBlocksPerMultiprocessor(&per_cu, (const void*)mega_fwd, NWAVES * 64, LDS_BYTES) != hipSuccess || per_cu < 1)
            fprintf(stderr, "kernel_launch: note: occupancy query reports %d workgroups per CU\n", per_cu);
        (void)hipGetLastError();
        grid = cus;
    }
    if (grid < 0) return;
    if (hipMemsetAsync((char*)d_ws + WS_CTL, 0, CTL_ZERO_BYTES, stream) != hipSuccess) { fprintf(stderr, "kernel_launch: memset failed\n"); return; }
    Args a{};
    for (int i = 0; i < N_IN; ++i) a.in[i] = (const float*)d_in[i];
    a.out = (float*)d_out; a.ws = (unsigned char*)d_ws;
#if MK_PER_PHASE
    for (int p = 0; p < N_PHASES; ++p) { a.ph_lo = p; a.ph_hi = p + 1; hipLaunchKernelGGL(mega_fwd, dim3(grid), dim3(NWAVES * 64), LDS_BYTES, stream, a); }
#else
    a.ph_lo = 0; a.ph_hi = N_PHASES;
    hipLaunchKernelGGL(mega_fwd, dim3(grid), dim3(NWAVES * 64), LDS_BYTES, stream, a);
#if LAUNCH_TWICE
    (void)hipMemsetAsync((char*)d_ws + WS_CTL, 0, CTL_ZERO_BYTES, stream);
    hipLaunchKernelGGL(mega_fwd, dim3(grid), dim3(NWAVES * 64), LDS_BYTES, stream, a);
#endif
#endif
    const hipError_t le = hipPeekAtLastError();
    if (le != hipSuccess) fprintf(stderr, "kernel_launch: launch failed: %s\n", hipGetErrorName(le));
}
```

```cpp
#include <hip/hip_runtime.h>
#include <cstdio>
#include <cstdint>

#ifndef FAST_A
#define FAST_A 1
#endif
#ifndef FAST_B
#define FAST_B 1
#endif
#ifndef FAST_C
#define FAST_C 1
#endif
#ifndef EXP
#define EXP 0
#endif
#ifndef LAUNCH_TWICE
#define LAUNCH_TWICE 0
#endif
#ifndef REPS
#define REPS 1
#endif
#ifndef PROBE_CAT
#define PROBE_CAT -1
#endif
#ifndef MK_PER_PHASE
#define MK_PER_PHASE 0
#endif

namespace pg8 {
#define PG8_LAS __attribute__((address_space(3)))
typedef unsigned short bf16_t;
typedef short bf16x8 __attribute__((ext_vector_type(8)));
typedef float f32x4 __attribute__((ext_vector_type(4)));
typedef unsigned u32x4 __attribute__((ext_vector_type(4)));
typedef unsigned u32x2 __attribute__((ext_vector_type(2)));
typedef float f32x2_t __attribute__((ext_vector_type(2)));
__device__ __forceinline__ float lo_sc(float d) { return __builtin_amdgcn_fmed3f(d * 512.f, -240.f, 240.f); }
constexpr float LO_SCALE = 512.f, LO_INV = 1.f / 512.f;
constexpr int BM = 256, BK = 64, HALF = 128, HTB = HALF * BK * 2  , STAGE_BYTES = 8 * HTB, NXCD = 8, WGM = 8;

__host__ __device__ __forceinline__ int lds_byte(int r, int c) { const int st = (r >> 4) * 2 + (c >> 5), rr = r & 15, cc = c & 31, ob = rr * 64 + cc * 2; return st * 1024 + (ob ^ (((ob >> 9) & 1) << 5)); }
__host__ __device__ __forceinline__ void stage_rc(int b, int& R, int& C) { const int st = b / 1024, sb = b % 1024, swz = sb ^ (((sb >> 9) & 1) << 5); R = (st >> 1) * 16 + swz / 64; C = (st & 1) * 32 + (swz % 64) / 2; }
__host__ __device__ __forceinline__ int perm32(int rho) { const int n = rho >> 4, i = rho & 15; return 8 * (i >> 2) + 4 * n + (i & 3); }

struct Unit { int pm, pn; };
__host__ __device__ __forceinline__ size_t tl_off(int row, int col, int ntk) { return ((((size_t)(row >> 8) * (size_t)ntk + (size_t)(col >> 6)) * 256 + (size_t)(row & 255)) * 64) + (size_t)(col & 63); }
__host__ __device__ __forceinline__ size_t tl_off32(int row, int col, int ntk) { return (((((size_t)(row >> 8) * (size_t)ntk + (size_t)(col >> 6)) * 2 + (size_t)((col >> 5) & 1)) * 256 + (size_t)(row & 255)) * 32) + (size_t)(col & 31); }
struct Gemm { const bf16_t* A; const bf16_t* Bt; int M, N, K, lda; int tiledA = 0; };

struct StaticOrder {
    int nM, nN, nwg, G, c;
    __host__ __device__ void init(int M, int N, int G_, int c_) { nM = M / BM; nN = N / BM; nwg = nM * nN; G = G_; c = c_; }
    __host__ __device__ bool next(int i, Unit& u) const {
        const long L = (long)i * G + c; if (L >= nwg) return false;
        int wgid = (int)L; { const int q = nwg / NXCD, r = nwg % NXCD, xcd = wgid % NXCD, off = wgid / NXCD; wgid = (xcd < r ? xcd * (q + 1) : r * (q + 1) + (xcd - r) * q) + off; }
        const int nig = WGM * nN, gid = wgid / nig, fm = gid * WGM, gsz = (nM - fm) < WGM ? (nM - fm) : WGM;
        if (nN == 8 && gsz == WGM) { u.pm = fm + ((wgid % nig) >> 3); u.pn = (wgid % nig) & 7; }
        else { u.pm = fm + ((wgid % nig) % gsz); u.pn = (wgid % nig) / gsz; }
        return true;
    }
    __device__ __forceinline__ void a_ready(const Unit&) const {}
    __device__ __forceinline__ void done(const Unit&) const {}
};

__device__ __forceinline__ unsigned cvt_pk_bf16(float lo, float hi) { unsigned r; asm volatile("v_cvt_pk_bf16_f32 %0, %1, %2" : "=v"(r) : "v"(lo), "v"(hi)); return r; }

struct EpiBf16 {
    static constexpr bool PERM = true, AFTER_DRAIN = false;
    bf16_t* O; int ldc;
    __device__ __forceinline__ void operator()(const f32x4 (&acc)[2][2][4][2], const Unit& u, int wr, int wc, int fr, int fq) const {
        const int row0 = u.pm * BM + wr * 64 + fr; const int col0 = u.pn * BM + wc * 32 + 8 * fq;
#pragma unroll
        for (int ai = 0; ai < 2; ++ai)
#pragma unroll
            for (int m = 0; m < 4; ++m) { bf16_t* rowp = O + (size_t)(row0 + ai * HALF + m * 16) * ldc + col0;
#pragma unroll
                for (int bj = 0; bj < 2; ++bj) { const f32x4 v0 = acc[ai][bj][m][0], v1 = acc[ai][bj][m][1];
                    u32x4 w; w.x = cvt_pk_bf16(v0[0], v0[1]); w.y = cvt_pk_bf16(v0[2], v0[3]); w.z = cvt_pk_bf16(v1[0], v1[1]); w.w = cvt_pk_bf16(v1[2], v1[3]);
                    *(u32x4*)(rowp + bj * HALF) = w; } }
    }
};
__device__ __forceinline__ float silu_mul(float g, float u) { return g * u * __builtin_amdgcn_rcpf(1.0f + __builtin_amdgcn_exp2f(-1.4426950408889634f * g)); }
struct EpiSwiGLU {
    static constexpr bool PERM = true, AFTER_DRAIN = false;
    bf16_t* O; int ldc;
    __device__ __forceinline__ void operator()(const f32x4 (&acc)[2][2][4][2], const Unit& u, int wr, int wc, int fr, int fq) const {
        const int row0 = u.pm * BM + wr * 64 + fr; const int col0 = u.pn * HALF + wc * 32 + 8 * fq;
#pragma unroll
        for (int ai = 0; ai < 2; ++ai)
#pragma unroll
            for (int m = 0; m < 4; ++m) { bf16_t* rowp = O + (size_t)(row0 + ai * HALF + m * 16) * ldc + col0;
                const f32x4 g0 = acc[ai][0][m][0], g1 = acc[ai][0][m][1], u0 = acc[ai][1][m][0], u1 = acc[ai][1][m][1];
                u32x4 w; w.x = cvt_pk_bf16(silu_mul(g0[0], u0[0]), silu_mul(g0[1], u0[1])); w.y = cvt_pk_bf16(silu_mul(g0[2], u0[2]), silu_mul(g0[3], u0[3]));
                w.z = cvt_pk_bf16(silu_mul(g1[0], u1[0]), silu_mul(g1[1], u1[1])); w.w = cvt_pk_bf16(silu_mul(g1[2], u1[2]), silu_mul(g1[3], u1[3]));
                *(u32x4*)rowp = w; }
    }
};
struct EpiResid {
    static constexpr bool PERM = false, AFTER_DRAIN = false;
    const float* hin; float* hout; int ldc; float alpha, s;
    __device__ __forceinline__ void operator()(const f32x4 (&acc)[2][2][4][2], const Unit& u, int wr, int wc, int fr, int fq) const {
        const int row0 = u.pm * BM + wr * 64 + fr, col0 = u.pn * BM + wc * 32 + 4 * fq;
#pragma unroll
        for (int ai = 0; ai < 2; ++ai)
#pragma unroll
            for (int m = 0; m < 4; ++m) { const size_t off = (size_t)(row0 + ai * HALF + m * 16) * ldc + col0;
#pragma unroll
                for (int bj = 0; bj < 2; ++bj)
#pragma unroll
                    for (int n = 0; n < 2; ++n) { const f32x4 hv = *(const f32x4*)(hin + off + bj * HALF + n * 16); *(f32x4*)(hout + off + bj * HALF + n * 16) = hv * alpha + acc[ai][bj][m][n] * s; } }
    }
};


struct RowStat { const float* sum; const float* ssq; float inv_n, eps; int mode; };
__device__ __forceinline__ void row_stat(const RowStat& st, int row, float& rs, float& rm) {
    if (st.mode == 0 || EXP == 1) { rs = 1.f; rm = 0.f; }
    else { const float q = st.ssq[row] * st.inv_n;
        if (st.mode == 1) { const float mean = st.sum[row] * st.inv_n; rs = __builtin_amdgcn_rsqf(q - mean * mean + st.eps); rm = rs * mean; }
        else { rs = __builtin_amdgcn_rsqf(q + st.eps); rm = 0.f; } }
}
__device__ __forceinline__ void row_stat8(const RowStat& st, int row0, float (&rs)[8], float (&rm)[8]) {
    if (st.mode == 0 || EXP == 1) {
#pragma unroll
        for (int i = 0; i < 8; ++i) { rs[i] = 1.f; rm[i] = 0.f; }
    } else {
        float q[8], sm[8];
#pragma unroll
        for (int i = 0; i < 8; ++i) { const int row = row0 + (i >> 2) * HALF + (i & 3) * 16; q[i] = st.ssq[row]; sm[i] = 0.f; }
        if (st.mode == 1) {
#pragma unroll
            for (int i = 0; i < 8; ++i) { const int row = row0 + (i >> 2) * HALF + (i & 3) * 16; sm[i] = st.sum[row]; }
        }
#pragma unroll
        for (int i = 0; i < 8; ++i) { const float mean = sm[i] * st.inv_n; rs[i] = __builtin_amdgcn_rsqf(q[i] * st.inv_n - mean * mean + st.eps); rm[i] = rs[i] * mean; }
    }
}
struct EpiAff {
    static constexpr bool PERM = true, AFTER_DRAIN = false;
    bf16_t* O; int ldc; RowStat st; const float* u; const float* v; float* ssq_out;
    const float* rope;
    __device__ __forceinline__ void operator()(const f32x4 (&acc)[2][2][4][2], const Unit& un, int wr, int wc, int fr, int fq) const {
        const int row0 = un.pm * BM + wr * 64 + fr; const int col0 = un.pn * BM + wc * 32 + 8 * fq;
        f32x4 uu[2][2], vv[2][2];
#pragma unroll
        for (int bj = 0; bj < 2; ++bj)
#pragma unroll
            for (int n = 0; n < 2; ++n) { if (u) { uu[bj][n] = *(const f32x4*)(u + col0 + bj * HALF + 4 * n); vv[bj][n] = *(const f32x4*)(v + col0 + bj * HALF + 4 * n); } else { uu[bj][n] = (f32x4){0.f, 0.f, 0.f, 0.f}; vv[bj][n] = uu[bj][n]; } }
        float* sq = nullptr; if (ssq_out && un.pn < 5) sq = ssq_out + (un.pn < 3 ? 0 : 32768);
        const bool dorope = (rope != nullptr) && ((un.pn % 12) < 8);
        float rs8[8], rm8[8]; row_stat8(st, row0, rs8, rm8);
#pragma unroll
        for (int ai = 0; ai < 2; ++ai)
#pragma unroll
            for (int m = 0; m < 4; ++m) { const int row = row0 + ai * HALF + m * 16; const float rs = rs8[ai * 4 + m], rm = rm8[ai * 4 + m];
                bf16_t* rowp = O + (size_t)row * ldc + col0; float ss = 0.f;
                f32x4 rc = {1.f, 1.f, 1.f, 1.f}, rsn = {0.f, 0.f, 0.f, 0.f};
                if (dorope) { const float* tp = rope + (size_t)(row & 2047) * 64 + wc * 16 + 4 * fq; rc = *(const f32x4*)tp; rsn = *(const f32x4*)(tp + 2048 * 64); }
#pragma unroll
                for (int bj = 0; bj < 2; ++bj) { f32x4 v0 = acc[ai][bj][m][0] * rs + (vv[bj][0] - uu[bj][0] * rm), v1 = acc[ai][bj][m][1] * rs + (vv[bj][1] - uu[bj][1] * rm);
                    if (dorope) { const f32x4 a0 = v0, a1 = v1;
                        v0[0] = a0[0] * rc[0] - a0[1] * rsn[0]; v0[1] = a0[0] * rsn[0] + a0[1] * rc[0]; v0[2] = a0[2] * rc[1] - a0[3] * rsn[1]; v0[3] = a0[2] * rsn[1] + a0[3] * rc[1];
                        v1[0] = a1[0] * rc[2] - a1[1] * rsn[2]; v1[1] = a1[0] * rsn[2] + a1[1] * rc[2]; v1[2] = a1[2] * rc[3] - a1[3] * rsn[3]; v1[3] = a1[2] * rsn[3] + a1[3] * rc[3]; }
                    ss += (v0[0] * v0[0] + v0[1] * v0[1]) + (v0[2] * v0[2] + v0[3] * v0[3]) + (v1[0] * v1[0] + v1[1] * v1[1]) + (v1[2] * v1[2] + v1[3] * v1[3]);
                    u32x4 w; w.x = cvt_pk_bf16(v0[0], v0[1]); w.y = cvt_pk_bf16(v0[2], v0[3]); w.z = cvt_pk_bf16(v1[0], v1[1]); w.w = cvt_pk_bf16(v1[2], v1[3]);
                    *(u32x4*)(rowp + bj * HALF) = w; }
                if (sq) { ss += __shfl_xor(ss, 16); ss += __shfl_xor(ss, 32); if (fq == 0) __hip_atomic_fetch_add(sq + row, ss, __ATOMIC_RELAXED, __HIP_MEMORY_SCOPE_AGENT); } }
    }
};
struct EpiAffA {
    static constexpr bool PERM = true, AFTER_DRAIN = false;
    bf16_t* O; int ldc; RowStat st; const float* u; const float* v; const float* qg; const float* kg; const float* taba; PG8_LAS float* xch;
    __device__ __forceinline__ void operator()(f32x4 (&acc)[2][2][4][2], const Unit& un, int wr, int wc, int fr, int fq) const {
        const int row0 = un.pm * BM + wr * 64 + fr; const int col0 = un.pn * BM + wc * 32 + 8 * fq;
        const bool nr = un.pn < 10;
        { f32x4 uu[2][2], vv[2][2];
#pragma unroll
          for (int bj = 0; bj < 2; ++bj)
#pragma unroll
            for (int n = 0; n < 2; ++n) { uu[bj][n] = *(const f32x4*)(u + col0 + bj * HALF + 4 * n); vv[bj][n] = *(const f32x4*)(v + col0 + bj * HALF + 4 * n); }
          float rs8[8], rm8[8]; row_stat8(st, row0, rs8, rm8);
#pragma unroll
          for (int ai = 0; ai < 2; ++ai)
#pragma unroll
            for (int m = 0; m < 4; ++m) { const float rs = rs8[ai * 4 + m], rm = rm8[ai * 4 + m]; float sq[2];
#pragma unroll
                for (int bj = 0; bj < 2; ++bj) { const f32x4 v0 = acc[ai][bj][m][0] * rs + (vv[bj][0] - uu[bj][0] * rm), v1 = acc[ai][bj][m][1] * rs + (vv[bj][1] - uu[bj][1] * rm);
                    acc[ai][bj][m][0] = v0; acc[ai][bj][m][1] = v1;
                    sq[bj] = (v0[0] * v0[0] + v0[1] * v0[1]) + (v0[2] * v0[2] + v0[3] * v0[3]) + (v1[0] * v1[0] + v1[1] * v1[1]) + (v1[2] * v1[2] + v1[3] * v1[3]); }
                if (nr) { sq[0] += __shfl_xor(sq[0], 16); sq[0] += __shfl_xor(sq[0], 32); sq[1] += __shfl_xor(sq[1], 16); sq[1] += __shfl_xor(sq[1], 32);
                    if (fq == 0) { const int rl = ai * HALF + wr * 64 + m * 16 + fr; xch[(rl * 2 + 0) * 4 + wc] = sq[0]; xch[(rl * 2 + 1) * 4 + wc] = sq[1]; } } }
        }
        if (nr) { asm volatile("s_waitcnt lgkmcnt(0)" ::: "memory"); __builtin_amdgcn_s_barrier(); asm volatile("" ::: "memory"); }
        f32x4 ga = {1.f, 1.f, 1.f, 1.f}, gb = ga;
        const int hf = wc >> 1, ib = (wc & 1) * 16 + 4 * fq;
        if (nr) { const float* gp = (un.pn < 8) ? qg : kg; ga = *(const f32x4*)(gp + 64 * hf + ib); gb = *(const f32x4*)(gp + 64 * hf + ib + 32); }
#pragma unroll
        for (int ai = 0; ai < 2; ++ai)
#pragma unroll
            for (int m = 0; m < 4; ++m) { const int row = row0 + ai * HALF + m * 16; bf16_t* rowp = O + (size_t)row * ldc + col0;
                f32x4 rc = {1.f, 1.f, 1.f, 1.f}, rsn = {0.f, 0.f, 0.f, 0.f};
                if (nr) { const int sp = row & 2047, pos = hf ? (sp & 63) : (sp >> 6); const float* tp = taba + pos * 32 + ib; rc = *(const f32x4*)tp; rsn = *(const f32x4*)(tp + 64 * 32); }
#pragma unroll
                for (int bj = 0; bj < 2; ++bj) { f32x4 v0 = acc[ai][bj][m][0], v1 = acc[ai][bj][m][1];
                    if (nr) { const int rl = ai * HALF + wr * 64 + m * 16 + fr; const f32x4 pp = *(const PG8_LAS f32x4*)(xch + (rl * 2 + bj) * 4);
                        const float rn = __builtin_amdgcn_rsqf(((pp[0] + pp[1]) + (pp[2] + pp[3])) * (1.f / 128.f) + 1e-6f);
                        const float a0 = v0[0] * rn * ga[0], b0 = v0[1] * rn * gb[0], a1 = v0[2] * rn * ga[1], b1 = v0[3] * rn * gb[1], a2 = v1[0] * rn * ga[2], b2 = v1[1] * rn * gb[2], a3 = v1[2] * rn * ga[3], b3 = v1[3] * rn * gb[3];
                        v0[0] = a0 * rc[0] - b0 * rsn[0]; v0[1] = a0 * rsn[0] + b0 * rc[0]; v0[2] = a1 * rc[1] - b1 * rsn[1]; v0[3] = a1 * rsn[1] + b1 * rc[1];
                        v1[0] = a2 * rc[2] - b2 * rsn[2]; v1[1] = a2 * rsn[2] + b2 * rc[2]; v1[2] = a3 * rc[3] - b3 * rsn[3]; v1[3] = a3 * rsn[3] + b3 * rc[3]; }
                    u32x4 w; w.x = cvt_pk_bf16(v0[0], v0[1]); w.y = cvt_pk_bf16(v0[2], v0[3]); w.z = cvt_pk_bf16(v1[0], v1[1]); w.w = cvt_pk_bf16(v1[2], v1[3]);
                    *(u32x4*)(rowp + bj * HALF) = w; } }
    }
};
struct EpiAffSwiGLU {
    static constexpr bool PERM = true, AFTER_DRAIN = false;
    bf16_t* O; int ldc; RowStat st; const float* u; const float* v;
    __device__ __forceinline__ void operator()(const f32x4 (&acc)[2][2][4][2], const Unit& un, int wr, int wc, int fr, int fq) const {
        const int row0 = un.pm * BM + wr * 64 + fr; const int col0 = un.pn * HALF + wc * 32 + 8 * fq, ucol0 = un.pn * BM + wc * 32 + 8 * fq;
        f32x4 uu[2][2], vv[2][2];
#pragma unroll
        for (int bj = 0; bj < 2; ++bj)
#pragma unroll
            for (int n = 0; n < 2; ++n) { uu[bj][n] = *(const f32x4*)(u + ucol0 + bj * HALF + 4 * n); vv[bj][n] = *(const f32x4*)(v + ucol0 + bj * HALF + 4 * n); }
        float rs8[8], rm8[8]; row_stat8(st, row0, rs8, rm8);
#pragma unroll
        for (int ai = 0; ai < 2; ++ai)
#pragma unroll
            for (int m = 0; m < 4; ++m) { const int row = row0 + ai * HALF + m * 16; const float rs = rs8[ai * 4 + m], rm = rm8[ai * 4 + m];
                bf16_t* rowp = O + ((((size_t)(row >> 8) * (size_t)(ldc >> 6) + (size_t)(col0 >> 6)) * BM + (size_t)(row & 255)) * BK + (size_t)(col0 & 63));
                const f32x4 g0 = acc[ai][0][m][0] * rs + (vv[0][0] - uu[0][0] * rm), g1 = acc[ai][0][m][1] * rs + (vv[0][1] - uu[0][1] * rm);
                const f32x4 u0 = acc[ai][1][m][0] * rs + (vv[1][0] - uu[1][0] * rm), u1 = acc[ai][1][m][1] * rs + (vv[1][1] - uu[1][1] * rm);
                u32x4 w; w.x = cvt_pk_bf16(silu_mul(g0[0], u0[0]), silu_mul(g0[1], u0[1])); w.y = cvt_pk_bf16(silu_mul(g0[2], u0[2]), silu_mul(g0[3], u0[3]));
                w.z = cvt_pk_bf16(silu_mul(g1[0], u1[0]), silu_mul(g1[1], u1[1])); w.w = cvt_pk_bf16(silu_mul(g1[2], u1[2]), silu_mul(g1[3], u1[3]));
                __builtin_nontemporal_store(w, (u32x4*)rowp); }
    }
};
struct EpiResid2 {
    static constexpr bool PERM = true, AFTER_DRAIN = false;
    bf16_t* hi; unsigned char* lo; float* sum_out; float* ssq_out; const float* g; const float* b; RowStat st; int ldc; float alpha, s;
    __device__ __forceinline__ void operator()(const f32x4 (&acc)[2][2][4][2], const Unit& un, int wr, int wc, int fr, int fq) const {
        const int row0 = un.pm * BM + wr * 64 + fr, col0 = un.pn * BM + wc * 32 + 8 * fq;
        f32x4 gg[2][2], bb[2][2];
#pragma unroll
        for (int bj = 0; bj < 2; ++bj)
#pragma unroll
            for (int n = 0; n < 2; ++n) { if (st.mode != 0) { gg[bj][n] = *(const f32x4*)(g + col0 + bj * HALF + 4 * n); bb[bj][n] = *(const f32x4*)(b + col0 + bj * HALF + 4 * n); } else { gg[bj][n] = (f32x4){1.f, 1.f, 1.f, 1.f}; bb[bj][n] = (f32x4){0.f, 0.f, 0.f, 0.f}; } }
        u32x4 x[8][2]; u32x2 xl[8][2]; float q8[8], s8[8];
#define RS2_LOAD(gi) do { const int ai_ = (gi) >> 2, m_ = (gi) & 3; const int row_ = row0 + ai_ * HALF + m_ * 16; const size_t off_ = tl_off32(row_, col0, ldc >> 6); \
            _Pragma("unroll") for (int bj = 0; bj < 2; ++bj) { \
                x[gi][bj] = *(const u32x4*)(hi + off_ + bj * (2 * 256 * 64)); xl[gi][bj] = *(const u32x2*)(lo + off_ + bj * (2 * 256 * 64)); } \
            q8[gi] = 0.f; s8[gi] = 0.f; if (st.mode == 1 && EXP != 1) { q8[gi] = st.ssq[row_]; s8[gi] = st.sum[row_]; } } while (0)
        RS2_LOAD(0);
#pragma unroll
        for (int gi = 0; gi < 8; ++gi) { const int ai = gi >> 2, m = gi & 3;
            if (gi + 1 < 8) { if (gi == 0) RS2_LOAD(1); else if (gi == 1) RS2_LOAD(2); else if (gi == 2) RS2_LOAD(3); else if (gi == 3) RS2_LOAD(4); else if (gi == 4) RS2_LOAD(5); else if (gi == 5) RS2_LOAD(6); else RS2_LOAD(7); }
            __builtin_amdgcn_sched_barrier(0);
            const int row = row0 + ai * HALF + m * 16; float rs = 1.f, rm = 0.f;
            if (st.mode == 1 && EXP != 1) { const float mean = s8[gi] * st.inv_n; rs = __builtin_amdgcn_rsqf(q8[gi] * st.inv_n - mean * mean + st.eps); rm = rs * mean; }
            const size_t off = tl_off32(row, col0, ldc >> 6); float sm = 0.f, ss = 0.f;
#pragma unroll
            for (int bj = 0; bj < 2; ++bj) {
                f32x4 x0, x1;
                { const u32x4 hw = x[gi][bj]; const u32x2 lw = xl[gi][bj];
                    const f32x2_t l01 = __builtin_amdgcn_cvt_pk_f32_fp8((int)lw[0], false), l23 = __builtin_amdgcn_cvt_pk_f32_fp8((int)lw[0], true), l45 = __builtin_amdgcn_cvt_pk_f32_fp8((int)lw[1], false), l67 = __builtin_amdgcn_cvt_pk_f32_fp8((int)lw[1], true);
                    x0[0] = __uint_as_float(hw[0] << 16) + l01[0] * LO_INV; x0[1] = __uint_as_float(hw[0] & 0xffff0000u) + l01[1] * LO_INV;
                    x0[2] = __uint_as_float(hw[1] << 16) + l23[0] * LO_INV; x0[3] = __uint_as_float(hw[1] & 0xffff0000u) + l23[1] * LO_INV;
                    x1[0] = __uint_as_float(hw[2] << 16) + l45[0] * LO_INV; x1[1] = __uint_as_float(hw[2] & 0xffff0000u) + l45[1] * LO_INV;
                    x1[2] = __uint_as_float(hw[3] << 16) + l67[0] * LO_INV; x1[3] = __uint_as_float(hw[3] & 0xffff0000u) + l67[1] * LO_INV; }
                const f32x4 h0 = (x0 * rs - rm) * gg[bj][0] + bb[bj][0], h1 = (x1 * rs - rm) * gg[bj][1] + bb[bj][1];
                const f32x4 p0 = h0 * alpha + acc[ai][bj][m][0] * s, p1 = h1 * alpha + acc[ai][bj][m][1] * s;
                u32x4 w; w.x = cvt_pk_bf16(p0[0], p0[1]); w.y = cvt_pk_bf16(p0[2], p0[3]); w.z = cvt_pk_bf16(p1[0], p1[1]); w.w = cvt_pk_bf16(p1[2], p1[3]);
                int l0 = __builtin_amdgcn_cvt_pk_fp8_f32(lo_sc(p0[0] - __uint_as_float(w.x << 16)), lo_sc(p0[1] - __uint_as_float(w.x & 0xffff0000u)), 0, false);
                l0 = __builtin_amdgcn_cvt_pk_fp8_f32(lo_sc(p0[2] - __uint_as_float(w.y << 16)), lo_sc(p0[3] - __uint_as_float(w.y & 0xffff0000u)), l0, true);
                int l1 = __builtin_amdgcn_cvt_pk_fp8_f32(lo_sc(p1[0] - __uint_as_float(w.z << 16)), lo_sc(p1[1] - __uint_as_float(w.z & 0xffff0000u)), 0, false);
                l1 = __builtin_amdgcn_cvt_pk_fp8_f32(lo_sc(p1[2] - __uint_as_float(w.w << 16)), lo_sc(p1[3] - __uint_as_float(w.w & 0xffff0000u)), l1, true);
                *(u32x4*)(hi + off + bj * (2 * 256 * 64)) = w; *(u32x2*)(lo + off + bj * (2 * 256 * 64)) = (u32x2){(unsigned)l0, (unsigned)l1};
                sm += ((p0[0] + p0[1]) + (p0[2] + p0[3])) + ((p1[0] + p1[1]) + (p1[2] + p1[3]));
                ss += (p0[0] * p0[0] + p0[1] * p0[1]) + (p0[2] * p0[2] + p0[3] * p0[3]) + (p1[0] * p1[0] + p1[1] * p1[1]) + (p1[2] * p1[2] + p1[3] * p1[3]); }
            sm += __shfl_xor(sm, 16); sm += __shfl_xor(sm, 32); ss += __shfl_xor(ss, 16); ss += __shfl_xor(ss, 32);
            if (fq == 0 && EXP != 1) { __hip_atomic_fetch_add(sum_out + row, sm, __ATOMIC_RELAXED, __HIP_MEMORY_SCOPE_AGENT); __hip_atomic_fetch_add(ssq_out + row, ss, __ATOMIC_RELAXED, __HIP_MEMORY_SCOPE_AGENT); }
        }
#undef RS2_LOAD
    }
};

template <class Epi, class Sched, bool ALIGN_EPI = false, bool SP2 = false>
__device__ __forceinline__ void gemm_phase(PG8_LAS unsigned char* lds, const Gemm g, const Sched& S, const Epi& E, int tid_) {
    asm volatile("" : "+v"(tid_));
    const int tid = tid_, wid = __builtin_amdgcn_readfirstlane(tid >> 6), lane = tid & 63, wr = wid >> 2, wc = wid & 3, fr = lane & 15, fq = lane >> 4;
    const int K = g.K, nt = K / BK;
    unsigned voffA[2], voffB[2];
#pragma unroll
    for (int i = 0; i < 2; ++i) { int R, C; stage_rc(tid * 16 + i * 8192, R, C); const int Rb = Epi::PERM ? ((R & ~31) + perm32(R & 31)) : R;
        voffA[i] = (g.tiledA == 2) ? (unsigned)((C >> 5) * (BM * 32) + R * 32 + (C & 31)) * 2u : (unsigned)(R * (g.tiledA ? BK : g.lda) + C) * 2u; voffB[i] = (unsigned)(Rb * BK + C) * 2u; }
    const size_t kstepR = (size_t)(BK * 2), kstep = (size_t)(BM * BK * 2)  , kstepA = g.tiledA ? (size_t)(BM * BK * 2) : kstepR;
    const size_t hstep = (size_t)(HALF * BK * 2), hstepA = (g.tiledA == 2) ? (size_t)(HALF * 32 * 2) : g.tiledA ? (size_t)(HALF * BK * 2) : (size_t)HALF * g.lda * 2;
    const size_t tstep = (size_t)nt * (BM * BK * 2), tstepA = g.tiledA ? (size_t)nt * (BM * BK * 2) : 2 * hstepA;
    const unsigned ldsw = (unsigned)wid * 1024u;
    const int aoff = lds_byte(wr * 64 + fr, fq * 8), boff = lds_byte(wc * 32 + fr, fq * 8);
#define PG8_SA(b, h) (((b) * 2 + (h)) * HTB)
#define PG8_SB(b, h) ((4 + (b) * 2 + (h)) * HTB)
#define PG8_STAGE(bufoff, gbase, voff) do { _Pragma("unroll") for (int _i = 0; _i < 2; ++_i) \
        __builtin_amdgcn_global_load_lds((const unsigned*)((const char*)(gbase) + (voff)[_i]), (PG8_LAS unsigned*)(lds + (bufoff) + ldsw + _i * 8192), 16, 0, 0); } while (0)
#define PG8_LDA(dst, b, h) do { _Pragma("unroll") for (int m = 0; m < 4; ++m) _Pragma("unroll") for (int k = 0; k < 2; ++k) dst[m][k] = *(const PG8_LAS bf16x8*)(lds + PG8_SA(b, h) + aoff + m * 2048 + k * 1024); } while (0)
#define PG8_LDB(dst, b, h) do { _Pragma("unroll") for (int n = 0; n < 2; ++n) _Pragma("unroll") for (int k = 0; k < 2; ++k) dst[n][k] = *(const PG8_LAS bf16x8*)(lds + PG8_SB(b, h) + boff + n * 2048 + k * 1024); } while (0)
#define PG8_MMA(ai, bj, At, Bt) do { __builtin_amdgcn_s_setprio(1); _Pragma("unroll") for (int m = 0; m < 4; ++m) _Pragma("unroll") for (int n = 0; n < 2; ++n) _Pragma("unroll") for (int k = 0; k < 2; ++k) \
        acc[ai][bj][m][n] = __builtin_amdgcn_mfma_f32_16x16x32_bf16(Bt[n][k], At[m][k], acc[ai][bj][m][n], 0, 0, 0); __builtin_amdgcn_s_setprio(0); } while (0)
#define PG8_WAIT_V(n) asm volatile("s_waitcnt vmcnt(" #n ")" ::: "memory")
#define PG8_WAIT_L(n) asm volatile("s_waitcnt lgkmcnt(" #n ")" ::: "memory")
#define PG8_BAR __builtin_amdgcn_s_barrier()
#define PG8_SCHED __builtin_amdgcn_sched_barrier(0)
    Unit cur, nxt; int ui = 0;
    if (!S.next(0, cur)) return;
    f32x4 acc[2][2][4][2];
#pragma unroll
    for (int a = 0; a < 2; ++a)
#pragma unroll
        for (int b = 0; b < 2; ++b)
#pragma unroll
            for (int m = 0; m < 4; ++m)
#pragma unroll
                for (int n = 0; n < 2; ++n) acc[a][b][m][n] = (f32x4){0.f, 0.f, 0.f, 0.f};
    bf16x8 At[4][2], B0[2][2], B1[2][2];
    const char* cA = (const char*)g.A + (size_t)cur.pm * tstepA; const char* cB = (const char*)g.Bt + (size_t)cur.pn * tstep;
    S.a_ready(cur);
    if constexpr (SP2) {
        PG8_STAGE(PG8_SB(0, 0), cB, voffB); PG8_STAGE(PG8_SB(0, 1), cB + hstep, voffB); PG8_STAGE(PG8_SA(0, 0), cA, voffA); PG8_STAGE(PG8_SA(0, 1), cA + hstepA, voffA);
        if (wr == 1) PG8_BAR;
        PG8_WAIT_V(2); PG8_BAR;
        PG8_STAGE(PG8_SB(1, 0), cB + kstep, voffB); PG8_STAGE(PG8_SA(1, 0), cA + kstepA, voffA); PG8_STAGE(PG8_SB(1, 1), cB + hstep + kstep, voffB);
        PG8_WAIT_V(6); PG8_BAR;
    } else {
        PG8_STAGE(PG8_SB(0, 0), cB, voffB); PG8_STAGE(PG8_SA(0, 0), cA, voffA); PG8_STAGE(PG8_SB(0, 1), cB + hstep, voffB); PG8_STAGE(PG8_SA(0, 1), cA + hstepA, voffA);
        if (wr == 1) PG8_BAR;
        PG8_WAIT_V(4); PG8_BAR;
        PG8_STAGE(PG8_SB(1, 0), cB + kstep, voffB); PG8_STAGE(PG8_SA(1, 0), cA + kstepA, voffA); PG8_STAGE(PG8_SB(1, 1), cB + hstep + kstep, voffB);
        PG8_WAIT_V(6); PG8_BAR;
    }
    for (;;) {
        const bool has_next = S.next(ui + 1, nxt);
        const char* nA = has_next ? (const char*)g.A + (size_t)nxt.pm * tstepA : cA; const char* nB = has_next ? (const char*)g.Bt + (size_t)nxt.pn * tstep : cB;
        for (int t = 0; t < nt; t += 2) {
            const bool last = (t == nt - 2);
            const char* a1 = cA + (size_t)(t + 1) * kstepA;
            const char* a2 = last ? nA : cA + (size_t)(t + 2) * kstepA; const char* b2 = last ? nB : cB + (size_t)(t + 2) * kstep;
            const char* a3 = a2 + kstepA; const char* b3 = b2 + kstep;
            if (last && has_next) S.a_ready(nxt);
            if constexpr (SP2) {
            PG8_LDB(B0, 0, 0); PG8_LDB(B1, 0, 1); PG8_SCHED; PG8_LDA(At, 0, 0); PG8_STAGE(PG8_SA(1, 1), a1 + hstepA, voffA);
            PG8_WAIT_V(8); PG8_WAIT_L(0); PG8_BAR; PG8_MMA(0, 0, At, B0); PG8_MMA(0, 1, At, B1); PG8_BAR; PG8_SCHED;
            PG8_LDA(At, 0, 1); PG8_STAGE(PG8_SB(0, 0), b2, voffB); PG8_STAGE(PG8_SB(0, 1), b2 + hstep, voffB); PG8_STAGE(PG8_SA(0, 0), a2, voffA);
            PG8_WAIT_V(8); PG8_WAIT_L(0); PG8_BAR; PG8_MMA(1, 0, At, B0); PG8_MMA(1, 1, At, B1); PG8_BAR; PG8_SCHED;
            PG8_LDB(B0, 1, 0); PG8_LDB(B1, 1, 1); PG8_SCHED; PG8_LDA(At, 1, 0); PG8_STAGE(PG8_SA(0, 1), a2 + hstepA, voffA);
            PG8_WAIT_V(8); PG8_WAIT_L(0); PG8_BAR; PG8_MMA(0, 0, At, B0); PG8_MMA(0, 1, At, B1); PG8_BAR; PG8_SCHED;
            PG8_LDA(At, 1, 1); PG8_STAGE(PG8_SB(1, 0), b3, voffB); PG8_STAGE(PG8_SB(1, 1), b3 + hstep, voffB); PG8_STAGE(PG8_SA(1, 0), a3, voffA);
            PG8_WAIT_V(8); PG8_WAIT_L(0); PG8_BAR; PG8_MMA(1, 0, At, B0); PG8_MMA(1, 1, At, B1); PG8_BAR; PG8_SCHED;
            } else {
            PG8_LDB(B0, 0, 0); PG8_SCHED; PG8_LDA(At, 0, 0); PG8_STAGE(PG8_SA(1, 1), a1 + hstepA, voffA);
            PG8_WAIT_L(8); PG8_BAR; PG8_WAIT_L(0); PG8_MMA(0, 0, At, B0); PG8_BAR; PG8_SCHED;
            PG8_LDB(B1, 0, 1); PG8_STAGE(PG8_SB(0, 0), b2, voffB);
            PG8_BAR; PG8_WAIT_L(0); PG8_MMA(0, 1, At, B1); PG8_BAR;
            PG8_LDA(At, 0, 1); PG8_STAGE(PG8_SA(0, 0), a2, voffA);
            PG8_BAR; PG8_WAIT_L(0); PG8_MMA(1, 0, At, B0); PG8_BAR; PG8_SCHED;
            PG8_STAGE(PG8_SB(0, 1), b2 + hstep, voffB);
            PG8_WAIT_V(6); PG8_BAR; PG8_MMA(1, 1, At, B1); PG8_BAR;
            PG8_LDB(B0, 1, 0); PG8_SCHED; PG8_LDA(At, 1, 0); PG8_STAGE(PG8_SA(0, 1), a2 + hstepA, voffA);
            PG8_WAIT_L(8); PG8_BAR; PG8_WAIT_L(0); PG8_MMA(0, 0, At, B0); PG8_BAR; PG8_SCHED;
            PG8_LDB(B1, 1, 1); PG8_STAGE(PG8_SB(1, 0), b3, voffB);
            PG8_BAR; PG8_WAIT_L(0); PG8_MMA(0, 1, At, B1); PG8_BAR;
            PG8_LDA(At, 1, 1); PG8_STAGE(PG8_SA(1, 0), a3, voffA);
            PG8_BAR; PG8_WAIT_L(0); PG8_MMA(1, 0, At, B0); PG8_BAR; PG8_SCHED;
            PG8_STAGE(PG8_SB(1, 1), b3 + hstep, voffB);
            PG8_WAIT_V(6); PG8_BAR; PG8_MMA(1, 1, At, B1); PG8_BAR;
            }
        }
        if constexpr (ALIGN_EPI) { if (wr == 0) PG8_BAR; }
#if PROBE_CAT == 20 || PROBE_CAT == 21
        { const unsigned long long te0_ = __builtin_amdgcn_s_memrealtime();
          E(acc, cur, wr, wc, fr, fq);
          asm volatile("s_waitcnt vmcnt(0)" ::: "memory");
          if (wid == 0) { volatile PG8_LAS unsigned long long* PRx = (volatile PG8_LAS unsigned long long*)(lds + 131072 + 320 + 64); volatile PG8_LAS unsigned* MISCx = (volatile PG8_LAS unsigned*)(lds + 131072 + 320);
            if (MISCx[22] == (PROBE_CAT == 20 ? 10u : 11u)) PRx[1] = PRx[1] + (__builtin_amdgcn_s_memrealtime() - te0_); } }
#else
        if constexpr (!Epi::AFTER_DRAIN) { E(acc, cur, wr, wc, fr, fq); S.done(cur); }
#endif
        if (!has_next) break;
#pragma unroll
        for (int a = 0; a < 2; ++a)
#pragma unroll
            for (int b = 0; b < 2; ++b)
#pragma unroll
                for (int m = 0; m < 4; ++m)
#pragma unroll
                    for (int n = 0; n < 2; ++n) acc[a][b][m][n] = (f32x4){0.f, 0.f, 0.f, 0.f};
        cur = nxt; cA = nA; cB = nB; ++ui;
        if constexpr (ALIGN_EPI) { if (wr == 1) PG8_BAR; }
    }
    PG8_WAIT_V(0);
    if constexpr (!ALIGN_EPI) { if (wr == 0) PG8_BAR; }
    PG8_BAR;
#undef PG8_SA
#undef PG8_SB
#undef PG8_STAGE
#undef PG8_LDA
#undef PG8_LDB
#undef PG8_MMA
#undef PG8_WAIT_V
#undef PG8_WAIT_L
#undef PG8_BAR
#undef PG8_SCHED
}
}

#ifndef PG8_SP2
#define PG8_SP2 true
#endif
#ifndef PG8_ALIGN
#define PG8_ALIGN true
#endif

constexpr int NWAVES = 8;
constexpr int BATCH = 16, SEQ = 2048, DM = 2048, DFF = 5632, MTOK = BATCH * SEQ, DEPTH = 4;
constexpr float ALPHA = 1.6817928305074292f;
constexpr float LN_EPS = 1e-5f, RMS_EPS = 1e-6f;
constexpr int A_QKV = 3072, B_QKV = 9216, C_IN = 1344, C_INP = 1536, C_QL = 768, C_KVL = 512, C_Q = 3072, C_KV = 4096;

constexpr size_t MiB = 1u << 20;
constexpr size_t WS_CTL = 0, CTL_ZERO_BYTES = 64 * 1024, DEV_ZERO_END = 8 * MiB;
constexpr size_t WS_STAT = 1 * MiB;
constexpr size_t WS_SSQC = 4 * MiB;
constexpr size_t WS_UV = 5 * MiB;
constexpr size_t WS_TABB = 8 * MiB;
constexpr size_t WS_TABC = 9 * MiB;
constexpr size_t WS_TABA = 10 * MiB;
constexpr size_t WS_WT = 12 * MiB;
constexpr size_t WT_BUF = 72 * MiB;
constexpr size_t WS_HB = 156 * MiB;
constexpr size_t WS_LO = 284 * MiB;
constexpr size_t WS_R = 412 * MiB;
constexpr size_t WS_END = WS_R + 900 * MiB;
constexpr int UV_STRIDE = 2 * 11264;
constexpr size_t WT_FFN_OUT = (size_t)2 * DFF * DM;
constexpr size_t WT_A_OUT = (size_t)A_QKV * DM, WT_B_OUT = (size_t)B_QKV * DM;
constexpr size_t WT_C_QUP = (size_t)C_INP * DM, WT_C_KVUP = WT_C_QUP + (size_t)C_Q * C_QL, WT_C_OUT = WT_C_KVUP + (size_t)C_KV * C_KVL;
constexpr size_t R_ACT = 0;
constexpr size_t RA_QKV = 0, RA_ATT = 192 * MiB;
constexpr size_t RB_QKV = 0, RB_ATT = 576 * MiB, RB_OG = 640 * MiB, RB_LSE = 832 * MiB;
constexpr size_t RC_IN = 0, RC_QN = 96 * MiB, RC_KVN = 144 * MiB, RC_KR = 176 * MiB, RC_Q = 192 * MiB, RC_KV = 384 * MiB, RC_ATT = 640 * MiB;
constexpr int CW_BAR = 4096;

constexpr int RING_OFF = 0, RING_BYTES = 131072;
constexpr int LDSCTL_OFF = RING_BYTES, MISC_OFF = LDSCTL_OFF + 320;
constexpr int XCH_OFF = RING_BYTES + 4096;
constexpr int LDS_BYTES = 147456;

#define GAS __attribute__((address_space(1)))
#define LAS __attribute__((address_space(3)))
typedef unsigned short bf16;
typedef unsigned v4u __attribute__((ext_vector_type(4)));
typedef unsigned v2u __attribute__((ext_vector_type(2)));
typedef float f32x4 __attribute__((ext_vector_type(4)));
typedef float f32x2 __attribute__((ext_vector_type(2)));
typedef GAS unsigned gu32;
#define RLX_AGENT __ATOMIC_RELAXED, __HIP_MEMORY_SCOPE_AGENT
#define LDS_WAIT() asm volatile("s_waitcnt lgkmcnt(0)" ::: "memory")
#define VM_WAIT() asm volatile("s_waitcnt vmcnt(0)" ::: "memory")
__device__ __forceinline__ unsigned f2bf(float f) { unsigned u = __builtin_bit_cast(unsigned, f); return (u + 0x7fffu + ((u >> 16) & 1u)) >> 16; }
__device__ __forceinline__ unsigned pk2(float lo, float hi) { return f2bf(lo) | (f2bf(hi) << 16); }
__device__ __forceinline__ float bflo(unsigned w) { return __uint_as_float(w << 16); }
__device__ __forceinline__ float bfhi(unsigned w) { return __uint_as_float(w & 0xffff0000u); }
__device__ __forceinline__ float bf1(bf16 b) { return __uint_as_float(((unsigned)b) << 16); }
__device__ __forceinline__ void unpack8(const v4u w, float (&x)[8]) { x[0] = bflo(w.x); x[1] = bfhi(w.x); x[2] = bflo(w.y); x[3] = bfhi(w.y); x[4] = bflo(w.z); x[5] = bfhi(w.z); x[6] = bflo(w.w); x[7] = bfhi(w.w); }
__device__ __forceinline__ void unpack8_lo(const v2u w, float (&x)[8]) { const f32x2 a = __builtin_amdgcn_cvt_pk_f32_fp8((int)w.x, false), b = __builtin_amdgcn_cvt_pk_f32_fp8((int)w.x, true), c = __builtin_amdgcn_cvt_pk_f32_fp8((int)w.y, false), d = __builtin_amdgcn_cvt_pk_f32_fp8((int)w.y, true);
    x[0] = a[0] * pg8::LO_INV; x[1] = a[1] * pg8::LO_INV; x[2] = b[0] * pg8::LO_INV; x[3] = b[1] * pg8::LO_INV; x[4] = c[0] * pg8::LO_INV; x[5] = c[1] * pg8::LO_INV; x[6] = d[0] * pg8::LO_INV; x[7] = d[1] * pg8::LO_INV; }
__device__ __forceinline__ v2u pack8_lo(float e0, float e1, float e2, float e3, float e4, float e5, float e6, float e7) {
    int a = __builtin_amdgcn_cvt_pk_fp8_f32(pg8::lo_sc(e0), pg8::lo_sc(e1), 0, false); a = __builtin_amdgcn_cvt_pk_fp8_f32(pg8::lo_sc(e2), pg8::lo_sc(e3), a, true);
    int b = __builtin_amdgcn_cvt_pk_fp8_f32(pg8::lo_sc(e4), pg8::lo_sc(e5), 0, false); b = __builtin_amdgcn_cvt_pk_fp8_f32(pg8::lo_sc(e6), pg8::lo_sc(e7), b, true);
    return (v2u){(unsigned)a, (unsigned)b}; }
__device__ __forceinline__ v4u pack8(const float (&x)[8]) { v4u w; w.x = pk2(x[0], x[1]); w.y = pk2(x[2], x[3]); w.z = pk2(x[4], x[5]); w.w = pk2(x[6], x[7]); return w; }

#define XB_TMO      128
#define XB_XCNT(j)  (256  + 64 * (j))
#define XB_XSUB(j)  (1280 + 64 * (j))
#define XB_XGEN(j)  (2304 + 64 * (j))
#define XB_TOP      3328
#define XB_TOPGEN   3392
#define XCD_BAR_WORDS 3456
#define XB_SPIN_CAP (1u << 22)
__device__ __forceinline__ unsigned xb_ld(unsigned* p)              { return __hip_atomic_load(p, __ATOMIC_RELAXED, __HIP_MEMORY_SCOPE_AGENT); }
__device__ __forceinline__ unsigned xb_add(unsigned* p, unsigned v) { return __hip_atomic_fetch_add(p, v, __ATOMIC_RELAXED, __HIP_MEMORY_SCOPE_AGENT); }
__device__ __forceinline__ unsigned xb_xcc_id() { return (unsigned)__builtin_amdgcn_s_getreg((3 << 11) | 20) & 0xFu; }
#define XB_SPIN(cond, bar) do { unsigned _sp = 0; while (cond) { __builtin_amdgcn_s_sleep(1); \
    if ((++_sp & 255u) == 0u) { if (xb_ld(&(bar)[XB_TMO])) break; if (_sp > XB_SPIN_CAP) { atomicAdd(&(bar)[XB_TMO], 1u); break; } } } } while (0)
struct XcdBarrier { unsigned* bar; unsigned x; volatile LAS unsigned* st; };
__device__ __forceinline__ XcdBarrier xcd_barrier_post(unsigned* bar, volatile LAS unsigned* st) {
    XcdBarrier b; b.bar = bar; b.x = xb_xcc_id(); b.st = st;
    if (threadIdx.x == 0) (void)xb_add(&bar[XB_XCNT(b.x)], 1u);
    return b;
}
__device__ __forceinline__ void xcd_barrier_complete(unsigned* bar, unsigned x, unsigned& nloc, unsigned& nx) {
    const unsigned G = gridDim.x * gridDim.y * gridDim.z;
    unsigned sum, cnt, mine, sp = 0u;
    for (;;) {
        sum = 0u; cnt = 0u; mine = 0u;
#pragma unroll
        for (unsigned j = 0; j < 16; ++j) { const unsigned c = xb_ld(&bar[XB_XCNT(j)]); sum += c; cnt += (c > 0u) ? 1u : 0u; mine = (j == x) ? c : mine; }
        if (sum == G) break;
        __builtin_amdgcn_s_sleep(1);
        if ((++sp & 255u) == 0u) { if (xb_ld(&bar[XB_TMO])) break; if (sp > XB_SPIN_CAP) { atomicAdd(&bar[XB_TMO], 1u); break; } }
    }
    nloc = mine > 0u ? mine : 1u; nx = cnt > 0u ? cnt : 1u;
}
__device__ __forceinline__ void xcd_barrier(const XcdBarrier& b, const int tid) {
    asm volatile("s_waitcnt vmcnt(0)" ::: "memory");
    __syncthreads();
    if (tid == 0) {
        unsigned* bar = b.bar; unsigned bx_ = b.x;
        asm volatile("" : "+s"(bar), "+s"(bx_));
        __builtin_amdgcn_s_waitcnt(0);
        unsigned nloc = b.st[0], nx = b.st[1];
        if (nloc == 0u) { xcd_barrier_complete(bar, bx_, nloc, nx); b.st[0] = nloc; b.st[1] = nx; }
        const unsigned old = xb_add(&bar[XB_XSUB(bx_)], 1u);
        const unsigned gen = old / nloc;
        if (old + 1u == (gen + 1u) * nloc) {
            __builtin_amdgcn_fence(__ATOMIC_RELEASE, "agent");
            asm volatile("s_waitcnt vmcnt(0)" ::: "memory");
            const unsigned og = xb_add(&bar[XB_TOP], 1u);
            const unsigned tg = og / nx;
            if (og + 1u == (tg + 1u) * nx) xb_add(&bar[XB_TOPGEN], 1u);
            else XB_SPIN(xb_ld(&bar[XB_TOPGEN]) == tg, bar);
            __builtin_amdgcn_fence(__ATOMIC_ACQUIRE, "agent");
            xb_add(&bar[XB_XGEN(bx_)], 1u);
            asm volatile("s_waitcnt vmcnt(0)" ::: "memory");
        } else {
            XB_SPIN(xb_ld(&bar[XB_XGEN(bx_)]) == gen, bar);
            __builtin_amdgcn_fence(__ATOMIC_ACQUIRE, "agent");
            asm volatile("s_waitcnt vmcnt(0)" ::: "memory");
        }
    }
    __syncthreads();
}

template <class T> __device__ __forceinline__ T* lnd(T* p) { asm volatile("" : "+s"(p)); return p; }
__device__ __forceinline__ float wave_sum(float v) {
#pragma unroll
    for (int o = 1; o < 64; o <<= 1) v += __shfl_xor(v, o);
    return v;
}
__device__ __forceinline__ int cvt_weight(const float* W, int K, int Nsrc, bf16* WT, int Ndst, int kind, const float* gk, const float* bk, float* uo, float* vo, LAS unsigned char* lds, int tile_off, int G, int bx, int tid) {
    asm volatile("" : "+v"(tid));
    const int wave = tid >> 6, lane = tid & 63;
    const int ntn = Ndst / 256, ntiles = (K / 64) * ntn;
    int t = ((bx - tile_off) % G + G) % G;
    f32x4 r[8];
#define CVT_LOAD(tt) do { const int kb_ = (tt) / ntn, tn_ = (tt) % ntn; int c_; \
        if (kind == 1) c_ = (lane < 32) ? (128 * tn_ + 4 * lane) : (DFF + 128 * tn_ + 4 * (lane - 32)); else c_ = 256 * tn_ + 4 * lane; \
        const bool ok_ = (kind == 1) || (c_ < Nsrc); const GAS float* src_ = (const GAS float*)W + (size_t)(64 * kb_ + 8 * wave) * Nsrc + (ok_ ? c_ : 0); \
        if (kind == 3 && tn_ < 10) {   \
            const GAS float* sp_ = (const GAS float*)W + (size_t)(64 * kb_ + 8 * wave) * Nsrc + 256 * tn_ + 128 * (lane >> 5) + 64 * ((lane >> 4) & 1) + 2 * (lane & 15); \
            _Pragma("unroll") for (int i_ = 0; i_ < 8; ++i_) { const f32x2 a_ = __builtin_nontemporal_load((const GAS f32x2*)(sp_ + (size_t)i_ * Nsrc)), b_ = __builtin_nontemporal_load((const GAS f32x2*)(sp_ + (size_t)i_ * Nsrc + 32)); r[i_] = (f32x4){a_.x, b_.x, a_.y, b_.y}; } \
        } else if (kind == 2 && (tn_ % 12) < 8) {   \
            const GAS float* sp_ = (const GAS float*)W + (size_t)(64 * kb_ + 8 * wave) * Nsrc + 256 * tn_ + 128 * (lane >> 5) + 2 * (lane & 31); \
            _Pragma("unroll") for (int i_ = 0; i_ < 8; ++i_) { const f32x2 a_ = __builtin_nontemporal_load((const GAS f32x2*)(sp_ + (size_t)i_ * Nsrc)), b_ = __builtin_nontemporal_load((const GAS f32x2*)(sp_ + (size_t)i_ * Nsrc + 64)); r[i_] = (f32x4){a_.x, b_.x, a_.y, b_.y}; } \
        } else { \
        _Pragma("unroll") for (int i_ = 0; i_ < 8; ++i_) { r[i_] = ok_ ? __builtin_nontemporal_load((const GAS f32x4*)(src_ + (size_t)i_ * Nsrc)) : (f32x4){0.f, 0.f, 0.f, 0.f}; } } } while (0)
    if (t < ntiles) CVT_LOAD(t);
    int buf = 0;
    const int c = lane & 7, nl = lane >> 3;
    for (; t < ntiles; t += G) {
        LAS unsigned char* tb = lds + buf * 65536;
#pragma unroll
        for (int i = 0; i < 8; ++i) { const int k = 8 * wave + i; *(LAS f32x4*)(tb + k * 1024 + ((lane ^ (wave & 7)) << 4)) = r[i]; }
        const int kb = t / ntn, tn = t % ntn, k0 = 64 * kb, n0 = 256 * tn;
        if (t + G < ntiles) CVT_LOAD(t + G);
        __syncthreads();
        f32x4 g0 = {1.f, 1.f, 1.f, 1.f}, g1 = g0, b0 = {0.f, 0.f, 0.f, 0.f}, b1 = b0;
        if (gk) { g0 = *(const GAS f32x4*)(gk + k0 + 8 * c); g1 = *(const GAS f32x4*)(gk + k0 + 8 * c + 4); }
        if (uo && bk) { b0 = *(const GAS f32x4*)(bk + k0 + 8 * c); b1 = *(const GAS f32x4*)(bk + k0 + 8 * c + 4); }
#pragma unroll
        for (int j = 0; j < 4; ++j) { const int n = 32 * wave + 8 * j + nl;
            float w[8];
#pragma unroll
            for (int e = 0; e < 8; ++e) w[e] = *(const LAS float*)(tb + (8 * c + e) * 1024 + ((((n >> 2) ^ c) & 63) << 4) + (n & 3) * 4);
            float us = 0.f, vs = 0.f;
            vs = w[0] * b0[0] + w[1] * b0[1] + w[2] * b0[2] + w[3] * b0[3] + w[4] * b1[0] + w[5] * b1[1] + w[6] * b1[2] + w[7] * b1[3];
            w[0] *= g0[0]; w[1] *= g0[1]; w[2] *= g0[2]; w[3] *= g0[3]; w[4] *= g1[0]; w[5] *= g1[1]; w[6] *= g1[2]; w[7] *= g1[3];
            us = ((w[0] + w[1]) + (w[2] + w[3])) + ((w[4] + w[5]) + (w[6] + w[7]));
            v4u o; o.x = pk2(w[0], w[1]); o.y = pk2(w[2], w[3]); o.z = pk2(w[4], w[5]); o.w = pk2(w[6], w[7]);
            *(GAS v4u*)(WT + ((size_t)tn * (size_t)(K / 64) + (size_t)kb) * (256 * 64) + (size_t)n * 64 + 8 * c) = o;
            if (uo) { us += __shfl_xor(us, 1); us += __shfl_xor(us, 2); us += __shfl_xor(us, 4); vs += __shfl_xor(vs, 1); vs += __shfl_xor(vs, 2); vs += __shfl_xor(vs, 4);
                if (c == 0) { __hip_atomic_fetch_add(uo + n0 + n, us, __ATOMIC_RELAXED, __HIP_MEMORY_SCOPE_AGENT); __hip_atomic_fetch_add(vo + n0 + n, vs, __ATOMIC_RELAXED, __HIP_MEMORY_SCOPE_AGENT); } }
        }
        buf ^= 1;
    }
#undef CVT_LOAD
    __syncthreads();
    return tile_off + ntiles;
}
__device__ __forceinline__ void ln_final(float* H, const bf16* HI, const unsigned char* LOW, const float* sum, const float* ssq, const float* g, const float* b, size_t gt, size_t NGT) {
    for (size_t q = gt; q < (size_t)MTOK * DM / 8; q += NGT) {
        const int sb = (int)(q >> 10), r = (int)((q & 1023) >> 2), ch = (int)(q & 3); const int m = (sb >> 6) * 256 + r, col = ((sb >> 1) & 31) * 64 + (sb & 1) * 32 + ch * 8;
        const float mean = sum[m] * (1.f / DM); const float rstd = __builtin_amdgcn_rsqf(ssq[m] * (1.f / DM) - mean * mean + LN_EPS);
        const v4u hv = *((const GAS v4u*)HI + q); const v2u lv = *((const GAS v2u*)LOW + q);
        float xh[8], xl[8]; unpack8(hv, xh); unpack8_lo(lv, xl);
        const f32x4 g0 = *(const GAS f32x4*)(g + col), g1 = *(const GAS f32x4*)(g + col + 4), b0 = *(const GAS f32x4*)(b + col), b1 = *(const GAS f32x4*)(b + col + 4);
        f32x4 y0, y1;
        y0[0] = ((xh[0] + xl[0]) - mean) * rstd * g0[0] + b0[0]; y0[1] = ((xh[1] + xl[1]) - mean) * rstd * g0[1] + b0[1]; y0[2] = ((xh[2] + xl[2]) - mean) * rstd * g0[2] + b0[2]; y0[3] = ((xh[3] + xl[3]) - mean) * rstd * g0[3] + b0[3];
        y1[0] = ((xh[4] + xl[4]) - mean) * rstd * g1[0] + b1[0]; y1[1] = ((xh[5] + xl[5]) - mean) * rstd * g1[1] + b1[1]; y1[2] = ((xh[6] + xl[6]) - mean) * rstd * g1[2] + b1[2]; y1[3] = ((xh[7] + xl[7]) - mean) * rstd * g1[3] + b1[3];
        GAS f32x4* xr = (GAS f32x4*)(H + (size_t)m * DM + col); xr[0] = y0; xr[1] = y1;
    }
}
__device__ __forceinline__ void krope_c(const bf16* CIN, bf16* KR, const unsigned char* ws, int gw, int NGW, int lane) {
    asm volatile("" : "+v"(lane));
    const float* cc = (const float*)(ws + WS_TABC); const float* sc = cc + 2048 * 32;
    const int sub = lane >> 3, i = lane & 7, f0 = (i & 3) * 8; const bool lowp = (i & 4) == 0;
    for (int t0 = gw * 8; t0 < MTOK; t0 += NGW * 8) { const int tok = t0 + sub, s = tok & (SEQ - 1);
        float x[8], y[8]; unpack8(*((const GAS v4u*)(CIN + (size_t)tok * C_INP + 1280) + i), x);
#pragma unroll
        for (int e = 0; e < 8; ++e) { const float p = __shfl_xor(x[e], 4); const float c = cc[s * 32 + f0 + e], sn = sc[s * 32 + f0 + e]; y[e] = lowp ? (x[e] * c - p * sn) : (x[e] * c + p * sn); }
        *((GAS v4u*)(KR + (size_t)tok * 64) + i) = pack8(y); }
}
__device__ __forceinline__ void ln_rows(float* H, bf16* HBo, const float* g, const float* b, int gw, int NGW, int lane) {
    asm volatile("" : "+v"(lane));
    for (int m = gw; m < MTOK; m += NGW) {
        GAS f32x4* xr = (GAS f32x4*)(H + (size_t)m * DM) + 2 * lane;
        f32x4 v[8]; float s = 0.f;
#pragma unroll
        for (int j = 0; j < 4; ++j) { v[2 * j] = xr[128 * j]; v[2 * j + 1] = xr[128 * j + 1]; }
#pragma unroll
        for (int j = 0; j < 8; ++j) s += (v[j].x + v[j].y) + (v[j].z + v[j].w);
        const float mean = wave_sum(s) * (1.f / DM); float s2 = 0.f;
#pragma unroll
        for (int j = 0; j < 8; ++j) { v[j] = v[j] - mean; s2 += (v[j].x * v[j].x + v[j].y * v[j].y) + (v[j].z * v[j].z + v[j].w * v[j].w); }
        const float rstd = 1.f / sqrtf(wave_sum(s2) * (1.f / DM) + LN_EPS);
        GAS v4u* ob = (GAS v4u*)(HBo + (size_t)m * DM) + lane;
#pragma unroll
        for (int j = 0; j < 4; ++j) {
            const f32x4 g0 = *((const f32x4*)g + 128 * j + 2 * lane), g1 = *((const f32x4*)g + 128 * j + 2 * lane + 1);
            const f32x4 b0 = *((const f32x4*)b + 128 * j + 2 * lane), b1 = *((const f32x4*)b + 128 * j + 2 * lane + 1);
            const f32x4 y0 = v[2 * j] * rstd * g0 + b0, y1 = v[2 * j + 1] * rstd * g1 + b1;
            xr[128 * j] = y0; xr[128 * j + 1] = y1;
            v4u o; o.x = pk2(y0.x, y0.y); o.y = pk2(y0.z, y0.w); o.z = pk2(y1.x, y1.y); o.w = pk2(y1.z, y1.w);
            ob[64 * j] = o;
        }
    }
}
__device__ __forceinline__ void cvt_rows_bf16(const float* X, bf16* O, unsigned char* OL, size_t n8, size_t gt, size_t NGT) {
    for (size_t i = gt; i < n8; i += NGT) { const f32x4 a = *((const GAS f32x4*)X + 2 * i), c = *((const GAS f32x4*)X + 2 * i + 1);
        v4u o; o.x = pk2(a.x, a.y); o.y = pk2(a.z, a.w); o.z = pk2(c.x, c.y); o.w = pk2(c.z, c.w); const size_t to_ = pg8::tl_off32((int)((i * 8) / DM), (int)((i * 8) % DM), DM / 64); *(GAS v4u*)(O + to_) = o;
        *(GAS v2u*)(OL + to_) = pack8_lo(a.x - bflo(o.x), a.y - bfhi(o.x), a.z - bflo(o.y), a.w - bfhi(o.y), c.x - bflo(o.z), c.y - bfhi(o.z), c.z - bflo(o.w), c.w - bfhi(o.w)); }
}
__device__ __forceinline__ void sincos_tab(float ang, float& c, float& s) {
    const double x = (double)ang; const double k = __builtin_rint(x * 0.15915494309189533577); const double r = x - k * 6.28318530717958647692;
    const double r2 = r * r; double sn = 0.0, cs = 0.0;
#pragma unroll
    for (int n = 14; n >= 0; --n) { sn = sn * (-r2) / (double)((2 * n + 2) * (2 * n + 3)) + 1.0; cs = cs * (-r2) / (double)((2 * n + 1) * (2 * n + 2)) + 1.0; }
    s = (float)(sn * r); c = (float)cs;
}
__device__ __forceinline__ void build_tables(unsigned char* ws, size_t gt, size_t NGT) {
    float* cb = (float*)(ws + WS_TABB); float* sb = cb + 2048 * 64;
    for (size_t i = gt; i < 2048 * 64; i += NGT) { const int pos = (int)(i >> 6), f = (int)(i & 63); const float inv = __builtin_amdgcn_exp2f(-13.287712379549449f * ((float)(2 * f) / 128.0f)); float c, s; sincos_tab((float)pos * inv, c, s); cb[i] = c; sb[i] = s; }
    float* cc = (float*)(ws + WS_TABC); float* sc = cc + 2048 * 32;
    for (size_t i = gt; i < 2048 * 32; i += NGT) { const int pos = (int)(i >> 5), f = (int)(i & 31); const float inv = __builtin_amdgcn_exp2f(-13.287712379549449f * ((float)(2 * f) / 64.0f)); float c, s; sincos_tab((float)pos * inv, c, s); cc[i] = c; sc[i] = s; }
    float* ca = (float*)(ws + WS_TABA); float* sa = ca + 64 * 32;
    for (size_t i = gt; i < 64 * 32; i += NGT) { const int pos = (int)(i >> 5), f = (int)(i & 31); const float inv = __builtin_amdgcn_exp2f(-13.287712379549449f * ((float)(2 * f) / 64.0f)); float c, s; sincos_tab((float)pos * inv, c, s); ca[i] = c; sa[i] = s; }
}

__device__ __forceinline__ void prep_a(bf16* QKV, const float* qg, const float* kg, const unsigned char* ws, int gw, int NGW, int lane) {
    asm volatile("" : "+v"(lane));
    const float* ca = (const float*)(ws + WS_TABA); const float* sa = ca + 64 * 32;
    const int i = lane & 15, half = i >> 3, f0 = (i & 3) * 8; const bool lowp = (i & 4) == 0;
    float gq[8], gk[8];
#pragma unroll
    for (int e = 0; e < 8; ++e) { gq[e] = qg[i * 8 + e]; gk[e] = kg[i * 8 + e]; }
    for (int tok = gw; tok < MTOK; tok += NGW) {
        const int s = tok & (SEQ - 1), pos = half ? (s & 63) : (s >> 6);
        float c[8], sn[8];
        { const f32x4 c0 = *(const GAS f32x4*)(ca + pos * 32 + f0), c1 = *(const GAS f32x4*)(ca + pos * 32 + f0 + 4), s0 = *(const GAS f32x4*)(sa + pos * 32 + f0), s1 = *(const GAS f32x4*)(sa + pos * 32 + f0 + 4);
          c[0] = c0.x; c[1] = c0.y; c[2] = c0.z; c[3] = c0.w; c[4] = c1.x; c[5] = c1.y; c[6] = c1.z; c[7] = c1.w;
          sn[0] = s0.x; sn[1] = s0.y; sn[2] = s0.z; sn[3] = s0.w; sn[4] = s1.x; sn[5] = s1.y; sn[6] = s1.z; sn[7] = s1.w; }
        GAS v4u* row = (GAS v4u*)(QKV + (size_t)tok * A_QKV) + lane;
        v4u w[5];
#pragma unroll
        for (int j = 0; j < 5; ++j) w[j] = row[64 * j];
#pragma unroll
        for (int j = 0; j < 5; ++j) {
            float x[8]; unpack8(w[j], x); float ss = 0.f;
#pragma unroll
            for (int e = 0; e < 8; ++e) ss += x[e] * x[e];
            ss += __shfl_xor(ss, 1); ss += __shfl_xor(ss, 2); ss += __shfl_xor(ss, 4); ss += __shfl_xor(ss, 8);
            const float r = 1.f / sqrtf(ss * (1.f / 128.f) + RMS_EPS);
            float y[8];
#pragma unroll
            for (int e = 0; e < 8; ++e) { x[e] = x[e] * r * (j < 4 ? gq[e] : gk[e]); const float p = __shfl_xor(x[e], 4); y[e] = lowp ? (x[e] * c[e] - p * sn[e]) : (x[e] * c[e] + p * sn[e]); }
            row[64 * j] = pack8(y);
        }
    }
}
__device__ __forceinline__ void prep_b(bf16* QKV, const unsigned char* ws, int gw, int NGW, int lane) {
    asm volatile("" : "+v"(lane));
    const float* cb = (const float*)(ws + WS_TABB); const float* sb = cb + 2048 * 64;
    const int i = lane & 15, f0 = (i & 7) * 8; const bool lowp = (i & 8) == 0;
    for (int tok = gw; tok < MTOK; tok += NGW) {
        const int s = tok & (SEQ - 1);
        float c[8], sn[8];
        { const f32x4 c0 = *(const GAS f32x4*)(cb + s * 64 + f0), c1 = *(const GAS f32x4*)(cb + s * 64 + f0 + 4), s0 = *(const GAS f32x4*)(sb + s * 64 + f0), s1 = *(const GAS f32x4*)(sb + s * 64 + f0 + 4);
          c[0] = c0.x; c[1] = c0.y; c[2] = c0.z; c[3] = c0.w; c[4] = c1.x; c[5] = c1.y; c[6] = c1.z; c[7] = c1.w;
          sn[0] = s0.x; sn[1] = s0.y; sn[2] = s0.z; sn[3] = s0.w; sn[4] = s1.x; sn[5] = s1.y; sn[6] = s1.z; sn[7] = s1.w; }
#pragma unroll
        for (int g = 0; g < 3; ++g) {
            GAS v4u* row = (GAS v4u*)(QKV + (size_t)tok * B_QKV + g * 3072) + lane;
            v4u w[4];
#pragma unroll
            for (int j = 0; j < 4; ++j) w[j] = row[64 * j];
#pragma unroll
            for (int j = 0; j < 4; ++j) { float x[8], y[8]; unpack8(w[j], x);
#pragma unroll
                for (int e = 0; e < 8; ++e) { const float p = __shfl_xor(x[e], 8); y[e] = lowp ? (x[e] * c[e] - p * sn[e]) : (x[e] * c[e] + p * sn[e]); }
                row[64 * j] = pack8(y); }
        }
    }
}
__device__ __forceinline__ void prep_c1(const bf16* CIN, bf16* CQN, bf16* CKVN, bf16* KR, const float* qg, const float* kvg, const unsigned char* ws, int gw, int NGW, int lane) {
    asm volatile("" : "+v"(lane));
    const float* cc = (const float*)(ws + WS_TABC); const float* sc = cc + 2048 * 32;
    for (int tok = gw; tok < MTOK; tok += NGW) {
        const GAS v4u* row = (const GAS v4u*)(CIN + (size_t)tok * C_INP);
        const v4u a0 = row[lane], a1 = (lane < 32) ? row[64 + lane] : (v4u){0u, 0u, 0u, 0u}, b0 = row[96 + lane], k0 = (lane < 8) ? row[160 + lane] : (v4u){0u, 0u, 0u, 0u};
        float x0[8], x1[8], y0[8], kx[8]; unpack8(a0, x0); unpack8(a1, x1); unpack8(b0, y0); unpack8(k0, kx);
        float sq = 0.f, skv = 0.f;
#pragma unroll
        for (int e = 0; e < 8; ++e) { sq += x0[e] * x0[e] + x1[e] * x1[e]; skv += y0[e] * y0[e]; }
        const float rq = 1.f / sqrtf(wave_sum(sq) * (1.f / 768.f) + RMS_EPS), rkv = 1.f / sqrtf(wave_sum(skv) * (1.f / 512.f) + RMS_EPS);
        { const f32x4 g0 = *(const GAS f32x4*)(qg + lane * 8), g1 = *(const GAS f32x4*)(qg + lane * 8 + 4);
          x0[0] *= rq * g0.x; x0[1] *= rq * g0.y; x0[2] *= rq * g0.z; x0[3] *= rq * g0.w; x0[4] *= rq * g1.x; x0[5] *= rq * g1.y; x0[6] *= rq * g1.z; x0[7] *= rq * g1.w;
          *((GAS v4u*)(CQN + (size_t)tok * C_QL) + lane) = pack8(x0); }
        if (lane < 32) { const f32x4 g0 = *(const GAS f32x4*)(qg + 512 + lane * 8), g1 = *(const GAS f32x4*)(qg + 512 + lane * 8 + 4);
          x1[0] *= rq * g0.x; x1[1] *= rq * g0.y; x1[2] *= rq * g0.z; x1[3] *= rq * g0.w; x1[4] *= rq * g1.x; x1[5] *= rq * g1.y; x1[6] *= rq * g1.z; x1[7] *= rq * g1.w;
          *((GAS v4u*)(CQN + (size_t)tok * C_QL) + 64 + lane) = pack8(x1); }
        { const f32x4 g0 = *(const GAS f32x4*)(kvg + lane * 8), g1 = *(const GAS f32x4*)(kvg + lane * 8 + 4);
          y0[0] *= rkv * g0.x; y0[1] *= rkv * g0.y; y0[2] *= rkv * g0.z; y0[3] *= rkv * g0.w; y0[4] *= rkv * g1.x; y0[5] *= rkv * g1.y; y0[6] *= rkv * g1.z; y0[7] *= rkv * g1.w;
          *((GAS v4u*)(CKVN + (size_t)tok * C_KVL) + lane) = pack8(y0); }
        {
          const int s = tok & (SEQ - 1), f0 = (lane & 3) * 8; const bool lowp = (lane & 4) == 0; float y[8];
#pragma unroll
          for (int e = 0; e < 8; ++e) { const float p = __shfl_xor(kx[e], 4); const float c = cc[s * 32 + f0 + e], sn = sc[s * 32 + f0 + e]; y[e] = lowp ? (kx[e] * c - p * sn) : (kx[e] * c + p * sn); }
          if (lane < 8) *((GAS v4u*)(KR + (size_t)tok * 64) + lane) = pack8(y); }
    }
}
__device__ __forceinline__ void prep_c2(bf16* Q, const unsigned char* ws, int gw, int NGW, int lane) {
    asm volatile("" : "+v"(lane));
    const float* cc = (const float*)(ws + WS_TABC); const float* sc = cc + 2048 * 32;
    const int i = lane & 7, f0 = (i & 3) * 8; const bool lowp = (i & 4) == 0;
    for (int tok = gw; tok < MTOK; tok += NGW) {
        const int s = tok & (SEQ - 1);
        float c[8], sn[8];
        { const f32x4 c0 = *(const GAS f32x4*)(cc + s * 32 + f0), c1 = *(const GAS f32x4*)(cc + s * 32 + f0 + 4), s0 = *(const GAS f32x4*)(sc + s * 32 + f0), s1 = *(const GAS f32x4*)(sc + s * 32 + f0 + 4);
          c[0] = c0.x; c[1] = c0.y; c[2] = c0.z; c[3] = c0.w; c[4] = c1.x; c[5] = c1.y; c[6] = c1.z; c[7] = c1.w;
          sn[0] = s0.x; sn[1] = s0.y; sn[2] = s0.z; sn[3] = s0.w; sn[4] = s1.x; sn[5] = s1.y; sn[6] = s1.z; sn[7] = s1.w; }
#pragma unroll
        for (int j = 0; j < 2; ++j) { const int h = (lane >> 3) + 8 * j;
            GAS v4u* p = (GAS v4u*)(Q + (size_t)tok * C_Q + h * 192 + 128) + i; float x[8], y[8]; unpack8(*p, x);
#pragma unroll
            for (int e = 0; e < 8; ++e) { const float q = __shfl_xor(x[e], 4); y[e] = lowp ? (x[e] * c[e] - q * sn[e]) : (x[e] * c[e] + q * sn[e]); }
            *p = pack8(y); }
    }
}

struct NState { float m, l, o[8]; };
__device__ __forceinline__ void nst_init(NState& S) { S.m = -1e30f; S.l = 0.f;
#pragma unroll
    for (int j = 0; j < 8; ++j) S.o[j] = 0.f; }
__device__ __forceinline__ void nst_update(NState& S, float s, bool valid, const v4u vv) {
    const float mn = valid ? fmaxf(S.m, s) : S.m; const float al = __builtin_amdgcn_exp2f(S.m - mn); const float p = valid ? __builtin_amdgcn_exp2f(s - mn) : 0.f;
    S.l = S.l * al + p; S.m = mn;
    S.o[0] = S.o[0] * al + p * bflo(vv.x); S.o[1] = S.o[1] * al + p * bfhi(vv.x); S.o[2] = S.o[2] * al + p * bflo(vv.y); S.o[3] = S.o[3] * al + p * bfhi(vv.y);
    S.o[4] = S.o[4] * al + p * bflo(vv.z); S.o[5] = S.o[5] * al + p * bfhi(vv.z); S.o[6] = S.o[6] * al + p * bflo(vv.w); S.o[7] = S.o[7] * al + p * bfhi(vv.w);
}
__device__ __forceinline__ void nst_finish(NState& S, bf16* out, int lane) {
#pragma unroll
    for (int x = 16; x <= 32; x <<= 1) {
        const float m2 = __shfl_xor(S.m, x), l2 = __shfl_xor(S.l, x); const float mn = fmaxf(S.m, m2); const float a = __builtin_amdgcn_exp2f(S.m - mn), b = __builtin_amdgcn_exp2f(m2 - mn);
        S.l = S.l * a + l2 * b; S.m = mn;
#pragma unroll
        for (int j = 0; j < 8; ++j) { const float o2 = __shfl_xor(S.o[j], x); S.o[j] = S.o[j] * a + o2 * b; }
    }
    if (lane < 16) { const float rl = 1.f / S.l; v4u w; w.x = pk2(S.o[0] * rl, S.o[1] * rl); w.y = pk2(S.o[2] * rl, S.o[3] * rl); w.z = pk2(S.o[4] * rl, S.o[5] * rl); w.w = pk2(S.o[6] * rl, S.o[7] * rl);
        *(GAS v4u*)(out + lane * 8) = w; }
}
__device__ __forceinline__ float dot8(const float (&q)[8], const v4u k) {
    return q[0] * bflo(k.x) + q[1] * bfhi(k.x) + q[2] * bflo(k.y) + q[3] * bfhi(k.y) + q[4] * bflo(k.z) + q[5] * bfhi(k.z) + q[6] * bflo(k.w) + q[7] * bfhi(k.w);
}
__device__ __forceinline__ float red16(float s) { s += __shfl_xor(s, 1); s += __shfl_xor(s, 2); s += __shfl_xor(s, 4); s += __shfl_xor(s, 8); return s; }
__device__ __forceinline__ void ldq8(float (&q)[8], const bf16* p, float sc) { const v4u w = *(const GAS v4u*)p;
    q[0] = bflo(w.x) * sc; q[1] = bfhi(w.x) * sc; q[2] = bflo(w.y) * sc; q[3] = bfhi(w.y) * sc; q[4] = bflo(w.z) * sc; q[5] = bfhi(w.z) * sc; q[6] = bflo(w.w) * sc; q[7] = bfhi(w.w) * sc; }

__device__ __forceinline__ void naive_attn_a(const bf16* QKV, bf16* ATT, int gw, int NGW, int lane) {
    asm volatile("" : "+v"(lane));
    const int g = lane >> 4, i = lane & 15; const float sc = 0.08838834764831845f * 1.4426950408889634f;
    for (int p = gw; p < MTOK * 16; p += NGW) {
        const int tok = p >> 4, h = p & 15, b = tok >> 11;
        float q[8]; ldq8(q, QKV + (size_t)tok * A_QKV + h * 128 + i * 8, sc);
        const bf16* kb = QKV + (size_t)(b * SEQ) * A_QKV + 2048 + (h >> 2) * 128 + i * 8;
        NState S; nst_init(S);
        for (int t0 = 0; t0 < SEQ; t0 += 4) { const bf16* kp = kb + (size_t)(t0 + g) * A_QKV; const v4u kk = *(const GAS v4u*)kp, vv = *(const GAS v4u*)(kp + 512);
            nst_update(S, red16(dot8(q, kk)), true, vv); }
        nst_finish(S, ATT + (size_t)tok * DM + h * 128, lane);
    }
}
__device__ __forceinline__ void naive_attn_b(const bf16* QKV, bf16* ATT, int gw, int NGW, int lane) {
    asm volatile("" : "+v"(lane));
    const int g = lane >> 4, i = lane & 15; const float sc = 0.08838834764831845f * 1.4426950408889634f;
    for (int p = gw; p < MTOK * 8; p += NGW) {
        const int tok = p >> 3, h = p & 7, s = tok & (SEQ - 1);
        NState S; nst_init(S);
        for (int grp = 0; grp < 3; ++grp) {
            const int dil = grp == 0 ? 1 : (grp == 1 ? 4 : 16);
            float q[8]; ldq8(q, QKV + (size_t)tok * B_QKV + grp * 3072 + h * 128 + i * 8, sc);
            for (int j0 = -64; j0 <= 64; j0 += 4) { const int j = j0 + g; const int t = s + j * dil; const bool valid = (j <= 64) && (t >= 0) && (t < SEQ);
                const int tc = valid ? t : s; const bf16* kp = QKV + (size_t)(tok - s + tc) * B_QKV + grp * 3072 + 1024 + h * 128 + i * 8;
                const v4u kk = *(const GAS v4u*)kp, vv = *(const GAS v4u*)(kp + 1024);
                nst_update(S, red16(dot8(q, kk)), valid, vv); }
        }
        nst_finish(S, ATT + (size_t)tok * 1024 + h * 128, lane);
    }
}
__device__ __forceinline__ void naive_attn_c(const bf16* Q, const bf16* KV, const bf16* KR, bf16* ATT, int gw, int NGW, int lane) {
    asm volatile("" : "+v"(lane));
    const int g = lane >> 4, i = lane & 15; const float sc = 0.07216878364870322f * 1.4426950408889634f;
    for (int p = gw; p < MTOK * 16; p += NGW) {
        const int tok = p >> 4, h = p & 15, b = tok >> 11;
        float q[8]; ldq8(q, Q + (size_t)tok * C_Q + h * 192 + i * 8, sc);
        float qr[4]; { const v2u w = *(const GAS v2u*)(Q + (size_t)tok * C_Q + h * 192 + 128 + i * 4); qr[0] = bflo(w.x) * sc; qr[1] = bfhi(w.x) * sc; qr[2] = bflo(w.y) * sc; qr[3] = bfhi(w.y) * sc; }
        const bf16* kb = KV + (size_t)(b * SEQ) * C_KV + h * 256 + i * 8; const bf16* rb = KR + (size_t)(b * SEQ) * 64 + i * 4;
        NState S; nst_init(S);
        for (int t0 = 0; t0 < SEQ; t0 += 4) { const bf16* kp = kb + (size_t)(t0 + g) * C_KV; const v4u kk = *(const GAS v4u*)kp, vv = *(const GAS v4u*)(kp + 128);
            const v2u kr = *(const GAS v2u*)(rb + (size_t)(t0 + g) * 64);
            const float d = dot8(q, kk) + qr[0] * bflo(kr.x) + qr[1] * bfhi(kr.x) + qr[2] * bflo(kr.y) + qr[3] * bfhi(kr.y);
            nst_update(S, red16(d), true, vv); }
        nst_finish(S, ATT + (size_t)tok * DM + h * 128, lane);
    }
}


namespace att {
using bf16x8 = __attribute__((ext_vector_type(8))) short;
using s16x4  = __attribute__((ext_vector_type(4))) short;
using f32x16 = __attribute__((ext_vector_type(16))) float;
using u32x4  = __attribute__((ext_vector_type(4))) unsigned;
typedef GAS const unsigned short* gptr;
constexpr int KVBLK = 64, QBLK = 32;
constexpr int SHM_V = 16384, SHM_K = 16384, SHM_KR = 8192;
constexpr int OFF_V = 0, OFF_K = 2 * SHM_V, OFF_KR = OFF_K + 2 * SHM_K, OFF_WS = OFF_KR + 2 * SHM_KR, LDS_ATT = OFF_WS + 8 * 256;
#define KSWZ(row, colB) ((row) * 256 + ((colB) ^ (((row) & 7) << 4)))
#define KSWZ2(row, colB) ((row) * 128 + ((colB) ^ (((row) & 7) << 4)))
#define SBAR() __builtin_amdgcn_sched_barrier(0)
__device__ __forceinline__ int crow(int r, int hi) { return (r & 3) + 8 * (r >> 2) + 4 * hi; }
__device__ __forceinline__ unsigned cvtpk(float lo, float hi) { unsigned r; asm volatile("v_cvt_pk_bf16_f32 %0, %1, %2" : "=v"(r) : "v"(lo), "v"(hi)); return r; }
template <int MODE> __device__ __forceinline__ int tokmap(int p, int logd, int logL) { return MODE == 1 ? (((p & ((1 << logL) - 1)) << logd) | (p >> logL)) : p; }

template <int MODE> __device__ __forceinline__ void partialSM(f32x16& p0, f32x16& p1, float& m_reg, float& mn, float& alpha) {
  constexpr float SCALE = (MODE == 2) ? 0.07216878364870322f : 0.08838834764831845f;
  constexpr float C = SCALE * 1.4426950408889634f;
  float pmax = p0[0];
#pragma unroll
  for (int r = 1; r < 16; ++r) pmax = fmaxf(pmax, p0[r]);
#pragma unroll
  for (int r = 0; r < 16; ++r) pmax = fmaxf(pmax, p1[r]);
  { auto rr = __builtin_amdgcn_permlane32_swap(__float_as_uint(pmax), __float_as_uint(pmax), false, false);
    pmax = fmaxf(__uint_as_float(rr[0]), __uint_as_float(rr[1])); }
  if (__builtin_expect(__all(pmax - m_reg <= 8.f / SCALE), 1)) { mn = m_reg; alpha = 1.f; }
  else { mn = fmaxf(m_reg, pmax); alpha = __builtin_amdgcn_exp2f((m_reg - mn) * C); m_reg = mn; }
  const float mnC = -mn * C;
#pragma unroll
  for (int r = 0; r < 16; ++r) p0[r] = fmaf(p0[r], C, mnC);
#pragma unroll
  for (int r = 0; r < 16; ++r) p1[r] = fmaf(p1[r], C, mnC);
#pragma unroll
  for (int r = 0; r < 16; ++r) p0[r] = __builtin_amdgcn_exp2f(p0[r]);
}
__device__ __forceinline__ void finishSM(f32x16& p0, f32x16& p1, float alpha, float& l_reg, bf16x8& pa0, bf16x8& pa1, bf16x8& pa2, bf16x8& pa3) {
#pragma unroll
  for (int r = 0; r < 16; ++r) p1[r] = __builtin_amdgcn_exp2f(p1[r]);
  float ps = 0;
#pragma unroll
  for (int r = 0; r < 16; ++r) ps += p0[r];
#pragma unroll
  for (int r = 0; r < 16; ++r) ps += p1[r];
  { auto rr = __builtin_amdgcn_permlane32_swap(__float_as_uint(ps), __float_as_uint(ps), false, false);
    ps = __uint_as_float(rr[0]) + __uint_as_float(rr[1]); }
  l_reg = l_reg * alpha + ps;
#define PK4(P, BASE, OUT) do { unsigned a0 = cvtpk(P[BASE + 0], P[BASE + 1]), a1 = cvtpk(P[BASE + 2], P[BASE + 3]);   \
    unsigned b0 = cvtpk(P[BASE + 4], P[BASE + 5]), b1 = cvtpk(P[BASE + 6], P[BASE + 7]);                              \
    auto r0 = __builtin_amdgcn_permlane32_swap(a0, b0, false, false); auto r1 = __builtin_amdgcn_permlane32_swap(a1, b1, false, false); \
    u32x4 w = {r0[0], r1[0], r0[1], r1[1]}; OUT = *reinterpret_cast<bf16x8*>(&w); } while (0)
  PK4(p0, 0, pa0); PK4(p0, 8, pa1); PK4(p1, 0, pa2); PK4(p1, 8, pa3);
#undef PK4
}
template <int MODE> __device__ __forceinline__ void qkt(f32x16& p0, f32x16& p1, const LAS char* Ks, const LAS char* KRs, const bf16x8* qr, int r32, int hi) {
  p0 = f32x16{}; p1 = f32x16{};
#pragma unroll
  for (int d0 = 0; d0 < 8; ++d0) { const int cb = (d0 * 16 + hi * 8) * 2;
    const bf16x8 b0 = *reinterpret_cast<const LAS bf16x8*>(Ks + KSWZ(r32, cb));
    const bf16x8 b1 = *reinterpret_cast<const LAS bf16x8*>(Ks + KSWZ(32 + r32, cb));
    p0 = __builtin_amdgcn_mfma_f32_32x32x16_bf16(b0, qr[d0], p0, 0, 0, 0);
    p1 = __builtin_amdgcn_mfma_f32_32x32x16_bf16(b1, qr[d0], p1, 0, 0, 0); }
  if constexpr (MODE == 2) {
#pragma unroll
    for (int d0 = 0; d0 < 4; ++d0) { const int cb = (d0 * 16 + hi * 8) * 2;
      const bf16x8 b0 = *reinterpret_cast<const LAS bf16x8*>(KRs + KSWZ2(r32, cb));
      const bf16x8 b1 = *reinterpret_cast<const LAS bf16x8*>(KRs + KSWZ2(32 + r32, cb));
      p0 = __builtin_amdgcn_mfma_f32_32x32x16_bf16(b0, qr[8 + d0], p0, 0, 0, 0);
      p1 = __builtin_amdgcn_mfma_f32_32x32x16_bf16(b1, qr[8 + d0], p1, 0, 0, 0); }
  }
}
__device__ __forceinline__ void bmask(f32x16& p0, f32x16& p1, int kb, int qp, int logL, int hi) {
  const int qc = qp >> logL;
#pragma unroll
  for (int r = 0; r < 16; ++r) { const int k0 = kb + crow(r, hi), k1 = k0 + 32; const int d0 = k0 - qp, d1 = k1 - qp;
    const bool v0 = (d0 <= 64) && (d0 >= -64) && ((k0 >> logL) == qc), v1 = (d1 <= 64) && (d1 >= -64) && ((k1 >> logL) == qc);
    p0[r] = v0 ? p0[r] : -3.0e38f; p1[r] = v1 ? p1[r] : -3.0e38f; }
}
__device__ __forceinline__ int v_st(int k, int c) { const int kk = (k & ~0xC) | ((k & 4) << 1) | ((k & 8) >> 1); return ((kk >> 3) * 4 + (c >> 5)) * 512 + ((kk & 7) * 32 + (c & 31)) * 2; }
__device__ __forceinline__ int v_rd_base(int lane) { return ((lane & 3) << 3) | (((lane >> 2) & 3) << 6) | (((lane >> 4) & 1) << 5) | (((lane >> 5) & 1) << 8); }
constexpr int v_rd_off(int d0, int ks, int half) { return d0 * 512 + ks * 4096 + half * 2048; }
template <int OFF> __device__ __forceinline__ s16x4 tr_read(int vb) {
  s16x4 r; asm volatile("ds_read_b64_tr_b16 %0, %1 offset:%2" : "=&v"(r) : "v"(vb), "i"(OFF) : "memory"); return r;
}
template <int D0> __device__ __forceinline__ void pv_one(f32x16& od, int vb, bf16x8 pa0, bf16x8 pa1, bf16x8 pa2, bf16x8 pa3) {
  const s16x4 l0 = tr_read<v_rd_off(D0, 0, 0)>(vb), h0 = tr_read<v_rd_off(D0, 0, 1)>(vb), l1 = tr_read<v_rd_off(D0, 1, 0)>(vb), h1 = tr_read<v_rd_off(D0, 1, 1)>(vb);
  const s16x4 l2 = tr_read<v_rd_off(D0, 2, 0)>(vb), h2 = tr_read<v_rd_off(D0, 2, 1)>(vb), l3 = tr_read<v_rd_off(D0, 3, 0)>(vb), h3 = tr_read<v_rd_off(D0, 3, 1)>(vb);
  asm volatile("s_waitcnt lgkmcnt(0)" ::: "memory"); SBAR();
#define PK(L, H) (bf16x8){L[0], L[1], L[2], L[3], H[0], H[1], H[2], H[3]}
  od = __builtin_amdgcn_mfma_f32_32x32x16_bf16(pa0, PK(l0, h0), od, 0, 0, 0);
  od = __builtin_amdgcn_mfma_f32_32x32x16_bf16(pa1, PK(l1, h1), od, 0, 0, 0);
  od = __builtin_amdgcn_mfma_f32_32x32x16_bf16(pa2, PK(l2, h2), od, 0, 0, 0);
  od = __builtin_amdgcn_mfma_f32_32x32x16_bf16(pa3, PK(l3, h3), od, 0, 0, 0);
#undef PK
}
__device__ __forceinline__ void pv_d0(f32x16* o, int vb, bf16x8 pa0, bf16x8 pa1, bf16x8 pa2, bf16x8 pa3) {
  pv_one<0>(o[0], vb, pa0, pa1, pa2, pa3); pv_one<1>(o[1], vb, pa0, pa1, pa2, pa3); pv_one<2>(o[2], vb, pa0, pa1, pa2, pa3); pv_one<3>(o[3], vb, pa0, pa1, pa2, pa3);
}

template <int MODE>
__device__ __forceinline__ void attn_unit(gptr Qb, gptr Kb, gptr Vb, gptr KRb, GAS unsigned short* Ob, GAS float* lse, const GAS float* tabc,
                                          const int p0, const int k0, const int logd, LAS char* lds, const int tid) {
  constexpr int SDEPTH = (MODE == 2) ? 1 : 2;
  constexpr int NQ = (MODE == 2) ? 12 : 8;
  constexpr int ldq = (MODE == 0) ? A_QKV : (MODE == 1) ? B_QKV : C_Q, ldk = (MODE == 0) ? A_QKV : (MODE == 1) ? B_QKV : C_KV, ldo = (MODE == 1) ? 1024 : DM, NT = (MODE == 1) ? 6 : SEQ / 64;
  constexpr float SCALE = (MODE == 2) ? 0.07216878364870322f : 0.08838834764831845f;
  const int wid = tid >> 6, lane = tid & 63, r32 = lane & 31, hi = lane >> 5;
  const int logL = 11 - logd;
  LAS char* V_lds = lds + OFF_V; LAS char* K_lds = lds + OFF_K; LAS char* KR_lds = lds + OFF_KR;
  LAS float* wsl = (LAS float*)(lds + OFF_WS) + wid * 64; LAS float* li_l = wsl; LAS float* al_l = wsl + 32;
  float m_reg = -1e30f, l_reg = 0; f32x16 o[4] = {}; bf16x8 qr[NQ];
  const int qp = p0 + wid * QBLK + r32;
  { gptr Qw = Qb + (unsigned)(tokmap<MODE>(qp, logd, logL) * ldq + hi * 8);
#pragma unroll
    for (int d0 = 0; d0 < NQ; ++d0) qr[d0] = *reinterpret_cast<GAS const bf16x8*>(Qw + d0 * 16); }
  if constexpr (MODE == 2) {
    const GAS float* cc = tabc + qp * 32 + hi * 8; const GAS float* sc = cc + 2048 * 32;
#pragma unroll
    for (int d = 0; d < 2; ++d) { bf16x8 xa = qr[8 + d], xb = qr[10 + d]; float c[8], sn[8];
      { const f32x4 c0 = *(const GAS f32x4*)(cc + 16 * d), c1 = *(const GAS f32x4*)(cc + 16 * d + 4), s0 = *(const GAS f32x4*)(sc + 16 * d), s1 = *(const GAS f32x4*)(sc + 16 * d + 4);
        c[0] = c0.x; c[1] = c0.y; c[2] = c0.z; c[3] = c0.w; c[4] = c1.x; c[5] = c1.y; c[6] = c1.z; c[7] = c1.w; sn[0] = s0.x; sn[1] = s0.y; sn[2] = s0.z; sn[3] = s0.w; sn[4] = s1.x; sn[5] = s1.y; sn[6] = s1.z; sn[7] = s1.w; }
#pragma unroll
      for (int e = 0; e < 8; ++e) { const float a = __uint_as_float(((unsigned)(unsigned short)xa[e]) << 16), b = __uint_as_float(((unsigned)(unsigned short)xb[e]) << 16);
        xa[e] = (short)f2bf(a * c[e] - b * sn[e]); xb[e] = (short)f2bf(a * sn[e] + b * c[e]); }
      qr[8 + d] = xa; qr[10 + d] = xb; } }
  const int sr = tid >> 4, sc = (tid & 15) * 8, vst0 = v_st(sr, sc), vst1 = v_st(32 + sr, sc);
  const int krr = tid >> 3, krc = (tid & 7) * 8;
  const int vb0 = (int)(unsigned)(uintptr_t)V_lds + v_rd_base(lane);
  struct { bf16x8 vs0, vs1, ks0, ks1, kr; } sr_[SDEPTH];
#define SLOAD(i, kk) do { const unsigned t0_ = (unsigned)tokmap<MODE>(k0 + (kk) + sr, logd, logL) * (unsigned)ldk + (unsigned)sc, t1_ = (unsigned)tokmap<MODE>(k0 + (kk) + 32 + sr, logd, logL) * (unsigned)ldk + (unsigned)sc; \
    sr_[i].vs0 = *reinterpret_cast<GAS const bf16x8*>(Vb + t0_); sr_[i].vs1 = *reinterpret_cast<GAS const bf16x8*>(Vb + t1_); \
    sr_[i].ks0 = *reinterpret_cast<GAS const bf16x8*>(Kb + t0_); sr_[i].ks1 = *reinterpret_cast<GAS const bf16x8*>(Kb + t1_); \
    if constexpr (MODE == 2) sr_[i].kr = *reinterpret_cast<GAS const bf16x8*>(KRb + (unsigned)((k0 + (kk) + krr) * 64 + krc)); } while (0)
#define SWRITE(b, i) do { *(LAS bf16x8*)(V_lds + (b) * SHM_V + vst0) = sr_[i].vs0; *(LAS bf16x8*)(V_lds + (b) * SHM_V + vst1) = sr_[i].vs1; const int kc = sc * 2; \
    *(LAS bf16x8*)(K_lds + (b) * SHM_K + KSWZ(sr, kc)) = sr_[i].ks0; *(LAS bf16x8*)(K_lds + (b) * SHM_K + KSWZ(32 + sr, kc)) = sr_[i].ks1; \
    if constexpr (MODE == 2) *(LAS bf16x8*)(KR_lds + (b) * SHM_KR + KSWZ2(krr, krc * 2)) = sr_[i].kr; } while (0)
#define SWAIT() do { if constexpr (SDEPTH == 2) asm volatile("s_waitcnt vmcnt(4)" ::: "memory"); else asm volatile("s_waitcnt vmcnt(0)" ::: "memory"); } while (0)
#define RESC(a) do { if (__any((a) < 1.f)) { if (hi == 0) al_l[r32] = (a); asm volatile("s_waitcnt lgkmcnt(0)" ::: "memory"); \
    _Pragma("unroll") for (int d = 0; d < 4; ++d) _Pragma("unroll") for (int r = 0; r < 16; ++r) o[d][r] *= al_l[crow(r, hi)]; } } while (0)
#define QKT(P0, P1, b, t) do { qkt<MODE>(P0, P1, K_lds + (b) * SHM_K, KR_lds + (b) * SHM_KR, qr, r32, hi); if constexpr (MODE == 1) bmask(P0, P1, k0 + (t) * KVBLK, qp, logL, hi); } while (0)
  bf16x8 pa0, pa1, pa2, pa3;
  if constexpr (MODE == 2) {
    f32x16 pA0, pA1; float mnA, alA;
    SLOAD(0, 0); asm volatile("s_waitcnt vmcnt(0)" ::: "memory"); SWRITE(0, 0); __syncthreads();
    for (int t = 0; t < NT; t += 2) {
      SLOAD(0, (t + 1) * KVBLK); SBAR();
      QKT(pA0, pA1, 0, t); partialSM<MODE>(pA0, pA1, m_reg, mnA, alA); RESC(alA);
      finishSM(pA0, pA1, alA, l_reg, pa0, pa1, pa2, pa3); SBAR();
      pv_d0(o, vb0, pa0, pa1, pa2, pa3);
      SWAIT(); SWRITE(1, 0); __syncthreads();
      if (t + 2 < NT) SLOAD(0, (t + 2) * KVBLK); SBAR();
      QKT(pA0, pA1, 1, t + 1); partialSM<MODE>(pA0, pA1, m_reg, mnA, alA); RESC(alA);
      finishSM(pA0, pA1, alA, l_reg, pa0, pa1, pa2, pa3); SBAR();
      pv_d0(o, vb0 + SHM_V, pa0, pa1, pa2, pa3);
      if (t + 2 < NT) { SWAIT(); SWRITE(0, 0); } __syncthreads();
    }
  } else {
  f32x16 pA0, pA1, pB0, pB1; float mnA, mnB, alA, alB;
  constexpr int SE = 0, SO = SDEPTH - 1;
  SLOAD(SE, 0); asm volatile("s_waitcnt vmcnt(0)" ::: "memory"); SWRITE(0, SE); __syncthreads();
  QKT(pA0, pA1, 0, 0); partialSM<MODE>(pA0, pA1, m_reg, mnA, alA);
  SLOAD(SO, KVBLK); if constexpr (SDEPTH == 2) { if (2 < NT) SLOAD(SE, 2 * KVBLK); }
  SWAIT(); SWRITE(1, SO); __syncthreads();
  for (int j = 1; j + 1 < NT; j += 2) {
    SBAR(); QKT(pB0, pB1, 1, j);
    finishSM(pA0, pA1, alA, l_reg, pa0, pa1, pa2, pa3); SBAR();
    SLOAD(SO, (j + SDEPTH) * KVBLK); SBAR();
    pv_d0(o, vb0, pa0, pa1, pa2, pa3); partialSM<MODE>(pB0, pB1, m_reg, mnB, alB);
    __syncthreads(); SWAIT(); SWRITE(0, SE);
    RESC(alB); __syncthreads();
    SBAR(); QKT(pA0, pA1, 0, j + 1);
    finishSM(pB0, pB1, alB, l_reg, pa0, pa1, pa2, pa3); SBAR();
    if (SDEPTH == 1 || j + 3 < NT) SLOAD(SE, (j + 1 + SDEPTH) * KVBLK); SBAR();
    pv_d0(o, vb0 + SHM_V, pa0, pa1, pa2, pa3); partialSM<MODE>(pA0, pA1, m_reg, mnA, alA);
    __syncthreads(); SWAIT(); SWRITE(1, SO);
    RESC(alA); __syncthreads();
  }
  SBAR(); QKT(pB0, pB1, 1, NT - 1);
  finishSM(pA0, pA1, alA, l_reg, pa0, pa1, pa2, pa3); SBAR();
  pv_d0(o, vb0, pa0, pa1, pa2, pa3); partialSM<MODE>(pB0, pB1, m_reg, mnB, alB);
  __syncthreads(); RESC(alB);
  finishSM(pB0, pB1, alB, l_reg, pa0, pa1, pa2, pa3); SBAR();
  pv_d0(o, vb0 + SHM_V, pa0, pa1, pa2, pa3);
  }
  if (hi == 0) li_l[r32] = l_reg; asm volatile("s_waitcnt lgkmcnt(0)" ::: "memory");
  if constexpr (MODE == 1) { if (hi == 0) lse[(unsigned)(tokmap<MODE>(qp, logd, logL) * 8)] = m_reg * SCALE + __builtin_amdgcn_logf(l_reg) * 0.6931471805599453f; }
#pragma unroll
  for (int r = 0; r < 16; ++r) { const int orow = crow(r, hi); const float rl = __builtin_amdgcn_rcpf(li_l[orow]);
    GAS unsigned short* Ow = Ob + (unsigned)(tokmap<MODE>(p0 + wid * QBLK + orow, logd, logL) * ldo + r32);
#pragma unroll
    for (int d0 = 0; d0 < 4; ++d0) Ow[d0 * 32] = (unsigned short)f2bf(o[d0][r] * rl); }
#undef SLOAD
#undef SWRITE
#undef SWAIT
#undef RESC
#undef QKT
}
}

__device__ __forceinline__ void attn_phase_a(const bf16* QKV, bf16* ATT, LAS char* lds, int G, int bx, int tid) {
    asm volatile("" : "+v"(tid));
    for (int u = bx; u < BATCH * 16 * 8; u += G) {
        int pair, j; if (G == 256) { pair = (u >> 8) * 8 + (bx & 7); j = bx >> 3; } else { pair = u >> 5; j = u & 31; }
        const int b = pair >> 2, kvh = pair & 3, hq = kvh * 4 + (j >> 3), qb = j & 7;
        att::gptr Qb = (att::gptr)(QKV + (size_t)b * SEQ * A_QKV + hq * 128); att::gptr Kb = (att::gptr)(QKV + (size_t)b * SEQ * A_QKV + 2048 + kvh * 128);
        att::attn_unit<0>(Qb, Kb, Kb + 512, Kb, (GAS unsigned short*)(ATT + (size_t)b * SEQ * DM + hq * 128), nullptr, nullptr, 256 * qb, 0, 0, lds, tid);
        __syncthreads();
    }
}
__device__ __forceinline__ void attn_phase_c(const bf16* Q, const bf16* KV, const bf16* KR, bf16* ATT, const float* tabc, LAS char* lds, int G, int bx, int tid) {
    asm volatile("" : "+v"(tid));
    for (int u = bx; u < BATCH * 16 * 8; u += G) {
        int pair, qb; if (G == 256) { pair = ((u >> 8) * 8 + (bx & 7)) * 4 + (bx >> 6); qb = (bx >> 3) & 7; } else { pair = u >> 3; qb = u & 7; }
        const int b = pair >> 4, h = pair & 15;
        att::gptr Qb = (att::gptr)(Q + (size_t)b * SEQ * C_Q + h * 192); att::gptr Kb = (att::gptr)(KV + (size_t)b * SEQ * C_KV + h * 256);
        att::attn_unit<2>(Qb, Kb, Kb + 128, (att::gptr)(KR + (size_t)b * SEQ * 64), (GAS unsigned short*)(ATT + (size_t)b * SEQ * DM + h * 128), nullptr, (const GAS float*)tabc, 256 * qb, 0, 0, lds, tid);
        __syncthreads();
    }
}
__device__ __forceinline__ void attn_phase_b(const bf16* QKV, bf16* OG, float* LSE, LAS char* lds, int G, int bx, int tid) {
    asm volatile("" : "+v"(tid));
    for (int u = bx; u < 3 * BATCH * 8 * 8; u += G) {
        const int qb = u & 7, h = (u >> 3) & 7, b = (u >> 6) & 15, grp = u >> 10, logd = 2 * grp;
        att::gptr Qb = (att::gptr)(QKV + (size_t)b * SEQ * B_QKV + grp * 3072 + h * 128);
        const int p0 = 256 * qb; int k0 = p0 - 64; k0 = k0 < 0 ? 0 : (k0 > SEQ - 384 ? SEQ - 384 : k0);
        att::attn_unit<1>(Qb, Qb + 1024, Qb + 2048, Qb, (GAS unsigned short*)(OG + (size_t)grp * MTOK * 1024 + (size_t)b * SEQ * 1024 + h * 128),
                          (GAS float*)(LSE + ((size_t)grp * MTOK + (size_t)b * SEQ) * 8 + h), nullptr, p0, k0, logd, lds, tid);
        __syncthreads();
    }
}
__device__ __forceinline__ void merge_b(const bf16* OG, const float* LSE, bf16* ATT, int gw, int NGW, int lane) {
    asm volatile("" : "+v"(lane));
    const int h = lane >> 3, c = (lane & 7) * 16;
    for (int tok = gw; tok < MTOK; tok += NGW) {
        const float l0 = LSE[(size_t)tok * 8 + h], l1 = LSE[((size_t)MTOK + tok) * 8 + h], l2 = LSE[((size_t)2 * MTOK + tok) * 8 + h];
        const float mx = fmaxf(l0, fmaxf(l1, l2)); float w0 = __expf(l0 - mx), w1 = __expf(l1 - mx), w2 = __expf(l2 - mx); const float rs = 1.f / (w0 + w1 + w2); w0 *= rs; w1 *= rs; w2 *= rs;
        const GAS v4u* a = (const GAS v4u*)(OG + (size_t)tok * 1024 + h * 128 + c); const GAS v4u* bq = (const GAS v4u*)(OG + ((size_t)MTOK + tok) * 1024 + h * 128 + c); const GAS v4u* cq = (const GAS v4u*)(OG + ((size_t)2 * MTOK + tok) * 1024 + h * 128 + c);
        GAS v4u* o = (GAS v4u*)(ATT + (size_t)tok * 1024 + h * 128 + c);
#pragma unroll
        for (int i = 0; i < 2; ++i) { const v4u x = a[i], y = bq[i], z = cq[i]; v4u r;
            r.x = pk2(w0 * bflo(x.x) + w1 * bflo(y.x) + w2 * bflo(z.x), w0 * bfhi(x.x) + w1 * bfhi(y.x) + w2 * bfhi(z.x));
            r.y = pk2(w0 * bflo(x.y) + w1 * bflo(y.y) + w2 * bflo(z.y), w0 * bfhi(x.y) + w1 * bfhi(y.y) + w2 * bfhi(z.y));
            r.z = pk2(w0 * bflo(x.z) + w1 * bflo(y.z) + w2 * bflo(z.z), w0 * bfhi(x.z) + w1 * bfhi(y.z) + w2 * bfhi(z.z));
            r.w = pk2(w0 * bflo(x.w) + w1 * bflo(y.w) + w2 * bflo(z.w), w0 * bfhi(x.w) + w1 * bfhi(y.w) + w2 * bfhi(z.w));
            o[i] = r; }
    }
}

constexpr int N_IN = 57;
struct Args { const float* in[N_IN]; float* out; unsigned char* ws; int ph_lo, ph_hi; };
__device__ __forceinline__ const float* arg_in(int idx) {
    typedef __attribute__((address_space(4))) const char* kptr;
    kptr kp = (kptr)__builtin_amdgcn_kernarg_segment_ptr();
    return *(const float* __attribute__((address_space(4))) const*)(kp + 8 * idx);
}
constexpr int N_PHASES = 1 + 7 + 8 + 8 + 7 + 1;

#define CVT_NEXT(PM) do { const int pm_ = (PM); \
                if (si + 1 < 3 * DEPTH && EXP != 3 && pm_ != 0) { \
                    const int lncur = (sub == 0) ? base + 2 : (sub == 1) ? base + 4 + nmix : base + 8 + nmix; \
                    const float* gk = arg_in(lncur); const float* bk = arg_in(lncur + 1); bf16* WN = WTB(si + 1); float* un = UVEC(si + 1); float* vn = un + 11264; LAS unsigned char* cl = lds + RING_OFF; int to = 0; \
                    if (sub == 0) { \
                        if (kind == 0) { if (pm_ & 1) to = cvt_weight(arg_in(base + 4), DM, A_QKV, WN, A_QKV, 3, gk, bk, un, vn, cl, to, G, bx, tid); else to = (DM / 64) * (A_QKV / 256); \
                                         if (pm_ & 2) to = cvt_weight(arg_in(base + 7), DM, DM, WN + WT_A_OUT, DM, 0, nullptr, nullptr, nullptr, nullptr, cl, to, G, bx, tid); } \
                        else if (kind == 1) { if (pm_ & 1) to = cvt_weight(arg_in(base + 4), DM, B_QKV, WN, B_QKV, 2, gk, bk, un, vn, cl, to, G, bx, tid); else to = (DM / 64) * (B_QKV / 256); \
                                              if (pm_ & 2) to = cvt_weight(arg_in(base + 5), 1024, DM, WN + WT_B_OUT, DM, 0, nullptr, nullptr, nullptr, nullptr, cl, to, G, bx, tid); } \
                        else { if (pm_ & 1) to = cvt_weight(arg_in(base + 4), DM, C_IN, WN, C_INP, 0, gk, bk, un, vn, cl, to, G, bx, tid); else to = (DM / 64) * (C_INP / 256); \
                               if (pm_ & 2) { to = cvt_weight(arg_in(base + 7), C_QL, C_Q, WN + WT_C_QUP, C_Q, 0, arg_in(base + 5), nullptr, nullptr, nullptr, cl, to, G, bx, tid); \
                               to = cvt_weight(arg_in(base + 8), C_KVL, C_KV, WN + WT_C_KVUP, C_KV, 0, arg_in(base + 6), nullptr, nullptr, nullptr, cl, to, G, bx, tid); \
                               to = cvt_weight(arg_in(base + 9), DM, DM, WN + WT_C_OUT, DM, 0, nullptr, nullptr, nullptr, nullptr, cl, to, G, bx, tid); } } \
                    } else { \
                        const int wi = (sub == 1) ? base + 6 + nmix : ((L + 1 == 1) ? 15 : (L + 1 == 2) ? 27 : 43); \
                        if (pm_ & 1) to = cvt_weight(arg_in(wi), DM, 2 * DFF, WN, 2 * DFF, 1, gk, bk, un, vn, cl, to, G, bx, tid); else to = (DM / 64) * (2 * DFF / 256); \
                        if (pm_ & 2) to = cvt_weight(arg_in(wi + 1), DFF, DM, WN + WT_FFN_OUT, DM, 0, nullptr, nullptr, nullptr, nullptr, cl, to, G, bx, tid); \
                    } \
                    (void)to; \
                } \
 } while (0)
__global__ void __launch_bounds__(NWAVES * 64, 2) mega_fwd(Args args) {
    extern __shared__ __attribute__((aligned(16))) unsigned char lds_raw[];
    LAS unsigned char* lds = (LAS unsigned char*)lds_raw;
    volatile LAS unsigned* MISC = (volatile LAS unsigned*)(lds + MISC_OFF);
    const int wave = __builtin_amdgcn_readfirstlane((int)threadIdx.x >> 6);
    unsigned char* const ws0 = args.ws; float* const out0 = args.out; const int G0 = gridDim.x, bx0 = blockIdx.x;
    for (int u = threadIdx.x; u < (LDS_BYTES - LDSCTL_OFF) / 4; u += NWAVES * 64) ((LAS unsigned*)(lds + LDSCTL_OFF))[u] = 0u;
    __syncthreads();
    XcdBarrier bar; bar.bar = (unsigned*)((gu32*)(ws0 + WS_CTL) + CW_BAR); bar.x = 0; bar.st = nullptr;
    if (!MK_PER_PHASE) bar = xcd_barrier_post((unsigned*)((gu32*)(ws0 + WS_CTL) + CW_BAR), MISC + 8);
    const int lo = args.ph_lo, hi = args.ph_hi;
    int ph = 0;
#define IN_PH() (lo <= ph && ph < hi)
#define SEAM_BAR() do { unsigned ones_ = ~0u; asm volatile("" : "+s"(ones_)); xcd_barrier(bar, wave * 64 + (int)__builtin_amdgcn_mbcnt_hi(ones_, __builtin_amdgcn_mbcnt_lo(ones_, 0u))); } while (0)
#if PROBE_CAT >= 0
    volatile LAS unsigned long long* PR = (volatile LAS unsigned long long*)(lds + MISC_OFF + 64);
    if (threadIdx.x == 0) { const unsigned long long t_ = __builtin_amdgcn_s_memrealtime(); PR[0] = t_; PR[1] = 0ull; PR[2] = t_; MISC[22] = 2u; }
#define SEAM() do { if (wave == 0) { const unsigned long long te_ = __builtin_amdgcn_s_memrealtime(); if (MISC[22] == (unsigned)PROBE_CAT) PR[1] = PR[1] + (te_ - PR[0]); PR[0] = te_; } \
    if (lo <= ph && ph + 1 < hi) SEAM_BAR(); if (wave == 0) { const unsigned long long ta_ = __builtin_amdgcn_s_memrealtime(); if (PROBE_CAT == 4) PR[1] = PR[1] + (ta_ - PR[0]); PR[0] = ta_; } ++ph; } while (0)
#define PCAT(c) do { if (wave == 0) MISC[22] = (unsigned)(c); } while (0)
#else
#define SEAM() do { if (!MK_PER_PHASE) { if (lo <= ph && ph + 1 < hi) SEAM_BAR(); } ++ph; } while (0)
#define PCAT(c) do { } while (0)
#endif
#define PH_VARS unsigned ones_ = ~0u; asm volatile("" : "+s"(ones_)); const int lane = (int)__builtin_amdgcn_mbcnt_hi(ones_, __builtin_amdgcn_mbcnt_lo(ones_, 0u)); const int tid = wave * 64 + lane; (void)lane; \
    unsigned char* ws = lnd(ws0); float* H32 = lnd(out0); bf16* WT0 = (bf16*)(ws + WS_WT); bf16* HB = (bf16*)(ws + WS_HB); unsigned char* LO = ws + WS_LO; unsigned char* R = ws + WS_R; \
    int G = G0, bx = bx0; asm volatile("" : "+s"(G), "+s"(bx)); const int vcu = (G % 8 == 0) ? (bx % 8) * (G / 8) + bx / 8 : bx; const int gw = vcu * NWAVES + wave, NGW = G * NWAVES; \
    const size_t gt = (size_t)vcu * (NWAVES * 64) + tid, NGT = (size_t)G * NWAVES * 64; LAS float* scr = (LAS float*)(lds + RING_OFF + wave * 16384); \
    (void)H32; (void)WT0; (void)HB; (void)LO; (void)R; (void)gw; (void)NGW; (void)gt; (void)NGT; (void)scr;

    for (int rep = 0; rep < REPS; ++rep) {
    PCAT(2);
    if (IN_PH()) { PH_VARS
        for (size_t i = gt; i < (DEV_ZERO_END - CTL_ZERO_BYTES) / 16; i += NGT) ((GAS v4u*)(ws + CTL_ZERO_BYTES))[i] = (v4u){0u, 0u, 0u, 0u};
        build_tables(ws, gt, NGT);
        cvt_rows_bf16(arg_in(0), HB, LO, (size_t)MTOK * DM / 8, gt, NGT);
        { int to = cvt_weight(arg_in(1), DM, 2 * DFF, WT0, 2 * DFF, 1, nullptr, nullptr, nullptr, nullptr, lds + RING_OFF, 0, G, bx, tid);
          (void)cvt_weight(arg_in(2), DFF, DM, WT0 + WT_FFN_OUT, DM, 0, nullptr, nullptr, nullptr, nullptr, lds + RING_OFF, to, G, bx, tid); }
    }
    SEAM();

    for (int L = 0; L < DEPTH; ++L) {
        const int kind = (L == 3) ? 0 : L;
        const int base = (L == 0) ? 1 : (L == 1) ? 15 : (L == 2) ? 27 : 43;
        const int nmix = (kind == 0) ? 4 : (kind == 1) ? 2 : 6;
        for (int sub = 0; sub < 3; ++sub) {
            const int si = L * 3 + sub;
            const int pbase = (L == 0) ? 1 : (L == 1) ? 1 : (L == 2) ? 15 : 27, pkind = (L == 0) ? 0 : (L - 1), pnmix = (pkind == 0) ? 4 : (pkind == 1) ? 2 : 6;
            const int lnprev = (sub == 0) ? pbase + 8 + pnmix : (sub == 1) ? base + 2 : base + 4 + nmix;
#define WTB(i) ((bf16*)(ws + WS_WT + (size_t)((i) & 1) * WT_BUF))
#define STAT_SUM(i) ((float*)(ws + WS_STAT) + (size_t)(i) * 2 * MTOK)
#define UVEC(i) ((float*)(ws + WS_UV) + (size_t)(i) * UV_STRIDE)
#define PREV_STAT() pg8::RowStat{STAT_SUM(si - 1), STAT_SUM(si - 1) + MTOK, 1.f / DM, LN_EPS, si == 0 ? 0 : 1}
            if (sub != 1) {
                PCAT(10);
                if (IN_PH()) { PH_VARS
                    pg8::Gemm g{lnd(HB), lnd(WTB(si)), MTOK, 2 * DFF, DM, DM, 2}; pg8::StaticOrder S; S.init(MTOK, 2 * DFF, G, bx);
                    pg8::EpiAffSwiGLU E{lnd((bf16*)(R + R_ACT)), DFF, PREV_STAT(), UVEC(si), UVEC(si) + 11264};
                    pg8::gemm_phase<pg8::EpiAffSwiGLU, pg8::StaticOrder, PG8_ALIGN, PG8_SP2>(lds + RING_OFF, g, S, E, tid);
                }
                SEAM();
            } else {
                PCAT(12);
                if (IN_PH()) { PH_VARS
                    if (kind == 0) {
                        pg8::Gemm g{lnd(HB), lnd(WTB(si)), MTOK, A_QKV, DM, DM, 2}; pg8::StaticOrder S; S.init(MTOK, A_QKV, G, bx);
                        pg8::EpiAffA E{lnd((bf16*)(R + RA_QKV)), A_QKV, PREV_STAT(), UVEC(si), UVEC(si) + 11264, arg_in(base + 5), arg_in(base + 6), (const float*)(ws + WS_TABA), (LAS float*)(lds + XCH_OFF)};
                        pg8::gemm_phase<pg8::EpiAffA, pg8::StaticOrder, PG8_ALIGN, PG8_SP2>(lds + RING_OFF, g, S, E, tid);
                    } else {
                    const int N = (kind == 1) ? B_QKV : C_INP;
                    pg8::Gemm g{lnd(HB), lnd(WTB(si)), MTOK, N, DM, DM, 2}; pg8::StaticOrder S; S.init(MTOK, N, G, bx);
                    pg8::EpiAff E{lnd((bf16*)(R + 0)), N, PREV_STAT(), UVEC(si), UVEC(si) + 11264, (kind == 2) ? (float*)(ws + WS_SSQC) : (float*)nullptr, (kind == 1) ? (const float*)(ws + WS_TABB) : (const float*)nullptr};
                    pg8::gemm_phase<pg8::EpiAff, pg8::StaticOrder, PG8_ALIGN, PG8_SP2>(lds + RING_OFF, g, S, E, tid);
                    }
                }
                SEAM();
                if (kind == 0) {
                    PCAT(14);
                    if (IN_PH()) { PH_VARS attn_phase_a((const bf16*)(R + RA_QKV), (bf16*)(R + RA_ATT), (LAS char*)(lds + RING_OFF), G, bx, tid); }
                    SEAM();
                } else if (kind == 1) {
                    PCAT(15);
                    if (IN_PH()) { PH_VARS attn_phase_b((const bf16*)(R + RB_QKV), (bf16*)(R + RB_OG), (float*)(R + RB_LSE), (LAS char*)(lds + RING_OFF), G, bx, tid); }
                    SEAM();
                    PCAT(17);
                    if (IN_PH()) { PH_VARS merge_b((const bf16*)(R + RB_OG), (const float*)(R + RB_LSE), (bf16*)(R + RB_ATT), gw, NGW, lane); }
                    SEAM();
                } else {
                    PCAT(12);
                    if (IN_PH()) { PH_VARS
                        krope_c((const bf16*)(R + RC_IN), (bf16*)(R + RC_KR), ws, gw, NGW, lane);
                        { pg8::Gemm g{lnd((const bf16*)(R + RC_IN)), lnd(WTB(si) + WT_C_QUP), MTOK, C_Q, C_QL, C_INP}; pg8::StaticOrder S; S.init(MTOK, C_Q, G, bx);
                          pg8::EpiAff E{lnd((bf16*)(R + RC_Q)), C_Q, pg8::RowStat{nullptr, (const float*)(ws + WS_SSQC), 1.f / C_QL, RMS_EPS, 2}, nullptr, nullptr, nullptr, nullptr};
                          pg8::gemm_phase<pg8::EpiAff, pg8::StaticOrder, PG8_ALIGN, PG8_SP2>(lds + RING_OFF, g, S, E, tid); }
                        { pg8::Gemm g{lnd((const bf16*)(R + RC_IN) + C_QL), lnd(WTB(si) + WT_C_KVUP), MTOK, C_KV, C_KVL, C_INP}; pg8::StaticOrder S; S.init(MTOK, C_KV, G, bx);
                          pg8::EpiAff E{lnd((bf16*)(R + RC_KV)), C_KV, pg8::RowStat{nullptr, (const float*)(ws + WS_SSQC) + MTOK, 1.f / C_KVL, RMS_EPS, 2}, nullptr, nullptr, nullptr, nullptr};
                          pg8::gemm_phase<pg8::EpiAff, pg8::StaticOrder, PG8_ALIGN, PG8_SP2>(lds + RING_OFF, g, S, E, tid); }
                    }
                    SEAM();
                    PCAT(16);
                    if (IN_PH()) { PH_VARS attn_phase_c((const bf16*)(R + RC_Q), (const bf16*)(R + RC_KV), (const bf16*)(R + RC_KR), (bf16*)(R + RC_ATT), (const float*)(ws + WS_TABC), (LAS char*)(lds + RING_OFF), G, bx, tid); }
                    SEAM();
                }
            }
            PCAT(sub == 1 ? 13 : 11);
            if (IN_PH()) { PH_VARS
                const int cls_ = (bx & 7) >> 1; const int pm_before = (cls_ == 0) ? 3 : (cls_ == 1) ? 1 : (cls_ == 2) ? 2 : 0;
                if (pm_before) { CVT_NEXT(pm_before); __syncthreads(); }
                const bf16* A; const bf16* Bt; int K; float s;
                if (sub != 1) { A = (const bf16*)(R + R_ACT); Bt = WTB(si) + WT_FFN_OUT; K = DFF; s = 0.5f; }
                else if (kind == 0) { A = (const bf16*)(R + RA_ATT); Bt = WTB(si) + WT_A_OUT; K = DM; s = 1.0f; }
                else if (kind == 1) { A = (const bf16*)(R + RB_ATT); Bt = WTB(si) + WT_B_OUT; K = 1024; s = 1.0f; }
                else { A = (const bf16*)(R + RC_ATT); Bt = WTB(si) + WT_C_OUT; K = DM; s = 1.0f; }
                pg8::Gemm g{lnd(A), lnd(Bt), MTOK, DM, K, K, (sub != 1) ? 1 : 0}; pg8::StaticOrder S; S.init(MTOK, DM, G, bx);
                pg8::EpiResid2 E{lnd(HB), lnd(LO), STAT_SUM(si), STAT_SUM(si) + MTOK, arg_in(lnprev), arg_in(lnprev + 1), PREV_STAT(), DM, ALPHA, s};
                pg8::gemm_phase<pg8::EpiResid2, pg8::StaticOrder, PG8_ALIGN, PG8_SP2>(lds + RING_OFF, g, S, E, tid);
                if (pm_before != 3) { __syncthreads(); CVT_NEXT(3 ^ pm_before); }
            }
            SEAM();
        }
    }
    PCAT(2);
    if (IN_PH()) { PH_VARS ln_final(H32, HB, LO, STAT_SUM(11), STAT_SUM(11) + MTOK, arg_in(55), arg_in(56), gt, NGT); }
    SEAM();
    }
#if PROBE_CAT >= 0
    SEAM_BAR();
    { unsigned on3_ = ~0u; asm volatile("" : "+s"(on3_)); const int ln_ = (int)__builtin_amdgcn_mbcnt_hi(on3_, __builtin_amdgcn_mbcnt_lo(on3_, 0u));
      for (size_t i = (size_t)bx0 * 512 + wave * 64 + ln_; i < (size_t)MTOK * DM / 4; i += (size_t)G0 * 512) ((GAS f32x4*)out0)[i] = (f32x4){16.f, 16.f, 16.f, 16.f}; }
    SEAM_BAR();
    { unsigned on2_ = ~0u; asm volatile("" : "+s"(on2_)); if (bx0 == 0 && wave == 0 && __builtin_amdgcn_mbcnt_hi(on2_, __builtin_amdgcn_mbcnt_lo(on2_, 0u)) == 0u) { const unsigned long long tot = __builtin_amdgcn_s_memrealtime() - PR[2]; out0[0] = (PROBE_CAT == 5) ? ((float)tot * 1e-5f - 15.0f) * 100.0f : (float)PR[1] * ((PROBE_CAT >= 6 && PROBE_CAT != 10) ? 1e-3f : 1e-4f); } }
#endif
#undef IN_PH
#undef SEAM
}

extern "C" void kernel_launch(void* const* d_in, const int* in_sizes, int n_in, void* d_out, int out_size, void* d_ws, size_t ws_size, hipStream_t stream) {
    static int grid = 0;
    if (grid == 0) {
        if (n_in != N_IN || in_sizes[0] != MTOK * DM || out_size != MTOK * DM || ws_size < WS_END) {
            fprintf(stderr, "kernel_launch: shape mismatch: n_in %d in0 %d out %d ws %zu (need >= %zu)\n", n_in, n_in > 0 ? in_sizes[0] : -1, out_size, ws_size, (size_t)WS_END); grid = -1; return; }
        int dev = 0, cus = 0, per_cu = 0;
        if (hipGetDevice(&dev) != hipSuccess || hipDeviceGetAttribute(&cus, hipDeviceAttributeMultiprocessorCount, dev) != hipSuccess) { fprintf(stderr, "kernel_launch: device query failed\n"); grid = -1; return; }
        if (hipFuncSetAttribute((const void*)mega_fwd, hipFuncAttributeMaxDynamicSharedMemorySize, LDS_BYTES) != hipSuccess) { fprintf(stderr, "kernel_launch: hipFuncSetAttribute failed\n"); grid = -1; return; }
        if (hipOccupancyMaxActiveBlocksPerMultiprocessor(&per_cu, (const void*)mega_fwd, NWAVES * 64, LDS_BYTES) != hipSuccess || per_cu < 1)
            fprintf(stderr, "kernel_launch: note: occupancy query reports %d workgroups per CU\n", per_cu);
        (void)hipGetLastError();
        grid = cus;
    }
    if (grid < 0) return;
    if (hipMemsetAsync((char*)d_ws + WS_CTL, 0, CTL_ZERO_BYTES, stream) != hipSuccess) { fprintf(stderr, "kernel_launch: memset failed\n"); return; }
    Args a{};
    for (int i = 0; i < N_IN; ++i) a.in[i] = (const float*)d_in[i];
    a.out = (float*)d_out; a.ws = (unsigned char*)d_ws;
#if MK_PER_PHASE
    for (int p = 0; p < N_PHASES; ++p) { a.ph_lo = p; a.ph_hi = p + 1; hipLaunchKernelGGL(mega_fwd, dim3(grid), dim3(NWAVES * 64), LDS_BYTES, stream, a); }
#else
    a.ph_lo = 0; a.ph_hi = N_PHASES;
    hipLaunchKernelGGL(mega_fwd, dim3(grid), dim3(NWAVES * 64), LDS_BYTES, stream, a);
#if LAUNCH_TWICE
    (void)hipMemsetAsync((char*)d_ws + WS_CTL, 0, CTL_ZERO_BYTES, stream);
    hipLaunchKernelGGL(mega_fwd, dim3(grid), dim3(NWAVES * 64), LDS_BYTES, stream, a);
#endif
#endif
    const hipError_t le = hipPeekAtLastError();
    if (le != hipSuccess) fprintf(stderr, "kernel_launch: launch failed: %s\n", hipGetErrorName(le));
}
```
